# Optimizing an MI355X kernel written in HIP

```python
import jax, jax.numpy as jnp
from jax import lax
import numpy as np

D_MODEL = 1024
BATCH = 4
SEQ = 8192
DEPTH = 1

RET_HEADS = 4
RET_DK = 64
RET_DV = 128
RET_CHUNK = 128
DSA_HEADS = 8
DSA_KV_HEADS = 2
DSA_HD = 64
IDX_HEADS = 8
IDX_HD = 64
TOPK_MAX = 256
Q_BLOCK = 128
N_EXPERTS = 32
TOP_K = 4
D_EXPERT = D_MODEL
SWIGLU_LIMIT = 7.0
SWIGLU_ALPHA = 1.702
MOE_BLOCK = 128
EPS = 1e-6

RET_W = RET_HEADS * RET_DV
DSA_W = DSA_HEADS * DSA_HD
MIX_W = RET_W + DSA_W
IN_SPLITS = (RET_HEADS * RET_DK,
             RET_HEADS * RET_DK,
             RET_W,
             RET_W,
             DSA_HEADS * DSA_HD,
             DSA_KV_HEADS * DSA_HD,
             DSA_KV_HEADS * DSA_HD,
             IDX_HEADS * IDX_HD,
             IDX_HD,
             IDX_HEADS)
IN_COLS = sum(IN_SPLITS)

kernel_name = 'hybrid_retention_dsa_moe_layer'


def rms_norm(x, g):
    xf = x.astype(jnp.float32)
    y = xf * lax.rsqrt(jnp.mean(xf * xf, axis=-1, keepdims=True) + EPS)
    return (y * g.astype(jnp.float32)).astype(x.dtype)


def retention(q, k, v):
    B, S, H, dk = q.shape
    dv = v.shape[-1]
    dt = q.dtype
    C = min(RET_CHUNK, S)
    N = S // C
    log_g = jnp.log1p(-jnp.exp2(-5.0 - jnp.arange(H, dtype=jnp.float32)))
    pos = jnp.arange(C, dtype=jnp.float32)
    diff = pos[:, None] - pos[None, :]
    d_inner = jnp.where(diff[None] >= 0,
                        jnp.exp(jnp.maximum(diff, 0.0)[None] * log_g[:, None, None]), 0.0)
    q_decay = jnp.exp((pos + 1.0)[None] * log_g[:, None])
    k_decay = jnp.exp((C - 1.0 - pos)[None] * log_g[:, None])
    chunk_decay = jnp.exp(C * log_g).astype(dt)
    qc = q.reshape(B, N, C, H, dk)
    kc = (k * (dk ** -0.5)).reshape(B, N, C, H, dk)
    vc = v.reshape(B, N, C, H, dv)
    s = jnp.einsum('bnihd,bnjhd->bnhij', qc, kc) * d_inner.astype(dt)
    o_in = jnp.einsum('bnhij,bnjhe->bnihe', s, vc)
    kv = jnp.einsum('bnjhd,bnjhe,hj->nbhde', kc, vc, k_decay.astype(dt))

    def step(R, kv_n):
        return R * chunk_decay[None, :, None, None] + kv_n, R

    _, r_prev = lax.scan(step, jnp.zeros((B, H, dk, dv), dt), kv)
    o_cross = jnp.einsum('bnihd,nbhde,hi->bnihe', qc, r_prev, q_decay.astype(dt))
    return (o_in + o_cross).reshape(B, S, H, dv)


def sparse_attention(q, k, v, q_idx, k_idx, w_idx):
    B, S, H, d = q.shape
    G = k.shape[2]
    R = H // G
    n_sel = min(TOPK_MAX, S // 4)
    QB = min(Q_BLOCK, S)
    NB = S // QB
    slopes = jnp.exp2(-8.0 * (jnp.arange(H, dtype=jnp.float32) + 1.0) / H).reshape(G, R)
    key_pos = jnp.arange(S)

    def to_blocks(a):
        return a.reshape((B, NB, QB) + a.shape[2:]).swapaxes(0, 1)

    def block(args):
        qb, qib, wb, blk = args
        t = blk * QB + jnp.arange(QB)
        rel = jnp.einsum('bqhe,bse->bqhs', qib, k_idx)
        score = jnp.einsum('bqhs,bqh->bqs', jax.nn.relu(rel), wb).astype(jnp.float32)
        causal = key_pos[None, :] <= t[:, None]
        score = jnp.where(causal[None], score, -jnp.inf)
        _, sel = lax.top_k(score, n_sel)
        k_sel = jax.vmap(lambda kk, ii: kk[ii])(k, sel)
        v_sel = jax.vmap(lambda vv, ii: vv[ii])(v, sel)
        qg = qb.reshape(B, QB, G, R, d)
        logits = jnp.einsum('bqgrd,bqkgd->bqgrk', qg, k_sel).astype(jnp.float32) * (d ** -0.5)
        dist = (t[None, :, None] - sel).astype(jnp.float32)
        logits = logits - slopes[None, None, :, :, None] * dist[:, :, None, None, :]
        logits = jnp.where((dist >= 0)[:, :, None, None, :], logits, -jnp.inf)
        p = jax.nn.softmax(logits, axis=-1).astype(v.dtype)
        o = jnp.einsum('bqgrk,bqkgd->bqgrd', p, v_sel)
        return o.reshape(B, QB, H * d)

    out = lax.map(block, (to_blocks(q), to_blocks(q_idx), to_blocks(w_idx), jnp.arange(NB)))
    return out.swapaxes(0, 1).reshape(B, S, H * d)


def moe(h, router_w, router_b, w_gu, b_gu, w_down, b_down):
    N, D = h.shape
    logits = (h @ router_w + router_b).astype(jnp.float32)
    top_vals, top_idx = lax.top_k(logits, TOP_K)
    gates = jax.nn.softmax(top_vals, axis=-1).astype(h.dtype)
    NK = N * TOP_K
    flat_e = top_idx.reshape(-1)
    flat_tok = jnp.repeat(jnp.arange(N), TOP_K)
    flat_g = gates.reshape(-1)
    order = jnp.argsort(flat_e)
    sorted_e = flat_e[order]
    counts = jnp.bincount(flat_e, length=N_EXPERTS)
    starts = jnp.cumsum(counts) - counts
    padded_counts = (counts + MOE_BLOCK - 1) // MOE_BLOCK * MOE_BLOCK
    padded_ends = jnp.cumsum(padded_counts)
    padded_starts = padded_ends - padded_counts
    dest = padded_starts[sorted_e] + (jnp.arange(NK) - starts[sorted_e])
    P = (NK + N_EXPERTS * (MOE_BLOCK - 1) + MOE_BLOCK - 1) // MOE_BLOCK * MOE_BLOCK
    n_blocks = P // MOE_BLOCK
    rows_tok = jnp.zeros((P,), jnp.int32).at[dest].set(flat_tok[order].astype(jnp.int32))
    rows_g = jnp.zeros((P,), h.dtype).at[dest].set(flat_g[order])
    block_e = jnp.clip(jnp.searchsorted(padded_ends, jnp.arange(n_blocks) * MOE_BLOCK, side='right'),
                       0, N_EXPERTS - 1)
    xs = h[rows_tok].reshape(n_blocks, MOE_BLOCK, D)

    def expert_block(args):
        xb, e = args
        gu = xb @ w_gu[e] + b_gu[e]
        gate, up = jnp.split(gu, 2, axis=-1)
        gate = jnp.minimum(gate, SWIGLU_LIMIT)
        up = jnp.clip(up, -SWIGLU_LIMIT, SWIGLU_LIMIT)
        glu = gate * jax.nn.sigmoid(SWIGLU_ALPHA * gate)
        return ((up + 1.0) * glu) @ w_down[e] + b_down[e]

    ys = lax.map(expert_block, (xs, block_e)).reshape(P, D) * rows_g[:, None]
    return jax.ops.segment_sum(ys, rows_tok, num_segments=N)


def hybrid_layer(x, c, ada_w, ada_b, norm1_g, w_in, mix_scale, w_o, norm2_g,
                 router_w, router_b, w_gu, b_gu, w_down, b_down):
    B, S, D = x.shape
    mod = jax.nn.silu(c) @ ada_w + ada_b
    sh1, sc1, g1, sh2, sc2, g2 = jnp.split(mod, 6, axis=-1)
    h = rms_norm(x, norm1_g) * (1.0 + sc1[:, None, :]) + sh1[:, None, :]
    proj = h @ w_in
    rq, rk, rv, rg, aq, ak, av, iq, ik, iw = jnp.split(proj, np.cumsum(IN_SPLITS)[:-1].tolist(), axis=-1)
    ret = retention(rq.reshape(B, S, RET_HEADS, RET_DK),
                    rk.reshape(B, S, RET_HEADS, RET_DK),
                    rv.reshape(B, S, RET_HEADS, RET_DV))
    ret32 = ret.astype(jnp.float32)
    ret = (ret32 * lax.rsqrt(jnp.mean(ret32 * ret32, axis=-1, keepdims=True) + EPS)).astype(x.dtype)
    ret = jax.nn.silu(rg) * ret.reshape(B, S, RET_W)
    att = sparse_attention(aq.reshape(B, S, DSA_HEADS, DSA_HD),
                           ak.reshape(B, S, DSA_KV_HEADS, DSA_HD),
                           av.reshape(B, S, DSA_KV_HEADS, DSA_HD),
                           iq.reshape(B, S, IDX_HEADS, IDX_HD),
                           ik,
                           iw * ((IDX_HD ** -0.5) * (IDX_HEADS ** -0.5)))
    mix = jnp.concatenate([ret, att], axis=-1) * mix_scale
    x = x + g1[:, None, :] * (mix @ w_o)
    h2 = rms_norm(x, norm2_g) * (1.0 + sc2[:, None, :]) + sh2[:, None, :]
    y = moe(h2.reshape(B * S, D), router_w, router_b, w_gu, b_gu, w_down, b_down).reshape(B, S, D)
    return x + g2[:, None, :] * y


def setup_inputs(seed: int = 0) -> dict:
    key = jax.random.key(seed)
    ks = jax.random.split(key, 16)
    f32 = jnp.float32

    def nrm(k, shape, scale):
        return jax.random.normal(k, shape, f32) * scale

    return {
        'x': nrm(ks[0], (BATCH, SEQ, D_MODEL), 1.0),
        'c': nrm(ks[1], (BATCH, D_MODEL), 1.0),
        'ada_w': nrm(ks[2], (DEPTH, D_MODEL, 6 * D_MODEL), 0.5 * D_MODEL ** -0.5),
        'ada_b': nrm(ks[3], (DEPTH, 6 * D_MODEL), 0.02),
        'norm1_g': 1.0 + nrm(ks[4], (DEPTH, D_MODEL), 0.02),
        'w_in': nrm(ks[5], (DEPTH, D_MODEL, IN_COLS), D_MODEL ** -0.5),
        'mix_scale': 1.0 + nrm(ks[6], (DEPTH, MIX_W), 0.02),
        'w_o': nrm(ks[7], (DEPTH, MIX_W, D_MODEL), MIX_W ** -0.5),
        'norm2_g': 1.0 + nrm(ks[8], (DEPTH, D_MODEL), 0.02),
        'router_w': nrm(ks[9], (DEPTH, D_MODEL, N_EXPERTS), D_MODEL ** -0.5),
        'router_b': nrm(ks[10], (DEPTH, N_EXPERTS), 0.01),
        'w_gu': nrm(ks[11], (DEPTH, N_EXPERTS, D_MODEL, 2 * D_EXPERT), D_MODEL ** -0.5),
        'b_gu': nrm(ks[12], (DEPTH, N_EXPERTS, 2 * D_EXPERT), 0.01),
        'w_down': nrm(ks[13], (DEPTH, N_EXPERTS, D_EXPERT, D_MODEL), D_EXPERT ** -0.5),
        'b_down': nrm(ks[14], (DEPTH, N_EXPERTS, D_MODEL), 0.01),
        'final_g': 1.0 + nrm(ks[15], (D_MODEL,), 0.02),
    }


def reference(x, c, ada_w, ada_b, norm1_g, w_in, mix_scale, w_o, norm2_g,
              router_w, router_b, w_gu, b_gu, w_down, b_down, final_g):
    for l in range(DEPTH):
        x = hybrid_layer(x, c, ada_w[l], ada_b[l], norm1_g[l], w_in[l], mix_scale[l], w_o[l],
                         norm2_g[l], router_w[l], router_b[l], w_gu[l], b_gu[l],
                         w_down[l], b_down[l])
    return rms_norm(x, final_g)
```

```cpp
#include <hip/hip_runtime.h>
#include <cstdio>
#include <cstdint>

#define LAS __attribute__((address_space(3)))
#define GAS __attribute__((address_space(1)))
typedef unsigned short bf16;
typedef short bf16x8 __attribute__((ext_vector_type(8)));
typedef short s16x4 __attribute__((ext_vector_type(4)));
typedef float f32x4 __attribute__((ext_vector_type(4)));
typedef float f32x16 __attribute__((ext_vector_type(16)));
typedef unsigned u32x4 __attribute__((ext_vector_type(4)));
typedef unsigned u32x2 __attribute__((ext_vector_type(2)));
typedef float f32x2_t __attribute__((ext_vector_type(2)));
typedef __bf16 bf16x2_t __attribute__((ext_vector_type(2)));

constexpr int DM = 1024, NBATCH = 4, SEQ = 8192, NTOK = NBATCH * SEQ;
constexpr int PJ = 3072;
constexpr int IN_COLS = 2888;
constexpr int C_RQ = 0, C_RK = 256, C_RV = 512, C_RG = 1024, C_AQ = 1536, C_AK = 2048, C_AV = 2176, C_IQ = 2304, C_IK = 2816, C_IW = 2880;
constexpr int NE = 32, TOPK = 4, MOE_ROWS = NTOK * TOPK + NE * 256;
constexpr int MOE_TILES = MOE_ROWS / 256;
constexpr float EPS = 1e-6f;
constexpr int NWAVES = 8, NTHR = 512;

constexpr size_t MiB = 1u << 20;
constexpr size_t WS_CTL = 0, CTL_ZERO_BYTES = 1 * MiB;
constexpr size_t WS_MOD = 1 * MiB;
constexpr size_t WS_TOPI = 2 * MiB;
constexpr size_t WS_TOPG = 2 * MiB + 512 * 1024;
constexpr size_t WS_BBASE = 3 * MiB;
constexpr size_t WS_ROWINFO = 4 * MiB;
constexpr size_t WS_ROWGATE = 5 * MiB;
constexpr size_t WS_WIN = 8 * MiB;
constexpr size_t WS_WO = 14 * MiB;
constexpr size_t WS_WGU = 16 * MiB;
constexpr size_t WS_WDN = 144 * MiB;
constexpr size_t WS_H0 = 208 * MiB;
constexpr size_t WS_PROJ = 272 * MiB;
constexpr size_t WS_XS = 208 * MiB;
constexpr size_t WS_Y = 208 * MiB;
constexpr size_t WS_KVT = 480 * MiB;
constexpr size_t WS_RPT = 512 * MiB;
constexpr size_t WS_SEL = 528 * MiB;
constexpr size_t WS_MIX = 544 * MiB;
constexpr size_t WS_H2 = 608 * MiB;
constexpr size_t WS_HB = 480 * MiB;
constexpr size_t WS_END = 752 * MiB;
constexpr int CW_GCNT = 1024;
constexpr int CW_BAR = 4096;

constexpr int LDS_BYTES = 147456;
constexpr int RING_BYTES = 131072;
constexpr int TILEE_OFF = 131072;
constexpr int MISC_OFF = 146432;

__device__ __forceinline__ unsigned cvtpk(float lo, float hi) { f32x2_t v = {lo, hi}; bf16x2_t b = __builtin_convertvector(v, bf16x2_t); return __builtin_bit_cast(unsigned, b); }
__device__ __forceinline__ float bflo(unsigned w) { return __builtin_bit_cast(float, w << 16); }
__device__ __forceinline__ float bfhi(unsigned w) { return __builtin_bit_cast(float, w & 0xffff0000u); }
__device__ __forceinline__ float bf2f(bf16 h) { return __builtin_bit_cast(float, (unsigned)h << 16); }
__device__ __forceinline__ bf16 f2bf(float f) { return (bf16)(cvtpk(f, 0.f) & 0xffffu); }
__device__ __forceinline__ float wave_sum(float v) {
#pragma unroll
    for (int o = 1; o < 64; o <<= 1) v += __shfl_xor(v, o);
    return v;
}
__device__ __forceinline__ int mbcnt64(unsigned long long m) { return (int)__builtin_amdgcn_mbcnt_hi((unsigned)(m >> 32), __builtin_amdgcn_mbcnt_lo((unsigned)m, 0u)); }
__device__ __forceinline__ s16x4 trread(const LAS void* p) { typedef short v4i16_t __attribute__((ext_vector_type(4))); return __builtin_bit_cast(s16x4, __builtin_amdgcn_ds_read_tr16_b64_v4i16((LAS v4i16_t*)p)); }
__device__ __forceinline__ bf16x8 cat8(s16x4 lo, s16x4 hi) { return (bf16x8){lo[0], lo[1], lo[2], lo[3], hi[0], hi[1], hi[2], hi[3]}; }
#define MFMA16(a, b, c) __builtin_amdgcn_mfma_f32_16x16x32_bf16((a), (b), (c), 0, 0, 0)
#define MFMA32(a, b, c) __builtin_amdgcn_mfma_f32_32x32x16_bf16((a), (b), (c), 0, 0, 0)

namespace pg8 {
#define PG8_LAS __attribute__((address_space(3)))
typedef unsigned short bf16_t;
typedef short bf16x8 __attribute__((ext_vector_type(8)));
typedef float f32x4 __attribute__((ext_vector_type(4)));
typedef unsigned u32x4 __attribute__((ext_vector_type(4)));
constexpr int BM = 256, BK = 64, HALF = 128, HTB = HALF * BK * 2  , STAGE_BYTES = 8 * HTB, NXCD = 8, WGM = 8;

__host__ __device__ __forceinline__ int lds_byte(int r, int c) { const int st = (r >> 4) * 2 + (c >> 5), rr = r & 15, cc = c & 31, ob = rr * 64 + cc * 2; return st * 1024 + (ob ^ (((ob >> 9) & 1) << 5)); }
__host__ __device__ __forceinline__ void stage_rc(int b, int& R, int& C) { const int st = b / 1024, sb = b % 1024, swz = sb ^ (((sb >> 9) & 1) << 5); R = (st >> 1) * 16 + swz / 64; C = (st & 1) * 32 + (swz % 64) / 2; }
__host__ __device__ __forceinline__ int perm32(int rho) { const int n = rho >> 4, i = rho & 15; return 8 * (i >> 2) + 4 * n + (i & 3); }

struct Unit { int pm, pn, e; size_t bo; };
struct Gemm { const bf16_t* A; const bf16_t* Bt; int M, N, K; };

struct StaticOrder {
    int nM, nN, nwg, G, c;
    __host__ __device__ void init(int M, int N, int G_, int c_) { nM = M / BM; nN = N / BM; nwg = nM * nN; G = G_; c = c_; }
    __host__ __device__ bool next(int i, Unit& u) const {
        const long L = (long)i * G + c; if (L >= nwg) return false;
        int wgid = (int)L; { const int q = nwg / NXCD, r = nwg % NXCD, xcd = wgid % NXCD, off = wgid / NXCD; wgid = (xcd < r ? xcd * (q + 1) : r * (q + 1) + (xcd - r) * q) + off; }
        const int nig = WGM * nN, gid = wgid / nig, fm = gid * WGM, gsz = (nM - fm) < WGM ? (nM - fm) : WGM;
        u.pm = fm + ((wgid % nig) % gsz); u.pn = (wgid % nig) / gsz; u.e = 0; u.bo = 0; return true;
    }
    __device__ __forceinline__ void a_ready(const Unit&) const {}
    __device__ __forceinline__ void done(const Unit&) const {}
};

template <class Epi, class Sched, bool ALIGN_EPI = false, bool SP2 = false>
__device__ __forceinline__ void gemm_phase(PG8_LAS unsigned char* lds, const Gemm g, const Sched& S, const Epi& E) {
    const int tid = threadIdx.x, wid = __builtin_amdgcn_readfirstlane(tid >> 6), lane = tid & 63, wr = wid >> 2, wc = wid & 3, fr = lane & 15, fq = lane >> 4;
    const int K = g.K, nt = K / BK;
    unsigned voffA[2], voffB[2];
#pragma unroll
    for (int i = 0; i < 2; ++i) { int R, C; stage_rc(tid * 16 + i * 8192, R, C); const int Rb = Epi::PERM ? ((R & ~31) + perm32(R & 31)) : R;
        voffA[i] = (unsigned)(R * K + C) * 2u; voffB[i] = (unsigned)(Rb * K + C) * 2u; }
    const size_t kstep = (size_t)(BK * 2);
    const size_t hstep = (size_t)HALF * K * 2;
    const size_t tstep = 2 * hstep;
    const unsigned ldsw = (unsigned)wid * 1024u;
    const int aoff = lds_byte(wr * 64 + fr, fq * 8), boff = lds_byte(wc * 32 + fr, fq * 8);
#define PG8_SA(b, h) (((b) * 2 + (h)) * HTB)
#define PG8_SB(b, h) ((4 + (b) * 2 + (h)) * HTB)
#define PG8_STAGE(bufoff, gbase, voff) do { _Pragma("unroll") for (int _i = 0; _i < 2; ++_i) \
        __builtin_amdgcn_global_load_lds((const unsigned*)((const char*)(gbase) + (voff)[_i]), (PG8_LAS unsigned*)(lds + (bufoff) + ldsw + _i * 8192), 16, 0, 0); } while (0)
#define PG8_LDA(dst, b, h) do { _Pragma("unroll") for (int m = 0; m < 4; ++m) _Pragma("unroll") for (int k = 0; k < 2; ++k) dst[m][k] = *(const PG8_LAS bf16x8*)(lds + PG8_SA(b, h) + aoff + m * 2048 + k * 1024); } while (0)
#define PG8_LDB(dst, b, h) do { _Pragma("unroll") for (int n = 0; n < 2; ++n) _Pragma("unroll") for (int k = 0; k < 2; ++k) dst[n][k] = *(const PG8_LAS bf16x8*)(lds + PG8_SB(b, h) + boff + n * 2048 + k * 1024); } while (0)
#define PG8_MMA(ai, bj, At, Bt) do { __builtin_amdgcn_s_setprio(1); _Pragma("unroll") for (int m = 0; m < 4; ++m) _Pragma("unroll") for (int n = 0; n < 2; ++n) _Pragma("unroll") for (int k = 0; k < 2; ++k) \
        acc[ai][bj][m][n] = __builtin_amdgcn_mfma_f32_16x16x32_bf16(Bt[n][k], At[m][k], acc[ai][bj][m][n], 0, 0, 0); __builtin_amdgcn_s_setprio(0); } while (0)
#define PG8_WAIT_V(n) asm volatile("s_waitcnt vmcnt(" #n ")" ::: "memory")
#define PG8_WAIT_L(n) asm volatile("s_waitcnt lgkmcnt(" #n ")" ::: "memory")
#define PG8_BAR __builtin_amdgcn_s_barrier()
#define PG8_SCHED __builtin_amdgcn_sched_barrier(0)
    Unit cur, nxt; int ui = 0;
    if (!S.next(0, cur)) return;
    f32x4 acc[2][2][4][2];
#pragma unroll
    for (int a = 0; a < 2; ++a)
#pragma unroll
        for (int b = 0; b < 2; ++b)
#pragma unroll
            for (int m = 0; m < 4; ++m)
#pragma unroll
                for (int n = 0; n < 2; ++n) acc[a][b][m][n] = (f32x4){0.f, 0.f, 0.f, 0.f};
    bf16x8 At[4][2], B0[2][2], B1[2][2];
    const char* cA = (const char*)g.A + (size_t)cur.pm * tstep; const char* cB = (const char*)g.Bt + (size_t)cur.pn * tstep + cur.bo;
    S.a_ready(cur);
    if constexpr (SP2) {
        PG8_STAGE(PG8_SB(0, 0), cB, voffB); PG8_STAGE(PG8_SB(0, 1), cB + hstep, voffB); PG8_STAGE(PG8_SA(0, 0), cA, voffA); PG8_STAGE(PG8_SA(0, 1), cA + hstep, voffA);
        if (wr == 1) PG8_BAR;
        PG8_WAIT_V(2); PG8_BAR;
        PG8_STAGE(PG8_SB(1, 0), cB + kstep, voffB); PG8_STAGE(PG8_SA(1, 0), cA + kstep, voffA); PG8_STAGE(PG8_SB(1, 1), cB + hstep + kstep, voffB);
        PG8_WAIT_V(6); PG8_BAR;
    } else {
        PG8_STAGE(PG8_SB(0, 0), cB, voffB); PG8_STAGE(PG8_SA(0, 0), cA, voffA); PG8_STAGE(PG8_SB(0, 1), cB + hstep, voffB); PG8_STAGE(PG8_SA(0, 1), cA + hstep, voffA);
        if (wr == 1) PG8_BAR;
        PG8_WAIT_V(4); PG8_BAR;
        PG8_STAGE(PG8_SB(1, 0), cB + kstep, voffB); PG8_STAGE(PG8_SA(1, 0), cA + kstep, voffA); PG8_STAGE(PG8_SB(1, 1), cB + hstep + kstep, voffB);
        PG8_WAIT_V(6); PG8_BAR;
    }
    for (;;) {
        const bool has_next = S.next(ui + 1, nxt);
        const char* nA = has_next ? (const char*)g.A + (size_t)nxt.pm * tstep : cA; const char* nB = has_next ? (const char*)g.Bt + (size_t)nxt.pn * tstep + nxt.bo : cB;
        for (int t = 0; t < nt; t += 2) {
            const bool last = (t == nt - 2);
            const char* a1 = cA + (size_t)(t + 1) * kstep;
            const char* a2 = last ? nA : cA + (size_t)(t + 2) * kstep; const char* b2 = last ? nB : cB + (size_t)(t + 2) * kstep;
            const char* a3 = a2 + kstep; const char* b3 = b2 + kstep;
            if (last && has_next) S.a_ready(nxt);
            if constexpr (SP2) {
            PG8_LDB(B0, 0, 0); PG8_LDB(B1, 0, 1); PG8_SCHED; PG8_LDA(At, 0, 0); PG8_STAGE(PG8_SA(1, 1), a1 + hstep, voffA);
            PG8_WAIT_V(8); PG8_WAIT_L(0); PG8_BAR; PG8_MMA(0, 0, At, B0); PG8_MMA(0, 1, At, B1); PG8_BAR; PG8_SCHED;
            PG8_LDA(At, 0, 1); PG8_STAGE(PG8_SB(0, 0), b2, voffB); PG8_STAGE(PG8_SB(0, 1), b2 + hstep, voffB); PG8_STAGE(PG8_SA(0, 0), a2, voffA);
            PG8_WAIT_V(8); PG8_WAIT_L(0); PG8_BAR; PG8_MMA(1, 0, At, B0); PG8_MMA(1, 1, At, B1); PG8_BAR; PG8_SCHED;
            PG8_LDB(B0, 1, 0); PG8_LDB(B1, 1, 1); PG8_SCHED; PG8_LDA(At, 1, 0); PG8_STAGE(PG8_SA(0, 1), a2 + hstep, voffA);
            PG8_WAIT_V(8); PG8_WAIT_L(0); PG8_BAR; PG8_MMA(0, 0, At, B0); PG8_MMA(0, 1, At, B1); PG8_BAR; PG8_SCHED;
            PG8_LDA(At, 1, 1); PG8_STAGE(PG8_SB(1, 0), b3, voffB); PG8_STAGE(PG8_SB(1, 1), b3 + hstep, voffB); PG8_STAGE(PG8_SA(1, 0), a3, voffA);
            PG8_WAIT_V(8); PG8_WAIT_L(0); PG8_BAR; PG8_MMA(1, 0, At, B0); PG8_MMA(1, 1, At, B1); PG8_BAR; PG8_SCHED;
            } else {
            PG8_LDB(B0, 0, 0); PG8_SCHED; PG8_LDA(At, 0, 0); PG8_STAGE(PG8_SA(1, 1), a1 + hstep, voffA);
            PG8_WAIT_L(8); PG8_BAR; PG8_WAIT_L(0); PG8_MMA(0, 0, At, B0); PG8_BAR; PG8_SCHED;
            PG8_LDB(B1, 0, 1); PG8_STAGE(PG8_SB(0, 0), b2, voffB);
            PG8_BAR; PG8_WAIT_L(0); PG8_MMA(0, 1, At, B1); PG8_BAR;
            PG8_LDA(At, 0, 1); PG8_STAGE(PG8_SA(0, 0), a2, voffA);
            PG8_BAR; PG8_WAIT_L(0); PG8_MMA(1, 0, At, B0); PG8_BAR; PG8_SCHED;
            PG8_STAGE(PG8_SB(0, 1), b2 + hstep, voffB);
            PG8_WAIT_V(6); PG8_BAR; PG8_MMA(1, 1, At, B1); PG8_BAR;
            PG8_LDB(B0, 1, 0); PG8_SCHED; PG8_LDA(At, 1, 0); PG8_STAGE(PG8_SA(0, 1), a2 + hstep, voffA);
            PG8_WAIT_L(8); PG8_BAR; PG8_WAIT_L(0); PG8_MMA(0, 0, At, B0); PG8_BAR; PG8_SCHED;
            PG8_LDB(B1, 1, 1); PG8_STAGE(PG8_SB(1, 0), b3, voffB);
            PG8_BAR; PG8_WAIT_L(0); PG8_MMA(0, 1, At, B1); PG8_BAR;
            PG8_LDA(At, 1, 1); PG8_STAGE(PG8_SA(1, 0), a3, voffA);
            PG8_BAR; PG8_WAIT_L(0); PG8_MMA(1, 0, At, B0); PG8_BAR; PG8_SCHED;
            PG8_STAGE(PG8_SB(1, 1), b3 + hstep, voffB);
            PG8_WAIT_V(6); PG8_BAR; PG8_MMA(1, 1, At, B1); PG8_BAR;
            }
        }
        if constexpr (ALIGN_EPI) { if (wr == 0) PG8_BAR; }
        if constexpr (!Epi::AFTER_DRAIN) { E(acc, cur, wr, wc, fr, fq); S.done(cur); }
        if (!has_next) break;
#pragma unroll
        for (int a = 0; a < 2; ++a)
#pragma unroll
            for (int b = 0; b < 2; ++b)
#pragma unroll
                for (int m = 0; m < 4; ++m)
#pragma unroll
                    for (int n = 0; n < 2; ++n) acc[a][b][m][n] = (f32x4){0.f, 0.f, 0.f, 0.f};
        cur = nxt; cA = nA; cB = nB; ++ui;
        if constexpr (ALIGN_EPI) { if (wr == 1) PG8_BAR; }
    }
    PG8_WAIT_V(0);
    if constexpr (!ALIGN_EPI) { if (wr == 0) PG8_BAR; }
    PG8_BAR;
    if constexpr (Epi::AFTER_DRAIN) { E.fused(acc, cur, wr, wc, fr, fq, lds, wid, lane); S.done(cur); }
#undef PG8_SA
#undef PG8_SB
#undef PG8_STAGE
#undef PG8_LDA
#undef PG8_LDB
#undef PG8_MMA
#undef PG8_WAIT_V
#undef PG8_WAIT_L
#undef PG8_BAR
#undef PG8_SCHED
}
}

struct EpiProj {
    static constexpr bool PERM = true, AFTER_DRAIN = false;
    bf16* O; int ldc;
    __device__ __forceinline__ void operator()(const f32x4 (&acc)[2][2][4][2], const pg8::Unit& u, int wr, int wc, int fr, int fq) const {
        const int row0 = u.pm * 256 + wr * 64 + fr; const int col0 = u.pn * 256 + wc * 32 + 8 * fq;
#pragma unroll
        for (int ai = 0; ai < 2; ++ai)
#pragma unroll
            for (int m = 0; m < 4; ++m) { bf16* rowp = O + (size_t)(row0 + ai * 128 + m * 16) * ldc + col0;
#pragma unroll
                for (int bj = 0; bj < 2; ++bj) { const f32x4 v0 = acc[ai][bj][m][0], v1 = acc[ai][bj][m][1];
                    u32x4 w; w.x = cvtpk(v0[0], v0[1]); w.y = cvtpk(v0[2], v0[3]); w.z = cvtpk(v1[0], v1[1]); w.w = cvtpk(v1[2], v1[3]);
                    *(u32x4*)(rowp + bj * 128) = w; } }
    }
};
struct EpiX1 {
    static constexpr bool PERM = false, AFTER_DRAIN = false;
    const float* x; const float* mod; float* out;
    __device__ __forceinline__ void operator()(const f32x4 (&acc)[2][2][4][2], const pg8::Unit& u, int wr, int wc, int fr, int fq) const {
        const int col0 = u.pn * 256 + wc * 32 + 4 * fq; const int b = (u.pm * 256) / SEQ;
        f32x4 g[2][2];
#pragma unroll
        for (int bj = 0; bj < 2; ++bj)
#pragma unroll
            for (int n = 0; n < 2; ++n) g[bj][n] = *(const f32x4*)(mod + (size_t)b * 6144 + 2 * 1024 + col0 + bj * 128 + n * 16);
#pragma unroll
        for (int ai = 0; ai < 2; ++ai)
#pragma unroll
            for (int m = 0; m < 4; ++m) { const size_t off = (size_t)(u.pm * 256 + ai * 128 + wr * 64 + m * 16 + fr) * DM + col0;
#pragma unroll
                for (int bj = 0; bj < 2; ++bj)
#pragma unroll
                    for (int n = 0; n < 2; ++n) { const f32x4 xv = *(const f32x4*)(x + off + bj * 128 + n * 16); *(f32x4*)(out + off + bj * 128 + n * 16) = xv + g[bj][n] * acc[ai][bj][m][n]; }
                if (m & 1) asm volatile("" ::: "memory"); }
    }
};
__device__ __forceinline__ float glu_f(float gate, float up) {
    gate = fminf(gate, 7.0f); up = fminf(fmaxf(up, -7.0f), 7.0f);
    const float sg = 1.0f / (1.0f + __expf(-1.702f * gate));
    return (up + 1.0f) * (gate * sg);
}
struct EpiGlu {
    static constexpr bool PERM = true, AFTER_DRAIN = false;
    bf16* H; const float* b_gu;
    __device__ __forceinline__ void operator()(const f32x4 (&acc)[2][2][4][2], const pg8::Unit& u, int wr, int wc, int fr, int fq) const {
        const int row0 = u.pm * 256 + wr * 64 + fr; const int c0 = u.pn * 128 + wc * 32 + 8 * fq;
        const float* bg = b_gu + (size_t)u.e * 2048 + c0; const float* bu = bg + 1024;
        const f32x4 bg0 = *(const f32x4*)bg, bg1 = *(const f32x4*)(bg + 4), bu0 = *(const f32x4*)bu, bu1 = *(const f32x4*)(bu + 4);
#pragma unroll
        for (int ai = 0; ai < 2; ++ai)
#pragma unroll
            for (int m = 0; m < 4; ++m) {
                const f32x4 g0 = acc[ai][0][m][0] + bg0, g1 = acc[ai][0][m][1] + bg1, u0 = acc[ai][1][m][0] + bu0, u1 = acc[ai][1][m][1] + bu1;
                u32x4 w; w.x = cvtpk(glu_f(g0[0], u0[0]), glu_f(g0[1], u0[1])); w.y = cvtpk(glu_f(g0[2], u0[2]), glu_f(g0[3], u0[3]));
                w.z = cvtpk(glu_f(g1[0], u1[0]), glu_f(g1[1], u1[1])); w.w = cvtpk(glu_f(g1[2], u1[2]), glu_f(g1[3], u1[3]));
                *(u32x4*)(H + (size_t)(row0 + ai * 128 + m * 16) * DM + c0) = w; }
    }
};
struct EpiDown {
    static constexpr bool PERM = true, AFTER_DRAIN = false;
    bf16* Y; const float* b_down; const int* rowinfo; const float* rowgate;
    __device__ __forceinline__ void operator()(const f32x4 (&acc)[2][2][4][2], const pg8::Unit& u, int wr, int wc, int fr, int fq) const {
        const int row0 = u.pm * 256 + wr * 64 + fr; const int col0 = u.pn * 256 + wc * 32 + 8 * fq;
        const float* bd = b_down + (size_t)u.e * 1024 + col0;
        f32x4 bv[2][2];
#pragma unroll
        for (int bj = 0; bj < 2; ++bj)
#pragma unroll
            for (int n = 0; n < 2; ++n) bv[bj][n] = *(const f32x4*)(bd + bj * 128 + 4 * n);
#pragma unroll
        for (int ai = 0; ai < 2; ++ai)
#pragma unroll
            for (int m = 0; m < 4; ++m) { const int row = row0 + ai * 128 + m * 16; const int dst = rowinfo[row]; const float gt = rowgate[row];
                if (dst >= 0) { bf16* rowp = Y + (size_t)dst * DM + col0;
#pragma unroll
                    for (int bj = 0; bj < 2; ++bj) { const f32x4 v0 = (acc[ai][bj][m][0] + bv[bj][0]) * gt, v1 = (acc[ai][bj][m][1] + bv[bj][1]) * gt;
                        u32x4 w; w.x = cvtpk(v0[0], v0[1]); w.y = cvtpk(v0[2], v0[3]); w.z = cvtpk(v1[0], v1[1]); w.w = cvtpk(v1[2], v1[3]);
                        *(u32x4*)(rowp + bj * 128) = w; } } }
    }
};
struct GroupedOrder {
    const LAS int* tile_e; int ntiles, nN, G, c; size_t estride;
    __device__ __forceinline__ bool next(int i, pg8::Unit& u) const {
        int pm, pn;
        if (G == 256) { const int x = c & 7, j = c >> 3, rpx = 32 / nN; pn = j % nN; pm = i * (8 * rpx) + x * rpx + j / nN; }
        else { const long L = (long)i * G + c; pm = (int)(L / nN); pn = (int)(L % nN); }
        if (pm >= ntiles) return false;
        u.pm = pm; u.pn = pn; u.e = __builtin_amdgcn_readfirstlane(tile_e[pm]); u.bo = (size_t)u.e * estride; return true;
    }
    __device__ __forceinline__ void a_ready(const pg8::Unit&) const {}
    __device__ __forceinline__ void done(const pg8::Unit&) const {}
};

#define XB_TMO      128
#define XB_XCNT(j)  (256  + 64 * (j))
#define XB_XSUB(j)  (1280 + 64 * (j))
#define XB_XGEN(j)  (2304 + 64 * (j))
#define XB_TOP      3328
#define XB_TOPGEN   3392
#define XCD_BAR_WORDS 3456
#define XB_SPIN_CAP (1u << 18)

__device__ __forceinline__ unsigned xb_ld(unsigned* p)              { return __hip_atomic_load(p, __ATOMIC_RELAXED, __HIP_MEMORY_SCOPE_AGENT); }
__device__ __forceinline__ unsigned xb_add(unsigned* p, unsigned v) { return __hip_atomic_fetch_add(p, v, __ATOMIC_RELAXED, __HIP_MEMORY_SCOPE_AGENT); }
__device__ __forceinline__ unsigned xb_xcc_id() { return (unsigned)__builtin_amdgcn_s_getreg((3 << 11) | 20) & 0xFu; }
#define XB_SPIN(cond, bar) do { unsigned _sp = 0; while (cond) { __builtin_amdgcn_s_sleep(1); \
    if ((++_sp & 255u) == 0u) { if (xb_ld(&(bar)[XB_TMO])) break; if (_sp > XB_SPIN_CAP) { atomicAdd(&(bar)[XB_TMO], 1u); break; } } } } while (0)

struct XcdBarrier {
    unsigned* bar; unsigned x;
    volatile LAS unsigned* st;
};

__device__ __forceinline__ XcdBarrier xcd_barrier_post(unsigned* bar, volatile LAS unsigned* st) {
    XcdBarrier b; b.bar = bar; b.x = xb_xcc_id(); b.st = st;
    if (threadIdx.x == 0) (void)xb_add(&bar[XB_XCNT(b.x)], 1u);
    return b;
}
__device__ __forceinline__ void xcd_barrier_complete(unsigned* bar, unsigned x, unsigned& nloc, unsigned& nx) {
    const unsigned G = gridDim.x * gridDim.y * gridDim.z;
    unsigned sum, cnt, mine, sp = 0u;
    for (;;) {
        sum = 0u; cnt = 0u; mine = 0u;
#pragma unroll
        for (unsigned j = 0; j < 16; ++j) { const unsigned c = xb_ld(&bar[XB_XCNT(j)]); sum += c; cnt += (c > 0u) ? 1u : 0u; mine = (j == x) ? c : mine; }
        if (sum == G) break;
        __builtin_amdgcn_s_sleep(1);
        if ((++sp & 255u) == 0u) { if (xb_ld(&bar[XB_TMO])) break; if (sp > XB_SPIN_CAP) { atomicAdd(&bar[XB_TMO], 1u); break; } }
    }
    nloc = mine > 0u ? mine : 1u; nx = cnt > 0u ? cnt : 1u;
}

__device__ __forceinline__ void xcd_barrier(const XcdBarrier& b) {
    asm volatile("s_waitcnt vmcnt(0)" ::: "memory");
    __syncthreads();
    if (threadIdx.x == 0) {
        unsigned* bar = b.bar;
        __builtin_amdgcn_s_waitcnt(0);
        unsigned nloc = b.st[0], nx = b.st[1];
        if (nloc == 0u) { xcd_barrier_complete(bar, b.x, nloc, nx); b.st[0] = nloc; b.st[1] = nx; }
        const unsigned old = xb_add(&bar[XB_XSUB(b.x)], 1u);
        const unsigned gen = old / nloc;
        if (old + 1u == (gen + 1u) * nloc) {
            __builtin_amdgcn_fence(__ATOMIC_RELEASE, "agent");
            asm volatile("s_waitcnt vmcnt(0)" ::: "memory");
            const unsigned og = xb_add(&bar[XB_TOP], 1u);
            const unsigned tg = og / nx;
            if (og + 1u == (tg + 1u) * nx) xb_add(&bar[XB_TOPGEN], 1u);
            else XB_SPIN(xb_ld(&bar[XB_TOPGEN]) == tg, bar);
            __builtin_amdgcn_fence(__ATOMIC_ACQUIRE, "agent");
            xb_add(&bar[XB_XGEN(b.x)], 1u);
            asm volatile("s_waitcnt vmcnt(0)" ::: "memory");
        } else {
            XB_SPIN(xb_ld(&bar[XB_XGEN(b.x)]) == gen, bar);
            __builtin_amdgcn_fence(__ATOMIC_ACQUIRE, "agent");
            asm volatile("s_waitcnt vmcnt(0)" ::: "memory");
        }
    }
    __syncthreads();
}

struct Frame {
    LAS unsigned char* lds;
    volatile LAS unsigned* MISC;
    unsigned* ctl;
    int tid, lane, wave, G, bid;
    const float *x, *c, *ada_w, *ada_b, *norm1_g, *w_in, *mix_scale, *w_o, *norm2_g, *router_w, *router_b, *w_gu, *b_gu, *w_down, *b_down, *final_g;
    float* out; unsigned char* ws;
};
__device__ __forceinline__ float log2gamma(int h) { return log2f(1.0f - exp2f(-5.0f - (float)h)); }

template <class RowMap>
__device__ __forceinline__ void transpose_item(const float* W, int N, bf16* WT, int K, const float* kscale, LAS float* scr, int kb, int nb, int lane, RowMap rm) {
    const int k0 = 64 * kb, n0 = 64 * nb;
#pragma unroll 4
    for (int i = 0; i < 16; ++i) {
        const int kk = 4 * i + (lane >> 4), nn = 4 * (lane & 15);
        f32x4 v = (f32x4){0.f, 0.f, 0.f, 0.f};
        if (n0 + nn < N) v = *(const f32x4*)(W + (size_t)(k0 + kk) * N + n0 + nn);
        if (kscale) v = v * kscale[k0 + kk];
        LAS float* s = scr + kk * 65 + nn; s[0] = v[0]; s[1] = v[1]; s[2] = v[2]; s[3] = v[3];
    }
    asm volatile("s_waitcnt lgkmcnt(0)" ::: "memory");
    const int cch = lane & 7;
#pragma unroll
    for (int j = 0; j < 8; ++j) {
        const int n = 8 * j + (lane >> 3); const LAS float* s = scr + (8 * cch) * 65 + n;
        u32x4 o; o.x = cvtpk(s[0 * 65], s[1 * 65]); o.y = cvtpk(s[2 * 65], s[3 * 65]); o.z = cvtpk(s[4 * 65], s[5 * 65]); o.w = cvtpk(s[6 * 65], s[7 * 65]);
        if (n0 + n < N) *(u32x4*)(WT + (size_t)rm(n0 + n) * K + k0 + 8 * cch) = o;
    }
    asm volatile("s_waitcnt lgkmcnt(0)" ::: "memory");
}
struct RmId { __device__ __forceinline__ int operator()(int n) const { return n; } };
struct RmGu { __device__ __forceinline__ int operator()(int n) const { const int j = n & 1023; return (j >> 7) * 256 + (n >> 10) * 128 + (j & 127); } };

__device__ __forceinline__ void phase_p0a(Frame& F) {
    if (F.bid < 96) {
        LAS float* sc = (LAS float*)F.lds;
        LAS float* part = (LAS float*)(F.lds + 16384);
        for (int i = F.tid; i < 1024; i += NTHR) {
#pragma unroll
            for (int b = 0; b < 4; ++b) { const float cv = F.c[b * 1024 + i]; sc[i * 4 + b] = cv / (1.0f + __expf(-cv)); }
        }
        __syncthreads();
        const int j0 = F.bid * 64;
        float a0 = 0.f, a1 = 0.f, a2 = 0.f, a3 = 0.f;
#pragma unroll 8
        for (int ii = 0; ii < 128; ++ii) {
            const int i = F.wave * 128 + ii; const float w = F.ada_w[(size_t)i * 6144 + j0 + F.lane];
            const f32x4 s4 = *(const LAS f32x4*)(sc + i * 4);
            a0 += s4[0] * w; a1 += s4[1] * w; a2 += s4[2] * w; a3 += s4[3] * w;
        }
        part[(F.wave * 4 + 0) * 64 + F.lane] = a0; part[(F.wave * 4 + 1) * 64 + F.lane] = a1; part[(F.wave * 4 + 2) * 64 + F.lane] = a2; part[(F.wave * 4 + 3) * 64 + F.lane] = a3;
        __syncthreads();
        if (F.tid < 256) { const int b = F.tid >> 6, l = F.tid & 63; float s = F.ada_b[j0 + l];
#pragma unroll
            for (int w = 0; w < 8; ++w) s += part[(w * 4 + b) * 64 + l];
            ((float*)(F.ws + WS_MOD))[b * 6144 + j0 + l] = s; }
        __syncthreads();
    }
    { int* ri = (int*)(F.ws + WS_ROWINFO); for (int i = F.bid * NTHR + F.tid; i < MOE_ROWS; i += F.G * NTHR) ri[i] = -1; }
    LAS float* scr = (LAS float*)(F.lds + F.wave * 16640);
    const int gw = F.bid * NWAVES + F.wave, NGW = F.G * NWAVES;
    constexpr int I_IN = 16 * 46, I_O = 16 * 16, I_GU = 32 * 16 * 32, I_DN = 32 * 16 * 16, NITEMS = I_IN + I_O + I_GU + I_DN;
    for (int it = gw; it < NITEMS; it += NGW) {
        int r = it;
        if (r < I_GU) { const int e = r / 512, q = r % 512; transpose_item(F.w_gu + (size_t)e * 1024 * 2048, 2048, (bf16*)(F.ws + WS_WGU) + (size_t)e * 2048 * 1024, 1024, nullptr, scr, q / 32, q % 32, F.lane, RmGu()); continue; } r -= I_GU;
        if (r < I_DN) { const int e = r / 256, q = r % 256; transpose_item(F.w_down + (size_t)e * 1024 * 1024, 1024, (bf16*)(F.ws + WS_WDN) + (size_t)e * 1024 * 1024, 1024, nullptr, scr, q / 16, q % 16, F.lane, RmId()); continue; } r -= I_DN;
        if (r < I_IN) { transpose_item(F.w_in, IN_COLS, (bf16*)(F.ws + WS_WIN), 1024, nullptr, scr, r / 46, r % 46, F.lane, RmId()); continue; } r -= I_IN;
        transpose_item(F.w_o, 1024, (bf16*)(F.ws + WS_WO), 1024, F.mix_scale, scr, r / 16, r % 16, F.lane, RmId());
    }
}

__device__ __forceinline__ void phase_p0b(Frame& F) {
    const int gw = F.bid * NWAVES + F.wave, NGW = F.G * NWAVES;
    const float* mod = (const float*)(F.ws + WS_MOD); bf16* h0 = (bf16*)(F.ws + WS_H0);
    for (int m = gw; m < NTOK; m += NGW) {
        const int b = m / SEQ;
        const f32x4* xr = (const f32x4*)(F.x + (size_t)m * DM) + F.lane;
        f32x4 v[4]; float s = 0.f;
#pragma unroll
        for (int j = 0; j < 4; ++j) { v[j] = xr[64 * j]; s += (v[j][0] * v[j][0] + v[j][1] * v[j][1]) + (v[j][2] * v[j][2] + v[j][3] * v[j][3]); }
        const float rstd = rsqrtf(wave_sum(s) * (1.f / DM) + EPS);
        u32x2* o8 = (u32x2*)(h0 + (size_t)m * DM) + F.lane;
#pragma unroll
        for (int j = 0; j < 4; ++j) { const int col = 4 * F.lane + 256 * j;
            const f32x4 g = *(const f32x4*)(F.norm1_g + col), sh = *(const f32x4*)(mod + b * 6144 + col), sc = *(const f32x4*)(mod + b * 6144 + 1024 + col);
            const f32x4 y = (v[j] * rstd) * g * (sc + 1.0f) + sh;
            u32x2 w; w.x = cvtpk(y[0], y[1]); w.y = cvtpk(y[2], y[3]); o8[64 * j] = w; }
    }
}

constexpr int VSTR = 144, KSTR = 80;
__device__ __forceinline__ void ret_stage_v(Frame& F, const bf16* proj, int tok0, int h, LAS bf16* Vs) {
    const int row = F.tid >> 2, q = F.tid & 3; const bf16* src = proj + (size_t)(tok0 + row) * PJ + C_RV + h * 128 + q * 32;
#pragma unroll
    for (int i = 0; i < 4; ++i) *(LAS u32x4*)(Vs + row * VSTR + q * 32 + 8 * i) = *(const u32x4*)(src + 8 * i);
}
__device__ __forceinline__ void ret_stage64(Frame& F, const bf16* src0, size_t pitch, LAS bf16* Ds) {
    const int row = F.tid >> 2, q = F.tid & 3; const bf16* src = src0 + (size_t)row * pitch + q * 16;
#pragma unroll
    for (int i = 0; i < 2; ++i) *(LAS u32x4*)(Ds + row * KSTR + q * 16 + 8 * i) = *(const u32x4*)(src + 8 * i);
}
__device__ __forceinline__ void ret_a_item(Frame& F, int item) {
    const bf16* proj = (const bf16*)(F.ws + WS_PROJ); float* kvt = (float*)(F.ws + WS_KVT) + (size_t)item * 8192;
    const int bh = item >> 6, n = item & 63, b = bh >> 2, h = bh & 3, tok0 = b * SEQ + n * 128;
    LAS bf16* Vs = (LAS bf16*)F.lds; LAS bf16* Ks = (LAS bf16*)(F.lds + 128 * VSTR * 2);
    const float lg = log2gamma(h);
    ret_stage_v(F, proj, tok0, h, Vs);
    { const int row = F.tid >> 2, q = F.tid & 3; const bf16* src = proj + (size_t)(tok0 + row) * PJ + C_RK + h * 64 + q * 16; const float dk = 0.125f * exp2f((float)(127 - row) * lg);
#pragma unroll
      for (int i = 0; i < 2; ++i) { const u32x4 w = *(const u32x4*)(src + 8 * i); u32x4 o;
          o.x = cvtpk(bflo(w.x) * dk, bfhi(w.x) * dk); o.y = cvtpk(bflo(w.y) * dk, bfhi(w.y) * dk); o.z = cvtpk(bflo(w.z) * dk, bfhi(w.z) * dk); o.w = cvtpk(bflo(w.w) * dk, bfhi(w.w) * dk);
          *(LAS u32x4*)(Ks + row * KSTR + q * 16 + 8 * i) = o; } }
    __syncthreads();
    const int lane = F.lane, n16 = lane & 15, c = lane >> 4, q4 = n16 >> 2, p4 = lane & 3, e0 = 16 * F.wave;
    f32x4 acc[4];
#pragma unroll
    for (int dt = 0; dt < 4; ++dt) acc[dt] = (f32x4){0.f, 0.f, 0.f, 0.f};
#pragma unroll
    for (int s = 0; s < 4; ++s) {
        const LAS bf16* ap = Vs + (32 * s + 4 * c + q4) * VSTR + e0 + 4 * p4;
        const bf16x8 A = cat8(trread(ap), trread(ap + 16 * VSTR));
#pragma unroll
        for (int dt = 0; dt < 4; ++dt) { const LAS bf16* bp = Ks + (32 * s + 4 * c + q4) * KSTR + 16 * dt + 4 * p4;
            const bf16x8 B = cat8(trread(bp), trread(bp + 16 * KSTR)); acc[dt] = MFMA16(A, B, acc[dt]); }
    }
#pragma unroll
    for (int dt = 0; dt < 4; ++dt)
#pragma unroll
        for (int r = 0; r < 4; ++r) kvt[(e0 + 4 * c + r) * 64 + 16 * dt + n16] = acc[dt][r];
    __syncthreads();
}
__device__ __forceinline__ void ret_scan(Frame& F) {
    const float* kvt = (const float*)(F.ws + WS_KVT); bf16* rpt = (bf16*)(F.ws + WS_RPT);
    for (int g = F.bid * NTHR + F.tid; g < 16 * 8192; g += F.G * NTHR) {
        const int bh = g >> 13, ed = g & 8191, h = bh & 3; const float gC = exp2f(128.0f * log2gamma(h));
        float R = 0.f; const size_t base = (size_t)bh * 64 * 8192 + ed;
#pragma unroll 8
        for (int n = 0; n < 64; ++n) { const float kv = kvt[base + (size_t)n * 8192]; rpt[base + (size_t)n * 8192] = f2bf(R); R = R * gC + kv; }
    }
}
__device__ __forceinline__ void ret_c_item(Frame& F, int item) {
    const bf16* proj = (const bf16*)(F.ws + WS_PROJ); const bf16* rpt = (const bf16*)(F.ws + WS_RPT) + (size_t)item * 8192; bf16* mix = (bf16*)(F.ws + WS_MIX);
    const int bh = item >> 6, n = item & 63, b = bh >> 2, h = bh & 3, tok0 = b * SEQ + n * 128;
    LAS bf16* Qs = (LAS bf16*)F.lds; LAS bf16* Ks = Qs + 128 * KSTR; LAS bf16* Vs = Ks + 128 * KSTR; LAS bf16* Rs = Vs + 128 * VSTR;
    const float lg = log2gamma(h);
    ret_stage64(F, proj + (size_t)tok0 * PJ + C_RQ + h * 64, PJ, Qs);
    ret_stage64(F, proj + (size_t)tok0 * PJ + C_RK + h * 64, PJ, Ks);
    ret_stage_v(F, proj, tok0, h, Vs);
    ret_stage64(F, rpt, 64, Rs);
    __syncthreads();
    const int lane = F.lane, n16 = lane & 15, c = lane >> 4, q4 = n16 >> 2, p4 = lane & 3, w = F.wave, i0 = 16 * w, il = i0 + n16;
    bf16x8 qf[2];
#pragma unroll
    for (int s = 0; s < 2; ++s) qf[s] = *(const LAS bf16x8*)(Qs + il * KSTR + 32 * s + 8 * c);
    f32x4 oin[8], ocr[8];
#pragma unroll
    for (int et = 0; et < 8; ++et) { oin[et] = (f32x4){0.f, 0.f, 0.f, 0.f}; ocr[et] = (f32x4){0.f, 0.f, 0.f, 0.f}; }
    const int nsp = (w >> 1) + 1;
    for (int sp = 0; sp < nsp; ++sp) {
        unsigned pw[4];
#pragma unroll
        for (int t2 = 0; t2 < 2; ++t2) { const int jt = 2 * sp + t2;
            const bf16x8 k0 = *(const LAS bf16x8*)(Ks + (16 * jt + n16) * KSTR + 8 * c), k1 = *(const LAS bf16x8*)(Ks + (16 * jt + n16) * KSTR + 32 + 8 * c);
            f32x4 st = MFMA16(k0, qf[0], ((f32x4){0.f, 0.f, 0.f, 0.f})); st = MFMA16(k1, qf[1], st);
            float pv[4];
#pragma unroll
            for (int r = 0; r < 4; ++r) { const int j = 16 * jt + 4 * c + r; const float f = (il >= j) ? 0.125f * exp2f((float)(il - j) * lg) : 0.f; pv[r] = st[r] * f; }
            pw[2 * t2] = cvtpk(pv[0], pv[1]); pw[2 * t2 + 1] = cvtpk(pv[2], pv[3]); }
        const bf16x8 P = __builtin_bit_cast(bf16x8, ((u32x4){pw[0], pw[1], pw[2], pw[3]}));
#pragma unroll
        for (int et = 0; et < 8; ++et) { const LAS bf16* ap = Vs + (32 * sp + 4 * c + q4) * VSTR + 16 * et + 4 * p4;
            const bf16x8 A = cat8(trread(ap), trread(ap + 16 * VSTR)); oin[et] = MFMA16(A, P, oin[et]); }
    }
#pragma unroll
    for (int et = 0; et < 8; ++et)
#pragma unroll
        for (int s = 0; s < 2; ++s) { const bf16x8 rf = *(const LAS bf16x8*)(Rs + (16 * et + n16) * KSTR + 32 * s + 8 * c); ocr[et] = MFMA16(rf, qf[s], ocr[et]); }
    const float qd = exp2f((float)(il + 1) * lg);
    float ss = 0.f;
#pragma unroll
    for (int et = 0; et < 8; ++et) { oin[et] = oin[et] + ocr[et] * qd; ss += (oin[et][0] * oin[et][0] + oin[et][1] * oin[et][1]) + (oin[et][2] * oin[et][2] + oin[et][3] * oin[et][3]); }
    ss += __shfl_xor(ss, 16); ss += __shfl_xor(ss, 32);
    const float rstd = rsqrtf(ss * (1.f / 128.f) + EPS);
    const bf16* gp = proj + (size_t)(tok0 + il) * PJ + C_RG + h * 128 + 4 * c; bf16* op = mix + (size_t)(tok0 + il) * DM + h * 128 + 4 * c;
#pragma unroll
    for (int et = 0; et < 8; ++et) { const u32x2 gw = *(const u32x2*)(gp + 16 * et);
        const float g0 = bflo(gw.x), g1 = bfhi(gw.x), g2 = bflo(gw.y), g3 = bfhi(gw.y);
        const float y0 = g0 / (1.f + __expf(-g0)) * (oin[et][0] * rstd), y1 = g1 / (1.f + __expf(-g1)) * (oin[et][1] * rstd), y2 = g2 / (1.f + __expf(-g2)) * (oin[et][2] * rstd), y3 = g3 / (1.f + __expf(-g3)) * (oin[et][3] * rstd);
        u32x2 o; o.x = cvtpk(y0, y1); o.y = cvtpk(y2, y3); *(u32x2*)(op + 16 * et) = o; }
    __syncthreads();
}

constexpr int QT = 64, KT = 64, CAP = 448, CAP_TRIG = 384, NSEL = 256;
constexpr int KTS = 72;
constexpr int CAND_BYTES = QT * CAP * 4, KTILE_BYTES = KT * KTS * 2;
constexpr float WSCALE = 0.125f * 0.35355339059327373f;
__device__ __forceinline__ unsigned fmap(float s) { const unsigned u = __builtin_bit_cast(unsigned, s); return (u & 0x80000000u) ? ~u : (u | 0x80000000u); }
__device__ __forceinline__ float funmap(unsigned m) { const unsigned u = (m & 0x80000000u) ? (m ^ 0x80000000u) : ~m; return __builtin_bit_cast(float, u); }
__device__ __forceinline__ unsigned compact_row(LAS unsigned* row, int cnt, int lane) {
    unsigned e[7];
#pragma unroll
    for (int j = 0; j < 7; ++j) { const int p = 64 * j + lane; e[j] = (p < cnt) ? row[p] : 0u; }
    unsigned prefix = 0u; int need = NSEL;
#pragma unroll 1
    for (int bit = 31; bit >= 0; --bit) {
        const unsigned tst = (prefix >> bit) | 1u;
        int cc = 0;
#pragma unroll
        for (int j = 0; j < 7; ++j) cc += __builtin_popcountll(__ballot((e[j] >> bit) == tst));
        if (cc >= need) prefix |= (1u << bit); else need -= cc;
    }
    int run = 0;
#pragma unroll
    for (int j = 0; j < 7; ++j) { const bool keep = e[j] >= prefix; const unsigned long long m = __ballot(keep);
        if (keep) row[run + mbcnt64(m)] = e[j];
        run += __builtin_popcountll(m); }
    return prefix;
}
__device__ __forceinline__ void dsa_a_unit(Frame& F, int b, int qt) {
    const bf16* proj = (const bf16*)(F.ws + WS_PROJ); bf16* sel = (bf16*)(F.ws + WS_SEL);
    LAS unsigned* cand = (LAS unsigned*)F.lds; LAS bf16* ktile = (LAS bf16*)(F.lds + CAND_BYTES);
    const int lane = F.lane, w = F.wave, r32 = lane & 31, hi = lane >> 5;
    const int tokb = b * SEQ, q0 = qt * QT;
    bf16x8 af[2][4]; float wv[2][16];
    { const int qq = 2 * ((r32 >> 2) & 1) + (r32 >> 4), hd = ((r32 >> 3) & 1) * 4 + (r32 & 3);
#pragma unroll
      for (int mt = 0; mt < 2; ++mt) { const bf16* qp = proj + (size_t)(tokb + q0 + 8 * w + 4 * mt + qq) * PJ + C_IQ + hd * 64 + 8 * hi;
#pragma unroll
          for (int s = 0; s < 4; ++s) af[mt][s] = *(const bf16x8*)(qp + 16 * s);
#pragma unroll
          for (int u = 0; u < 2; ++u) { const u32x4 ww = *(const u32x4*)(proj + (size_t)(tokb + q0 + 8 * w + 4 * mt + 2 * hi + u) * PJ + C_IW);
              wv[mt][8 * u + 0] = bflo(ww.x) * WSCALE; wv[mt][8 * u + 1] = bfhi(ww.x) * WSCALE; wv[mt][8 * u + 2] = bflo(ww.y) * WSCALE; wv[mt][8 * u + 3] = bfhi(ww.y) * WSCALE;
              wv[mt][8 * u + 4] = bflo(ww.z) * WSCALE; wv[mt][8 * u + 5] = bfhi(ww.z) * WSCALE; wv[mt][8 * u + 6] = bflo(ww.w) * WSCALE; wv[mt][8 * u + 7] = bfhi(ww.w) * WSCALE; } } }
    float thrf[2][2]; int cntv[2][2];
#pragma unroll
    for (int mt = 0; mt < 2; ++mt)
#pragma unroll
        for (int u = 0; u < 2; ++u) { thrf[mt][u] = -INFINITY; cntv[mt][u] = 0; }
    const int NT = qt + 1;
    const int skey = F.tid >> 3, spc = F.tid & 7;
    const bf16* ksrc = proj + (size_t)(tokb + skey) * PJ + C_IK + spc * 8;
    { const u32x4 v = *(const u32x4*)ksrc; *(LAS u32x4*)(ktile + skey * KTS + spc * 8) = v; }
    __syncthreads();
    for (int kt = 0; kt < NT; ++kt) {
        u32x4 pre = (u32x4){0u, 0u, 0u, 0u};
        if (kt + 1 < NT) pre = *(const u32x4*)(ksrc + (size_t)(kt + 1) * KT * PJ);
        const LAS bf16* cur = ktile + (kt & 1) * (KT * KTS);
#pragma unroll
        for (int sub = 0; sub < 2; ++sub) {
            bf16x8 bfr[4];
#pragma unroll
            for (int s = 0; s < 4; ++s) bfr[s] = *(const LAS bf16x8*)(cur + (sub * 32 + r32) * KTS + 16 * s + 8 * hi);
            const int key = kt * KT + sub * 32 + r32;
#pragma unroll
            for (int mt = 0; mt < 2; ++mt) {
                f32x16 acc;
#pragma unroll
                for (int r = 0; r < 16; ++r) acc[r] = 0.f;
#pragma unroll
                for (int s = 0; s < 4; ++s) acc = MFMA32(af[mt][s], bfr[s], acc);
                float sc[2] = {0.f, 0.f};
#pragma unroll
                for (int r = 0; r < 16; ++r) sc[r >> 3] += wv[mt][r] * fmaxf(acc[r], 0.f);
#pragma unroll
                for (int u = 0; u < 2; ++u) {
                    const int ql = 8 * w + 4 * mt + 2 * hi + u;
                    const bool valid = (sc[u] >= thrf[mt][u]) && (key <= q0 + ql);
                    const unsigned long long m = __ballot(valid);
                    const int nlo = __builtin_popcount((unsigned)m), nhi = __builtin_popcount((unsigned)(m >> 32));
                    const int off = mbcnt64(m) - (hi ? nlo : 0);
                    if (valid) cand[ql * CAP + cntv[mt][u] + off] = (fmap(sc[u]) & 0xFFFFE000u) | (unsigned)(8191 - key);
                    cntv[mt][u] += hi ? nhi : nlo;
                }
            }
        }
#pragma unroll
        for (int mt = 0; mt < 2; ++mt)
#pragma unroll
            for (int hh = 0; hh < 2; ++hh)
#pragma unroll
                for (int u = 0; u < 2; ++u) {
                    const int cq = __builtin_amdgcn_readlane(cntv[mt][u], hh * 32);
                    if (cq > CAP_TRIG) { const unsigned P = compact_row(cand + (8 * w + 4 * mt + 2 * hh + u) * CAP, cq, lane);
                        if (hi == hh) { cntv[mt][u] = NSEL; thrf[mt][u] = funmap(P & 0xFFFFE000u); } }
                }
        if (kt + 1 < NT) *(LAS u32x4*)(ktile + ((kt + 1) & 1) * (KT * KTS) + skey * KTS + spc * 8) = pre;
        __syncthreads();
    }
#pragma unroll
    for (int mt = 0; mt < 2; ++mt)
#pragma unroll
        for (int hh = 0; hh < 2; ++hh)
#pragma unroll
            for (int u = 0; u < 2; ++u) {
                int cq = __builtin_amdgcn_readlane(cntv[mt][u], hh * 32);
                const int ql = 8 * w + 4 * mt + 2 * hh + u; LAS unsigned* row = cand + ql * CAP;
                if (cq > NSEL) { (void)compact_row(row, cq, lane); cq = NSEL; }
                bf16* so = sel + (size_t)(tokb + q0 + ql) * NSEL;
#pragma unroll
                for (int j = 0; j < 4; ++j) { const int p = 64 * j + lane; const unsigned v = row[p]; so[p] = (p < cq) ? (bf16)(8191u - (v & 0x1FFFu)) : (bf16)0; }
            }
    __syncthreads();
}

constexpr int VROW = 144;
constexpr int DSAB_WAVE_BYTES = 512 + 32 * VROW * 2;
__device__ __forceinline__ void dsa_b_query(Frame& F, int b, int t, LAS unsigned char* wl) {
    const bf16* proj = (const bf16*)(F.ws + WS_PROJ); const bf16* sel = (const bf16*)(F.ws + WS_SEL); bf16* mix = (bf16*)(F.ws + WS_MIX);
    const int lane = F.lane, n16 = lane & 15, c = lane >> 4, q4 = n16 >> 2, p4 = lane & 3;
    const int tok = b * SEQ + t, nsel = (t + 1 < NSEL) ? t + 1 : NSEL;
    LAS bf16* sl = (LAS bf16*)wl; LAS bf16* vl = (LAS bf16*)(wl + 512);
    *(LAS u32x2*)(sl + 4 * lane) = *(const u32x2*)(sel + (size_t)tok * NSEL + 4 * lane);
    bf16x8 qf[2][2];
#pragma unroll
    for (int g = 0; g < 2; ++g)
#pragma unroll
        for (int s = 0; s < 2; ++s) { bf16x8 v = (bf16x8){0, 0, 0, 0, 0, 0, 0, 0};
            if (n16 < 4) v = *(const bf16x8*)(proj + (size_t)tok * PJ + C_AQ + (g * 4 + n16) * 64 + 32 * s + 8 * c);
            qf[g][s] = v; }
    const bf16* kvbase = proj + (size_t)b * SEQ * PJ;
    bf16x8 pf[2][8];
#pragma unroll
    for (int g = 0; g < 2; ++g) {
        f32x4 acc[16];
#pragma unroll
        for (int kt = 0; kt < 16; ++kt) {
            const int key = sl[16 * kt + n16];
            const bf16* kp = kvbase + (size_t)key * PJ + C_AK + g * 64 + 8 * c;
            const bf16x8 a0 = *(const bf16x8*)kp, a1 = *(const bf16x8*)(kp + 32);
            acc[kt] = MFMA16(a0, qf[g][0], ((f32x4){0.f, 0.f, 0.f, 0.f})); acc[kt] = MFMA16(a1, qf[g][1], acc[kt]);
            if ((kt & 3) == 3) asm volatile("" ::: "memory");
        }
        const float slope = exp2f(-(float)(g * 4 + (n16 & 3) + 1));
        float mx = -INFINITY;
#pragma unroll
        for (int kt = 0; kt < 16; ++kt) { const u32x2 kk = *(const LAS u32x2*)(sl + 16 * kt + 4 * c);
            const int k4[4] = {(int)(kk.x & 0xffffu), (int)(kk.x >> 16), (int)(kk.y & 0xffffu), (int)(kk.y >> 16)};
#pragma unroll
            for (int r = 0; r < 4; ++r) { const int p = 16 * kt + 4 * c + r; float lgt = acc[kt][r] * 0.125f - slope * (float)(t - k4[r]); if (p >= nsel) lgt = -INFINITY; acc[kt][r] = lgt; mx = fmaxf(mx, lgt); } }
        mx = fmaxf(mx, __shfl_xor(mx, 16)); mx = fmaxf(mx, __shfl_xor(mx, 32));
        float sum = 0.f;
#pragma unroll
        for (int kt = 0; kt < 16; ++kt)
#pragma unroll
            for (int r = 0; r < 4; ++r) { const float e = __builtin_amdgcn_exp2f((acc[kt][r] - mx) * 1.4426950408889634f); acc[kt][r] = e; sum += e; }
        sum += __shfl_xor(sum, 16); sum += __shfl_xor(sum, 32);
        const float inv = 1.0f / sum;
#pragma unroll
        for (int sp = 0; sp < 8; ++sp) { u32x4 pw; pw.x = cvtpk(acc[2 * sp][0] * inv, acc[2 * sp][1] * inv); pw.y = cvtpk(acc[2 * sp][2] * inv, acc[2 * sp][3] * inv);
            pw.z = cvtpk(acc[2 * sp + 1][0] * inv, acc[2 * sp + 1][1] * inv); pw.w = cvtpk(acc[2 * sp + 1][2] * inv, acc[2 * sp + 1][3] * inv); pf[g][sp] = __builtin_bit_cast(bf16x8, pw); }
    }
    f32x4 O[2][4];
#pragma unroll
    for (int g = 0; g < 2; ++g)
#pragma unroll
        for (int dt = 0; dt < 4; ++dt) O[g][dt] = (f32x4){0.f, 0.f, 0.f, 0.f};
#pragma unroll
    for (int sp = 0; sp < 8; ++sp) {
#pragma unroll
        for (int i = 0; i < 8; ++i) { const int row = 4 * i + c; const int key = sl[32 * sp + row];
            *(LAS u32x4*)(vl + row * VROW + n16 * 8) = *(const u32x4*)(kvbase + (size_t)key * PJ + C_AV + n16 * 8); }
#pragma unroll
        for (int dt = 0; dt < 4; ++dt) {
            const LAS bf16* vp = vl + (4 * c + q4) * VROW + dt * 16 + 4 * p4;
            O[0][dt] = MFMA16(pf[0][sp], cat8(trread(vp), trread(vp + 16 * VROW)), O[0][dt]);
            O[1][dt] = MFMA16(pf[1][sp], cat8(trread(vp + 64), trread(vp + 64 + 16 * VROW)), O[1][dt]);
        }
        asm volatile("" ::: "memory");
    }
    if (lane < 16) { bf16* op = mix + (size_t)tok * DM + 512 + lane;
#pragma unroll
        for (int g = 0; g < 2; ++g)
#pragma unroll
            for (int dt = 0; dt < 4; ++dt)
#pragma unroll
                for (int r = 0; r < 4; ++r) op[(g * 4 + r) * 64 + 16 * dt] = f2bf(O[g][dt][r]); }
}

constexpr int HSTR = 1028;
__device__ __forceinline__ void phase_router(Frame& F) {
    const float* x1 = F.out; const float* mod = (const float*)(F.ws + WS_MOD); bf16* h2 = (bf16*)(F.ws + WS_H2);
    int* topi = (int*)(F.ws + WS_TOPI); float* topg = (float*)(F.ws + WS_TOPG); int* bbase = (int*)(F.ws + WS_BBASE);
    LAS float* hs = (LAS float*)F.lds; LAS float* part = (LAS float*)(F.lds + 16 * HSTR * 4); LAS int* hist = (LAS int*)(F.lds + 16 * HSTR * 4 + 8 * 16 * 32 * 4);
    const int lane = F.lane, w = F.wave;
    for (int blk = F.bid; blk < NTOK / 128; blk += F.G) {
        const int T0 = blk * 128, b = T0 / SEQ;
        if (F.tid < 32) hist[F.tid] = 0;
        f32x4 ca[4], cb[4];
#pragma unroll
        for (int j = 0; j < 4; ++j) { const int col = 4 * lane + 256 * j;
            ca[j] = *(const f32x4*)(F.norm2_g + col) * (*(const f32x4*)(mod + b * 6144 + 4 * 1024 + col) + 1.0f); cb[j] = *(const f32x4*)(mod + b * 6144 + 3 * 1024 + col); }
        __syncthreads();
        for (int pass = 0; pass < 8; ++pass) {
#pragma unroll
            for (int tt = 0; tt < 2; ++tt) { const int tl = 2 * w + tt, tok = T0 + pass * 16 + tl;
                const f32x4* xr = (const f32x4*)(x1 + (size_t)tok * DM) + lane; f32x4 v[4]; float s = 0.f;
#pragma unroll
                for (int j = 0; j < 4; ++j) { v[j] = xr[64 * j]; s += (v[j][0] * v[j][0] + v[j][1] * v[j][1]) + (v[j][2] * v[j][2] + v[j][3] * v[j][3]); }
                const float rstd = rsqrtf(wave_sum(s) * (1.f / DM) + EPS);
                u32x2* o8 = (u32x2*)(h2 + (size_t)tok * DM) + lane;
#pragma unroll
                for (int j = 0; j < 4; ++j) { const f32x4 y = (v[j] * rstd) * ca[j] + cb[j];
                    u32x2 pk; pk.x = cvtpk(y[0], y[1]); pk.y = cvtpk(y[2], y[3]); o8[64 * j] = pk;
                    *(LAS f32x4*)(hs + tl * HSTR + 4 * lane + 256 * j) = y; } }
            __syncthreads();
            { const int ti = lane & 15, kk = lane >> 5, e = lane & 31; f32x16 acc;
#pragma unroll
              for (int r = 0; r < 16; ++r) acc[r] = 0.f;
              const LAS float* hp = hs + ti * HSTR + 128 * w + 64 * kk; const float* rwp = F.router_w + (size_t)(128 * w + 64 * kk) * NE + e;
#pragma unroll 4
              for (int s4 = 0; s4 < 16; ++s4) { const f32x4 a4 = *(const LAS f32x4*)(hp + 4 * s4);
#pragma unroll
                  for (int q = 0; q < 4; ++q) acc = __builtin_amdgcn_mfma_f32_32x32x2f32(a4[q], rwp[(4 * s4 + q) * NE], acc, 0, 0, 0); }
#pragma unroll
              for (int r = 0; r < 8; ++r) part[(w * 16 + (r & 3) + 8 * (r >> 2) + 4 * kk) * 32 + e] = acc[r]; }
            __syncthreads();
            { const int tl = F.tid >> 5, e = F.tid & 31, tok = T0 + pass * 16 + tl; float lg = F.router_b[e];
#pragma unroll
              for (int ww = 0; ww < 8; ++ww) lg += part[(ww * 16 + tl) * 32 + e];
              float myv = lg; float tv[4]; int ti4[4]; bool mine = false;
#pragma unroll
              for (int k = 0; k < 4; ++k) { float bv = myv; int bi = e;
#pragma unroll
                  for (int o = 16; o >= 1; o >>= 1) { const float ov = __shfl_xor(bv, o); const int oi = __shfl_xor(bi, o); if (ov > bv || (ov == bv && oi < bi)) { bv = ov; bi = oi; } }
                  tv[k] = bv; ti4[k] = bi; if (bi == e) { myv = -INFINITY; mine = true; } }
              if (mine) atomicAdd((int*)hist + e, 1);
              if (e == 0) { const float e0 = 1.0f, e1 = __expf(tv[1] - tv[0]), e2 = __expf(tv[2] - tv[0]), e3 = __expf(tv[3] - tv[0]); const float inv = 1.0f / (e0 + e1 + e2 + e3);
                  *(int4*)(topi + (size_t)tok * 4) = make_int4(ti4[0], ti4[1], ti4[2], ti4[3]); *(f32x4*)(topg + (size_t)tok * 4) = (f32x4){e0 * inv, e1 * inv, e2 * inv, e3 * inv}; } }
            __syncthreads();
        }
        if (F.tid < 32) { const int base = atomicAdd((int*)(F.ctl + CW_GCNT) + F.tid, hist[F.tid]); bbase[blk * 32 + F.tid] = base; }
        __syncthreads();
    }
}
__device__ __forceinline__ int moe_layout(Frame& F, LAS int* offs, LAS int* tile_e) {
    if (F.tid == 0) { int o = 0;
        for (int e = 0; e < NE; ++e) { const int cnt = (int)__hip_atomic_load(F.ctl + CW_GCNT + e, __ATOMIC_RELAXED, __HIP_MEMORY_SCOPE_AGENT); const int nt = (cnt + 255) >> 8;
            offs[e] = o; if (tile_e) for (int t = 0; t < nt; ++t) tile_e[(o >> 8) + t] = e; o += nt << 8; }
        offs[NE] = o >> 8; }
    __syncthreads();
    return offs[NE];
}
__device__ __forceinline__ void phase_place(Frame& F) {
    const bf16* h2 = (const bf16*)(F.ws + WS_H2); bf16* xs = (bf16*)(F.ws + WS_XS);
    const int* topi = (const int*)(F.ws + WS_TOPI); const float* topg = (const float*)(F.ws + WS_TOPG); const int* bbase = (const int*)(F.ws + WS_BBASE);
    int* rowinfo = (int*)(F.ws + WS_ROWINFO); float* rowgate = (float*)(F.ws + WS_ROWGATE);
    LAS int* offs = (LAS int*)F.lds; LAS int* lcur = offs + 64; LAS int* posl = offs + 128;
    (void)moe_layout(F, offs, nullptr);
    for (int blk = F.bid; blk < NTOK / 128; blk += F.G) {
        const int T0 = blk * 128;
        if (F.tid < 32) lcur[F.tid] = 0;
        __syncthreads();
        { const int i = F.tid, tok = T0 + (i >> 2); const int e = topi[(size_t)tok * 4 + (i & 3)];
          const int rank = atomicAdd((int*)lcur + e, 1); const int pos = offs[e] + bbase[blk * 32 + e] + rank;
          rowinfo[pos] = tok * 4 + (i & 3); rowgate[pos] = topg[(size_t)tok * 4 + (i & 3)]; posl[i] = pos; }
        __syncthreads();
        for (int jj = 0; jj < 64; ++jj) { const int i = F.wave * 64 + jj; const int pos = posl[i]; const int tok = T0 + (i >> 2);
            const u32x4* src = (const u32x4*)(h2 + (size_t)tok * DM) + F.lane; u32x4* dst = (u32x4*)(xs + (size_t)pos * DM) + F.lane;
            const u32x4 v0 = src[0], v1 = src[64]; dst[0] = v0; dst[64] = v1; }
        __syncthreads();
    }
}
__device__ __forceinline__ void phase_final(Frame& F) {
    const float* mod = (const float*)(F.ws + WS_MOD); const bf16* Y = (const bf16*)(F.ws + WS_Y);
    const int gw = F.bid * NWAVES + F.wave, NGW = F.G * NWAVES;
    for (int m = gw; m < NTOK; m += NGW) {
        const int b = m / SEQ; f32x4* xr = (f32x4*)(F.out + (size_t)m * DM) + F.lane; f32x4 v[4]; float s = 0.f;
#pragma unroll
        for (int j = 0; j < 4; ++j) { const int col = 4 * F.lane + 256 * j; f32x4 y = (f32x4){0.f, 0.f, 0.f, 0.f};
#pragma unroll
            for (int k = 0; k < 4; ++k) { const u32x2 w = *((const u32x2*)(Y + ((size_t)m * 4 + k) * DM) + F.lane + 64 * j); y[0] += bflo(w.x); y[1] += bfhi(w.x); y[2] += bflo(w.y); y[3] += bfhi(w.y); }
            v[j] = xr[64 * j] + *(const f32x4*)(mod + b * 6144 + 5 * 1024 + col) * y;
            s += (v[j][0] * v[j][0] + v[j][1] * v[j][1]) + (v[j][2] * v[j][2] + v[j][3] * v[j][3]); }
        const float rstd = rsqrtf(wave_sum(s) * (1.f / DM) + EPS);
#pragma unroll
        for (int j = 0; j < 4; ++j) xr[64 * j] = (v[j] * rstd) * *(const f32x4*)(F.final_g + 4 * F.lane + 256 * j);
    }
}

#ifndef MK_N_LAUNCHES
#define MK_N_LAUNCHES 1
#endif
constexpr int N_PHASES = 12;
struct Args { const float* in[16]; float* out; unsigned char* ws; int ph_lo, ph_hi; };
static_assert(sizeof(Args) == 16 * 8 + 8 + 8 + 8, "Args has no padding");

__global__ void __launch_bounds__(NTHR, 2) mk_fwd(Args args) {
    extern __shared__ __attribute__((aligned(16))) unsigned char lds_raw[];
    Frame F;
    F.lds = (LAS unsigned char*)lds_raw;
    F.MISC = (volatile LAS unsigned*)(F.lds + MISC_OFF);
    F.tid = threadIdx.x; F.lane = F.tid & 63; F.wave = __builtin_amdgcn_readfirstlane(F.tid >> 6);
    F.G = gridDim.x; F.bid = blockIdx.x;
    F.ws = args.ws; F.ctl = (unsigned*)(args.ws + WS_CTL); F.out = args.out;
    F.x = args.in[0]; F.c = args.in[1]; F.ada_w = args.in[2]; F.ada_b = args.in[3]; F.norm1_g = args.in[4]; F.w_in = args.in[5]; F.mix_scale = args.in[6]; F.w_o = args.in[7];
    F.norm2_g = args.in[8]; F.router_w = args.in[9]; F.router_b = args.in[10]; F.w_gu = args.in[11]; F.b_gu = args.in[12]; F.w_down = args.in[13]; F.b_down = args.in[14]; F.final_g = args.in[15];
    for (int u = F.tid; u < (LDS_BYTES - MISC_OFF) / 4; u += NTHR) ((LAS unsigned*)(F.lds + MISC_OFF))[u] = 0u;
    __syncthreads();
    const int lo = args.ph_lo, hi = args.ph_hi;
    XcdBarrier bar; bar.bar = (unsigned*)(F.ctl + CW_BAR); bar.x = 0; bar.st = nullptr;
    if (hi - lo > 1) bar = xcd_barrier_post((unsigned*)(F.ctl + CW_BAR), F.MISC + 8);
#define IN(k) (lo <= (k) && (k) < hi)
#define SEAM(k) do { if (IN(k) && IN((k) + 1)) xcd_barrier(bar); } while (0)

    if (IN(0)) { phase_p0a(F); } SEAM(0);
    if (IN(1)) { phase_p0b(F); } SEAM(1);
    if (IN(2)) {
        pg8::Gemm g{(const bf16*)(F.ws + WS_H0), (const bf16*)(F.ws + WS_WIN), NTOK, PJ, DM}; pg8::StaticOrder S; S.init(NTOK, PJ, F.G, F.bid);
        EpiProj E{(bf16*)(F.ws + WS_PROJ), PJ};
        pg8::gemm_phase<EpiProj, pg8::StaticOrder, true, true>(F.lds, g, S, E);
    } SEAM(2);
    if (IN(3)) {
        for (int it = F.bid; it < 1024; it += F.G) ret_a_item(F, it);
        for (int u = F.bid; u < 256; u += F.G) { const int b = u >> 6, j = u & 63; dsa_a_unit(F, b, j); dsa_a_unit(F, b, 127 - j); }
    } SEAM(3);
    if (IN(4)) {
        ret_scan(F);
        LAS unsigned char* wl = F.lds + F.wave * DSAB_WAVE_BYTES;
        for (int blk = F.bid; blk < NTOK / 128; blk += F.G)
            for (int qi = 0; qi < 16; ++qi) { const int tok = blk * 128 + F.wave * 16 + qi; dsa_b_query(F, tok / SEQ, tok % SEQ, wl); }
    } SEAM(4);
    if (IN(5)) { for (int it = F.bid; it < 1024; it += F.G) ret_c_item(F, it); } SEAM(5);
    if (IN(6)) {
        pg8::Gemm g{(const bf16*)(F.ws + WS_MIX), (const bf16*)(F.ws + WS_WO), NTOK, DM, DM}; pg8::StaticOrder S; S.init(NTOK, DM, F.G, F.bid);
        EpiX1 E{F.x, (const float*)(F.ws + WS_MOD), F.out};
        pg8::gemm_phase<EpiX1, pg8::StaticOrder, true, true>(F.lds, g, S, E);
    } SEAM(6);
    if (IN(7)) { phase_router(F); } SEAM(7);
    if (IN(8)) { phase_place(F); } SEAM(8);
    if (IN(9)) {
        LAS int* tile_e = (LAS int*)(F.lds + TILEE_OFF); const int nt = moe_layout(F, (LAS int*)(F.lds + TILEE_OFF + 4096), tile_e);
        pg8::Gemm g{(const bf16*)(F.ws + WS_XS), (const bf16*)(F.ws + WS_WGU), MOE_ROWS, 2048, DM};
        GroupedOrder S{tile_e, nt, 8, F.G, F.bid, (size_t)2048 * 1024 * 2};
        EpiGlu E{(bf16*)(F.ws + WS_HB), F.b_gu};
        pg8::gemm_phase<EpiGlu, GroupedOrder, true, true>(F.lds, g, S, E);
    } SEAM(9);
    if (IN(10)) {
        LAS int* tile_e = (LAS int*)(F.lds + TILEE_OFF); const int nt = moe_layout(F, (LAS int*)(F.lds + TILEE_OFF + 4096), tile_e);
        pg8::Gemm g{(const bf16*)(F.ws + WS_HB), (const bf16*)(F.ws + WS_WDN), MOE_ROWS, DM, DM};
        GroupedOrder S{tile_e, nt, 4, F.G, F.bid, (size_t)1024 * 1024 * 2};
        EpiDown E{(bf16*)(F.ws + WS_Y), F.b_down, (const int*)(F.ws + WS_ROWINFO), (const float*)(F.ws + WS_ROWGATE)};
        pg8::gemm_phase<EpiDown, GroupedOrder, true, true>(F.lds, g, S, E);
    } SEAM(10);
    if (IN(11)) { phase_final(F); }
#undef IN
#undef SEAM
}

extern "C" void kernel_launch(void* const* d_in, const int* in_sizes, int n_in, void* d_out, int out_size, void* d_ws, size_t ws_size, hipStream_t stream) {
    static int grid = 0;
    if (grid == 0) {
        if (n_in != 16 || out_size != NTOK * DM || ws_size < WS_END) { fprintf(stderr, "kernel_launch: unexpected problem (n_in %d out %d ws %zu); nothing launched\n", n_in, out_size, ws_size); grid = -1; return; }
        int dev = 0, cus = 0;
        if (hipGetDevice(&dev) != hipSuccess || hipDeviceGetAttribute(&cus, hipDeviceAttributeMultiprocessorCount, dev) != hipSuccess) { grid = -1; return; }
        if (hipFuncSetAttribute((const void*)mk_fwd, hipFuncAttributeMaxDynamicSharedMemorySize, LDS_BYTES) != hipSuccess) { fprintf(stderr, "kernel_launch: hipFuncSetAttribute failed\n"); grid = -1; return; }
        int per_cu = 0;
        if (hipOccupancyMaxActiveBlocksPerMultiprocessor(&per_cu, (const void*)mk_fwd, NTHR, LDS_BYTES) != hipSuccess || per_cu < 1) fprintf(stderr, "kernel_launch: occupancy query reports %d workgroups per CU\n", per_cu);
        (void)hipGetLastError();
        grid = cus;
    }
    if (grid < 0) return;
    (void)hipMemsetAsync((char*)d_ws + WS_CTL, 0, CTL_ZERO_BYTES, stream);
    Args a{};
    for (int i = 0; i < 16; ++i) a.in[i] = (const float*)d_in[i];
    a.out = (float*)d_out; a.ws = (unsigned char*)d_ws;
#if MK_N_LAUNCHES == 1
    a.ph_lo = 0; a.ph_hi = N_PHASES;
    hipLaunchKernelGGL(mk_fwd, dim3(grid), dim3(NTHR), LDS_BYTES, stream, a);
#else
    for (int p = 0; p < N_PHASES; ++p) { a.ph_lo = p; a.ph_hi = p + 1; hipLaunchKernelGGL(mk_fwd, dim3(grid), dim3(NTHR), LDS_BYTES, stream, a); }
#endif
}
```

```cpp
#include <hip/hip_runtime.h>
#include <cstdio>
#include <cstdint>

#define LAS __attribute__((address_space(3)))
#define GAS __attribute__((address_space(1)))
typedef unsigned short bf16;
typedef short bf16x8 __attribute__((ext_vector_type(8)));
typedef short s16x4 __attribute__((ext_vector_type(4)));
typedef float f32x4 __attribute__((ext_vector_type(4)));
typedef float f32x16 __attribute__((ext_vector_type(16)));
typedef unsigned u32x4 __attribute__((ext_vector_type(4)));
typedef unsigned u32x2 __attribute__((ext_vector_type(2)));
typedef float f32x2_t __attribute__((ext_vector_type(2)));
typedef __bf16 bf16x2_t __attribute__((ext_vector_type(2)));

constexpr int DM = 1024, NBATCH = 4, SEQ = 8192, NTOK = NBATCH * SEQ;
constexpr int PJ = 3072;
constexpr int IN_COLS = 2888;
constexpr int C_RQ = 0, C_RK = 256, C_RV = 512, C_RG = 1024, C_AQ = 1536, C_AK = 2048, C_AV = 2176, C_IQ = 2304, C_IK = 2816, C_IW = 2880;
constexpr int NE = 32, TOPK = 4, MOE_ROWS = NTOK * TOPK + NE * 256;
constexpr int MOE_TILES = MOE_ROWS / 256;
constexpr float EPS = 1e-6f;
constexpr int NWAVES = 8, NTHR = 512;

constexpr size_t MiB = 1u << 20;
constexpr size_t WS_CTL = 0, CTL_ZERO_BYTES = 1 * MiB;
constexpr size_t WS_MOD = 1 * MiB;
constexpr size_t WS_TOPI = 2 * MiB;
constexpr size_t WS_TOPG = 2 * MiB + 512 * 1024;
constexpr size_t WS_BBASE = 3 * MiB;
constexpr size_t WS_ROWINFO = 4 * MiB;
constexpr size_t WS_ROWGATE = 5 * MiB;
constexpr size_t WS_WIN = 8 * MiB;
constexpr size_t WS_WO = 14 * MiB;
constexpr size_t WS_WGU = 16 * MiB;
constexpr size_t WS_WDN = 144 * MiB;
constexpr size_t WS_H0 = 208 * MiB;
constexpr size_t WS_PROJ = 272 * MiB;
constexpr size_t WS_XS = 208 * MiB;
constexpr size_t WS_Y = 208 * MiB;
constexpr size_t WS_KVT = 480 * MiB;
constexpr size_t WS_RPT = 512 * MiB;
constexpr size_t WS_SEL = 528 * MiB;
constexpr size_t WS_MIX = 544 * MiB;
constexpr size_t WS_H2 = 608 * MiB;
constexpr size_t WS_HB = 480 * MiB;
constexpr size_t WS_END = 752 * MiB;
constexpr int CW_GCNT = 1024;
constexpr int CW_BAR = 4096;

constexpr int LDS_BYTES = 147456;
constexpr int RING_BYTES = 131072;
constexpr int TILEE_OFF = 131072;
constexpr int MISC_OFF = 146432;

__device__ __forceinline__ unsigned cvtpk(float lo, float hi) { f32x2_t v = {lo, hi}; bf16x2_t b = __builtin_convertvector(v, bf16x2_t); return __builtin_bit_cast(unsigned, b); }
__device__ __forceinline__ float bflo(unsigned w) { return __builtin_bit_cast(float, w << 16); }
__device__ __forceinline__ float bfhi(unsigned w) { return __builtin_bit_cast(float, w & 0xffff0000u); }
__device__ __forceinline__ float bf2f(bf16 h) { return __builtin_bit_cast(float, (unsigned)h << 16); }
__device__ __forceinline__ bf16 f2bf(float f) { return (bf16)(cvtpk(f, 0.f) & 0xffffu); }
__device__ __forceinline__ float wave_sum(float v) {
#pragma unroll
    for (int o = 1; o < 64; o <<= 1) v += __shfl_xor(v, o);
    return v;
}
__device__ __forceinline__ int mbcnt64(unsigned long long m) { return (int)__builtin_amdgcn_mbcnt_hi((unsigned)(m >> 32), __builtin_amdgcn_mbcnt_lo((unsigned)m, 0u)); }
__device__ __forceinline__ s16x4 trread(const LAS void* p) { typedef short v4i16_t __attribute__((ext_vector_type(4))); return __builtin_bit_cast(s16x4, __builtin_amdgcn_ds_read_tr16_b64_v4i16((LAS v4i16_t*)p)); }
__device__ __forceinline__ bf16x8 cat8(s16x4 lo, s16x4 hi) { return (bf16x8){lo[0], lo[1], lo[2], lo[3], hi[0], hi[1], hi[2], hi[3]}; }
#define MFMA16(a, b, c) __builtin_amdgcn_mfma_f32_16x16x32_bf16((a), (b), (c), 0, 0, 0)
#define MFMA32(a, b, c) __builtin_amdgcn_mfma_f32_32x32x16_bf16((a), (b), (c), 0, 0, 0)

namespace pg8 {
#define PG8_LAS __attribute__((address_space(3)))
typedef unsigned short bf16_t;
typedef short bf16x8 __attribute__((ext_vector_type(8)));
typedef float f32x4 __attribute__((ext_vector_type(4)));
typedef unsigned u32x4 __attribute__((ext_vector_type(4)));
constexpr int BM = 256, BK = 64, HALF = 128, HTB = HALF * BK * 2  , STAGE_BYTES = 8 * HTB, NXCD = 8, WGM = 8;

__host__ __device__ __forceinline__ int lds_byte(int r, int c) { const int st = (r >> 4) * 2 + (c >> 5), rr = r & 15, cc = c & 31, ob = rr * 64 + cc * 2; return st * 1024 + (ob ^ (((ob >> 9) & 1) << 5)); }
__host__ __device__ __forceinline__ void stage_rc(int b, int& R, int& C) { const int st = b / 1024, sb = b % 1024, swz = sb ^ (((sb >> 9) & 1) << 5); R = (st >> 1) * 16 + swz / 64; C = (st & 1) * 32 + (swz % 64) / 2; }
__host__ __device__ __forceinline__ int perm32(int rho) { const int n = rho >> 4, i = rho & 15; return 8 * (i >> 2) + 4 * n + (i & 3); }

struct Unit { int pm, pn, e; size_t bo; };
struct Gemm { const bf16_t* A; const bf16_t* Bt; int M, N, K; };

struct StaticOrder {
    int nM, nN, nwg, G, c;
    __host__ __device__ void init(int M, int N, int G_, int c_) { nM = M / BM; nN = N / BM; nwg = nM * nN; G = G_; c = c_; }
    __host__ __device__ bool next(int i, Unit& u) const {
        const long L = (long)i * G + c; if (L >= nwg) return false;
        int wgid = (int)L; { const int q = nwg / NXCD, r = nwg % NXCD, xcd = wgid % NXCD, off = wgid / NXCD; wgid = (xcd < r ? xcd * (q + 1) : r * (q + 1) + (xcd - r) * q) + off; }
        const int nig = WGM * nN, gid = wgid / nig, fm = gid * WGM, gsz = (nM - fm) < WGM ? (nM - fm) : WGM;
        u.pm = fm + ((wgid % nig) % gsz); u.pn = (wgid % nig) / gsz; u.e = 0; u.bo = 0; return true;
    }
    __device__ __forceinline__ void a_ready(const Unit&) const {}
    __device__ __forceinline__ void done(const Unit&) const {}
};

template <class Epi, class Sched, bool ALIGN_EPI = false, bool SP2 = false>
__device__ __forceinline__ void gemm_phase(PG8_LAS unsigned char* lds, const Gemm g, const Sched& S, const Epi& E) {
    const int tid = threadIdx.x, wid = __builtin_amdgcn_readfirstlane(tid >> 6), lane = tid & 63, wr = wid >> 2, wc = wid & 3, fr = lane & 15, fq = lane >> 4;
    const int K = g.K, nt = K / BK;
    unsigned voffA[2], voffB[2];
#pragma unroll
    for (int i = 0; i < 2; ++i) { int R, C; stage_rc(tid * 16 + i * 8192, R, C); const int Rb = Epi::PERM ? ((R & ~31) + perm32(R & 31)) : R;
        voffA[i] = (unsigned)(R * K + C) * 2u; voffB[i] = (unsigned)(Rb * K + C) * 2u; }
    const size_t kstep = (size_t)(BK * 2);
    const size_t hstep = (size_t)HALF * K * 2;
    const size_t tstep = 2 * hstep;
    const unsigned ldsw = (unsigned)wid * 1024u;
    const int aoff = lds_byte(wr * 64 + fr, fq * 8), boff = lds_byte(wc * 32 + fr, fq * 8);
#define PG8_SA(b, h) (((b) * 2 + (h)) * HTB)
#define PG8_SB(b, h) ((4 + (b) * 2 + (h)) * HTB)
#define PG8_STAGE(bufoff, gbase, voff) do { _Pragma("unroll") for (int _i = 0; _i < 2; ++_i) \
        __builtin_amdgcn_global_load_lds((const unsigned*)((const char*)(gbase) + (voff)[_i]), (PG8_LAS unsigned*)(lds + (bufoff) + ldsw + _i * 8192), 16, 0, 0); } while (0)
#define PG8_LDA(dst, b, h) do { _Pragma("unroll") for (int m = 0; m < 4; ++m) _Pragma("unroll") for (int k = 0; k < 2; ++k) dst[m][k] = *(const PG8_LAS bf16x8*)(lds + PG8_SA(b, h) + aoff + m * 2048 + k * 1024); } while (0)
#define PG8_LDB(dst, b, h) do { _Pragma("unroll") for (int n = 0; n < 2; ++n) _Pragma("unroll") for (int k = 0; k < 2; ++k) dst[n][k] = *(const PG8_LAS bf16x8*)(lds + PG8_SB(b, h) + boff + n * 2048 + k * 1024); } while (0)
#define PG8_MMA(ai, bj, At, Bt) do { __builtin_amdgcn_s_setprio(1); _Pragma("unroll") for (int m = 0; m < 4; ++m) _Pragma("unroll") for (int n = 0; n < 2; ++n) _Pragma("unroll") for (int k = 0; k < 2; ++k) \
        acc[ai][bj][m][n] = __builtin_amdgcn_mfma_f32_16x16x32_bf16(Bt[n][k], At[m][k], acc[ai][bj][m][n], 0, 0, 0); __builtin_amdgcn_s_setprio(0); } while (0)
#define PG8_WAIT_V(n) asm volatile("s_waitcnt vmcnt(" #n ")" ::: "memory")
#define PG8_WAIT_L(n) asm volatile("s_waitcnt lgkmcnt(" #n ")" ::: "memory")
#define PG8_BAR __builtin_amdgcn_s_barrier()
#define PG8_SCHED __builtin_amdgcn_sched_barrier(0)
    Unit cur, nxt; int ui = 0;
    if (!S.next(0, cur)) return;
    f32x4 acc[2][2][4][2];
#pragma unroll
    for (int a = 0; a < 2; ++a)
#pragma unroll
        for (int b = 0; b < 2; ++b)
#pragma unroll
            for (int m = 0; m < 4; ++m)
#pragma unroll
                for (int n = 0; n < 2; ++n) acc[a][b][m][n] = (f32x4){0.f, 0.f, 0.f, 0.f};
    bf16x8 At[4][2], B0[2][2], B1[2][2];
    const char* cA = (const char*)g.A + (size_t)cur.pm * tstep; const char* cB = (const char*)g.Bt + (size_t)cur.pn * tstep + cur.bo;
    S.a_ready(cur);
    if constexpr (SP2) {
        PG8_STAGE(PG8_SB(0, 0), cB, voffB); PG8_STAGE(PG8_SB(0, 1), cB + hstep, voffB); PG8_STAGE(PG8_SA(0, 0), cA, voffA); PG8_STAGE(PG8_SA(0, 1), cA + hstep, voffA);
        if (wr == 1) PG8_BAR;
        PG8_WAIT_V(2); PG8_BAR;
        PG8_STAGE(PG8_SB(1, 0), cB + kstep, voffB); PG8_STAGE(PG8_SA(1, 0), cA + kstep, voffA); PG8_STAGE(PG8_SB(1, 1), cB + hstep + kstep, voffB);
        PG8_WAIT_V(6); PG8_BAR;
    } else {
        PG8_STAGE(PG8_SB(0, 0), cB, voffB); PG8_STAGE(PG8_SA(0, 0), cA, voffA); PG8_STAGE(PG8_SB(0, 1), cB + hstep, voffB); PG8_STAGE(PG8_SA(0, 1), cA + hstep, voffA);
        if (wr == 1) PG8_BAR;
        PG8_WAIT_V(4); PG8_BAR;
        PG8_STAGE(PG8_SB(1, 0), cB + kstep, voffB); PG8_STAGE(PG8_SA(1, 0), cA + kstep, voffA); PG8_STAGE(PG8_SB(1, 1), cB + hstep + kstep, voffB);
        PG8_WAIT_V(6); PG8_BAR;
    }
    for (;;) {
        const bool has_next = S.next(ui + 1, nxt);
        const char* nA = has_next ? (const char*)g.A + (size_t)nxt.pm * tstep : cA; const char* nB = has_next ? (const char*)g.Bt + (size_t)nxt.pn * tstep + nxt.bo : cB;
        for (int t = 0; t < nt; t += 2) {
            const bool last = (t == nt - 2);
            const char* a1 = cA + (size_t)(t + 1) * kstep;
            const char* a2 = last ? nA : cA + (size_t)(t + 2) * kstep; const char* b2 = last ? nB : cB + (size_t)(t + 2) * kstep;
            const char* a3 = a2 + kstep; const char* b3 = b2 + kstep;
            if (last && has_next) S.a_ready(nxt);
            if constexpr (SP2) {
            PG8_LDB(B0, 0, 0); PG8_LDB(B1, 0, 1); PG8_SCHED; PG8_LDA(At, 0, 0); PG8_STAGE(PG8_SA(1, 1), a1 + hstep, voffA);
            PG8_WAIT_V(8); PG8_WAIT_L(0); PG8_BAR; PG8_MMA(0, 0, At, B0); PG8_MMA(0, 1, At, B1); PG8_BAR; PG8_SCHED;
            PG8_LDA(At, 0, 1); PG8_STAGE(PG8_SB(0, 0), b2, voffB); PG8_STAGE(PG8_SB(0, 1), b2 + hstep, voffB); PG8_STAGE(PG8_SA(0, 0), a2, voffA);
            PG8_WAIT_V(8); PG8_WAIT_L(0); PG8_BAR; PG8_MMA(1, 0, At, B0); PG8_MMA(1, 1, At, B1); PG8_BAR; PG8_SCHED;
            PG8_LDB(B0, 1, 0); PG8_LDB(B1, 1, 1); PG8_SCHED; PG8_LDA(At, 1, 0); PG8_STAGE(PG8_SA(0, 1), a2 + hstep, voffA);
            PG8_WAIT_V(8); PG8_WAIT_L(0); PG8_BAR; PG8_MMA(0, 0, At, B0); PG8_MMA(0, 1, At, B1); PG8_BAR; PG8_SCHED;
            PG8_LDA(At, 1, 1); PG8_STAGE(PG8_SB(1, 0), b3, voffB); PG8_STAGE(PG8_SB(1, 1), b3 + hstep, voffB); PG8_STAGE(PG8_SA(1, 0), a3, voffA);
            PG8_WAIT_V(8); PG8_WAIT_L(0); PG8_BAR; PG8_MMA(1, 0, At, B0); PG8_MMA(1, 1, At, B1); PG8_BAR; PG8_SCHED;
            } else {
            PG8_LDB(B0, 0, 0); PG8_SCHED; PG8_LDA(At, 0, 0); PG8_STAGE(PG8_SA(1, 1), a1 + hstep, voffA);
            PG8_WAIT_L(8); PG8_BAR; PG8_WAIT_L(0); PG8_MMA(0, 0, At, B0); PG8_BAR; PG8_SCHED;
            PG8_LDB(B1, 0, 1); PG8_STAGE(PG8_SB(0, 0), b2, voffB);
            PG8_BAR; PG8_WAIT_L(0); PG8_MMA(0, 1, At, B1); PG8_BAR;
            PG8_LDA(At, 0, 1); PG8_STAGE(PG8_SA(0, 0), a2, voffA);
            PG8_BAR; PG8_WAIT_L(0); PG8_MMA(1, 0, At, B0); PG8_BAR; PG8_SCHED;
            PG8_STAGE(PG8_SB(0, 1), b2 + hstep, voffB);
            PG8_WAIT_V(6); PG8_BAR; PG8_MMA(1, 1, At, B1); PG8_BAR;
            PG8_LDB(B0, 1, 0); PG8_SCHED; PG8_LDA(At, 1, 0); PG8_STAGE(PG8_SA(0, 1), a2 + hstep, voffA);
            PG8_WAIT_L(8); PG8_BAR; PG8_WAIT_L(0); PG8_MMA(0, 0, At, B0); PG8_BAR; PG8_SCHED;
            PG8_LDB(B1, 1, 1); PG8_STAGE(PG8_SB(1, 0), b3, voffB);
            PG8_BAR; PG8_WAIT_L(0); PG8_MMA(0, 1, At, B1); PG8_BAR;
            PG8_LDA(At, 1, 1); PG8_STAGE(PG8_SA(1, 0), a3, voffA);
            PG8_BAR; PG8_WAIT_L(0); PG8_MMA(1, 0, At, B0); PG8_BAR; PG8_SCHED;
            PG8_STAGE(PG8_SB(1, 1), b3 + hstep, voffB);
            PG8_WAIT_V(6); PG8_BAR; PG8_MMA(1, 1, At, B1); PG8_BAR;
            }
        }
        if constexpr (ALIGN_EPI) { if (wr == 0) PG8_BAR; }
        if constexpr (!Epi::AFTER_DRAIN) { E(acc, cur, wr, wc, fr, fq); S.done(cur); }
        if (!has_next) break;
#pragma unroll
        for (int a = 0; a < 2; ++a)
#pragma unroll
            for (int b = 0; b < 2; ++b)
#pragma unroll
                for (int m = 0; m < 4; ++m)
#pragma unroll
                    for (int n = 0; n < 2; ++n) acc[a][b][m][n] = (f32x4){0.f, 0.f, 0.f, 0.f};
        cur = nxt; cA = nA; cB = nB; ++ui;
        if constexpr (ALIGN_EPI) { if (wr == 1) PG8_BAR; }
    }
    PG8_WAIT_V(0);
    if constexpr (!ALIGN_EPI) { if (wr == 0) PG8_BAR; }
    PG8_BAR;
    if constexpr (Epi::AFTER_DRAIN) { E.fused(acc, cur, wr, wc, fr, fq, lds, wid, lane); S.done(cur); }
#undef PG8_SA
#undef PG8_SB
#undef PG8_STAGE
#undef PG8_LDA
#undef PG8_LDB
#undef PG8_MMA
#undef PG8_WAIT_V
#undef PG8_WAIT_L
#undef PG8_BAR
#undef PG8_SCHED
}
}

struct EpiProj {
    static constexpr bool PERM = true, AFTER_DRAIN = false;
    bf16* O; int ldc;
    __device__ __forceinline__ void operator()(const f32x4 (&acc)[2][2][4][2], const pg8::Unit& u, int wr, int wc, int fr, int fq) const {
        const int row0 = u.pm * 256 + wr * 64 + fr; const int col0 = u.pn * 256 + wc * 32 + 8 * fq;
#pragma unroll
        for (int ai = 0; ai < 2; ++ai)
#pragma unroll
            for (int m = 0; m < 4; ++m) { bf16* rowp = O + (size_t)(row0 + ai * 128 + m * 16) * ldc + col0;
#pragma unroll
                for (int bj = 0; bj < 2; ++bj) { const f32x4 v0 = acc[ai][bj][m][0], v1 = acc[ai][bj][m][1];
                    u32x4 w; w.x = cvtpk(v0[0], v0[1]); w.y = cvtpk(v0[2], v0[3]); w.z = cvtpk(v1[0], v1[1]); w.w = cvtpk(v1[2], v1[3]);
                    *(u32x4*)(rowp + bj * 128) = w; } }
    }
};
struct EpiX1 {
    static constexpr bool PERM = false, AFTER_DRAIN = false;
    const float* x; const float* mod; float* out;
    __device__ __forceinline__ void operator()(const f32x4 (&acc)[2][2][4][2], const pg8::Unit& u, int wr, int wc, int fr, int fq) const {
        const int col0 = u.pn * 256 + wc * 32 + 4 * fq; const int b = (u.pm * 256) / SEQ;
        f32x4 g[2][2];
#pragma unroll
        for (int bj = 0; bj < 2; ++bj)
#pragma unroll
            for (int n = 0; n < 2; ++n) g[bj][n] = *(const f32x4*)(mod + (size_t)b * 6144 + 2 * 1024 + col0 + bj * 128 + n * 16);
#pragma unroll
        for (int ai = 0; ai < 2; ++ai)
#pragma unroll
            for (int m = 0; m < 4; ++m) { const size_t off = (size_t)(u.pm * 256 + ai * 128 + wr * 64 + m * 16 + fr) * DM + col0;
#pragma unroll
                for (int bj = 0; bj < 2; ++bj)
#pragma unroll
                    for (int n = 0; n < 2; ++n) { const f32x4 xv = *(const f32x4*)(x + off + bj * 128 + n * 16); *(f32x4*)(out + off + bj * 128 + n * 16) = xv + g[bj][n] * acc[ai][bj][m][n]; }
                if (m & 1) asm volatile("" ::: "memory"); }
    }
};
__device__ __forceinline__ float glu_f(float gate, float up) {
    gate = fminf(gate, 7.0f); up = fminf(fmaxf(up, -7.0f), 7.0f);
    const float sg = 1.0f / (1.0f + __expf(-1.702f * gate));
    return (up + 1.0f) * (gate * sg);
}
struct EpiGlu {
    static constexpr bool PERM = true, AFTER_DRAIN = false;
    bf16* H; const float* b_gu;
    __device__ __forceinline__ void operator()(const f32x4 (&acc)[2][2][4][2], const pg8::Unit& u, int wr, int wc, int fr, int fq) const {
        const int row0 = u.pm * 256 + wr * 64 + fr; const int c0 = u.pn * 128 + wc * 32 + 8 * fq;
        const float* bg = b_gu + (size_t)u.e * 2048 + c0; const float* bu = bg + 1024;
        const f32x4 bg0 = *(const f32x4*)bg, bg1 = *(const f32x4*)(bg + 4), bu0 = *(const f32x4*)bu, bu1 = *(const f32x4*)(bu + 4);
#pragma unroll
        for (int ai = 0; ai < 2; ++ai)
#pragma unroll
            for (int m = 0; m < 4; ++m) {
                const f32x4 g0 = acc[ai][0][m][0] + bg0, g1 = acc[ai][0][m][1] + bg1, u0 = acc[ai][1][m][0] + bu0, u1 = acc[ai][1][m][1] + bu1;
                u32x4 w; w.x = cvtpk(glu_f(g0[0], u0[0]), glu_f(g0[1], u0[1])); w.y = cvtpk(glu_f(g0[2], u0[2]), glu_f(g0[3], u0[3]));
                w.z = cvtpk(glu_f(g1[0], u1[0]), glu_f(g1[1], u1[1])); w.w = cvtpk(glu_f(g1[2], u1[2]), glu_f(g1[3], u1[3]));
                *(u32x4*)(H + (size_t)(row0 + ai * 128 + m * 16) * DM + c0) = w; }
    }
};
struct EpiDown {
    static constexpr bool PERM = true, AFTER_DRAIN = false;
    bf16* Y; const float* b_down; const int* rowinfo; const float* rowgate;
    __device__ __forceinline__ void operator()(const f32x4 (&acc)[2][2][4][2], const pg8::Unit& u, int wr, int wc, int fr, int fq) const {
        const int row0 = u.pm * 256 + wr * 64 + fr; const int col0 = u.pn * 256 + wc * 32 + 8 * fq;
        const float* bd = b_down + (size_t)u.e * 1024 + col0;
        f32x4 bv[2][2];
#pragma unroll
        for (int bj = 0; bj < 2; ++bj)
#pragma unroll
            for (int n = 0; n < 2; ++n) bv[bj][n] = *(const f32x4*)(bd + bj * 128 + 4 * n);
#pragma unroll
        for (int ai = 0; ai < 2; ++ai)
#pragma unroll
            for (int m = 0; m < 4; ++m) { const int row = row0 + ai * 128 + m * 16; const int dst = rowinfo[row]; const float gt = rowgate[row];
                if (dst >= 0) { bf16* rowp = Y + (size_t)dst * DM + col0;
#pragma unroll
                    for (int bj = 0; bj < 2; ++bj) { const f32x4 v0 = (acc[ai][bj][m][0] + bv[bj][0]) * gt, v1 = (acc[ai][bj][m][1] + bv[bj][1]) * gt;
                        u32x4 w; w.x = cvtpk(v0[0], v0[1]); w.y = cvtpk(v0[2], v0[3]); w.z = cvtpk(v1[0], v1[1]); w.w = cvtpk(v1[2], v1[3]);
                        *(u32x4*)(rowp + bj * 128) = w; } } }
    }
};
struct GroupedOrder {
    const LAS int* tile_e; int ntiles, nN, G, c; size_t estride;
    __device__ __forceinline__ bool next(int i, pg8::Unit& u) const {
        int pm, pn;
        if (G == 256) { const int x = c & 7, j = c >> 3, rpx = 32 / nN; pn = j % nN; pm = i * (8 * rpx) + x * rpx + j / nN; }
        else { const long L = (long)i * G + c; pm = (int)(L / nN); pn = (int)(L % nN); }
        if (pm >= ntiles) return false;
        u.pm = pm; u.pn = pn; u.e = __builtin_amdgcn_readfirstlane(tile_e[pm]); u.bo = (size_t)u.e * estride; return true;
    }
    __device__ __forceinline__ void a_ready(const pg8::Unit&) const {}
    __device__ __forceinline__ void done(const pg8::Unit&) const {}
};

#define XB_TMO      128
#define XB_XCNT(j)  (256  + 64 * (j))
#define XB_XSUB(j)  (1280 + 64 * (j))
#define XB_XGEN(j)  (2304 + 64 * (j))
#define XB_TOP      3328
#define XB_TOPGEN   3392
#define XCD_BAR_WORDS 3456
#define XB_SPIN_CAP (1u << 18)

__device__ __forceinline__ unsigned xb_ld(unsigned* p)              { return __hip_atomic_load(p, __ATOMIC_RELAXED, __HIP_MEMORY_SCOPE_AGENT); }
__device__ __forceinline__ unsigned xb_add(unsigned* p, unsigned v) { return __hip_atomic_fetch_add(p, v, __ATOMIC_RELAXED, __HIP_MEMORY_SCOPE_AGENT); }
__device__ __forceinline__ unsigned xb_xcc_id() { return (unsigned)__builtin_amdgcn_s_getreg((3 << 11) | 20) & 0xFu; }
#define XB_SPIN(cond, bar) do { unsigned _sp = 0; while (cond) { __builtin_amdgcn_s_sleep(1); \
    if ((++_sp & 255u) == 0u) { if (xb_ld(&(bar)[XB_TMO])) break; if (_sp > XB_SPIN_CAP) { atomicAdd(&(bar)[XB_TMO], 1u); break; } } } } while (0)

struct XcdBarrier {
    unsigned* bar; unsigned x;
    volatile LAS unsigned* st;
};

__device__ __forceinline__ XcdBarrier xcd_barrier_post(unsigned* bar, volatile LAS unsigned* st) {
    XcdBarrier b; b.bar = bar; b.x = xb_xcc_id(); b.st = st;
    if (threadIdx.x == 0) (void)xb_add(&bar[XB_XCNT(b.x)], 1u);
    return b;
}
__device__ __forceinline__ void xcd_barrier_complete(unsigned* bar, unsigned x, unsigned& nloc, unsigned& nx) {
    const unsigned G = gridDim.x * gridDim.y * gridDim.z;
    unsigned sum, cnt, mine, sp = 0u;
    for (;;) {
        sum = 0u; cnt = 0u; mine = 0u;
#pragma unroll
        for (unsigned j = 0; j < 16; ++j) { const unsigned c = xb_ld(&bar[XB_XCNT(j)]); sum += c; cnt += (c > 0u) ? 1u : 0u; mine = (j == x) ? c : mine; }
        if (sum == G) break;
        __builtin_amdgcn_s_sleep(1);
        if ((++sp & 255u) == 0u) { if (xb_ld(&bar[XB_TMO])) break; if (sp > XB_SPIN_CAP) { atomicAdd(&bar[XB_TMO], 1u); break; } }
    }
    nloc = mine > 0u ? mine : 1u; nx = cnt > 0u ? cnt : 1u;
}

__device__ __forceinline__ void xcd_barrier(const XcdBarrier& b) {
    asm volatile("s_waitcnt vmcnt(0)" ::: "memory");
    __syncthreads();
    if (threadIdx.x == 0) {
        unsigned* bar = b.bar;
        __builtin_amdgcn_s_waitcnt(0);
        unsigned nloc = b.st[0], nx = b.st[1];
        if (nloc == 0u) { xcd_barrier_complete(bar, b.x, nloc, nx); b.st[0] = nloc; b.st[1] = nx; }
        const unsigned old = xb_add(&bar[XB_XSUB(b.x)], 1u);
        const unsigned gen = old / nloc;
        if (old + 1u == (gen + 1u) * nloc) {
            __builtin_amdgcn_fence(__ATOMIC_RELEASE, "agent");
            asm volatile("s_waitcnt vmcnt(0)" ::: "memory");
            const unsigned og = xb_add(&bar[XB_TOP], 1u);
            const unsigned tg = og / nx;
            if (og + 1u == (tg + 1u) * nx) xb_add(&bar[XB_TOPGEN], 1u);
            else XB_SPIN(xb_ld(&bar[XB_TOPGEN]) == tg, bar);
            __builtin_amdgcn_fence(__ATOMIC_ACQUIRE, "agent");
            xb_add(&bar[XB_XGEN(b.x)], 1u);
            asm volatile("s_waitcnt vmcnt(0)" ::: "memory");
        } else {
            XB_SPIN(xb_ld(&bar[XB_XGEN(b.x)]) == gen, bar);
            __builtin_amdgcn_fence(__ATOMIC_ACQUIRE, "agent");
            asm volatile("s_waitcnt vmcnt(0)" ::: "memory");
        }
    }
    __syncthreads();
}

struct Frame {
    LAS unsigned char* lds;
    volatile LAS unsigned* MISC;
    unsigned* ctl;
    int tid, lane, wave, G, bid;
    const float *x, *c, *ada_w, *ada_b, *norm1_g, *w_in, *mix_scale, *w_o, *norm2_g, *router_w, *router_b, *w_gu, *b_gu, *w_down, *b_down, *final_g;
    float* out; unsigned char* ws;
    unsigned long long tacc;
};
__device__ __forceinline__ float log2gamma(int h) { return log2f(1.0f - exp2f(-5.0f - (float)h)); }

template <class RowMap>
__device__ __forceinline__ void transpose_item(const float* W, int N, bf16* WT, int K, const float* kscale, LAS float* scr, int kb, int nb, int lane, RowMap rm) {
    const int k0 = 64 * kb, n0 = 64 * nb;
#pragma unroll 4
    for (int i = 0; i < 16; ++i) {
        const int kk = 4 * i + (lane >> 4), nn = 4 * (lane & 15);
        f32x4 v = (f32x4){0.f, 0.f, 0.f, 0.f};
        if (n0 + nn < N) v = *(const f32x4*)(W + (size_t)(k0 + kk) * N + n0 + nn);
        if (kscale) v = v * kscale[k0 + kk];
        LAS float* s = scr + kk * 65 + nn; s[0] = v[0]; s[1] = v[1]; s[2] = v[2]; s[3] = v[3];
    }
    asm volatile("s_waitcnt lgkmcnt(0)" ::: "memory");
    const int cch = lane & 7;
#pragma unroll
    for (int j = 0; j < 8; ++j) {
        const int n = 8 * j + (lane >> 3); const LAS float* s = scr + (8 * cch) * 65 + n;
        u32x4 o; o.x = cvtpk(s[0 * 65], s[1 * 65]); o.y = cvtpk(s[2 * 65], s[3 * 65]); o.z = cvtpk(s[4 * 65], s[5 * 65]); o.w = cvtpk(s[6 * 65], s[7 * 65]);
        if (n0 + n < N) *(u32x4*)(WT + (size_t)rm(n0 + n) * K + k0 + 8 * cch) = o;
    }
    asm volatile("s_waitcnt lgkmcnt(0)" ::: "memory");
}
struct RmId { __device__ __forceinline__ int operator()(int n) const { return n; } };
struct RmGu { __device__ __forceinline__ int operator()(int n) const { const int j = n & 1023; return (j >> 7) * 256 + (n >> 10) * 128 + (j & 127); } };

__device__ __forceinline__ void phase_p0a(Frame& F) {
    if (F.bid < 96) {
        LAS float* sc = (LAS float*)F.lds;
        LAS float* part = (LAS float*)(F.lds + 16384);
        for (int i = F.tid; i < 1024; i += NTHR) {
#pragma unroll
            for (int b = 0; b < 4; ++b) { const float cv = F.c[b * 1024 + i]; sc[i * 4 + b] = cv / (1.0f + __expf(-cv)); }
        }
        __syncthreads();
        const int j0 = F.bid * 64;
        float a0 = 0.f, a1 = 0.f, a2 = 0.f, a3 = 0.f;
#pragma unroll 8
        for (int ii = 0; ii < 128; ++ii) {
            const int i = F.wave * 128 + ii; const float w = F.ada_w[(size_t)i * 6144 + j0 + F.lane];
            const f32x4 s4 = *(const LAS f32x4*)(sc + i * 4);
            a0 += s4[0] * w; a1 += s4[1] * w; a2 += s4[2] * w; a3 += s4[3] * w;
        }
        part[(F.wave * 4 + 0) * 64 + F.lane] = a0; part[(F.wave * 4 + 1) * 64 + F.lane] = a1; part[(F.wave * 4 + 2) * 64 + F.lane] = a2; part[(F.wave * 4 + 3) * 64 + F.lane] = a3;
        __syncthreads();
        if (F.tid < 256) { const int b = F.tid >> 6, l = F.tid & 63; float s = F.ada_b[j0 + l];
#pragma unroll
            for (int w = 0; w < 8; ++w) s += part[(w * 4 + b) * 64 + l];
            ((float*)(F.ws + WS_MOD))[b * 6144 + j0 + l] = s; }
        __syncthreads();
    }
    { int* ri = (int*)(F.ws + WS_ROWINFO); for (int i = F.bid * NTHR + F.tid; i < MOE_ROWS; i += F.G * NTHR) ri[i] = -1; }
    LAS float* scr = (LAS float*)(F.lds + F.wave * 16640);
    const int gw = F.bid * NWAVES + F.wave, NGW = F.G * NWAVES;
    constexpr int I_IN = 16 * 46, I_O = 16 * 16, I_GU = 32 * 16 * 32, I_DN = 32 * 16 * 16, NITEMS = I_IN + I_O + I_GU + I_DN;
    for (int it = gw; it < NITEMS; it += NGW) {
        int r = it;
        if (r < I_GU) { const int e = r / 512, q = r % 512; transpose_item(F.w_gu + (size_t)e * 1024 * 2048, 2048, (bf16*)(F.ws + WS_WGU) + (size_t)e * 2048 * 1024, 1024, nullptr, scr, q / 32, q % 32, F.lane, RmGu()); continue; } r -= I_GU;
        if (r < I_DN) { const int e = r / 256, q = r % 256; transpose_item(F.w_down + (size_t)e * 1024 * 1024, 1024, (bf16*)(F.ws + WS_WDN) + (size_t)e * 1024 * 1024, 1024, nullptr, scr, q / 16, q % 16, F.lane, RmId()); continue; } r -= I_DN;
        if (r < I_IN) { transpose_item(F.w_in, IN_COLS, (bf16*)(F.ws + WS_WIN), 1024, nullptr, scr, r / 46, r % 46, F.lane, RmId()); continue; } r -= I_IN;
        transpose_item(F.w_o, 1024, (bf16*)(F.ws + WS_WO), 1024, F.mix_scale, scr, r / 16, r % 16, F.lane, RmId());
    }
}

__device__ __forceinline__ void phase_p0b(Frame& F) {
    const int gw = F.bid * NWAVES + F.wave, NGW = F.G * NWAVES;
    const float* mod = (const float*)(F.ws + WS_MOD); bf16* h0 = (bf16*)(F.ws + WS_H0);
    for (int m = gw; m < NTOK; m += NGW) {
        const int b = m / SEQ;
        const f32x4* xr = (const f32x4*)(F.x + (size_t)m * DM) + F.lane;
        f32x4 v[4]; float s = 0.f;
#pragma unroll
        for (int j = 0; j < 4; ++j) { v[j] = xr[64 * j]; s += (v[j][0] * v[j][0] + v[j][1] * v[j][1]) + (v[j][2] * v[j][2] + v[j][3] * v[j][3]); }
        const float rstd = rsqrtf(wave_sum(s) * (1.f / DM) + EPS);
        u32x2* o8 = (u32x2*)(h0 + (size_t)m * DM) + F.lane;
#pragma unroll
        for (int j = 0; j < 4; ++j) { const int col = 4 * F.lane + 256 * j;
            const f32x4 g = *(const f32x4*)(F.norm1_g + col), sh = *(const f32x4*)(mod + b * 6144 + col), sc = *(const f32x4*)(mod + b * 6144 + 1024 + col);
            const f32x4 y = (v[j] * rstd) * g * (sc + 1.0f) + sh;
            u32x2 w; w.x = cvtpk(y[0], y[1]); w.y = cvtpk(y[2], y[3]); o8[64 * j] = w; }
    }
}

constexpr int VSTR = 144, KSTR = 80;
__device__ __forceinline__ void ret_stage_v(Frame& F, const bf16* proj, int tok0, int h, LAS bf16* Vs) {
    const int row = F.tid >> 2, q = F.tid & 3; const bf16* src = proj + (size_t)(tok0 + row) * PJ + C_RV + h * 128 + q * 32;
#pragma unroll
    for (int i = 0; i < 4; ++i) *(LAS u32x4*)(Vs + row * VSTR + q * 32 + 8 * i) = *(const u32x4*)(src + 8 * i);
}
__device__ __forceinline__ void ret_stage64(Frame& F, const bf16* src0, size_t pitch, LAS bf16* Ds) {
    const int row = F.tid >> 2, q = F.tid & 3; const bf16* src = src0 + (size_t)row * pitch + q * 16;
#pragma unroll
    for (int i = 0; i < 2; ++i) *(LAS u32x4*)(Ds + row * KSTR + q * 16 + 8 * i) = *(const u32x4*)(src + 8 * i);
}
__device__ __forceinline__ void ret_a_item(Frame& F, int item) {
    const bf16* proj = (const bf16*)(F.ws + WS_PROJ); float* kvt = (float*)(F.ws + WS_KVT) + (size_t)item * 8192;
    const int bh = item >> 6, n = item & 63, b = bh >> 2, h = bh & 3, tok0 = b * SEQ + n * 128;
    LAS bf16* Vs = (LAS bf16*)F.lds; LAS bf16* Ks = (LAS bf16*)(F.lds + 128 * VSTR * 2);
    const float lg = log2gamma(h);
    ret_stage_v(F, proj, tok0, h, Vs);
    { const int row = F.tid >> 2, q = F.tid & 3; const bf16* src = proj + (size_t)(tok0 + row) * PJ + C_RK + h * 64 + q * 16; const float dk = 0.125f * exp2f((float)(127 - row) * lg);
#pragma unroll
      for (int i = 0; i < 2; ++i) { const u32x4 w = *(const u32x4*)(src + 8 * i); u32x4 o;
          o.x = cvtpk(bflo(w.x) * dk, bfhi(w.x) * dk); o.y = cvtpk(bflo(w.y) * dk, bfhi(w.y) * dk); o.z = cvtpk(bflo(w.z) * dk, bfhi(w.z) * dk); o.w = cvtpk(bflo(w.w) * dk, bfhi(w.w) * dk);
          *(LAS u32x4*)(Ks + row * KSTR + q * 16 + 8 * i) = o; } }
    __syncthreads();
    const int lane = F.lane, n16 = lane & 15, c = lane >> 4, q4 = n16 >> 2, p4 = lane & 3, e0 = 16 * F.wave;
    f32x4 acc[4];
#pragma unroll
    for (int dt = 0; dt < 4; ++dt) acc[dt] = (f32x4){0.f, 0.f, 0.f, 0.f};
#pragma unroll
    for (int s = 0; s < 4; ++s) {
        const LAS bf16* ap = Vs + (32 * s + 4 * c + q4) * VSTR + e0 + 4 * p4;
        const bf16x8 A = cat8(trread(ap), trread(ap + 16 * VSTR));
#pragma unroll
        for (int dt = 0; dt < 4; ++dt) { const LAS bf16* bp = Ks + (32 * s + 4 * c + q4) * KSTR + 16 * dt + 4 * p4;
            const bf16x8 B = cat8(trread(bp), trread(bp + 16 * KSTR)); acc[dt] = MFMA16(A, B, acc[dt]); }
    }
#pragma unroll
    for (int dt = 0; dt < 4; ++dt)
#pragma unroll
        for (int r = 0; r < 4; ++r) kvt[(e0 + 4 * c + r) * 64 + 16 * dt + n16] = acc[dt][r];
    __syncthreads();
}
__device__ __forceinline__ void ret_scan(Frame& F) {
    const float* kvt = (const float*)(F.ws + WS_KVT); bf16* rpt = (bf16*)(F.ws + WS_RPT);
    for (int g = F.bid * NTHR + F.tid; g < 16 * 8192; g += F.G * NTHR) {
        const int bh = g >> 13, ed = g & 8191, h = bh & 3; const float gC = exp2f(128.0f * log2gamma(h));
        float R = 0.f; const size_t base = (size_t)bh * 64 * 8192 + ed;
#pragma unroll 8
        for (int n = 0; n < 64; ++n) { const float kv = kvt[base + (size_t)n * 8192]; rpt[base + (size_t)n * 8192] = f2bf(R); R = R * gC + kv; }
    }
}
__device__ __forceinline__ void ret_c_item(Frame& F, int item) {
    const bf16* proj = (const bf16*)(F.ws + WS_PROJ); const bf16* rpt = (const bf16*)(F.ws + WS_RPT) + (size_t)item * 8192; bf16* mix = (bf16*)(F.ws + WS_MIX);
    const int bh = item >> 6, n = item & 63, b = bh >> 2, h = bh & 3, tok0 = b * SEQ + n * 128;
    LAS bf16* Qs = (LAS bf16*)F.lds; LAS bf16* Ks = Qs + 128 * KSTR; LAS bf16* Vs = Ks + 128 * KSTR; LAS bf16* Rs = Vs + 128 * VSTR;
    const float lg = log2gamma(h);
    ret_stage64(F, proj + (size_t)tok0 * PJ + C_RQ + h * 64, PJ, Qs);
    ret_stage64(F, proj + (size_t)tok0 * PJ + C_RK + h * 64, PJ, Ks);
    ret_stage_v(F, proj, tok0, h, Vs);
    ret_stage64(F, rpt, 64, Rs);
    __syncthreads();
    const int lane = F.lane, n16 = lane & 15, c = lane >> 4, q4 = n16 >> 2, p4 = lane & 3, w = F.wave, i0 = 16 * w, il = i0 + n16;
    bf16x8 qf[2];
#pragma unroll
    for (int s = 0; s < 2; ++s) qf[s] = *(const LAS bf16x8*)(Qs + il * KSTR + 32 * s + 8 * c);
    f32x4 oin[8], ocr[8];
#pragma unroll
    for (int et = 0; et < 8; ++et) { oin[et] = (f32x4){0.f, 0.f, 0.f, 0.f}; ocr[et] = (f32x4){0.f, 0.f, 0.f, 0.f}; }
    const int nsp = (w >> 1) + 1;
    for (int sp = 0; sp < nsp; ++sp) {
        unsigned pw[4];
#pragma unroll
        for (int t2 = 0; t2 < 2; ++t2) { const int jt = 2 * sp + t2;
            const bf16x8 k0 = *(const LAS bf16x8*)(Ks + (16 * jt + n16) * KSTR + 8 * c), k1 = *(const LAS bf16x8*)(Ks + (16 * jt + n16) * KSTR + 32 + 8 * c);
            f32x4 st = MFMA16(k0, qf[0], ((f32x4){0.f, 0.f, 0.f, 0.f})); st = MFMA16(k1, qf[1], st);
            float pv[4];
#pragma unroll
            for (int r = 0; r < 4; ++r) { const int j = 16 * jt + 4 * c + r; const float f = (il >= j) ? 0.125f * exp2f((float)(il - j) * lg) : 0.f; pv[r] = st[r] * f; }
            pw[2 * t2] = cvtpk(pv[0], pv[1]); pw[2 * t2 + 1] = cvtpk(pv[2], pv[3]); }
        const bf16x8 P = __builtin_bit_cast(bf16x8, ((u32x4){pw[0], pw[1], pw[2], pw[3]}));
#pragma unroll
        for (int et = 0; et < 8; ++et) { const LAS bf16* ap = Vs + (32 * sp + 4 * c + q4) * VSTR + 16 * et + 4 * p4;
            const bf16x8 A = cat8(trread(ap), trread(ap + 16 * VSTR)); oin[et] = MFMA16(A, P, oin[et]); }
    }
#pragma unroll
    for (int et = 0; et < 8; ++et)
#pragma unroll
        for (int s = 0; s < 2; ++s) { const bf16x8 rf = *(const LAS bf16x8*)(Rs + (16 * et + n16) * KSTR + 32 * s + 8 * c); ocr[et] = MFMA16(rf, qf[s], ocr[et]); }
    const float qd = exp2f((float)(il + 1) * lg);
    float ss = 0.f;
#pragma unroll
    for (int et = 0; et < 8; ++et) { oin[et] = oin[et] + ocr[et] * qd; ss += (oin[et][0] * oin[et][0] + oin[et][1] * oin[et][1]) + (oin[et][2] * oin[et][2] + oin[et][3] * oin[et][3]); }
    ss += __shfl_xor(ss, 16); ss += __shfl_xor(ss, 32);
    const float rstd = rsqrtf(ss * (1.f / 128.f) + EPS);
    const bf16* gp = proj + (size_t)(tok0 + il) * PJ + C_RG + h * 128 + 4 * c; bf16* op = mix + (size_t)(tok0 + il) * DM + h * 128 + 4 * c;
#pragma unroll
    for (int et = 0; et < 8; ++et) { const u32x2 gw = *(const u32x2*)(gp + 16 * et);
        const float g0 = bflo(gw.x), g1 = bfhi(gw.x), g2 = bflo(gw.y), g3 = bfhi(gw.y);
        const float y0 = g0 / (1.f + __expf(-g0)) * (oin[et][0] * rstd), y1 = g1 / (1.f + __expf(-g1)) * (oin[et][1] * rstd), y2 = g2 / (1.f + __expf(-g2)) * (oin[et][2] * rstd), y3 = g3 / (1.f + __expf(-g3)) * (oin[et][3] * rstd);
        u32x2 o; o.x = cvtpk(y0, y1); o.y = cvtpk(y2, y3); *(u32x2*)(op + 16 * et) = o; }
    __syncthreads();
}

constexpr int QT = 64, KT = 64, CAP = 512, CAP_TRIG = CAP - KT, NSEL = 256, NREG = CAP / 64;
constexpr int KTS = 72;
constexpr int CAND_BYTES = QT * CAP * 4, KTILE_BYTES = KT * KTS * 2;
constexpr float WSCALE = 0.125f * 0.35355339059327373f;
__device__ __forceinline__ unsigned fmap(float s) { const unsigned u = __builtin_bit_cast(unsigned, s); return (u & 0x80000000u) ? ~u : (u | 0x80000000u); }
__device__ __forceinline__ float funmap(unsigned m) { const unsigned u = (m & 0x80000000u) ? (m ^ 0x80000000u) : ~m; return __builtin_bit_cast(float, u); }
#define DPP_ROR(v, n) ((unsigned)__builtin_amdgcn_update_dpp(0, (int)(v), 0x120 + (n), 0xf, 0xf, false))
#define DPP_SHR0(v, n) ((unsigned)__builtin_amdgcn_update_dpp(0, (int)(v), 0x110 + (n), 0xf, 0xf, true))
__device__ __forceinline__ unsigned wave_umin(unsigned v) {
    v = min(v, DPP_ROR(v, 1)); v = min(v, DPP_ROR(v, 2)); v = min(v, DPP_ROR(v, 4)); v = min(v, DPP_ROR(v, 8));
    const unsigned a = __builtin_amdgcn_readlane(v, 0), b = __builtin_amdgcn_readlane(v, 16), c = __builtin_amdgcn_readlane(v, 32), d = __builtin_amdgcn_readlane(v, 48);
    return min(min(a, b), min(c, d));
}
__device__ __forceinline__ unsigned wave_umax(unsigned v) {
    v = max(v, DPP_ROR(v, 1)); v = max(v, DPP_ROR(v, 2)); v = max(v, DPP_ROR(v, 4)); v = max(v, DPP_ROR(v, 8));
    const unsigned a = __builtin_amdgcn_readlane(v, 0), b = __builtin_amdgcn_readlane(v, 16), c = __builtin_amdgcn_readlane(v, 32), d = __builtin_amdgcn_readlane(v, 48);
    return max(max(a, b), max(c, d));
}
__device__ __forceinline__ unsigned wave_scan_incl(unsigned v, int lane) {
    v += DPP_SHR0(v, 1); v += DPP_SHR0(v, 2); v += DPP_SHR0(v, 4); v += DPP_SHR0(v, 8);
    const unsigned t0 = __builtin_amdgcn_readlane(v, 15), t1 = __builtin_amdgcn_readlane(v, 31), t2 = __builtin_amdgcn_readlane(v, 47);
    const int rw = lane >> 4;
    return v + (rw == 1 ? t0 : rw == 2 ? t0 + t1 : rw == 3 ? t0 + t1 + t2 : 0u);
}
__device__ __forceinline__ int select_row(LAS unsigned* row, int cnt, int limit, LAS unsigned* hist, int lane, unsigned& minkey) {
    unsigned e[NREG]; unsigned act = 0u, keep = 0u;
#pragma unroll
    for (int j = 0; j < NREG; ++j) { const int p = 64 * j + lane; const bool v = p < cnt; e[j] = v ? row[p] : 0u; act |= v ? (1u << j) : 0u; }
    int need = NSEL; bool first = true;
    for (;;) {
        unsigned lo = 0xFFFFFFFFu, hi = 0u;
#pragma unroll
        for (int j = 0; j < NREG; ++j) { const bool a = (act >> j) & 1u; lo = min(lo, a ? e[j] : 0xFFFFFFFFu); hi = max(hi, a ? e[j] : 0u); }
        lo = wave_umin(lo); hi = wave_umax(hi);
        if (hi == lo) break;
        hist[lane] = 0u;
        int rb[NREG];
        if (first) {
            const float slo = funmap(lo & 0xFFFFE000u), shi = funmap(hi & 0xFFFFE000u);
            const float scale = (shi > slo) ? 63.999f / (shi - slo) : 0.f;
#pragma unroll
            for (int j = 0; j < NREG; ++j) { int bn = (int)((funmap(e[j] & 0xFFFFE000u) - slo) * scale); bn = bn > 63 ? 63 : (bn < 0 ? 0 : bn); rb[j] = 63 - bn; }
        } else {
            const float scale = 63.999f / (float)(hi - lo);
#pragma unroll
            for (int j = 0; j < NREG; ++j) { int bn = (int)((float)(e[j] - lo) * scale); bn = bn > 63 ? 63 : (bn < 0 ? 0 : bn); rb[j] = 63 - bn; }
        }
        first = false;
#pragma unroll
        for (int j = 0; j < NREG; ++j) __hip_atomic_fetch_add(hist + rb[j], (act >> j) & 1u, __ATOMIC_RELAXED, __HIP_MEMORY_SCOPE_WAVEFRONT);
        const unsigned h = hist[lane];
        const unsigned ps = wave_scan_incl(h, lane);
        const unsigned long long m = __ballot(ps >= (unsigned)need);
        const int ls = (int)__builtin_ctzll(m);
        const int cge = (int)__builtin_amdgcn_readlane(ps, ls), nb = (int)__builtin_amdgcn_readlane(h, ls);
#pragma unroll
        for (int j = 0; j < NREG; ++j) { const unsigned a = (act >> j) & 1u; const unsigned kp = a & (unsigned)(rb[j] < ls), dr = a & (unsigned)(rb[j] > ls); keep |= kp << j; act &= ~((kp | dr) << j); }
        need -= cge - nb;
        if ((NSEL - need) + nb <= limit) break;
    }
    keep |= act;
    int run = 0; unsigned mk = 0xFFFFFFFFu;
#pragma unroll
    for (int j = 0; j < NREG; ++j) { const bool k = (keep >> j) & 1u; const unsigned long long m = __ballot(k);
        if (k) row[run + mbcnt64(m)] = e[j];
        mk = min(mk, k ? e[j] : 0xFFFFFFFFu);
        run += __builtin_popcountll(m); }
    minkey = wave_umin(mk);
    return run;
}
__device__ __forceinline__ int compact_stream(LAS unsigned* row, int cnt, LAS unsigned* hist, int lane, float& thrf) {
    unsigned e[NREG];
#pragma unroll
    for (int j = 0; j < NREG; ++j) e[j] = row[64 * j + lane];
    const unsigned lo = wave_umin(min(e[0], e[1])), hi = wave_umax(max(e[0], e[1]));
    const float slo = funmap(lo & 0xFFFFE000u), shi = funmap(hi & 0xFFFFE000u);
    bool ok = shi > slo; int newcnt = 0, bstar = 0; int bn[NREG]; float scale = 0.f;
    if (ok) {
        scale = 63.999f / (shi - slo);
        hist[lane] = 0u;
#pragma unroll
        for (int j = 0; j < NREG; ++j) { int b = (int)((funmap(e[j] & 0xFFFFE000u) - slo) * scale); b = b > 63 ? 63 : (b < 0 ? 0 : b); bn[j] = b;
            __hip_atomic_fetch_add(hist + (63 - b), (64 * j + lane < cnt) ? 1u : 0u, __ATOMIC_RELAXED, __HIP_MEMORY_SCOPE_WAVEFRONT); }
        const unsigned h = hist[lane];
        const unsigned ps = wave_scan_incl(h, lane);
        const unsigned long long m = __ballot(ps >= (unsigned)NSEL);
        const int ls = (int)__builtin_ctzll(m);
        newcnt = (int)__builtin_amdgcn_readlane(ps, ls); bstar = 63 - ls;
        ok = newcnt <= NSEL + 96;
    }
    if (!ok) { unsigned P; const int nc = select_row(row, cnt, NSEL + 64, hist, lane, P); thrf = funmap(P & 0xFFFFE000u); return nc; }
    int run = 0;
#pragma unroll
    for (int j = 0; j < NREG; ++j) { const bool k = (64 * j + lane < cnt) && (bn[j] >= bstar); const unsigned long long m = __ballot(k);
        if (k) row[run + mbcnt64(m)] = e[j];
        run += __builtin_popcountll(m); }
    if (bstar > 0) thrf = slo + ((float)bstar - 0.01f) / scale;
    return run;
}
#if defined(PROBE_SUB)
#define PSUB_T(i) do { const unsigned long long _t = __builtin_amdgcn_s_memrealtime(); if ((i) == PROBE_SUB) F.tacc += _t - psub_last; psub_last = _t; } while (0)
#else
#define PSUB_T(i) do { } while (0)
#endif
__device__ __forceinline__ void dsa_a_unit(Frame& F, int b, int qt) {
#if defined(PROBE_SUB)
    unsigned long long psub_last = 0ull;
#endif
    const bf16* proj = (const bf16*)(F.ws + WS_PROJ); bf16* sel = (bf16*)(F.ws + WS_SEL);
    LAS unsigned* cand = (LAS unsigned*)F.lds; LAS bf16* ktile = (LAS bf16*)(F.lds + CAND_BYTES);
    LAS unsigned* hist = (LAS unsigned*)(F.lds + CAND_BYTES + KTILE_BYTES) + 64 * F.wave;
    LAS int* rowcnt = (LAS int*)(F.lds + CAND_BYTES + KTILE_BYTES + 2048); LAS float* rowthr = (LAS float*)(F.lds + CAND_BYTES + KTILE_BYTES + 2048 + 256);
    const int lane = F.lane, w = F.wave, r32 = lane & 31, hi = lane >> 5;
    const int tokb = b * SEQ, q0 = qt * QT;
    bf16x8 af[2][4]; float wv[2][16];
    { const int qq = 2 * ((r32 >> 2) & 1) + (r32 >> 4), hd = ((r32 >> 3) & 1) * 4 + (r32 & 3);
#pragma unroll
      for (int mt = 0; mt < 2; ++mt) { const bf16* qp = proj + (size_t)(tokb + q0 + 8 * w + 4 * mt + qq) * PJ + C_IQ + hd * 64 + 8 * hi;
#pragma unroll
          for (int s = 0; s < 4; ++s) af[mt][s] = *(const bf16x8*)(qp + 16 * s);
#pragma unroll
          for (int u = 0; u < 2; ++u) { const u32x4 ww = *(const u32x4*)(proj + (size_t)(tokb + q0 + 8 * w + 4 * mt + 2 * hi + u) * PJ + C_IW);
              wv[mt][8 * u + 0] = bflo(ww.x) * WSCALE; wv[mt][8 * u + 1] = bfhi(ww.x) * WSCALE; wv[mt][8 * u + 2] = bflo(ww.y) * WSCALE; wv[mt][8 * u + 3] = bfhi(ww.y) * WSCALE;
              wv[mt][8 * u + 4] = bflo(ww.z) * WSCALE; wv[mt][8 * u + 5] = bfhi(ww.z) * WSCALE; wv[mt][8 * u + 6] = bflo(ww.w) * WSCALE; wv[mt][8 * u + 7] = bfhi(ww.w) * WSCALE; } } }
    float thrf[2][2]; int cntv[2][2];
#pragma unroll
    for (int mt = 0; mt < 2; ++mt)
#pragma unroll
        for (int u = 0; u < 2; ++u) { thrf[mt][u] = -INFINITY; cntv[mt][u] = 0; }
    if (lane < 8) { rowcnt[8 * w + lane] = 0; rowthr[8 * w + lane] = -INFINITY; }
    const int NT = qt + 1;
    const int skey = F.tid >> 3, spc = F.tid & 7;
    const bf16* ksrc = proj + (size_t)(tokb + skey) * PJ + C_IK + spc * 8;
    { const u32x4 v = *(const u32x4*)ksrc; *(LAS u32x4*)(ktile + skey * KTS + spc * 8) = v; }
    __syncthreads();
    for (int kt = 0; kt < NT; ++kt) {
        PSUB_T(0);
        u32x4 pre = (u32x4){0u, 0u, 0u, 0u};
        if (kt + 1 < NT) pre = *(const u32x4*)(ksrc + (size_t)(kt + 1) * KT * PJ);
        const LAS bf16* cur = ktile;
#pragma unroll
        for (int sub = 0; sub < 2; ++sub) {
            bf16x8 bfr[4];
#pragma unroll
            for (int s = 0; s < 4; ++s) bfr[s] = *(const LAS bf16x8*)(cur + (sub * 32 + r32) * KTS + 16 * s + 8 * hi);
            const int key = kt * KT + sub * 32 + r32;
#pragma unroll
            for (int mt = 0; mt < 2; ++mt) {
                f32x16 acc;
#pragma unroll
                for (int r = 0; r < 16; ++r) acc[r] = 0.f;
#pragma unroll
                for (int s = 0; s < 4; ++s) acc = MFMA32(af[mt][s], bfr[s], acc);
                float sc[2] = {0.f, 0.f};
#pragma unroll
                for (int r = 0; r < 16; ++r) sc[r >> 3] += wv[mt][r] * fmaxf(acc[r], 0.f);
#pragma unroll
                for (int u = 0; u < 2; ++u) {
                    const int ql = 8 * w + 4 * mt + 2 * hi + u;
                    const bool valid = (sc[u] >= thrf[mt][u]) && (key <= q0 + ql);
                    const unsigned long long m = __ballot(valid);
                    const int nlo = __builtin_popcount((unsigned)m), nhi = __builtin_popcount((unsigned)(m >> 32));
                    const int off = mbcnt64(m) - (hi ? nlo : 0);
                    if (valid) cand[ql * CAP + cntv[mt][u] + off] = (fmap(sc[u]) & 0xFFFFE000u) | (unsigned)(8191 - key);
                    cntv[mt][u] += hi ? nhi : nlo;
                }
            }
        }
        PSUB_T(1);
        int anyc = 0;
#pragma unroll
        for (int mt = 0; mt < 2; ++mt)
#pragma unroll
            for (int u = 0; u < 2; ++u) anyc |= (cntv[mt][u] > CAP_TRIG) ? 1 : 0;
        PSUB_T(2);
        const int doc = __syncthreads_or(anyc);
        if (kt + 1 < NT) *(LAS u32x4*)(ktile + skey * KTS + spc * 8) = pre;
        if (doc) {
            if ((lane & 31) == 0) {
#pragma unroll
                for (int mt = 0; mt < 2; ++mt)
#pragma unroll
                    for (int u = 0; u < 2; ++u) rowcnt[8 * w + 4 * mt + 2 * hi + u] = cntv[mt][u];
            }
#pragma unroll 1
            for (int rr = 0; rr < 8; ++rr) { const int rowi = 8 * w + rr; const int cq = __builtin_amdgcn_readfirstlane(rowcnt[rowi]);
                if (cq > NSEL + 64) { float tf = rowthr[rowi]; const int nc = compact_stream(cand + rowi * CAP, cq, hist, lane, tf);
                    if (lane == 0) { rowcnt[rowi] = nc; rowthr[rowi] = tf; } } }
#pragma unroll
            for (int mt = 0; mt < 2; ++mt)
#pragma unroll
                for (int u = 0; u < 2; ++u) { cntv[mt][u] = rowcnt[8 * w + 4 * mt + 2 * hi + u]; thrf[mt][u] = rowthr[8 * w + 4 * mt + 2 * hi + u]; }
        }
        __syncthreads();
        PSUB_T(3);
    }
    if ((lane & 31) == 0) {
#pragma unroll
        for (int mt = 0; mt < 2; ++mt)
#pragma unroll
            for (int u = 0; u < 2; ++u) rowcnt[8 * w + 4 * mt + 2 * hi + u] = cntv[mt][u];
    }
#pragma unroll 1
    for (int rr = 0; rr < 8; ++rr) { const int ql = 8 * w + rr; LAS unsigned* row = cand + ql * CAP; int cq = __builtin_amdgcn_readfirstlane(rowcnt[ql]);
        if (cq > NSEL) { unsigned P; cq = select_row(row, cq, NSEL, hist, lane, P); }
        bf16* so = sel + (size_t)(tokb + q0 + ql) * NSEL;
#pragma unroll
        for (int j = 0; j < 4; ++j) { const int p = 64 * j + lane; const unsigned v = row[p]; so[p] = (p < cq) ? (bf16)(8191u - (v & 0x1FFFu)) : (bf16)0; } }
    __syncthreads();
}

constexpr int VROW = 144;
constexpr int DSB_VL = 0, DSB_VL_WAVE = 32 * VROW * 2;
constexpr int DSB_PART = 8 * DSB_VL_WAVE;
constexpr int DSB_ML = DSB_PART + 2 * 8 * 8 * 64 * 4;
constexpr int DSB_SEL = DSB_ML + 2 * 8 * 8 * 2 * 4;
static_assert(DSB_SEL + 64 * 256 * 2 <= MISC_OFF, "DSA-B LDS map");
struct DsbFrags { u32x4 k[2][2][2]; bf16x8 q[2][2]; };
__device__ __forceinline__ void dsb_issue(Frame& F, const bf16* proj, int tok, int ql, DsbFrags& R) {
    const int lane = F.lane, n16 = lane & 15, c = lane >> 4, w = F.wave;
    const LAS bf16* sl = (const LAS bf16*)(F.lds + DSB_SEL) + ql * 256 + w * 32;
    const char* kvbase = (const char*)(proj + (size_t)(tok / SEQ) * SEQ * PJ);
#pragma unroll
    for (int kt = 0; kt < 2; ++kt) { const unsigned ko = (unsigned)sl[16 * kt + n16] * (unsigned)(PJ * 2) + (unsigned)((C_AK + 8 * c) * 2);
#pragma unroll
        for (int g = 0; g < 2; ++g)
#pragma unroll
            for (int s = 0; s < 2; ++s) R.k[kt][g][s] = *(const u32x4*)(kvbase + ko + (g * 64 + 32 * s) * 2); }
    const char* qbase = (const char*)(proj + (size_t)tok * PJ + C_AQ); const unsigned qo = (unsigned)((n16 * 64 + 8 * c) * 2);
#pragma unroll
    for (int g = 0; g < 2; ++g)
#pragma unroll
        for (int s = 0; s < 2; ++s) { bf16x8 v = (bf16x8){0, 0, 0, 0, 0, 0, 0, 0};
            if (n16 < 4) v = *(const bf16x8*)(qbase + qo + (g * 256 + 32 * s) * 2);
            R.q[g][s] = v; }
}
__device__ __forceinline__ void dsb_compute(Frame& F, const bf16* proj, int tok, int ql, int par, const DsbFrags& R, DsbFrags& Rn, bool has_next) {
    bf16* mix = (bf16*)(F.ws + WS_MIX);
    const int lane = F.lane, n16 = lane & 15, c = lane >> 4, q4 = n16 >> 2, p4 = lane & 3, w = F.wave;
    const int t = tok % SEQ, nsel = (t + 1 < NSEL) ? t + 1 : NSEL;
    const LAS bf16* sl = (const LAS bf16*)(F.lds + DSB_SEL) + ql * 256 + w * 32;
    LAS bf16* vl = (LAS bf16*)(F.lds + DSB_VL + w * DSB_VL_WAVE);
    LAS float* part = (LAS float*)(F.lds + DSB_PART) + par * (8 * 8 * 64); LAS float* ml = (LAS float*)(F.lds + DSB_ML) + par * (8 * 8 * 2);
    u32x4 vr[8];
    { const char* kvbase = (const char*)(proj + (size_t)(tok / SEQ) * SEQ * PJ);
#pragma unroll
      for (int i = 0; i < 8; ++i) { const unsigned vo = (unsigned)sl[4 * i + c] * (unsigned)(PJ * 2) + (unsigned)((C_AV + n16 * 8) * 2); vr[i] = *(const u32x4*)(kvbase + vo); } }
    f32x4 acc[2][2];
#pragma unroll
    for (int kt = 0; kt < 2; ++kt)
#pragma unroll
        for (int g = 0; g < 2; ++g) { acc[kt][g] = MFMA16(__builtin_bit_cast(bf16x8, R.k[kt][g][0]), R.q[g][0], ((f32x4){0.f, 0.f, 0.f, 0.f})); acc[kt][g] = MFMA16(__builtin_bit_cast(bf16x8, R.k[kt][g][1]), R.q[g][1], acc[kt][g]); }
    asm volatile("" ::: "memory");
    if (has_next) dsb_issue(F, proj, tok + 1, ql + 1, Rn);
    float mw[2] = {-INFINITY, -INFINITY};
    const float slope[2] = {exp2f(-(float)((n16 & 3) + 1)), exp2f(-(float)((n16 & 3) + 5))};
#pragma unroll
    for (int kt = 0; kt < 2; ++kt) { const u32x2 kk = *(const LAS u32x2*)(sl + 16 * kt + 4 * c);
        const int k4[4] = {(int)(kk.x & 0xffffu), (int)(kk.x >> 16), (int)(kk.y & 0xffffu), (int)(kk.y >> 16)};
#pragma unroll
        for (int r = 0; r < 4; ++r) { const int p = 32 * w + 16 * kt + 4 * c + r; const float dist = (float)(t - k4[r]);
#pragma unroll
            for (int g = 0; g < 2; ++g) { float lgt = acc[kt][g][r] * 0.125f - slope[g] * dist; if (p >= nsel) lgt = -INFINITY; acc[kt][g][r] = lgt; mw[g] = fmaxf(mw[g], lgt); } } }
    bf16x8 pf[2]; float lw[2];
#pragma unroll
    for (int g = 0; g < 2; ++g) { mw[g] = fmaxf(mw[g], __shfl_xor(mw[g], 16)); mw[g] = fmaxf(mw[g], __shfl_xor(mw[g], 32));
        const float mm = (mw[g] == -INFINITY) ? 0.f : mw[g]; float s = 0.f;
#pragma unroll
        for (int kt = 0; kt < 2; ++kt)
#pragma unroll
            for (int r = 0; r < 4; ++r) { const float e = __builtin_amdgcn_exp2f((acc[kt][g][r] - mm) * 1.4426950408889634f); acc[kt][g][r] = e; s += e; }
        s += __shfl_xor(s, 16); s += __shfl_xor(s, 32); lw[g] = s;
        u32x4 pw; pw.x = cvtpk(acc[0][g][0], acc[0][g][1]); pw.y = cvtpk(acc[0][g][2], acc[0][g][3]); pw.z = cvtpk(acc[1][g][0], acc[1][g][1]); pw.w = cvtpk(acc[1][g][2], acc[1][g][3]);
        pf[g] = __builtin_bit_cast(bf16x8, pw); }
#pragma unroll
    for (int i = 0; i < 8; ++i) *(LAS u32x4*)(vl + (4 * i + c) * VROW + n16 * 8) = vr[i];
    f32x4 O[2][4];
#pragma unroll
    for (int dt = 0; dt < 4; ++dt) { const LAS bf16* vp = vl + (4 * c + q4) * VROW + dt * 16 + 4 * p4;
        O[0][dt] = MFMA16(pf[0], cat8(trread(vp), trread(vp + 16 * VROW)), ((f32x4){0.f, 0.f, 0.f, 0.f}));
        O[1][dt] = MFMA16(pf[1], cat8(trread(vp + 64), trread(vp + 64 + 16 * VROW)), ((f32x4){0.f, 0.f, 0.f, 0.f})); }
    if (lane < 16) {
#pragma unroll
        for (int g = 0; g < 2; ++g)
#pragma unroll
            for (int dt = 0; dt < 4; ++dt)
#pragma unroll
                for (int r = 0; r < 4; ++r) part[(w * 8 + g * 4 + r) * 64 + 16 * dt + lane] = O[g][dt][r];
        if (lane < 4) {
#pragma unroll
            for (int g = 0; g < 2; ++g) { ml[(w * 8 + g * 4 + lane) * 2] = mw[g]; ml[(w * 8 + g * 4 + lane) * 2 + 1] = lw[g]; } } }
    __syncthreads();
    { const int h = F.tid >> 6, d = F.tid & 63; float M = -INFINITY;
#pragma unroll
      for (int ww = 0; ww < 8; ++ww) M = fmaxf(M, ml[(ww * 8 + h) * 2]);
      float num = 0.f, den = 0.f;
#pragma unroll
      for (int ww = 0; ww < 8; ++ww) { const float mv = ml[(ww * 8 + h) * 2]; const float f = (mv == -INFINITY) ? 0.f : __builtin_amdgcn_exp2f((mv - M) * 1.4426950408889634f);
          num += f * part[(ww * 8 + h) * 64 + d]; den += f * ml[(ww * 8 + h) * 2 + 1]; }
      mix[(size_t)tok * DM + 512 + h * 64 + d] = f2bf(num / den); }
}
__device__ __forceinline__ void phase_dsa_b(Frame& F) {
    const bf16* proj = (const bf16*)(F.ws + WS_PROJ); const bf16* sel = (const bf16*)(F.ws + WS_SEL);
    for (int blk = F.bid; blk < NTOK / 64; blk += F.G) {
        int T0 = blk * 64;
        if (F.G == 256) { const int x = F.bid & 7, jj = F.bid >> 3, r = blk >> 8; T0 = (x & 3) * SEQ + ((r * 32 + jj) * 2 + (x >> 2)) * 64; }
        __syncthreads();
        { const u32x4* src = (const u32x4*)(sel + (size_t)T0 * NSEL) + F.tid; LAS u32x4* dst = (LAS u32x4*)(F.lds + DSB_SEL) + F.tid;
#pragma unroll
          for (int i = 0; i < 4; ++i) dst[i * NTHR] = src[i * NTHR]; }
        __syncthreads();
        DsbFrags A, B;
        dsb_issue(F, proj, T0, 0, A);
        for (int q = 0; q < 64; q += 2) {
            dsb_compute(F, proj, T0 + q, q, 0, A, B, true);
            dsb_compute(F, proj, T0 + q + 1, q + 1, 1, B, A, q + 2 < 64);
        }
    }
}

constexpr int HSTR = 1028;
__device__ __forceinline__ void phase_router(Frame& F) {
    const float* x1 = F.out; const float* mod = (const float*)(F.ws + WS_MOD); bf16* h2 = (bf16*)(F.ws + WS_H2);
    int* topi = (int*)(F.ws + WS_TOPI); float* topg = (float*)(F.ws + WS_TOPG); int* bbase = (int*)(F.ws + WS_BBASE);
    LAS float* hs = (LAS float*)F.lds; LAS float* part = (LAS float*)(F.lds + 16 * HSTR * 4); LAS int* hist = (LAS int*)(F.lds + 16 * HSTR * 4 + 8 * 16 * 32 * 4);
    const int lane = F.lane, w = F.wave;
    for (int blk = F.bid; blk < NTOK / 128; blk += F.G) {
        const int T0 = blk * 128, b = T0 / SEQ;
        if (F.tid < 32) hist[F.tid] = 0;
        f32x4 ca[4], cb[4];
#pragma unroll
        for (int j = 0; j < 4; ++j) { const int col = 4 * lane + 256 * j;
            ca[j] = *(const f32x4*)(F.norm2_g + col) * (*(const f32x4*)(mod + b * 6144 + 4 * 1024 + col) + 1.0f); cb[j] = *(const f32x4*)(mod + b * 6144 + 3 * 1024 + col); }
        __syncthreads();
        for (int pass = 0; pass < 8; ++pass) {
#pragma unroll
            for (int tt = 0; tt < 2; ++tt) { const int tl = 2 * w + tt, tok = T0 + pass * 16 + tl;
                const f32x4* xr = (const f32x4*)(x1 + (size_t)tok * DM) + lane; f32x4 v[4]; float s = 0.f;
#pragma unroll
                for (int j = 0; j < 4; ++j) { v[j] = xr[64 * j]; s += (v[j][0] * v[j][0] + v[j][1] * v[j][1]) + (v[j][2] * v[j][2] + v[j][3] * v[j][3]); }
                const float rstd = rsqrtf(wave_sum(s) * (1.f / DM) + EPS);
                u32x2* o8 = (u32x2*)(h2 + (size_t)tok * DM) + lane;
#pragma unroll
                for (int j = 0; j < 4; ++j) { const f32x4 y = (v[j] * rstd) * ca[j] + cb[j];
                    u32x2 pk; pk.x = cvtpk(y[0], y[1]); pk.y = cvtpk(y[2], y[3]); o8[64 * j] = pk;
                    *(LAS f32x4*)(hs + tl * HSTR + 4 * lane + 256 * j) = y; } }
            __syncthreads();
            { const int ti = lane & 15, kk = lane >> 5, e = lane & 31; f32x16 acc;
#pragma unroll
              for (int r = 0; r < 16; ++r) acc[r] = 0.f;
              const LAS float* hp = hs + ti * HSTR + 128 * w + 64 * kk; const float* rwp = F.router_w + (size_t)(128 * w + 64 * kk) * NE + e;
#pragma unroll 4
              for (int s4 = 0; s4 < 16; ++s4) { const f32x4 a4 = *(const LAS f32x4*)(hp + 4 * s4);
#pragma unroll
                  for (int q = 0; q < 4; ++q) acc = __builtin_amdgcn_mfma_f32_32x32x2f32(a4[q], rwp[(4 * s4 + q) * NE], acc, 0, 0, 0); }
#pragma unroll
              for (int r = 0; r < 8; ++r) part[(w * 16 + (r & 3) + 8 * (r >> 2) + 4 * kk) * 32 + e] = acc[r]; }
            __syncthreads();
            { const int tl = F.tid >> 5, e = F.tid & 31, tok = T0 + pass * 16 + tl; float lg = F.router_b[e];
#pragma unroll
              for (int ww = 0; ww < 8; ++ww) lg += part[(ww * 16 + tl) * 32 + e];
              float myv = lg; float tv[4]; int ti4[4]; bool mine = false;
#pragma unroll
              for (int k = 0; k < 4; ++k) { float bv = myv; int bi = e;
#pragma unroll
                  for (int o = 16; o >= 1; o >>= 1) { const float ov = __shfl_xor(bv, o); const int oi = __shfl_xor(bi, o); if (ov > bv || (ov == bv && oi < bi)) { bv = ov; bi = oi; } }
                  tv[k] = bv; ti4[k] = bi; if (bi == e) { myv = -INFINITY; mine = true; } }
              if (mine) atomicAdd((int*)hist + e, 1);
              if (e == 0) { const float e0 = 1.0f, e1 = __expf(tv[1] - tv[0]), e2 = __expf(tv[2] - tv[0]), e3 = __expf(tv[3] - tv[0]); const float inv = 1.0f / (e0 + e1 + e2 + e3);
                  *(int4*)(topi + (size_t)tok * 4) = make_int4(ti4[0], ti4[1], ti4[2], ti4[3]); *(f32x4*)(topg + (size_t)tok * 4) = (f32x4){e0 * inv, e1 * inv, e2 * inv, e3 * inv}; } }
            __syncthreads();
        }
        if (F.tid < 32) { const int base = atomicAdd((int*)(F.ctl + CW_GCNT) + F.tid, hist[F.tid]); bbase[blk * 32 + F.tid] = base; }
        __syncthreads();
    }
}
__device__ __forceinline__ int moe_layout(Frame& F, LAS int* offs, LAS int* tile_e) {
    if (F.tid == 0) { int o = 0;
        for (int e = 0; e < NE; ++e) { const int cnt = (int)__hip_atomic_load(F.ctl + CW_GCNT + e, __ATOMIC_RELAXED, __HIP_MEMORY_SCOPE_AGENT); const int nt = (cnt + 255) >> 8;
            offs[e] = o; if (tile_e) for (int t = 0; t < nt; ++t) tile_e[(o >> 8) + t] = e; o += nt << 8; }
        offs[NE] = o >> 8; }
    __syncthreads();
    return offs[NE];
}
__device__ __forceinline__ void phase_place(Frame& F) {
    const bf16* h2 = (const bf16*)(F.ws + WS_H2); bf16* xs = (bf16*)(F.ws + WS_XS);
    const int* topi = (const int*)(F.ws + WS_TOPI); const float* topg = (const float*)(F.ws + WS_TOPG); const int* bbase = (const int*)(F.ws + WS_BBASE);
    int* rowinfo = (int*)(F.ws + WS_ROWINFO); float* rowgate = (float*)(F.ws + WS_ROWGATE);
    LAS int* offs = (LAS int*)F.lds; LAS int* lcur = offs + 64; LAS int* posl = offs + 128;
    (void)moe_layout(F, offs, nullptr);
    for (int blk = F.bid; blk < NTOK / 128; blk += F.G) {
        const int T0 = blk * 128;
        if (F.tid < 32) lcur[F.tid] = 0;
        __syncthreads();
        { const int i = F.tid, tok = T0 + (i >> 2); const int e = topi[(size_t)tok * 4 + (i & 3)];
          const int rank = atomicAdd((int*)lcur + e, 1); const int pos = offs[e] + bbase[blk * 32 + e] + rank;
          rowinfo[pos] = tok * 4 + (i & 3); rowgate[pos] = topg[(size_t)tok * 4 + (i & 3)]; posl[i] = pos; }
        __syncthreads();
        for (int jj = 0; jj < 64; ++jj) { const int i = F.wave * 64 + jj; const int pos = posl[i]; const int tok = T0 + (i >> 2);
            const u32x4* src = (const u32x4*)(h2 + (size_t)tok * DM) + F.lane; u32x4* dst = (u32x4*)(xs + (size_t)pos * DM) + F.lane;
            const u32x4 v0 = src[0], v1 = src[64]; dst[0] = v0; dst[64] = v1; }
        __syncthreads();
    }
}
__device__ __forceinline__ void phase_final(Frame& F) {
    const float* mod = (const float*)(F.ws + WS_MOD); const bf16* Y = (const bf16*)(F.ws + WS_Y);
    const int gw = F.bid * NWAVES + F.wave, NGW = F.G * NWAVES;
    for (int m = gw; m < NTOK; m += NGW) {
        const int b = m / SEQ; f32x4* xr = (f32x4*)(F.out + (size_t)m * DM) + F.lane; f32x4 v[4]; float s = 0.f;
#pragma unroll
        for (int j = 0; j < 4; ++j) { const int col = 4 * F.lane + 256 * j; f32x4 y = (f32x4){0.f, 0.f, 0.f, 0.f};
#pragma unroll
            for (int k = 0; k < 4; ++k) { const u32x2 w = *((const u32x2*)(Y + ((size_t)m * 4 + k) * DM) + F.lane + 64 * j); y[0] += bflo(w.x); y[1] += bfhi(w.x); y[2] += bflo(w.y); y[3] += bfhi(w.y); }
            v[j] = xr[64 * j] + *(const f32x4*)(mod + b * 6144 + 5 * 1024 + col) * y;
            s += (v[j][0] * v[j][0] + v[j][1] * v[j][1]) + (v[j][2] * v[j][2] + v[j][3] * v[j][3]); }
        const float rstd = rsqrtf(wave_sum(s) * (1.f / DM) + EPS);
#pragma unroll
        for (int j = 0; j < 4; ++j) xr[64 * j] = (v[j] * rstd) * *(const f32x4*)(F.final_g + 4 * F.lane + 256 * j);
    }
}

#ifndef MK_N_LAUNCHES
#define MK_N_LAUNCHES 1
#endif
constexpr int N_PHASES = 12;
struct Args { const float* in[16]; float* out; unsigned char* ws; int ph_lo, ph_hi; };
static_assert(sizeof(Args) == 16 * 8 + 8 + 8 + 8, "Args has no padding");

__global__ void __launch_bounds__(NTHR, 2) mk_fwd(Args args) {
    extern __shared__ __attribute__((aligned(16))) unsigned char lds_raw[];
    Frame F;
    F.lds = (LAS unsigned char*)lds_raw;
    F.MISC = (volatile LAS unsigned*)(F.lds + MISC_OFF);
    F.tid = threadIdx.x; F.lane = F.tid & 63; F.wave = __builtin_amdgcn_readfirstlane(F.tid >> 6);
    F.G = gridDim.x; F.bid = blockIdx.x; F.tacc = 0ull;
    F.ws = args.ws; F.ctl = (unsigned*)(args.ws + WS_CTL); F.out = args.out;
    F.x = args.in[0]; F.c = args.in[1]; F.ada_w = args.in[2]; F.ada_b = args.in[3]; F.norm1_g = args.in[4]; F.w_in = args.in[5]; F.mix_scale = args.in[6]; F.w_o = args.in[7];
    F.norm2_g = args.in[8]; F.router_w = args.in[9]; F.router_b = args.in[10]; F.w_gu = args.in[11]; F.b_gu = args.in[12]; F.w_down = args.in[13]; F.b_down = args.in[14]; F.final_g = args.in[15];
    for (int u = F.tid; u < (LDS_BYTES - MISC_OFF) / 4; u += NTHR) ((LAS unsigned*)(F.lds + MISC_OFF))[u] = 0u;
    __syncthreads();
    const int lo = args.ph_lo, hi = args.ph_hi;
    XcdBarrier bar; bar.bar = (unsigned*)(F.ctl + CW_BAR); bar.x = 0; bar.st = nullptr;
    if (hi - lo > 1) bar = xcd_barrier_post((unsigned*)(F.ctl + CW_BAR), F.MISC + 8);
#define IN(k) (lo <= (k) && (k) < hi)
#if defined(PROBE_PHASE)
    unsigned long long tp0 = 0ull, tp1 = 0ull;
#define STAMP(k) do { if ((k) == PROBE_PHASE) tp0 = __builtin_amdgcn_s_memrealtime(); if ((k) == PROBE_PHASE + 1) tp1 = __builtin_amdgcn_s_memrealtime(); } while (0)
#else
#define STAMP(k) do { } while (0)
#endif
#define SEAM(k) do { if (IN(k) && IN((k) + 1)) xcd_barrier(bar); } while (0)

    STAMP(0); if (IN(0)) { phase_p0a(F); } SEAM(0);
    STAMP(1); if (IN(1)) { phase_p0b(F); } SEAM(1);
    STAMP(2); if (IN(2)) {
        pg8::Gemm g{(const bf16*)(F.ws + WS_H0), (const bf16*)(F.ws + WS_WIN), NTOK, PJ, DM}; pg8::StaticOrder S; S.init(NTOK, PJ, F.G, F.bid);
        EpiProj E{(bf16*)(F.ws + WS_PROJ), PJ};
        pg8::gemm_phase<EpiProj, pg8::StaticOrder, true, true>(F.lds, g, S, E);
    } SEAM(2);
    STAMP(3); if (IN(3)) {
#if defined(PROBE_SUB)
        const unsigned long long tra0 = __builtin_amdgcn_s_memrealtime();
#endif
        for (int it = F.bid; it < 1024; it += F.G) ret_a_item(F, it);
#if defined(PROBE_SUB)
        if (PROBE_SUB == 4) F.tacc += __builtin_amdgcn_s_memrealtime() - tra0;
#endif
        for (int u = F.bid; u < 256; u += F.G) { int b = u >> 6, j = u & 63;
            if (F.G == 256) { const int x = u & 7, jj = u >> 3; b = x & 3; j = (x >> 2) * 32 + jj; }
            dsa_a_unit(F, b, j); dsa_a_unit(F, b, 127 - j); }
    } SEAM(3);
    STAMP(4); if (IN(4)) {
#if defined(PROBE_SUB)
        const unsigned long long tsc0 = __builtin_amdgcn_s_memrealtime();
#endif
        ret_scan(F);
#if defined(PROBE_SUB)
        if (PROBE_SUB == 5) F.tacc += __builtin_amdgcn_s_memrealtime() - tsc0;
#endif
        __syncthreads();
        phase_dsa_b(F);
    } SEAM(4);
    STAMP(5); if (IN(5)) { for (int it = F.bid; it < 1024; it += F.G) ret_c_item(F, it); } SEAM(5);
    STAMP(6); if (IN(6)) {
        pg8::Gemm g{(const bf16*)(F.ws + WS_MIX), (const bf16*)(F.ws + WS_WO), NTOK, DM, DM}; pg8::StaticOrder S; S.init(NTOK, DM, F.G, F.bid);
        EpiX1 E{F.x, (const float*)(F.ws + WS_MOD), F.out};
        pg8::gemm_phase<EpiX1, pg8::StaticOrder, true, true>(F.lds, g, S, E);
    } SEAM(6);
    STAMP(7); if (IN(7)) { phase_router(F); } SEAM(7);
    STAMP(8); if (IN(8)) { phase_place(F); } SEAM(8);
    STAMP(9); if (IN(9)) {
        LAS int* tile_e = (LAS int*)(F.lds + TILEE_OFF); const int nt = moe_layout(F, (LAS int*)(F.lds + TILEE_OFF + 4096), tile_e);
        pg8::Gemm g{(const bf16*)(F.ws + WS_XS), (const bf16*)(F.ws + WS_WGU), MOE_ROWS, 2048, DM};
        GroupedOrder S{tile_e, nt, 8, F.G, F.bid, (size_t)2048 * 1024 * 2};
        EpiGlu E{(bf16*)(F.ws + WS_HB), F.b_gu};
        pg8::gemm_phase<EpiGlu, GroupedOrder, true, true>(F.lds, g, S, E);
    } SEAM(9);
    STAMP(10); if (IN(10)) {
        LAS int* tile_e = (LAS int*)(F.lds + TILEE_OFF); const int nt = moe_layout(F, (LAS int*)(F.lds + TILEE_OFF + 4096), tile_e);
        pg8::Gemm g{(const bf16*)(F.ws + WS_HB), (const bf16*)(F.ws + WS_WDN), MOE_ROWS, DM, DM};
        GroupedOrder S{tile_e, nt, 4, F.G, F.bid, (size_t)1024 * 1024 * 2};
        EpiDown E{(bf16*)(F.ws + WS_Y), F.b_down, (const int*)(F.ws + WS_ROWINFO), (const float*)(F.ws + WS_ROWGATE)};
        pg8::gemm_phase<EpiDown, GroupedOrder, true, true>(F.lds, g, S, E);
    } SEAM(10);
    STAMP(11); if (IN(11)) { phase_final(F); }
    STAMP(12);
#if defined(PROBE_SUB)
    if (F.bid == 0 && F.tid == 0) { const unsigned long long te = __builtin_amdgcn_s_memrealtime(); while (__builtin_amdgcn_s_memrealtime() - te < F.tacc) __builtin_amdgcn_s_sleep(8); }
#elif defined(PROBE_PHASE)
    if (F.bid == 0 && F.tid == 0) { const unsigned long long te = __builtin_amdgcn_s_memrealtime(), dur = tp1 - tp0; while (__builtin_amdgcn_s_memrealtime() - te < dur) __builtin_amdgcn_s_sleep(8); }
#endif
#undef IN
#undef SEAM
}

extern "C" void kernel_launch(void* const* d_in, const int* in_sizes, int n_in, void* d_out, int out_size, void* d_ws, size_t ws_size, hipStream_t stream) {
    static int grid = 0;
    if (grid == 0) {
        if (n_in != 16 || out_size != NTOK * DM || ws_size < WS_END) { fprintf(stderr, "kernel_launch: unexpected problem (n_in %d out %d ws %zu); nothing launched\n", n_in, out_size, ws_size); grid = -1; return; }
        int dev = 0, cus = 0;
        if (hipGetDevice(&dev) != hipSuccess || hipDeviceGetAttribute(&cus, hipDeviceAttributeMultiprocessorCount, dev) != hipSuccess) { grid = -1; return; }
        if (hipFuncSetAttribute((const void*)mk_fwd, hipFuncAttributeMaxDynamicSharedMemorySize, LDS_BYTES) != hipSuccess) { fprintf(stderr, "kernel_launch: hipFuncSetAttribute failed\n"); grid = -1; return; }
        int per_cu = 0;
        if (hipOccupancyMaxActiveBlocksPerMultiprocessor(&per_cu, (const void*)mk_fwd, NTHR, LDS_BYTES) != hipSuccess || per_cu < 1) fprintf(stderr, "kernel_launch: occupancy query reports %d workgroups per CU\n", per_cu);
        (void)hipGetLastError();
        grid = cus;
    }
    if (grid < 0) return;
    (void)hipMemsetAsync((char*)d_ws + WS_CTL, 0, CTL_ZERO_BYTES, stream);
    Args a{};
    for (int i = 0; i < 16; ++i) a.in[i] = (const float*)d_in[i];
    a.out = (float*)d_out; a.ws = (unsigned char*)d_ws;
#if MK_N_LAUNCHES == 1
    a.ph_lo = 0; a.ph_hi = N_PHASES;
    hipLaunchKernelGGL(mk_fwd, dim3(grid), dim3(NTHR), LDS_BYTES, stream, a);
#else
    for (int p = 0; p < N_PHASES; ++p) { a.ph_lo = p; a.ph_hi = p + 1; hipLaunchKernelGGL(mk_fwd, dim3(grid), dim3(NTHR), LDS_BYTES, stream, a); }
#endif
}
```

```cpp
#include <hip/hip_runtime.h>
#include <cstdio>
#include <cstdint>

#define LAS __attribute__((address_space(3)))
#define GAS __attribute__((address_space(1)))
typedef unsigned short bf16;
typedef short bf16x8 __attribute__((ext_vector_type(8)));
typedef short s16x4 __attribute__((ext_vector_type(4)));
typedef float f32x4 __attribute__((ext_vector_type(4)));
typedef float f32x16 __attribute__((ext_vector_type(16)));
typedef unsigned u32x4 __attribute__((ext_vector_type(4)));
typedef unsigned u32x2 __attribute__((ext_vector_type(2)));
typedef float f32x2_t __attribute__((ext_vector_type(2)));
typedef __bf16 bf16x2_t __attribute__((ext_vector_type(2)));

constexpr int DM = 1024, NBATCH = 4, SEQ = 8192, NTOK = NBATCH * SEQ;
constexpr int PJ = 3072;
constexpr int IN_COLS = 2888;
constexpr int C_RQ = 0, C_RK = 256, C_RV = 512, C_RG = 1024, C_AQ = 1536, C_AK = 2048, C_AV = 2176, C_IQ = 2304, C_IK = 2816, C_IW = 2880;
constexpr int NE = 32, TOPK = 4, MOE_ROWS = NTOK * TOPK + NE * 256;
constexpr int MOE_TILES = MOE_ROWS / 256;
constexpr float EPS = 1e-6f;
constexpr int NWAVES = 8, NTHR = 512;

constexpr size_t MiB = 1u << 20;
constexpr size_t WS_CTL = 0, CTL_ZERO_BYTES = 1 * MiB;
constexpr size_t WS_MOD = 1 * MiB;
constexpr size_t WS_TOPI = 2 * MiB;
constexpr size_t WS_TOPG = 2 * MiB + 512 * 1024;
constexpr size_t WS_BBASE = 3 * MiB;
constexpr size_t WS_ROWINFO = 4 * MiB;
constexpr size_t WS_ROWGATE = 5 * MiB;
constexpr size_t WS_WIN = 8 * MiB;
constexpr size_t WS_WO = 14 * MiB;
constexpr size_t WS_WGU = 16 * MiB;
constexpr size_t WS_WDN = 144 * MiB;
constexpr size_t WS_H0 = 208 * MiB;
constexpr size_t WS_PROJ = 272 * MiB;
constexpr size_t WS_XS = 208 * MiB;
constexpr size_t WS_Y = 208 * MiB;
constexpr size_t WS_KVT = 480 * MiB;
constexpr size_t WS_RPT = 512 * MiB;
constexpr size_t WS_SEL = 528 * MiB;
constexpr size_t WS_MIX = 544 * MiB;
constexpr size_t WS_H2 = 608 * MiB;
constexpr size_t WS_HB = 480 * MiB;
constexpr size_t WS_END = 752 * MiB;
constexpr int CW_GCNT = 1024;
constexpr int CW_BAR = 4096;

constexpr int LDS_BYTES = 147456;
constexpr int RING_BYTES = 131072;
constexpr int TILEE_OFF = 131072;
constexpr int MISC_OFF = 146432;
constexpr int PTR_OFF = MISC_OFF + 512;

__device__ __forceinline__ int hw_lane() { int l; asm volatile("v_mbcnt_lo_u32_b32 %0, -1, 0\n\tv_mbcnt_hi_u32_b32 %0, -1, %0" : "=v"(l)); return l; }
__device__ __forceinline__ unsigned cvtpk(float lo, float hi) { f32x2_t v = {lo, hi}; bf16x2_t b = __builtin_convertvector(v, bf16x2_t); return __builtin_bit_cast(unsigned, b); }
__device__ __forceinline__ float bflo(unsigned w) { return __builtin_bit_cast(float, w << 16); }
__device__ __forceinline__ float bfhi(unsigned w) { return __builtin_bit_cast(float, w & 0xffff0000u); }
__device__ __forceinline__ float bf2f(bf16 h) { return __builtin_bit_cast(float, (unsigned)h << 16); }
__device__ __forceinline__ bf16 f2bf(float f) { return (bf16)(cvtpk(f, 0.f) & 0xffffu); }
__device__ __forceinline__ float wave_sum(float v) {
#pragma unroll
    for (int o = 1; o < 64; o <<= 1) v += __shfl_xor(v, o);
    return v;
}
__device__ __forceinline__ int mbcnt64(unsigned long long m) { return (int)__builtin_amdgcn_mbcnt_hi((unsigned)(m >> 32), __builtin_amdgcn_mbcnt_lo((unsigned)m, 0u)); }
__device__ __forceinline__ s16x4 trread(const LAS void* p) { typedef short v4i16_t __attribute__((ext_vector_type(4))); return __builtin_bit_cast(s16x4, __builtin_amdgcn_ds_read_tr16_b64_v4i16((LAS v4i16_t*)p)); }
__device__ __forceinline__ bf16x8 cat8(s16x4 lo, s16x4 hi) { return (bf16x8){lo[0], lo[1], lo[2], lo[3], hi[0], hi[1], hi[2], hi[3]}; }
#define MFMA16(a, b, c) __builtin_amdgcn_mfma_f32_16x16x32_bf16((a), (b), (c), 0, 0, 0)
#define MFMA32(a, b, c) __builtin_amdgcn_mfma_f32_32x32x16_bf16((a), (b), (c), 0, 0, 0)

namespace pg8 {
#define PG8_LAS __attribute__((address_space(3)))
typedef unsigned short bf16_t;
typedef short bf16x8 __attribute__((ext_vector_type(8)));
typedef float f32x4 __attribute__((ext_vector_type(4)));
typedef unsigned u32x4 __attribute__((ext_vector_type(4)));
constexpr int BM = 256, BK = 64, HALF = 128, HTB = HALF * BK * 2  , STAGE_BYTES = 8 * HTB, NXCD = 8, WGM = 8;

__host__ __device__ __forceinline__ int lds_byte(int r, int c) { const int st = (r >> 4) * 2 + (c >> 5), rr = r & 15, cc = c & 31, ob = rr * 64 + cc * 2; return st * 1024 + (ob ^ (((ob >> 9) & 1) << 5)); }
__host__ __device__ __forceinline__ void stage_rc(int b, int& R, int& C) { const int st = b / 1024, sb = b % 1024, swz = sb ^ (((sb >> 9) & 1) << 5); R = (st >> 1) * 16 + swz / 64; C = (st & 1) * 32 + (swz % 64) / 2; }
__host__ __device__ __forceinline__ int perm32(int rho) { const int n = rho >> 4, i = rho & 15; return 8 * (i >> 2) + 4 * n + (i & 3); }

typedef int v8i32 __attribute__((ext_vector_type(8))); typedef int v4i32 __attribute__((ext_vector_type(4)));
__device__ __forceinline__ v8i32 pg8_cat(bf16x8 a, bf16x8 b) { return __builtin_shufflevector(__builtin_bit_cast(v4i32, a), __builtin_bit_cast(v4i32, b), 0, 1, 2, 3, 4, 5, 6, 7); }
struct Unit { int pm, pn, e; size_t bo; };
struct Gemm { const bf16_t* A; const bf16_t* Bt; int M, N, K; };

struct StaticOrder {
    int nM, nN, nwg, G, c;
    __host__ __device__ void init(int M, int N, int G_, int c_) { nM = M / BM; nN = N / BM; nwg = nM * nN; G = G_; c = c_; }
    __host__ __device__ bool next(int i, Unit& u) const {
        const long L = (long)i * G + c; if (L >= nwg) return false;
        int wgid = (int)L; { const int q = nwg / NXCD, r = nwg % NXCD, xcd = wgid % NXCD, off = wgid / NXCD; wgid = (xcd < r ? xcd * (q + 1) : r * (q + 1) + (xcd - r) * q) + off; }
        const int nig = WGM * nN, gid = wgid / nig, fm = gid * WGM, gsz = (nM - fm) < WGM ? (nM - fm) : WGM;
        u.pm = fm + ((wgid % nig) % gsz); u.pn = (wgid % nig) / gsz; u.e = 0; u.bo = 0; return true;
    }
    __device__ __forceinline__ void a_ready(const Unit&) const {}
    __device__ __forceinline__ void done(const Unit&) const {}
};

template <class Epi, class Sched, bool ALIGN_EPI = false, bool SP2 = false, bool F8 = false>
__device__ __forceinline__ void gemm_phase(PG8_LAS unsigned char* lds, const Gemm g, const Sched& S, const Epi& E, const int wid) {
    const int lane = hw_lane(), tid = wid * 64 + lane, wr = wid >> 2, wc = wid & 3, fr = lane & 15, fq = lane >> 4;
    constexpr int ESZ = F8 ? 1 : 2;
    const int K = g.K, nt = K * ESZ / (BK * 2);
    unsigned voffA[2], voffB[2];
#pragma unroll
    for (int i = 0; i < 2; ++i) { int R, C; stage_rc(tid * 16 + i * 8192, R, C); const int Rb = Epi::PERM ? ((R & ~31) + perm32(R & 31)) : R;
        voffA[i] = (unsigned)(R * K * ESZ + C * 2); voffB[i] = (unsigned)(Rb * K * ESZ + C * 2); }
    const size_t kstep = (size_t)(BK * 2);
    const size_t hstep = (size_t)HALF * K * ESZ;
    const size_t tstep = 2 * hstep;
    const unsigned ldsw = (unsigned)wid * 1024u;
    const int aoff = lds_byte(wr * 64 + fr, fq * 8), boff = lds_byte(wc * 32 + fr, fq * 8);
#define PG8_SA(b, h) (((b) * 2 + (h)) * HTB)
#define PG8_SB(b, h) ((4 + (b) * 2 + (h)) * HTB)
#define PG8_STAGE(bufoff, gbase, voff) do { _Pragma("unroll") for (int _i = 0; _i < 2; ++_i) { \
        if constexpr (F8) { unsigned _keep; const unsigned _l = (unsigned)(__UINTPTR_TYPE__)(lds + (bufoff) + ldsw + _i * 8192);   \
            asm volatile("s_mov_b32 %0, m0\n\ts_mov_b32 m0, %3\n\ts_nop 0\n\tglobal_load_lds_dwordx4 %1, %2\n\ts_mov_b32 m0, %0" : "=&s"(_keep) : "v"((voff)[_i]), "s"((const char*)(gbase)), "s"(_l) : "memory"); } \
        else __builtin_amdgcn_global_load_lds((const unsigned*)((const char*)(gbase) + (voff)[_i]), (PG8_LAS unsigned*)(lds + (bufoff) + ldsw + _i * 8192), 16, 0, 0); } } while (0)
#define PG8_LDA(dst, b, h) do { _Pragma("unroll") for (int m = 0; m < 4; ++m) _Pragma("unroll") for (int k = 0; k < 2; ++k) dst[m][k] = *(const PG8_LAS bf16x8*)(lds + PG8_SA(b, h) + aoff + m * 2048 + k * 1024); } while (0)
#define PG8_LDB(dst, b, h) do { _Pragma("unroll") for (int n = 0; n < 2; ++n) _Pragma("unroll") for (int k = 0; k < 2; ++k) dst[n][k] = *(const PG8_LAS bf16x8*)(lds + PG8_SB(b, h) + boff + n * 2048 + k * 1024); } while (0)
#define PG8_MMA(ai, bj, At, Bt) do { __builtin_amdgcn_s_setprio(1); _Pragma("unroll") for (int m = 0; m < 4; ++m) _Pragma("unroll") for (int n = 0; n < 2; ++n) { \
        if constexpr (F8) { acc[ai][bj][m][n] = __builtin_amdgcn_mfma_scale_f32_16x16x128_f8f6f4(pg8_cat(Bt[n][0], Bt[n][1]), pg8_cat(At[m][0], At[m][1]), acc[ai][bj][m][n], 0, 0, 0, 0, 0, 0); } \
        else { _Pragma("unroll") for (int k = 0; k < 2; ++k) acc[ai][bj][m][n] = __builtin_amdgcn_mfma_f32_16x16x32_bf16(Bt[n][k], At[m][k], acc[ai][bj][m][n], 0, 0, 0); } } __builtin_amdgcn_s_setprio(0); } while (0)
#define PG8_WAIT_V(n) asm volatile("s_waitcnt vmcnt(" #n ")" ::: "memory")
#define PG8_WAIT_L(n) asm volatile("s_waitcnt lgkmcnt(" #n ")" ::: "memory")
#define PG8_BAR __builtin_amdgcn_s_barrier()
#define PG8_SCHED __builtin_amdgcn_sched_barrier(0)
    Unit cur, nxt; int ui = 0;
    if (!S.next(0, cur)) return;
    f32x4 acc[2][2][4][2];
#pragma unroll
    for (int a = 0; a < 2; ++a)
#pragma unroll
        for (int b = 0; b < 2; ++b)
#pragma unroll
            for (int m = 0; m < 4; ++m)
#pragma unroll
                for (int n = 0; n < 2; ++n) acc[a][b][m][n] = (f32x4){0.f, 0.f, 0.f, 0.f};
    bf16x8 At[4][2], B0[2][2], B1[2][2];
    const char* cA = (const char*)g.A + (size_t)cur.pm * tstep; const char* cB = (const char*)g.Bt + (size_t)cur.pn * tstep + cur.bo;
    S.a_ready(cur);
    if constexpr (SP2) {
        PG8_STAGE(PG8_SB(0, 0), cB, voffB); PG8_STAGE(PG8_SB(0, 1), cB + hstep, voffB); PG8_STAGE(PG8_SA(0, 0), cA, voffA); PG8_STAGE(PG8_SA(0, 1), cA + hstep, voffA);
        if (wr == 1) PG8_BAR;
        PG8_WAIT_V(2); PG8_BAR;
        PG8_STAGE(PG8_SB(1, 0), cB + kstep, voffB); PG8_STAGE(PG8_SA(1, 0), cA + kstep, voffA); PG8_STAGE(PG8_SB(1, 1), cB + hstep + kstep, voffB);
        PG8_WAIT_V(6); PG8_BAR;
    } else {
        PG8_STAGE(PG8_SB(0, 0), cB, voffB); PG8_STAGE(PG8_SA(0, 0), cA, voffA); PG8_STAGE(PG8_SB(0, 1), cB + hstep, voffB); PG8_STAGE(PG8_SA(0, 1), cA + hstep, voffA);
        if (wr == 1) PG8_BAR;
        PG8_WAIT_V(4); PG8_BAR;
        PG8_STAGE(PG8_SB(1, 0), cB + kstep, voffB); PG8_STAGE(PG8_SA(1, 0), cA + kstep, voffA); PG8_STAGE(PG8_SB(1, 1), cB + hstep + kstep, voffB);
        PG8_WAIT_V(6); PG8_BAR;
    }
    for (;;) {
        const bool has_next = S.next(ui + 1, nxt);
        const char* nA = has_next ? (const char*)g.A + (size_t)nxt.pm * tstep : cA; const char* nB = has_next ? (const char*)g.Bt + (size_t)nxt.pn * tstep + nxt.bo : cB;
        for (int t = 0; t < nt; t += 2) {
            const bool last = (t == nt - 2);
            const char* a1 = cA + (size_t)(t + 1) * kstep;
            const char* a2 = last ? nA : cA + (size_t)(t + 2) * kstep; const char* b2 = last ? nB : cB + (size_t)(t + 2) * kstep;
            const char* a3 = a2 + kstep; const char* b3 = b2 + kstep;
            if (last && has_next) S.a_ready(nxt);
            if constexpr (SP2) {
            PG8_LDB(B0, 0, 0); PG8_LDB(B1, 0, 1); PG8_SCHED; PG8_LDA(At, 0, 0); PG8_STAGE(PG8_SA(1, 1), a1 + hstep, voffA);
            PG8_WAIT_V(8); PG8_WAIT_L(0); PG8_BAR; PG8_MMA(0, 0, At, B0); PG8_MMA(0, 1, At, B1); PG8_BAR; PG8_SCHED;
            PG8_LDA(At, 0, 1); PG8_STAGE(PG8_SB(0, 0), b2, voffB); PG8_STAGE(PG8_SB(0, 1), b2 + hstep, voffB); PG8_STAGE(PG8_SA(0, 0), a2, voffA);
            PG8_WAIT_V(8); PG8_WAIT_L(0); PG8_BAR; PG8_MMA(1, 0, At, B0); PG8_MMA(1, 1, At, B1); PG8_BAR; PG8_SCHED;
            PG8_LDB(B0, 1, 0); PG8_LDB(B1, 1, 1); PG8_SCHED; PG8_LDA(At, 1, 0); PG8_STAGE(PG8_SA(0, 1), a2 + hstep, voffA);
            PG8_WAIT_V(8); PG8_WAIT_L(0); PG8_BAR; PG8_MMA(0, 0, At, B0); PG8_MMA(0, 1, At, B1); PG8_BAR; PG8_SCHED;
            PG8_LDA(At, 1, 1); PG8_STAGE(PG8_SB(1, 0), b3, voffB); PG8_STAGE(PG8_SB(1, 1), b3 + hstep, voffB); PG8_STAGE(PG8_SA(1, 0), a3, voffA);
            PG8_WAIT_V(8); PG8_WAIT_L(0); PG8_BAR; PG8_MMA(1, 0, At, B0); PG8_MMA(1, 1, At, B1); PG8_BAR; PG8_SCHED;
            } else {
            PG8_LDB(B0, 0, 0); PG8_SCHED; PG8_LDA(At, 0, 0); PG8_STAGE(PG8_SA(1, 1), a1 + hstep, voffA);
            PG8_WAIT_L(8); PG8_BAR; PG8_WAIT_L(0); PG8_MMA(0, 0, At, B0); PG8_BAR; PG8_SCHED;
            PG8_LDB(B1, 0, 1); PG8_STAGE(PG8_SB(0, 0), b2, voffB);
            PG8_BAR; PG8_WAIT_L(0); PG8_MMA(0, 1, At, B1); PG8_BAR;
            PG8_LDA(At, 0, 1); PG8_STAGE(PG8_SA(0, 0), a2, voffA);
            PG8_BAR; PG8_WAIT_L(0); PG8_MMA(1, 0, At, B0); PG8_BAR; PG8_SCHED;
            PG8_STAGE(PG8_SB(0, 1), b2 + hstep, voffB);
            PG8_WAIT_V(6); PG8_BAR; PG8_MMA(1, 1, At, B1); PG8_BAR;
            PG8_LDB(B0, 1, 0); PG8_SCHED; PG8_LDA(At, 1, 0); PG8_STAGE(PG8_SA(0, 1), a2 + hstep, voffA);
            PG8_WAIT_L(8); PG8_BAR; PG8_WAIT_L(0); PG8_MMA(0, 0, At, B0); PG8_BAR; PG8_SCHED;
            PG8_LDB(B1, 1, 1); PG8_STAGE(PG8_SB(1, 0), b3, voffB);
            PG8_BAR; PG8_WAIT_L(0); PG8_MMA(0, 1, At, B1); PG8_BAR;
            PG8_LDA(At, 1, 1); PG8_STAGE(PG8_SA(1, 0), a3, voffA);
            PG8_BAR; PG8_WAIT_L(0); PG8_MMA(1, 0, At, B0); PG8_BAR; PG8_SCHED;
            PG8_STAGE(PG8_SB(1, 1), b3 + hstep, voffB);
            PG8_WAIT_V(6); PG8_BAR; PG8_MMA(1, 1, At, B1); PG8_BAR;
            }
        }
        if constexpr (ALIGN_EPI) { if (wr == 0) PG8_BAR; }
        if constexpr (!Epi::AFTER_DRAIN) { E(acc, cur, wr, wc, fr, fq); S.done(cur); }
        if (!has_next) break;
#pragma unroll
        for (int a = 0; a < 2; ++a)
#pragma unroll
            for (int b = 0; b < 2; ++b)
#pragma unroll
                for (int m = 0; m < 4; ++m)
#pragma unroll
                    for (int n = 0; n < 2; ++n) acc[a][b][m][n] = (f32x4){0.f, 0.f, 0.f, 0.f};
        cur = nxt; cA = nA; cB = nB; ++ui;
        if constexpr (ALIGN_EPI) { if (wr == 1) PG8_BAR; }
    }
    PG8_WAIT_V(0);
    if constexpr (!ALIGN_EPI) { if (wr == 0) PG8_BAR; }
    PG8_BAR;
    if constexpr (Epi::AFTER_DRAIN) { E.fused(acc, cur, wr, wc, fr, fq, lds, wid, lane); S.done(cur); }
#undef PG8_SA
#undef PG8_SB
#undef PG8_STAGE
#undef PG8_LDA
#undef PG8_LDB
#undef PG8_MMA
#undef PG8_WAIT_V
#undef PG8_WAIT_L
#undef PG8_BAR
#undef PG8_SCHED
}
}

struct EpiProj {
    static constexpr bool PERM = true, AFTER_DRAIN = false;
    bf16* O; int ldc;
    __device__ __forceinline__ void operator()(const f32x4 (&acc)[2][2][4][2], const pg8::Unit& u, int wr, int wc, int fr, int fq) const {
        const int row0 = u.pm * 256 + wr * 64 + fr; const int col0 = u.pn * 256 + wc * 32 + 8 * fq;
#pragma unroll
        for (int ai = 0; ai < 2; ++ai)
#pragma unroll
            for (int m = 0; m < 4; ++m) { bf16* rowp = O + (size_t)(row0 + ai * 128 + m * 16) * ldc + col0;
#pragma unroll
                for (int bj = 0; bj < 2; ++bj) { const f32x4 v0 = acc[ai][bj][m][0], v1 = acc[ai][bj][m][1];
                    u32x4 w; w.x = cvtpk(v0[0], v0[1]); w.y = cvtpk(v0[2], v0[3]); w.z = cvtpk(v1[0], v1[1]); w.w = cvtpk(v1[2], v1[3]);
                    *(u32x4*)(rowp + bj * 128) = w; } }
    }
};
struct EpiX1 {
    static constexpr bool PERM = false, AFTER_DRAIN = false;
    const float* x; const float* mod; float* out;
    __device__ __forceinline__ void operator()(const f32x4 (&acc)[2][2][4][2], const pg8::Unit& u, int wr, int wc, int fr, int fq) const {
        const int col0 = u.pn * 256 + wc * 32 + 4 * fq; const int b = (u.pm * 256) / SEQ;
        f32x4 g[2][2];
#pragma unroll
        for (int bj = 0; bj < 2; ++bj)
#pragma unroll
            for (int n = 0; n < 2; ++n) g[bj][n] = *(const f32x4*)(mod + (size_t)b * 6144 + 2 * 1024 + col0 + bj * 128 + n * 16);
#pragma unroll
        for (int ai = 0; ai < 2; ++ai)
#pragma unroll
            for (int m = 0; m < 4; ++m) { const size_t off = (size_t)(u.pm * 256 + ai * 128 + wr * 64 + m * 16 + fr) * DM + col0;
#pragma unroll
                for (int bj = 0; bj < 2; ++bj)
#pragma unroll
                    for (int n = 0; n < 2; ++n) { const f32x4 xv = *(const f32x4*)(x + off + bj * 128 + n * 16); *(f32x4*)(out + off + bj * 128 + n * 16) = xv + g[bj][n] * acc[ai][bj][m][n]; }
                if (m & 1) asm volatile("" ::: "memory"); }
    }
};
__device__ __forceinline__ float glu_f(float gate, float up) {
    gate = fminf(gate, 7.0f); up = fminf(fmaxf(up, -7.0f), 7.0f);
    const float sg = __builtin_amdgcn_rcpf(1.0f + __expf(-1.702f * gate));
    return (up + 1.0f) * (gate * sg);
}
__device__ __forceinline__ unsigned pk4_fp8(float a, float b, float c, float d) { int w = __builtin_amdgcn_cvt_pk_fp8_f32(a, b, 0, false); w = __builtin_amdgcn_cvt_pk_fp8_f32(c, d, w, true); return (unsigned)w; }
constexpr float W8_SCALE = 64.0f, W8_INV = 1.0f / 64.0f;
struct EpiGlu8 {
    static constexpr bool PERM = true, AFTER_DRAIN = false;
    unsigned char* H; const float* b_gu;
    __device__ __forceinline__ void operator()(const f32x4 (&acc)[2][2][4][2], const pg8::Unit& u, int wr, int wc, int fr, int fq) const {
        const int row0 = u.pm * 256 + wr * 64 + fr; const int c0 = u.pn * 128 + wc * 32 + 8 * fq;
        const float* bg = b_gu + (size_t)u.e * 2048 + c0; const float* bu = bg + 1024;
        const f32x4 bg0 = *(const f32x4*)bg, bg1 = *(const f32x4*)(bg + 4), bu0 = *(const f32x4*)bu, bu1 = *(const f32x4*)(bu + 4);
#pragma unroll
        for (int ai = 0; ai < 2; ++ai)
#pragma unroll
            for (int m = 0; m < 4; ++m) {
                const f32x4 g0 = acc[ai][0][m][0] * W8_INV + bg0, g1 = acc[ai][0][m][1] * W8_INV + bg1, u0 = acc[ai][1][m][0] * W8_INV + bu0, u1 = acc[ai][1][m][1] * W8_INV + bu1;
                u32x2 w; w.x = pk4_fp8(glu_f(g0[0], u0[0]), glu_f(g0[1], u0[1]), glu_f(g0[2], u0[2]), glu_f(g0[3], u0[3]));
                w.y = pk4_fp8(glu_f(g1[0], u1[0]), glu_f(g1[1], u1[1]), glu_f(g1[2], u1[2]), glu_f(g1[3], u1[3]));
                *(u32x2*)(H + (size_t)(row0 + ai * 128 + m * 16) * DM + c0) = w; }
    }
};
struct EpiGlu {
    static constexpr bool PERM = true, AFTER_DRAIN = false;
    bf16* H; const float* b_gu;
    __device__ __forceinline__ void operator()(const f32x4 (&acc)[2][2][4][2], const pg8::Unit& u, int wr, int wc, int fr, int fq) const {
        const int row0 = u.pm * 256 + wr * 64 + fr; const int c0 = u.pn * 128 + wc * 32 + 8 * fq;
        const float* bg = b_gu + (size_t)u.e * 2048 + c0; const float* bu = bg + 1024;
        const f32x4 bg0 = *(const f32x4*)bg, bg1 = *(const f32x4*)(bg + 4), bu0 = *(const f32x4*)bu, bu1 = *(const f32x4*)(bu + 4);
#pragma unroll
        for (int ai = 0; ai < 2; ++ai)
#pragma unroll
            for (int m = 0; m < 4; ++m) {
                const f32x4 g0 = acc[ai][0][m][0] + bg0, g1 = acc[ai][0][m][1] + bg1, u0 = acc[ai][1][m][0] + bu0, u1 = acc[ai][1][m][1] + bu1;
                u32x4 w; w.x = cvtpk(glu_f(g0[0], u0[0]), glu_f(g0[1], u0[1])); w.y = cvtpk(glu_f(g0[2], u0[2]), glu_f(g0[3], u0[3]));
                w.z = cvtpk(glu_f(g1[0], u1[0]), glu_f(g1[1], u1[1])); w.w = cvtpk(glu_f(g1[2], u1[2]), glu_f(g1[3], u1[3]));
                *(u32x4*)(H + (size_t)(row0 + ai * 128 + m * 16) * DM + c0) = w; }
    }
};
template <bool F8> struct EpiDownT {
    static constexpr bool PERM = true, AFTER_DRAIN = false;
    bf16* Y; const float* b_down; const int* rowinfo; const float* rowgate;
    __device__ __forceinline__ void operator()(const f32x4 (&acc)[2][2][4][2], const pg8::Unit& u, int wr, int wc, int fr, int fq) const {
        const int row0 = u.pm * 256 + wr * 64 + fr; const int col0 = u.pn * 256 + wc * 32 + 8 * fq;
        const float* bd = b_down + (size_t)u.e * 1024 + col0;
        f32x4 bv[2][2];
#pragma unroll
        for (int bj = 0; bj < 2; ++bj)
#pragma unroll
            for (int n = 0; n < 2; ++n) bv[bj][n] = *(const f32x4*)(bd + bj * 128 + 4 * n);
#pragma unroll
        for (int ai = 0; ai < 2; ++ai)
#pragma unroll
            for (int m = 0; m < 4; ++m) { const int row = row0 + ai * 128 + m * 16; const int dst = rowinfo[row]; const float gt = rowgate[row];
                if (dst >= 0) { bf16* rowp = Y + (size_t)dst * DM + col0;
#pragma unroll
                    for (int bj = 0; bj < 2; ++bj) { const float sa = F8 ? W8_INV : 1.0f; const f32x4 v0 = (acc[ai][bj][m][0] * sa + bv[bj][0]) * gt, v1 = (acc[ai][bj][m][1] * sa + bv[bj][1]) * gt;
                        u32x4 w; w.x = cvtpk(v0[0], v0[1]); w.y = cvtpk(v0[2], v0[3]); w.z = cvtpk(v1[0], v1[1]); w.w = cvtpk(v1[2], v1[3]);
                        *(u32x4*)(rowp + bj * 128) = w; } } }
    }
};
struct GroupedOrder {
    const LAS int* tile_e; int ntiles, nN, G, c; size_t estride;
    __device__ __forceinline__ bool next(int i, pg8::Unit& u) const {
        int pm, pn;
        if (G == 256) { const int x = c & 7, j = c >> 3, rpx = 32 / nN; pn = j % nN; pm = i * (8 * rpx) + x * rpx + j / nN; }
        else { const long L = (long)i * G + c; pm = (int)(L / nN); pn = (int)(L % nN); }
        if (pm >= ntiles) return false;
        u.pm = pm; u.pn = pn; u.e = __builtin_amdgcn_readfirstlane(tile_e[pm]); u.bo = (size_t)u.e * estride; return true;
    }
    __device__ __forceinline__ void a_ready(const pg8::Unit&) const {}
    __device__ __forceinline__ void done(const pg8::Unit&) const {}
};

#define XB_TMO      128
#define XB_XCNT(j)  (256  + 64 * (j))
#define XB_XSUB(j)  (1280 + 64 * (j))
#define XB_XGEN(j)  (2304 + 64 * (j))
#define XB_TOP      3328
#define XB_TOPGEN   3392
#define XCD_BAR_WORDS 3456
#define XB_SPIN_CAP (1u << 18)

__device__ __forceinline__ unsigned xb_ld(unsigned* p)              { return __hip_atomic_load(p, __ATOMIC_RELAXED, __HIP_MEMORY_SCOPE_AGENT); }
__device__ __forceinline__ unsigned xb_add(unsigned* p, unsigned v) { return __hip_atomic_fetch_add(p, v, __ATOMIC_RELAXED, __HIP_MEMORY_SCOPE_AGENT); }
__device__ __forceinline__ unsigned xb_xcc_id() { return (unsigned)__builtin_amdgcn_s_getreg((3 << 11) | 20) & 0xFu; }
#define XB_SPIN(cond, bar) do { unsigned _sp = 0; while (cond) { __builtin_amdgcn_s_sleep(1); \
    if ((++_sp & 255u) == 0u) { if (xb_ld(&(bar)[XB_TMO])) break; if (_sp > XB_SPIN_CAP) { atomicAdd(&(bar)[XB_TMO], 1u); break; } } } } while (0)

struct XcdBarrier {
    unsigned* bar; unsigned x; bool w0;
    volatile LAS unsigned* st;
};

__device__ __forceinline__ XcdBarrier xcd_barrier_post(unsigned* bar, volatile LAS unsigned* st, bool w0) {
    XcdBarrier b; b.bar = bar; b.x = xb_xcc_id(); b.st = st; b.w0 = w0;
    if (w0 && hw_lane() == 0) (void)xb_add(&bar[XB_XCNT(b.x)], 1u);
    return b;
}
__device__ __forceinline__ void xcd_barrier_complete(unsigned* bar, unsigned x, unsigned& nloc, unsigned& nx) {
    const unsigned G = gridDim.x * gridDim.y * gridDim.z;
    unsigned sum, cnt, mine, sp = 0u;
    for (;;) {
        sum = 0u; cnt = 0u; mine = 0u;
#pragma unroll
        for (unsigned j = 0; j < 16; ++j) { const unsigned c = xb_ld(&bar[XB_XCNT(j)]); sum += c; cnt += (c > 0u) ? 1u : 0u; mine = (j == x) ? c : mine; }
        if (sum == G) break;
        __builtin_amdgcn_s_sleep(1);
        if ((++sp & 255u) == 0u) { if (xb_ld(&bar[XB_TMO])) break; if (sp > XB_SPIN_CAP) { atomicAdd(&bar[XB_TMO], 1u); break; } }
    }
    nloc = mine > 0u ? mine : 1u; nx = cnt > 0u ? cnt : 1u;
}

__device__ __forceinline__ void xcd_barrier(const XcdBarrier& b) {
    asm volatile("s_waitcnt vmcnt(0)" ::: "memory");
    __syncthreads();
    if (b.w0 && hw_lane() == 0) {
        unsigned* bar = b.bar;
        __builtin_amdgcn_s_waitcnt(0);
        unsigned nloc = b.st[0], nx = b.st[1];
        if (nloc == 0u) { xcd_barrier_complete(bar, b.x, nloc, nx); b.st[0] = nloc; b.st[1] = nx; }
        const unsigned old = xb_add(&bar[XB_XSUB(b.x)], 1u);
        const unsigned gen = old / nloc;
        if (old + 1u == (gen + 1u) * nloc) {
            __builtin_amdgcn_fence(__ATOMIC_RELEASE, "agent");
            asm volatile("s_waitcnt vmcnt(0)" ::: "memory");
            const unsigned og = xb_add(&bar[XB_TOP], 1u);
            const unsigned tg = og / nx;
            if (og + 1u == (tg + 1u) * nx) xb_add(&bar[XB_TOPGEN], 1u);
            else XB_SPIN(xb_ld(&bar[XB_TOPGEN]) == tg, bar);
            __builtin_amdgcn_fence(__ATOMIC_ACQUIRE, "agent");
            xb_add(&bar[XB_XGEN(b.x)], 1u);
            asm volatile("s_waitcnt vmcnt(0)" ::: "memory");
        } else {
            XB_SPIN(xb_ld(&bar[XB_XGEN(b.x)]) == gen, bar);
            __builtin_amdgcn_fence(__ATOMIC_ACQUIRE, "agent");
            asm volatile("s_waitcnt vmcnt(0)" ::: "memory");
        }
    }
    __syncthreads();
}

struct Frame {
    LAS unsigned char* lds;
    volatile LAS unsigned* MISC;
    unsigned* ctl;
    int wave, G, bid;
    __device__ __forceinline__ int lane() const { return hw_lane(); }
    __device__ __forceinline__ int tid() const { return wave * 64 + hw_lane(); }
    __device__ __forceinline__ const float* in(int i) const { const LAS unsigned* p = (const LAS unsigned*)(lds + PTR_OFF) + 2 * i;
        const unsigned lo = __builtin_amdgcn_readfirstlane(p[0]), hi = __builtin_amdgcn_readfirstlane(p[1]); return (const float*)(((unsigned long long)hi << 32) | lo); }
    float* out; unsigned char* ws;
    unsigned long long tacc;
};
__device__ __forceinline__ float log2gamma(int h) { return log2f(1.0f - exp2f(-5.0f - (float)h)); }

template <bool F8, class RowMap>
__device__ __forceinline__ void transpose_item(const float* W, int N, bf16* WT, int K, const float* kscale, LAS float* scr, int kb, int nb, int lane, RowMap rm) {
    const int k0 = 64 * kb, n0 = 64 * nb;
#pragma unroll 4
    for (int i = 0; i < 16; ++i) {
        const int kk = 4 * i + (lane >> 4), nn = 4 * (lane & 15);
        f32x4 v = (f32x4){0.f, 0.f, 0.f, 0.f};
        if (n0 + nn < N) v = *(const f32x4*)(W + (size_t)(k0 + kk) * N + n0 + nn);
        if (kscale) v = v * kscale[k0 + kk];
        LAS float* s = scr + kk * 65 + nn; s[0] = v[0]; s[1] = v[1]; s[2] = v[2]; s[3] = v[3];
    }
    asm volatile("s_waitcnt lgkmcnt(0)" ::: "memory");
    const int cch = lane & 7;
#pragma unroll
    for (int j = 0; j < 8; ++j) {
        const int n = 8 * j + (lane >> 3); const LAS float* s = scr + (8 * cch) * 65 + n;
        if constexpr (F8) {
            u32x2 o; o.x = pk4_fp8(s[0 * 65] * W8_SCALE, s[1 * 65] * W8_SCALE, s[2 * 65] * W8_SCALE, s[3 * 65] * W8_SCALE); o.y = pk4_fp8(s[4 * 65] * W8_SCALE, s[5 * 65] * W8_SCALE, s[6 * 65] * W8_SCALE, s[7 * 65] * W8_SCALE);
            if (n0 + n < N) *(u32x2*)((unsigned char*)WT + (size_t)rm(n0 + n) * K + k0 + 8 * cch) = o;
        } else {
        u32x4 o; o.x = cvtpk(s[0 * 65], s[1 * 65]); o.y = cvtpk(s[2 * 65], s[3 * 65]); o.z = cvtpk(s[4 * 65], s[5 * 65]); o.w = cvtpk(s[6 * 65], s[7 * 65]);
        if (n0 + n < N) *(u32x4*)(WT + (size_t)rm(n0 + n) * K + k0 + 8 * cch) = o; }
    }
    asm volatile("s_waitcnt lgkmcnt(0)" ::: "memory");
}
struct RmId { __device__ __forceinline__ int operator()(int n) const { return n; } };
struct RmGu { __device__ __forceinline__ int operator()(int n) const { const int j = n & 1023; return (j >> 7) * 256 + (n >> 10) * 128 + (j & 127); } };

__device__ __forceinline__ void phase_p0a(Frame& F) {
    const float* const c_in = F.in(1); const float* const ada_w = F.in(2); const float* const ada_b = F.in(3); const float* const w_in = F.in(5); const float* const mix_scale = F.in(6);
    const float* const w_o = F.in(7); const float* const w_gu = F.in(11); const float* const w_down = F.in(13);
    if (F.bid < 96) {
        LAS float* sc = (LAS float*)F.lds;
        LAS float* part = (LAS float*)(F.lds + 16384);
        for (int i = F.tid(); i < 1024; i += NTHR) {
#pragma unroll
            for (int b = 0; b < 4; ++b) { const float cv = c_in[b * 1024 + i]; sc[i * 4 + b] = cv / (1.0f + __expf(-cv)); }
        }
        __syncthreads();
        const int j0 = F.bid * 64;
        float a0 = 0.f, a1 = 0.f, a2 = 0.f, a3 = 0.f;
#pragma unroll 8
        for (int ii = 0; ii < 128; ++ii) {
            const int i = F.wave * 128 + ii; const float w = ada_w[(size_t)i * 6144 + j0 + F.lane()];
            const f32x4 s4 = *(const LAS f32x4*)(sc + i * 4);
            a0 += s4[0] * w; a1 += s4[1] * w; a2 += s4[2] * w; a3 += s4[3] * w;
        }
        part[(F.wave * 4 + 0) * 64 + F.lane()] = a0; part[(F.wave * 4 + 1) * 64 + F.lane()] = a1; part[(F.wave * 4 + 2) * 64 + F.lane()] = a2; part[(F.wave * 4 + 3) * 64 + F.lane()] = a3;
        __syncthreads();
        if (F.tid() < 256) { const int b = F.tid() >> 6, l = F.tid() & 63; float s = ada_b[j0 + l];
#pragma unroll
            for (int w = 0; w < 8; ++w) s += part[(w * 4 + b) * 64 + l];
            ((float*)(F.ws + WS_MOD))[b * 6144 + j0 + l] = s; }
        __syncthreads();
    }
    { int* ri = (int*)(F.ws + WS_ROWINFO); for (int i = F.bid * NTHR + F.tid(); i < MOE_ROWS; i += F.G * NTHR) ri[i] = -1; }
    LAS float* scr = (LAS float*)(F.lds + F.wave * 16640);
    const int gw = F.bid * NWAVES + F.wave, NGW = F.G * NWAVES;
    constexpr int I_IN = 16 * 46, I_O = 16 * 16, I_GU = 32 * 16 * 32, I_DN = 32 * 16 * 16, NITEMS = I_IN + I_O + I_GU + I_DN;
    for (int it = gw; it < NITEMS; it += NGW) {
        int r = it;
        if (r < I_GU) { const int e = r / 512, q = r % 512; transpose_item<true>(w_gu + (size_t)e * 1024 * 2048, 2048, (bf16*)(F.ws + WS_WGU + (size_t)e * 2048 * 1024), 1024, nullptr, scr, q / 32, q % 32, F.lane(), RmGu()); continue; } r -= I_GU;
        if (r < I_DN) { const int e = r / 256, q = r % 256; transpose_item<true>(w_down + (size_t)e * 1024 * 1024, 1024, (bf16*)(F.ws + WS_WDN + (size_t)e * 1024 * 1024), 1024, nullptr, scr, q / 16, q % 16, F.lane(), RmId()); continue; } r -= I_DN;
        if (r < I_IN) { transpose_item<false>(w_in, IN_COLS, (bf16*)(F.ws + WS_WIN), 1024, nullptr, scr, r / 46, r % 46, F.lane(), RmId()); continue; } r -= I_IN;
        transpose_item<false>(w_o, 1024, (bf16*)(F.ws + WS_WO), 1024, mix_scale, scr, r / 16, r % 16, F.lane(), RmId());
    }
}

__device__ __forceinline__ void phase_p0b(Frame& F) {
    const float* const x_in = F.in(0); const float* const norm1_g = F.in(4);
    const int gw = F.bid * NWAVES + F.wave, NGW = F.G * NWAVES;
    const float* mod = (const float*)(F.ws + WS_MOD); bf16* h0 = (bf16*)(F.ws + WS_H0);
    for (int m = gw; m < NTOK; m += NGW) {
        const int b = m / SEQ;
        const f32x4* xr = (const f32x4*)(x_in + (size_t)m * DM) + F.lane();
        f32x4 v[4]; float s = 0.f;
#pragma unroll
        for (int j = 0; j < 4; ++j) { v[j] = xr[64 * j]; s += (v[j][0] * v[j][0] + v[j][1] * v[j][1]) + (v[j][2] * v[j][2] + v[j][3] * v[j][3]); }
        const float rstd = rsqrtf(wave_sum(s) * (1.f / DM) + EPS);
        u32x2* o8 = (u32x2*)(h0 + (size_t)m * DM) + F.lane();
#pragma unroll
        for (int j = 0; j < 4; ++j) { const int col = 4 * F.lane() + 256 * j;
            const f32x4 g = *(const f32x4*)(norm1_g + col), sh = *(const f32x4*)(mod + b * 6144 + col), sc = *(const f32x4*)(mod + b * 6144 + 1024 + col);
            const f32x4 y = (v[j] * rstd) * g * (sc + 1.0f) + sh;
            u32x2 w; w.x = cvtpk(y[0], y[1]); w.y = cvtpk(y[2], y[3]); o8[64 * j] = w; }
    }
}

constexpr int VSTR = 144, KSTR = 80;
__device__ __forceinline__ void ret_stage_v(Frame& F, const bf16* proj, int tok0, int h, LAS bf16* Vs) {
    const int row = F.tid() >> 2, q = F.tid() & 3; const bf16* src = proj + (size_t)(tok0 + row) * PJ + C_RV + h * 128 + q * 32;
#pragma unroll
    for (int i = 0; i < 4; ++i) *(LAS u32x4*)(Vs + row * VSTR + q * 32 + 8 * i) = *(const u32x4*)(src + 8 * i);
}
__device__ __forceinline__ void ret_stage64(Frame& F, const bf16* src0, size_t pitch, LAS bf16* Ds) {
    const int row = F.tid() >> 2, q = F.tid() & 3; const bf16* src = src0 + (size_t)row * pitch + q * 16;
#pragma unroll
    for (int i = 0; i < 2; ++i) *(LAS u32x4*)(Ds + row * KSTR + q * 16 + 8 * i) = *(const u32x4*)(src + 8 * i);
}
__device__ __forceinline__ void ret_a_item(Frame& F, int item) {
    const bf16* proj = (const bf16*)(F.ws + WS_PROJ); float* kvt = (float*)(F.ws + WS_KVT) + (size_t)item * 8192;
    const int bh = item >> 6, n = item & 63, b = bh >> 2, h = bh & 3, tok0 = b * SEQ + n * 128;
    LAS bf16* Vs = (LAS bf16*)F.lds; LAS bf16* Ks = (LAS bf16*)(F.lds + 128 * VSTR * 2);
    const float lg = log2gamma(h);
    ret_stage_v(F, proj, tok0, h, Vs);
    { const int row = F.tid() >> 2, q = F.tid() & 3; const bf16* src = proj + (size_t)(tok0 + row) * PJ + C_RK + h * 64 + q * 16; const float dk = 0.125f * exp2f((float)(127 - row) * lg);
#pragma unroll
      for (int i = 0; i < 2; ++i) { const u32x4 w = *(const u32x4*)(src + 8 * i); u32x4 o;
          o.x = cvtpk(bflo(w.x) * dk, bfhi(w.x) * dk); o.y = cvtpk(bflo(w.y) * dk, bfhi(w.y) * dk); o.z = cvtpk(bflo(w.z) * dk, bfhi(w.z) * dk); o.w = cvtpk(bflo(w.w) * dk, bfhi(w.w) * dk);
          *(LAS u32x4*)(Ks + row * KSTR + q * 16 + 8 * i) = o; } }
    __syncthreads();
    const int lane = F.lane(), n16 = lane & 15, c = lane >> 4, q4 = n16 >> 2, p4 = lane & 3, e0 = 16 * F.wave;
    f32x4 acc[4];
#pragma unroll
    for (int dt = 0; dt < 4; ++dt) acc[dt] = (f32x4){0.f, 0.f, 0.f, 0.f};
#pragma unroll
    for (int s = 0; s < 4; ++s) {
        const LAS bf16* ap = Vs + (32 * s + 4 * c + q4) * VSTR + e0 + 4 * p4;
        const bf16x8 A = cat8(trread(ap), trread(ap + 16 * VSTR));
#pragma unroll
        for (int dt = 0; dt < 4; ++dt) { const LAS bf16* bp = Ks + (32 * s + 4 * c + q4) * KSTR + 16 * dt + 4 * p4;
            const bf16x8 B = cat8(trread(bp), trread(bp + 16 * KSTR)); acc[dt] = MFMA16(A, B, acc[dt]); }
    }
#pragma unroll
    for (int dt = 0; dt < 4; ++dt)
#pragma unroll
        for (int r = 0; r < 4; ++r) kvt[(e0 + 4 * c + r) * 64 + 16 * dt + n16] = acc[dt][r];
    __syncthreads();
}
__device__ __forceinline__ void ret_scan(Frame& F) {
    const float* kvt = (const float*)(F.ws + WS_KVT); bf16* rpt = (bf16*)(F.ws + WS_RPT);
    for (int g = F.bid * NTHR + F.tid(); g < 16 * 8192; g += F.G * NTHR) {
        const int bh = g >> 13, ed = g & 8191, h = bh & 3; const float gC = exp2f(128.0f * log2gamma(h));
        float R = 0.f; const size_t base = (size_t)bh * 64 * 8192 + ed;
#pragma unroll 8
        for (int n = 0; n < 64; ++n) { const float kv = kvt[base + (size_t)n * 8192]; rpt[base + (size_t)n * 8192] = f2bf(R); R = R * gC + kv; }
    }
}
__device__ __forceinline__ void ret_c_item(Frame& F, int item) {
    const bf16* proj = (const bf16*)(F.ws + WS_PROJ); const bf16* rpt = (const bf16*)(F.ws + WS_RPT) + (size_t)item * 8192; bf16* mix = (bf16*)(F.ws + WS_MIX);
    const int bh = item >> 6, n = item & 63, b = bh >> 2, h = bh & 3, tok0 = b * SEQ + n * 128;
    LAS bf16* Qs = (LAS bf16*)F.lds; LAS bf16* Ks = Qs + 128 * KSTR; LAS bf16* Vs = Ks + 128 * KSTR; LAS bf16* Rs = Vs + 128 * VSTR;
    const float lg = log2gamma(h);
    ret_stage64(F, proj + (size_t)tok0 * PJ + C_RQ + h * 64, PJ, Qs);
    ret_stage64(F, proj + (size_t)tok0 * PJ + C_RK + h * 64, PJ, Ks);
    ret_stage_v(F, proj, tok0, h, Vs);
    ret_stage64(F, rpt, 64, Rs);
    __syncthreads();
    const int lane = F.lane(), n16 = lane & 15, c = lane >> 4, q4 = n16 >> 2, p4 = lane & 3, w = F.wave, i0 = 16 * w, il = i0 + n16;
    bf16x8 qf[2];
#pragma unroll
    for (int s = 0; s < 2; ++s) qf[s] = *(const LAS bf16x8*)(Qs + il * KSTR + 32 * s + 8 * c);
    f32x4 oin[8], ocr[8];
#pragma unroll
    for (int et = 0; et < 8; ++et) { oin[et] = (f32x4){0.f, 0.f, 0.f, 0.f}; ocr[et] = (f32x4){0.f, 0.f, 0.f, 0.f}; }
    const int nsp = (w >> 1) + 1;
    for (int sp = 0; sp < nsp; ++sp) {
        unsigned pw[4];
#pragma unroll
        for (int t2 = 0; t2 < 2; ++t2) { const int jt = 2 * sp + t2;
            const bf16x8 k0 = *(const LAS bf16x8*)(Ks + (16 * jt + n16) * KSTR + 8 * c), k1 = *(const LAS bf16x8*)(Ks + (16 * jt + n16) * KSTR + 32 + 8 * c);
            f32x4 st = MFMA16(k0, qf[0], ((f32x4){0.f, 0.f, 0.f, 0.f})); st = MFMA16(k1, qf[1], st);
            float pv[4];
#pragma unroll
            for (int r = 0; r < 4; ++r) { const int j = 16 * jt + 4 * c + r; const float f = (il >= j) ? 0.125f * exp2f((float)(il - j) * lg) : 0.f; pv[r] = st[r] * f; }
            pw[2 * t2] = cvtpk(pv[0], pv[1]); pw[2 * t2 + 1] = cvtpk(pv[2], pv[3]); }
        const bf16x8 P = __builtin_bit_cast(bf16x8, ((u32x4){pw[0], pw[1], pw[2], pw[3]}));
#pragma unroll
        for (int et = 0; et < 8; ++et) { const LAS bf16* ap = Vs + (32 * sp + 4 * c + q4) * VSTR + 16 * et + 4 * p4;
            const bf16x8 A = cat8(trread(ap), trread(ap + 16 * VSTR)); oin[et] = MFMA16(A, P, oin[et]); }
    }
#pragma unroll
    for (int et = 0; et < 8; ++et)
#pragma unroll
        for (int s = 0; s < 2; ++s) { const bf16x8 rf = *(const LAS bf16x8*)(Rs + (16 * et + n16) * KSTR + 32 * s + 8 * c); ocr[et] = MFMA16(rf, qf[s], ocr[et]); }
    const float qd = exp2f((float)(il + 1) * lg);
    float ss = 0.f;
#pragma unroll
    for (int et = 0; et < 8; ++et) { oin[et] = oin[et] + ocr[et] * qd; ss += (oin[et][0] * oin[et][0] + oin[et][1] * oin[et][1]) + (oin[et][2] * oin[et][2] + oin[et][3] * oin[et][3]); }
    ss += __shfl_xor(ss, 16); ss += __shfl_xor(ss, 32);
    const float rstd = rsqrtf(ss * (1.f / 128.f) + EPS);
    const bf16* gp = proj + (size_t)(tok0 + il) * PJ + C_RG + h * 128 + 4 * c; bf16* op = mix + (size_t)(tok0 + il) * DM + h * 128 + 4 * c;
#pragma unroll
    for (int et = 0; et < 8; ++et) { const u32x2 gw = *(const u32x2*)(gp + 16 * et);
        const float g0 = bflo(gw.x), g1 = bfhi(gw.x), g2 = bflo(gw.y), g3 = bfhi(gw.y);
        const float y0 = g0 / (1.f + __expf(-g0)) * (oin[et][0] * rstd), y1 = g1 / (1.f + __expf(-g1)) * (oin[et][1] * rstd), y2 = g2 / (1.f + __expf(-g2)) * (oin[et][2] * rstd), y3 = g3 / (1.f + __expf(-g3)) * (oin[et][3] * rstd);
        u32x2 o; o.x = cvtpk(y0, y1); o.y = cvtpk(y2, y3); *(u32x2*)(op + 16 * et) = o; }
    __syncthreads();
}

constexpr int QT = 64, KT = 64, CAP = 512, CAP_TRIG = CAP - KT, NSEL = 256, NREG = CAP / 64;
constexpr int KTS = 72;
constexpr int CAND_BYTES = QT * CAP * 4, KTILE_BYTES = KT * KTS * 2;
constexpr float WSCALE = 0.125f * 0.35355339059327373f;
__device__ __forceinline__ unsigned fmap(float s) { const unsigned u = __builtin_bit_cast(unsigned, s); return (u & 0x80000000u) ? ~u : (u | 0x80000000u); }
__device__ __forceinline__ float funmap(unsigned m) { const unsigned u = (m & 0x80000000u) ? (m ^ 0x80000000u) : ~m; return __builtin_bit_cast(float, u); }
#define DPP_ROR(v, n) ((unsigned)__builtin_amdgcn_update_dpp(0, (int)(v), 0x120 + (n), 0xf, 0xf, false))
#define DPP_SHR0(v, n) ((unsigned)__builtin_amdgcn_update_dpp(0, (int)(v), 0x110 + (n), 0xf, 0xf, true))
__device__ __forceinline__ unsigned wave_umin(unsigned v) {
    v = min(v, DPP_ROR(v, 1)); v = min(v, DPP_ROR(v, 2)); v = min(v, DPP_ROR(v, 4)); v = min(v, DPP_ROR(v, 8));
    const unsigned a = __builtin_amdgcn_readlane(v, 0), b = __builtin_amdgcn_readlane(v, 16), c = __builtin_amdgcn_readlane(v, 32), d = __builtin_amdgcn_readlane(v, 48);
    return min(min(a, b), min(c, d));
}
__device__ __forceinline__ unsigned wave_umax(unsigned v) {
    v = max(v, DPP_ROR(v, 1)); v = max(v, DPP_ROR(v, 2)); v = max(v, DPP_ROR(v, 4)); v = max(v, DPP_ROR(v, 8));
    const unsigned a = __builtin_amdgcn_readlane(v, 0), b = __builtin_amdgcn_readlane(v, 16), c = __builtin_amdgcn_readlane(v, 32), d = __builtin_amdgcn_readlane(v, 48);
    return max(max(a, b), max(c, d));
}
__device__ __forceinline__ unsigned wave_scan_incl(unsigned v, int lane) {
    v += DPP_SHR0(v, 1); v += DPP_SHR0(v, 2); v += DPP_SHR0(v, 4); v += DPP_SHR0(v, 8);
    const unsigned t0 = __builtin_amdgcn_readlane(v, 15), t1 = __builtin_amdgcn_readlane(v, 31), t2 = __builtin_amdgcn_readlane(v, 47);
    const int rw = lane >> 4;
    return v + (rw == 1 ? t0 : rw == 2 ? t0 + t1 : rw == 3 ? t0 + t1 + t2 : 0u);
}
__device__ __forceinline__ int select_row(LAS unsigned* row, int cnt, int limit, LAS unsigned* hist, int lane, unsigned& minkey) {
    unsigned e[NREG]; unsigned act = 0u, keep = 0u;
#pragma unroll
    for (int j = 0; j < NREG; ++j) { const int p = 64 * j + lane; const bool v = p < cnt; e[j] = v ? row[p] : 0u; act |= v ? (1u << j) : 0u; }
    int need = NSEL; bool first = true;
    for (;;) {
        unsigned lo = 0xFFFFFFFFu, hi = 0u;
#pragma unroll
        for (int j = 0; j < NREG; ++j) { const bool a = (act >> j) & 1u; lo = min(lo, a ? e[j] : 0xFFFFFFFFu); hi = max(hi, a ? e[j] : 0u); }
        lo = wave_umin(lo); hi = wave_umax(hi);
        if (hi == lo) break;
        hist[lane] = 0u;
        int rb[NREG];
        if (first) {
            const float slo = funmap(lo & 0xFFFFE000u), shi = funmap(hi & 0xFFFFE000u);
            const float scale = (shi > slo) ? 63.999f / (shi - slo) : 0.f;
#pragma unroll
            for (int j = 0; j < NREG; ++j) { int bn = (int)((funmap(e[j] & 0xFFFFE000u) - slo) * scale); bn = bn > 63 ? 63 : (bn < 0 ? 0 : bn); rb[j] = 63 - bn; }
        } else {
            const float scale = 63.999f / (float)(hi - lo);
#pragma unroll
            for (int j = 0; j < NREG; ++j) { int bn = (int)((float)(e[j] - lo) * scale); bn = bn > 63 ? 63 : (bn < 0 ? 0 : bn); rb[j] = 63 - bn; }
        }
        first = false;
#pragma unroll
        for (int j = 0; j < NREG; ++j) __hip_atomic_fetch_add(hist + rb[j], (act >> j) & 1u, __ATOMIC_RELAXED, __HIP_MEMORY_SCOPE_WAVEFRONT);
        const unsigned h = hist[lane];
        const unsigned ps = wave_scan_incl(h, lane);
        const unsigned long long m = __ballot(ps >= (unsigned)need);
        const int ls = (int)__builtin_ctzll(m);
        const int cge = (int)__builtin_amdgcn_readlane(ps, ls), nb = (int)__builtin_amdgcn_readlane(h, ls);
#pragma unroll
        for (int j = 0; j < NREG; ++j) { const unsigned a = (act >> j) & 1u; const unsigned kp = a & (unsigned)(rb[j] < ls), dr = a & (unsigned)(rb[j] > ls); keep |= kp << j; act &= ~((kp | dr) << j); }
        need -= cge - nb;
        if ((NSEL - need) + nb <= limit) break;
    }
    keep |= act;
    int run = 0; unsigned mk = 0xFFFFFFFFu;
#pragma unroll
    for (int j = 0; j < NREG; ++j) { const bool k = (keep >> j) & 1u; const unsigned long long m = __ballot(k);
        if (k) row[run + mbcnt64(m)] = e[j];
        mk = min(mk, k ? e[j] : 0xFFFFFFFFu);
        run += __builtin_popcountll(m); }
    minkey = wave_umin(mk);
    return run;
}
__device__ __forceinline__ int compact_stream(LAS unsigned* row, int cnt, LAS unsigned* hist, int lane, float& thrf) {
    unsigned e[NREG];
#pragma unroll
    for (int j = 0; j < NREG; ++j) e[j] = row[64 * j + lane];
    const unsigned lo = wave_umin(min(e[0], e[1])), hi = wave_umax(max(e[0], e[1]));
    const float slo = funmap(lo & 0xFFFFE000u), shi = funmap(hi & 0xFFFFE000u);
    bool ok = shi > slo; int newcnt = 0, bstar = 0; int bn[NREG]; float scale = 0.f;
    if (ok) {
        scale = 63.999f / (shi - slo);
        hist[lane] = 0u;
#pragma unroll
        for (int j = 0; j < NREG; ++j) { int b = (int)((funmap(e[j] & 0xFFFFE000u) - slo) * scale); b = b > 63 ? 63 : (b < 0 ? 0 : b); bn[j] = b;
            __hip_atomic_fetch_add(hist + (63 - b), (64 * j + lane < cnt) ? 1u : 0u, __ATOMIC_RELAXED, __HIP_MEMORY_SCOPE_WAVEFRONT); }
        const unsigned h = hist[lane];
        const unsigned ps = wave_scan_incl(h, lane);
        const unsigned long long m = __ballot(ps >= (unsigned)NSEL);
        const int ls = (int)__builtin_ctzll(m);
        newcnt = (int)__builtin_amdgcn_readlane(ps, ls); bstar = 63 - ls;
        ok = newcnt <= NSEL + 96;
    }
    if (!ok) { unsigned P; const int nc = select_row(row, cnt, NSEL + 64, hist, lane, P); thrf = funmap(P & 0xFFFFE000u); return nc; }
    int run = 0;
#pragma unroll
    for (int j = 0; j < NREG; ++j) { const bool k = (64 * j + lane < cnt) && (bn[j] >= bstar); const unsigned long long m = __ballot(k);
        if (k) row[run + mbcnt64(m)] = e[j];
        run += __builtin_popcountll(m); }
    if (bstar > 0) thrf = slo + ((float)bstar - 0.01f) / scale;
    return run;
}
#if defined(PROBE_SUB)
#define PSUB_T(i) do { const unsigned long long _t = __builtin_amdgcn_s_memrealtime(); if ((i) == PROBE_SUB) F.tacc += _t - psub_last; psub_last = _t; } while (0)
#else
#define PSUB_T(i) do { } while (0)
#endif
__device__ __forceinline__ void dsa_a_unit(Frame& F, int b, int qt) {
#if defined(PROBE_SUB)
    unsigned long long psub_last = 0ull;
#endif
    const bf16* proj = (const bf16*)(F.ws + WS_PROJ); bf16* sel = (bf16*)(F.ws + WS_SEL);
    LAS unsigned* cand = (LAS unsigned*)F.lds; LAS bf16* ktile = (LAS bf16*)(F.lds + CAND_BYTES);
    LAS unsigned* hist = (LAS unsigned*)(F.lds + CAND_BYTES + KTILE_BYTES) + 64 * F.wave;
    LAS int* rowcnt = (LAS int*)(F.lds + CAND_BYTES + KTILE_BYTES + 2048); LAS float* rowthr = (LAS float*)(F.lds + CAND_BYTES + KTILE_BYTES + 2048 + 256);
    const int lane = F.lane(), w = F.wave, r32 = lane & 31, hi = lane >> 5;
    const int tokb = b * SEQ, q0 = qt * QT;
    bf16x8 af[2][4]; float wv[2][16];
    { const int qq = 2 * ((r32 >> 2) & 1) + (r32 >> 4), hd = ((r32 >> 3) & 1) * 4 + (r32 & 3);
#pragma unroll
      for (int mt = 0; mt < 2; ++mt) { const bf16* qp = proj + (size_t)(tokb + q0 + 8 * w + 4 * mt + qq) * PJ + C_IQ + hd * 64 + 8 * hi;
#pragma unroll
          for (int s = 0; s < 4; ++s) af[mt][s] = *(const bf16x8*)(qp + 16 * s);
#pragma unroll
          for (int u = 0; u < 2; ++u) { const u32x4 ww = *(const u32x4*)(proj + (size_t)(tokb + q0 + 8 * w + 4 * mt + 2 * hi + u) * PJ + C_IW);
              wv[mt][8 * u + 0] = bflo(ww.x) * WSCALE; wv[mt][8 * u + 1] = bfhi(ww.x) * WSCALE; wv[mt][8 * u + 2] = bflo(ww.y) * WSCALE; wv[mt][8 * u + 3] = bfhi(ww.y) * WSCALE;
              wv[mt][8 * u + 4] = bflo(ww.z) * WSCALE; wv[mt][8 * u + 5] = bfhi(ww.z) * WSCALE; wv[mt][8 * u + 6] = bflo(ww.w) * WSCALE; wv[mt][8 * u + 7] = bfhi(ww.w) * WSCALE; } } }
    float thrf[2][2]; int cntv[2][2];
#pragma unroll
    for (int mt = 0; mt < 2; ++mt)
#pragma unroll
        for (int u = 0; u < 2; ++u) { thrf[mt][u] = -INFINITY; cntv[mt][u] = 0; }
    if (lane < 8) { rowcnt[8 * w + lane] = 0; rowthr[8 * w + lane] = -INFINITY; }
    const int NT = qt + 1;
    const int skey = F.tid() >> 3, spc = F.tid() & 7;
    const bf16* ksrc = proj + (size_t)(tokb + skey) * PJ + C_IK + spc * 8;
    { const u32x4 v = *(const u32x4*)ksrc; *(LAS u32x4*)(ktile + skey * KTS + spc * 8) = v; }
    __syncthreads();
    for (int kt = 0; kt < NT; ++kt) {
        PSUB_T(0);
        u32x4 pre = (u32x4){0u, 0u, 0u, 0u};
        if (kt + 1 < NT) pre = *(const u32x4*)(ksrc + (size_t)(kt + 1) * KT * PJ);
        const LAS bf16* cur = ktile;
#pragma unroll
        for (int sub = 0; sub < 2; ++sub) {
            bf16x8 bfr[4];
#pragma unroll
            for (int s = 0; s < 4; ++s) bfr[s] = *(const LAS bf16x8*)(cur + (sub * 32 + r32) * KTS + 16 * s + 8 * hi);
            const int key = kt * KT + sub * 32 + r32;
#pragma unroll
            for (int mt = 0; mt < 2; ++mt) {
                f32x16 acc;
#pragma unroll
                for (int r = 0; r < 16; ++r) acc[r] = 0.f;
#pragma unroll
                for (int s = 0; s < 4; ++s) acc = MFMA32(af[mt][s], bfr[s], acc);
                float sc[2] = {0.f, 0.f};
#pragma unroll
                for (int r = 0; r < 16; ++r) sc[r >> 3] += wv[mt][r] * fmaxf(acc[r], 0.f);
#pragma unroll
                for (int u = 0; u < 2; ++u) {
                    const int ql = 8 * w + 4 * mt + 2 * hi + u;
                    const bool valid = (sc[u] >= thrf[mt][u]) && (key <= q0 + ql);
                    const unsigned long long m = __ballot(valid);
                    const int nlo = __builtin_popcount((unsigned)m), nhi = __builtin_popcount((unsigned)(m >> 32));
                    const int off = mbcnt64(m) - (hi ? nlo : 0);
                    if (valid) cand[ql * CAP + cntv[mt][u] + off] = (fmap(sc[u]) & 0xFFFFE000u) | (unsigned)(8191 - key);
                    cntv[mt][u] += hi ? nhi : nlo;
                }
            }
        }
        PSUB_T(1);
        int anyc = 0;
#pragma unroll
        for (int mt = 0; mt < 2; ++mt)
#pragma unroll
            for (int u = 0; u < 2; ++u) anyc |= (cntv[mt][u] > CAP_TRIG) ? 1 : 0;
        PSUB_T(2);
        const int doc = __syncthreads_or(anyc);
        if (kt + 1 < NT) *(LAS u32x4*)(ktile + skey * KTS + spc * 8) = pre;
        if (doc) {
            if ((lane & 31) == 0) {
#pragma unroll
                for (int mt = 0; mt < 2; ++mt)
#pragma unroll
                    for (int u = 0; u < 2; ++u) rowcnt[8 * w + 4 * mt + 2 * hi + u] = cntv[mt][u];
            }
#pragma unroll 1
            for (int rr = 0; rr < 8; ++rr) { const int rowi = 8 * w + rr; const int cq = __builtin_amdgcn_readfirstlane(rowcnt[rowi]);
                if (cq > NSEL + 64) { float tf = rowthr[rowi]; const int nc = compact_stream(cand + rowi * CAP, cq, hist, lane, tf);
                    if (lane == 0) { rowcnt[rowi] = nc; rowthr[rowi] = tf; } } }
#pragma unroll
            for (int mt = 0; mt < 2; ++mt)
#pragma unroll
                for (int u = 0; u < 2; ++u) { cntv[mt][u] = rowcnt[8 * w + 4 * mt + 2 * hi + u]; thrf[mt][u] = rowthr[8 * w + 4 * mt + 2 * hi + u]; }
        }
        __syncthreads();
        PSUB_T(3);
    }
    PSUB_T(5);
    if ((lane & 31) == 0) {
#pragma unroll
        for (int mt = 0; mt < 2; ++mt)
#pragma unroll
            for (int u = 0; u < 2; ++u) rowcnt[8 * w + 4 * mt + 2 * hi + u] = cntv[mt][u];
    }
#pragma unroll 1
    for (int rr = 0; rr < 8; ++rr) { const int ql = 8 * w + rr; LAS unsigned* row = cand + ql * CAP; int cq = __builtin_amdgcn_readfirstlane(rowcnt[ql]);
        if (cq > NSEL) { unsigned P; cq = select_row(row, cq, NSEL, hist, lane, P); }
        bf16* so = sel + (size_t)(tokb + q0 + ql) * NSEL;
#pragma unroll
        for (int j = 0; j < 4; ++j) { const int p = 64 * j + lane; const unsigned v = row[p]; so[p] = (p < cq) ? (bf16)(8191u - (v & 0x1FFFu)) : (bf16)0; } }
    PSUB_T(6);
    __syncthreads();
}

constexpr int VROW = 144;
constexpr int DSB_VL = 0, DSB_VL_WAVE = 32 * VROW * 2;
constexpr int DSB_PART = 8 * DSB_VL_WAVE;
constexpr int DSB_ML = DSB_PART + 2 * 8 * 8 * 64 * 4;
constexpr int DSB_SEL = DSB_ML + 2 * 8 * 8 * 2 * 4;
static_assert(DSB_SEL + 64 * 256 * 2 <= MISC_OFF, "DSA-B LDS map");
struct DsbFrags { u32x4 k[2][2][2]; bf16x8 q[2][2]; };
__device__ __forceinline__ void dsb_issue(Frame& F, const bf16* proj, int tok, int ql, DsbFrags& R) {
    const int lane = F.lane(), n16 = lane & 15, c = lane >> 4, w = F.wave;
    const LAS bf16* sl = (const LAS bf16*)(F.lds + DSB_SEL) + ql * 256 + w * 32;
    const char* kvbase = (const char*)(proj + (size_t)(tok / SEQ) * SEQ * PJ);
#pragma unroll
    for (int kt = 0; kt < 2; ++kt) { const unsigned ko = (unsigned)sl[16 * kt + n16] * (unsigned)(PJ * 2) + (unsigned)((C_AK + 8 * c) * 2);
#pragma unroll
        for (int g = 0; g < 2; ++g)
#pragma unroll
            for (int s = 0; s < 2; ++s) R.k[kt][g][s] = *(const u32x4*)(kvbase + ko + (g * 64 + 32 * s) * 2); }
    const char* qbase = (const char*)(proj + (size_t)tok * PJ + C_AQ); const unsigned qo = (unsigned)((n16 * 64 + 8 * c) * 2);
#pragma unroll
    for (int g = 0; g < 2; ++g)
#pragma unroll
        for (int s = 0; s < 2; ++s) { bf16x8 v = (bf16x8){0, 0, 0, 0, 0, 0, 0, 0};
            if (n16 < 4) v = *(const bf16x8*)(qbase + qo + (g * 256 + 32 * s) * 2);
            R.q[g][s] = v; }
}
__device__ __forceinline__ void dsb_compute(Frame& F, const bf16* proj, int tok, int ql, int par, const DsbFrags& R, DsbFrags& Rn, bool has_next) {
    bf16* mix = (bf16*)(F.ws + WS_MIX);
    const int lane = F.lane(), n16 = lane & 15, c = lane >> 4, q4 = n16 >> 2, p4 = lane & 3, w = F.wave;
    const int t = tok % SEQ, nsel = (t + 1 < NSEL) ? t + 1 : NSEL;
    const LAS bf16* sl = (const LAS bf16*)(F.lds + DSB_SEL) + ql * 256 + w * 32;
    LAS bf16* vl = (LAS bf16*)(F.lds + DSB_VL + w * DSB_VL_WAVE);
    LAS float* part = (LAS float*)(F.lds + DSB_PART) + par * (8 * 8 * 64); LAS float* ml = (LAS float*)(F.lds + DSB_ML) + par * (8 * 8 * 2);
    u32x4 vr[8];
    { const char* kvbase = (const char*)(proj + (size_t)(tok / SEQ) * SEQ * PJ);
#pragma unroll
      for (int i = 0; i < 8; ++i) { const unsigned vo = (unsigned)sl[4 * i + c] * (unsigned)(PJ * 2) + (unsigned)((C_AV + n16 * 8) * 2); vr[i] = *(const u32x4*)(kvbase + vo); } }
    f32x4 acc[2][2];
#pragma unroll
    for (int kt = 0; kt < 2; ++kt)
#pragma unroll
        for (int g = 0; g < 2; ++g) { acc[kt][g] = MFMA16(__builtin_bit_cast(bf16x8, R.k[kt][g][0]), R.q[g][0], ((f32x4){0.f, 0.f, 0.f, 0.f})); acc[kt][g] = MFMA16(__builtin_bit_cast(bf16x8, R.k[kt][g][1]), R.q[g][1], acc[kt][g]); }
    asm volatile("" ::: "memory");
    if (has_next) dsb_issue(F, proj, tok + 1, ql + 1, Rn);
    float mw[2] = {-INFINITY, -INFINITY};
    const float slope[2] = {exp2f(-(float)((n16 & 3) + 1)), exp2f(-(float)((n16 & 3) + 5))};
#pragma unroll
    for (int kt = 0; kt < 2; ++kt) { const u32x2 kk = *(const LAS u32x2*)(sl + 16 * kt + 4 * c);
        const int k4[4] = {(int)(kk.x & 0xffffu), (int)(kk.x >> 16), (int)(kk.y & 0xffffu), (int)(kk.y >> 16)};
#pragma unroll
        for (int r = 0; r < 4; ++r) { const int p = 32 * w + 16 * kt + 4 * c + r; const float dist = (float)(t - k4[r]);
#pragma unroll
            for (int g = 0; g < 2; ++g) { float lgt = acc[kt][g][r] * 0.125f - slope[g] * dist; if (p >= nsel) lgt = -INFINITY; acc[kt][g][r] = lgt; mw[g] = fmaxf(mw[g], lgt); } } }
    bf16x8 pf[2]; float lw[2];
#pragma unroll
    for (int g = 0; g < 2; ++g) { mw[g] = fmaxf(mw[g], __shfl_xor(mw[g], 16)); mw[g] = fmaxf(mw[g], __shfl_xor(mw[g], 32));
        const float mm = (mw[g] == -INFINITY) ? 0.f : mw[g]; float s = 0.f;
#pragma unroll
        for (int kt = 0; kt < 2; ++kt)
#pragma unroll
            for (int r = 0; r < 4; ++r) { const float e = __builtin_amdgcn_exp2f((acc[kt][g][r] - mm) * 1.4426950408889634f); acc[kt][g][r] = e; s += e; }
        s += __shfl_xor(s, 16); s += __shfl_xor(s, 32); lw[g] = s;
        u32x4 pw; pw.x = cvtpk(acc[0][g][0], acc[0][g][1]); pw.y = cvtpk(acc[0][g][2], acc[0][g][3]); pw.z = cvtpk(acc[1][g][0], acc[1][g][1]); pw.w = cvtpk(acc[1][g][2], acc[1][g][3]);
        pf[g] = __builtin_bit_cast(bf16x8, pw); }
#pragma unroll
    for (int i = 0; i < 8; ++i) *(LAS u32x4*)(vl + (4 * i + c) * VROW + n16 * 8) = vr[i];
    f32x4 O[2][4];
#pragma unroll
    for (int dt = 0; dt < 4; ++dt) { const LAS bf16* vp = vl + (4 * c + q4) * VROW + dt * 16 + 4 * p4;
        O[0][dt] = MFMA16(pf[0], cat8(trread(vp), trread(vp + 16 * VROW)), ((f32x4){0.f, 0.f, 0.f, 0.f}));
        O[1][dt] = MFMA16(pf[1], cat8(trread(vp + 64), trread(vp + 64 + 16 * VROW)), ((f32x4){0.f, 0.f, 0.f, 0.f})); }
    if (lane < 16) {
#pragma unroll
        for (int g = 0; g < 2; ++g)
#pragma unroll
            for (int dt = 0; dt < 4; ++dt)
#pragma unroll
                for (int r = 0; r < 4; ++r) part[(w * 8 + g * 4 + r) * 64 + 16 * dt + lane] = O[g][dt][r];
        if (lane < 4) {
#pragma unroll
            for (int g = 0; g < 2; ++g) { ml[(w * 8 + g * 4 + lane) * 2] = mw[g]; ml[(w * 8 + g * 4 + lane) * 2 + 1] = lw[g]; } } }
    __syncthreads();
    { const int h = F.tid() >> 6, d = F.tid() & 63; float M = -INFINITY;
#pragma unroll
      for (int ww = 0; ww < 8; ++ww) M = fmaxf(M, ml[(ww * 8 + h) * 2]);
      float num = 0.f, den = 0.f;
#pragma unroll
      for (int ww = 0; ww < 8; ++ww) { const float mv = ml[(ww * 8 + h) * 2]; const float f = (mv == -INFINITY) ? 0.f : __builtin_amdgcn_exp2f((mv - M) * 1.4426950408889634f);
          num += f * part[(ww * 8 + h) * 64 + d]; den += f * ml[(ww * 8 + h) * 2 + 1]; }
      mix[(size_t)tok * DM + 512 + h * 64 + d] = f2bf(num / den); }
}
__device__ __forceinline__ void phase_dsa_b(Frame& F) {
    const bf16* proj = (const bf16*)(F.ws + WS_PROJ); const bf16* sel = (const bf16*)(F.ws + WS_SEL);
    for (int blk = F.bid; blk < NTOK / 64; blk += F.G) {
        int T0 = blk * 64;
        if (F.G == 256) { const int x = F.bid & 7, jj = F.bid >> 3, r = blk >> 8; T0 = (x & 3) * SEQ + ((r * 32 + jj) * 2 + (x >> 2)) * 64; }
        __syncthreads();
        { const u32x4* src = (const u32x4*)(sel + (size_t)T0 * NSEL) + F.tid(); LAS u32x4* dst = (LAS u32x4*)(F.lds + DSB_SEL) + F.tid();
#pragma unroll
          for (int i = 0; i < 4; ++i) dst[i * NTHR] = src[i * NTHR]; }
        __syncthreads();
        DsbFrags A, B;
        dsb_issue(F, proj, T0, 0, A);
        for (int q = 0; q < 64; q += 2) {
            dsb_compute(F, proj, T0 + q, q, 0, A, B, true);
            dsb_compute(F, proj, T0 + q + 1, q + 1, 1, B, A, q + 2 < 64);
        }
    }
}

constexpr int HSTR = 1028;
__device__ __forceinline__ void phase_router(Frame& F) {
    const float* const norm2_g = F.in(8); const float* const router_w = F.in(9); const float* const router_b = F.in(10);
    const float* x1 = F.out; const float* mod = (const float*)(F.ws + WS_MOD); unsigned char* h2 = (unsigned char*)(F.ws + WS_H2);
    int* topi = (int*)(F.ws + WS_TOPI); float* topg = (float*)(F.ws + WS_TOPG); int* bbase = (int*)(F.ws + WS_BBASE);
    LAS float* hs = (LAS float*)F.lds; LAS float* part = (LAS float*)(F.lds + 16 * HSTR * 4); LAS int* hist = (LAS int*)(F.lds + 16 * HSTR * 4 + 8 * 16 * 32 * 4);
    const int lane = F.lane(), w = F.wave;
    for (int blk = F.bid; blk < NTOK / 128; blk += F.G) {
        const int T0 = blk * 128, b = T0 / SEQ;
        if (F.tid() < 32) hist[F.tid()] = 0;
        f32x4 ca[4], cb[4];
#pragma unroll
        for (int j = 0; j < 4; ++j) { const int col = 4 * lane + 256 * j;
            ca[j] = *(const f32x4*)(norm2_g + col) * (*(const f32x4*)(mod + b * 6144 + 4 * 1024 + col) + 1.0f); cb[j] = *(const f32x4*)(mod + b * 6144 + 3 * 1024 + col); }
        __syncthreads();
        for (int pass = 0; pass < 8; ++pass) {
#pragma unroll
            for (int tt = 0; tt < 2; ++tt) { const int tl = 2 * w + tt, tok = T0 + pass * 16 + tl;
                const f32x4* xr = (const f32x4*)(x1 + (size_t)tok * DM) + lane; f32x4 v[4]; float s = 0.f;
#pragma unroll
                for (int j = 0; j < 4; ++j) { v[j] = xr[64 * j]; s += (v[j][0] * v[j][0] + v[j][1] * v[j][1]) + (v[j][2] * v[j][2] + v[j][3] * v[j][3]); }
                const float rstd = rsqrtf(wave_sum(s) * (1.f / DM) + EPS);
                unsigned* o4 = (unsigned*)(h2 + (size_t)tok * DM) + lane;
#pragma unroll
                for (int j = 0; j < 4; ++j) { const f32x4 y = (v[j] * rstd) * ca[j] + cb[j];
                    o4[64 * j] = pk4_fp8(y[0], y[1], y[2], y[3]);
                    *(LAS f32x4*)(hs + tl * HSTR + 4 * lane + 256 * j) = y; } }
            __syncthreads();
            { const int ti = lane & 15, kk = lane >> 5, e = lane & 31; f32x16 acc;
#pragma unroll
              for (int r = 0; r < 16; ++r) acc[r] = 0.f;
              const LAS float* hp = hs + ti * HSTR + 128 * w + 64 * kk; const float* rwp = router_w + (size_t)(128 * w + 64 * kk) * NE + e;
#pragma unroll 4
              for (int s4 = 0; s4 < 16; ++s4) { const f32x4 a4 = *(const LAS f32x4*)(hp + 4 * s4);
#pragma unroll
                  for (int q = 0; q < 4; ++q) acc = __builtin_amdgcn_mfma_f32_32x32x2f32(a4[q], rwp[(4 * s4 + q) * NE], acc, 0, 0, 0); }
#pragma unroll
              for (int r = 0; r < 8; ++r) part[(w * 16 + (r & 3) + 8 * (r >> 2) + 4 * kk) * 32 + e] = acc[r]; }
            __syncthreads();
            { const int tl = F.tid() >> 5, e = F.tid() & 31, tok = T0 + pass * 16 + tl; float lg = router_b[e];
#pragma unroll
              for (int ww = 0; ww < 8; ++ww) lg += part[(ww * 16 + tl) * 32 + e];
              float myv = lg; float tv[4]; int ti4[4]; bool mine = false;
#pragma unroll
              for (int k = 0; k < 4; ++k) { float bv = myv; int bi = e;
#pragma unroll
                  for (int o = 16; o >= 1; o >>= 1) { const float ov = __shfl_xor(bv, o); const int oi = __shfl_xor(bi, o); if (ov > bv || (ov == bv && oi < bi)) { bv = ov; bi = oi; } }
                  tv[k] = bv; ti4[k] = bi; if (bi == e) { myv = -INFINITY; mine = true; } }
              if (mine) atomicAdd((int*)hist + e, 1);
              if (e == 0) { const float e0 = 1.0f, e1 = __expf(tv[1] - tv[0]), e2 = __expf(tv[2] - tv[0]), e3 = __expf(tv[3] - tv[0]); const float inv = 1.0f / (e0 + e1 + e2 + e3);
                  *(int4*)(topi + (size_t)tok * 4) = make_int4(ti4[0], ti4[1], ti4[2], ti4[3]); *(f32x4*)(topg + (size_t)tok * 4) = (f32x4){e0 * inv, e1 * inv, e2 * inv, e3 * inv}; } }
            __syncthreads();
        }
        if (F.tid() < 32) { const int base = atomicAdd((int*)(F.ctl + CW_GCNT) + F.tid(), hist[F.tid()]); bbase[blk * 32 + F.tid()] = base; }
        __syncthreads();
    }
}
__device__ __forceinline__ int moe_layout(Frame& F, LAS int* offs, LAS int* tile_e) {
    if (F.tid() == 0) { int o = 0;
        for (int e = 0; e < NE; ++e) { const int cnt = (int)__hip_atomic_load(F.ctl + CW_GCNT + e, __ATOMIC_RELAXED, __HIP_MEMORY_SCOPE_AGENT); const int nt = (cnt + 255) >> 8;
            offs[e] = o; if (tile_e) for (int t = 0; t < nt; ++t) tile_e[(o >> 8) + t] = e; o += nt << 8; }
        offs[NE] = o >> 8; }
    __syncthreads();
    return offs[NE];
}
__device__ __forceinline__ void phase_place(Frame& F) {
    const unsigned char* h2 = (const unsigned char*)(F.ws + WS_H2); unsigned char* xs = (unsigned char*)(F.ws + WS_XS);
    const int* topi = (const int*)(F.ws + WS_TOPI); const float* topg = (const float*)(F.ws + WS_TOPG); const int* bbase = (const int*)(F.ws + WS_BBASE);
    int* rowinfo = (int*)(F.ws + WS_ROWINFO); float* rowgate = (float*)(F.ws + WS_ROWGATE);
    LAS int* offs = (LAS int*)F.lds; LAS int* lcur = offs + 64; LAS int* posl = offs + 128;
    (void)moe_layout(F, offs, nullptr);
    for (int blk = F.bid; blk < NTOK / 128; blk += F.G) {
        const int T0 = blk * 128;
        if (F.tid() < 32) lcur[F.tid()] = 0;
        __syncthreads();
        { const int i = F.tid(), tok = T0 + (i >> 2); const int e = topi[(size_t)tok * 4 + (i & 3)];
          const int rank = atomicAdd((int*)lcur + e, 1); const int pos = offs[e] + bbase[blk * 32 + e] + rank;
          rowinfo[pos] = tok * 4 + (i & 3); rowgate[pos] = topg[(size_t)tok * 4 + (i & 3)]; posl[i] = pos; }
        __syncthreads();
        for (int jj = 0; jj < 64; ++jj) { const int i = F.wave * 64 + jj; const int pos = posl[i]; const int tok = T0 + (i >> 2);
            const u32x4* src = (const u32x4*)(h2 + (size_t)tok * DM) + F.lane(); u32x4* dst = (u32x4*)(xs + (size_t)pos * DM) + F.lane();
            dst[0] = src[0]; }
        __syncthreads();
    }
}
__device__ __forceinline__ void phase_final(Frame& F) {
    const float* const final_g = F.in(15);
    const float* mod = (const float*)(F.ws + WS_MOD); const bf16* Y = (const bf16*)(F.ws + WS_Y);
    const int gw = F.bid * NWAVES + F.wave, NGW = F.G * NWAVES;
    for (int m = gw; m < NTOK; m += NGW) {
        const int b = m / SEQ; f32x4* xr = (f32x4*)(F.out + (size_t)m * DM) + F.lane(); f32x4 v[4]; float s = 0.f;
#pragma unroll
        for (int j = 0; j < 4; ++j) { const int col = 4 * F.lane() + 256 * j; f32x4 y = (f32x4){0.f, 0.f, 0.f, 0.f};
#pragma unroll
            for (int k = 0; k < 4; ++k) { const u32x2 w = *((const u32x2*)(Y + ((size_t)m * 4 + k) * DM) + F.lane() + 64 * j); y[0] += bflo(w.x); y[1] += bfhi(w.x); y[2] += bflo(w.y); y[3] += bfhi(w.y); }
            v[j] = xr[64 * j] + *(const f32x4*)(mod + b * 6144 + 5 * 1024 + col) * y;
            s += (v[j][0] * v[j][0] + v[j][1] * v[j][1]) + (v[j][2] * v[j][2] + v[j][3] * v[j][3]); }
        const float rstd = rsqrtf(wave_sum(s) * (1.f / DM) + EPS);
#pragma unroll
        for (int j = 0; j < 4; ++j) xr[64 * j] = (v[j] * rstd) * *(const f32x4*)(final_g + 4 * F.lane() + 256 * j);
    }
}

#ifndef MK_N_LAUNCHES
#define MK_N_LAUNCHES 1
#endif
constexpr int N_PHASES = 12;
struct Args { const float* in[16]; float* out; unsigned char* ws; int ph_lo, ph_hi; };
static_assert(sizeof(Args) == 16 * 8 + 8 + 8 + 8, "Args has no padding");

__global__ void __launch_bounds__(NTHR, 2) mk_fwd(Args args) {
    extern __shared__ __attribute__((aligned(16))) unsigned char lds_raw[];
    Frame F;
    F.lds = (LAS unsigned char*)lds_raw;
    F.MISC = (volatile LAS unsigned*)(F.lds + MISC_OFF);
    F.wave = __builtin_amdgcn_readfirstlane((int)threadIdx.x >> 6);
    F.G = gridDim.x; F.bid = blockIdx.x; F.tacc = 0ull;
    F.ws = args.ws; F.ctl = (unsigned*)(args.ws + WS_CTL); F.out = args.out;
    for (int u = F.tid(); u < (LDS_BYTES - MISC_OFF) / 4; u += NTHR) ((LAS unsigned*)(F.lds + MISC_OFF))[u] = 0u;
    __syncthreads();
    if (F.tid() < 16) *(LAS unsigned long long*)(F.lds + PTR_OFF + 8 * F.tid()) = (unsigned long long)args.in[F.tid()];
    __syncthreads();
    const int lo = args.ph_lo, hi = args.ph_hi;
    XcdBarrier bar; bar.bar = (unsigned*)(F.ctl + CW_BAR); bar.x = 0; bar.st = nullptr; bar.w0 = (F.wave == 0);
    if (hi - lo > 1) bar = xcd_barrier_post((unsigned*)(F.ctl + CW_BAR), F.MISC + 8, F.wave == 0);
#define IN(k) (lo <= (k) && (k) < hi)
#if defined(PROBE_PHASE)
    unsigned long long tp0 = 0ull, tp1 = 0ull;
#define STAMP(k) do { if ((k) == PROBE_PHASE) tp0 = __builtin_amdgcn_s_memrealtime(); if ((k) == PROBE_PHASE + 1) tp1 = __builtin_amdgcn_s_memrealtime(); } while (0)
#else
#define STAMP(k) do { } while (0)
#endif
#define SEAM(k) do { if (IN(k) && IN((k) + 1)) xcd_barrier(bar); } while (0)

    STAMP(0); if (IN(0)) { phase_p0a(F); } SEAM(0);
    STAMP(1); if (IN(1)) { phase_p0b(F); } SEAM(1);
    STAMP(2); if (IN(2)) {
        pg8::Gemm g{(const bf16*)(F.ws + WS_H0), (const bf16*)(F.ws + WS_WIN), NTOK, PJ, DM}; pg8::StaticOrder S; S.init(NTOK, PJ, F.G, F.bid);
        EpiProj E{(bf16*)(F.ws + WS_PROJ), PJ};
        pg8::gemm_phase<EpiProj, pg8::StaticOrder, true, true>(F.lds, g, S, E, F.wave);
    } SEAM(2);
    STAMP(3); if (IN(3)) {
#if defined(PROBE_SUB)
        const unsigned long long tra0 = __builtin_amdgcn_s_memrealtime();
#endif
        for (int it = F.bid; it < 1024; it += F.G) ret_a_item(F, it);
#if defined(PROBE_SUB)
        if (PROBE_SUB == 4) F.tacc += __builtin_amdgcn_s_memrealtime() - tra0;
#endif
        for (int u = F.bid; u < 256; u += F.G) { int b = u >> 6, j = u & 63;
            if (F.G == 256) { const int x = u & 7, jj = u >> 3; b = x & 3; j = (x >> 2) * 32 + jj; }
            dsa_a_unit(F, b, j); dsa_a_unit(F, b, 127 - j); }
    } SEAM(3);
    STAMP(4); if (IN(4)) {
#if defined(PROBE_SUB)
        const unsigned long long tsc0 = __builtin_amdgcn_s_memrealtime();
#endif
        ret_scan(F);
#if defined(PROBE_SUB)
        if (PROBE_SUB == 5) F.tacc += __builtin_amdgcn_s_memrealtime() - tsc0;
#endif
        __syncthreads();
        phase_dsa_b(F);
    } SEAM(4);
    STAMP(5); if (IN(5)) { for (int it = F.bid; it < 1024; it += F.G) ret_c_item(F, it); } SEAM(5);
    STAMP(6); if (IN(6)) {
        pg8::Gemm g{(const bf16*)(F.ws + WS_MIX), (const bf16*)(F.ws + WS_WO), NTOK, DM, DM}; pg8::StaticOrder S; S.init(NTOK, DM, F.G, F.bid);
        EpiX1 E{F.in(0), (const float*)(F.ws + WS_MOD), F.out};
        pg8::gemm_phase<EpiX1, pg8::StaticOrder, true, true>(F.lds, g, S, E, F.wave);
    } SEAM(6);
    STAMP(7); if (IN(7)) { phase_router(F); } SEAM(7);
    STAMP(8); if (IN(8)) { phase_place(F); } SEAM(8);
    STAMP(9); if (IN(9)) {
        LAS int* tile_e = (LAS int*)(F.lds + TILEE_OFF); const int nt = moe_layout(F, (LAS int*)(F.lds + TILEE_OFF + 4096), tile_e);
        pg8::Gemm g{(const bf16*)(F.ws + WS_XS), (const bf16*)(F.ws + WS_WGU), MOE_ROWS, 2048, DM};
        GroupedOrder S{tile_e, nt, 8, F.G, F.bid, (size_t)2048 * 1024};
        EpiGlu8 E{(unsigned char*)(F.ws + WS_HB), F.in(12)};
        pg8::gemm_phase<EpiGlu8, GroupedOrder, true, true, true>(F.lds, g, S, E, F.wave);
    } SEAM(9);
    STAMP(10); if (IN(10)) {
        LAS int* tile_e = (LAS int*)(F.lds + TILEE_OFF); const int nt = moe_layout(F, (LAS int*)(F.lds + TILEE_OFF + 4096), tile_e);
        pg8::Gemm g{(const bf16*)(F.ws + WS_HB), (const bf16*)(F.ws + WS_WDN), MOE_ROWS, DM, DM};
        GroupedOrder S{tile_e, nt, 4, F.G, F.bid, (size_t)1024 * 1024};
        EpiDownT<true> E{(bf16*)(F.ws + WS_Y), F.in(14), (const int*)(F.ws + WS_ROWINFO), (const float*)(F.ws + WS_ROWGATE)};
        pg8::gemm_phase<EpiDownT<true>, GroupedOrder, true, true, true>(F.lds, g, S, E, F.wave);
    } SEAM(10);
    STAMP(11); if (IN(11)) { phase_final(F); }
    STAMP(12);
#if defined(PROBE_SUB)
    if (F.bid == 0 && F.tid() == 0) { const unsigned long long te = __builtin_amdgcn_s_memrealtime(); while (__builtin_amdgcn_s_memrealtime() - te < F.tacc) __builtin_amdgcn_s_sleep(8); }
#elif defined(PROBE_PHASE)
    if (F.bid == 0 && F.tid() == 0) { const unsigned long long te = __builtin_amdgcn_s_memrealtime(), dur = tp1 - tp0; while (__builtin_amdgcn_s_memrealtime() - te < dur) __builtin_amdgcn_s_sleep(8); }
#endif
#undef IN
#undef SEAM
}

extern "C" void kernel_launch(void* const* d_in, const int* in_sizes, int n_in, void* d_out, int out_size, void* d_ws, size_t ws_size, hipStream_t stream) {
    static int grid = 0;
    if (grid == 0) {
        if (n_in != 16 || out_size != NTOK * DM || ws_size < WS_END) { fprintf(stderr, "kernel_launch: unexpected problem (n_in %d out %d ws %zu); nothing launched\n", n_in, out_size, ws_size); grid = -1; return; }
        int dev = 0, cus = 0;
        if (hipGetDevice(&dev) != hipSuccess || hipDeviceGetAttribute(&cus, hipDeviceAttributeMultiprocessorCount, dev) != hipSuccess) { grid = -1; return; }
        if (hipFuncSetAttribute((const void*)mk_fwd, hipFuncAttributeMaxDynamicSharedMemorySize, LDS_BYTES) != hipSuccess) { fprintf(stderr, "kernel_launch: hipFuncSetAttribute failed\n"); grid = -1; return; }
        int per_cu = 0;
        if (hipOccupancyMaxActiveBlocksPerMultiprocessor(&per_cu, (const void*)mk_fwd, NTHR, LDS_BYTES) != hipSuccess || per_cu < 1) fprintf(stderr, "kernel_launch: occupancy query reports %d workgroups per CU\n", per_cu);
        (void)hipGetLastError();
        grid = cus;
    }
    if (grid < 0) return;
    (void)hipMemsetAsync((char*)d_ws + WS_CTL, 0, CTL_ZERO_BYTES, stream);
    Args a{};
    for (int i = 0; i < 16; ++i) a.in[i] = (const float*)d_in[i];
    a.out = (float*)d_out; a.ws = (unsigned char*)d_ws;
#if MK_N_LAUNCHES == 1
    a.ph_lo = 0; a.ph_hi = N_PHASES;
    hipLaunchKernelGGL(mk_fwd, dim3(grid), dim3(NTHR), LDS_BYTES, stream, a);
#else
    for (int p = 0; p < N_PHASES; ++p) { a.ph_lo = p; a.ph_hi = p + 1; hipLaunchKernelGGL(mk_fwd, dim3(grid), dim3(NTHR), LDS_BYTES, stream, a); }
#endif
}
```

```cpp
#include <hip/hip_runtime.h>
#include <cstdio>
#include <cstdint>

#define LAS __attribute__((address_space(3)))
#define GAS __attribute__((address_space(1)))
typedef unsigned short bf16;
typedef short bf16x8 __attribute__((ext_vector_type(8)));
typedef short s16x4 __attribute__((ext_vector_type(4)));
typedef float f32x4 __attribute__((ext_vector_type(4)));
typedef float f32x16 __attribute__((ext_vector_type(16)));
typedef unsigned u32x4 __attribute__((ext_vector_type(4)));
typedef unsigned u32x2 __attribute__((ext_vector_type(2)));
typedef float f32x2_t __attribute__((ext_vector_type(2)));
typedef __bf16 bf16x2_t __attribute__((ext_vector_type(2)));

constexpr int DM = 1024, NBATCH = 4, SEQ = 8192, NTOK = NBATCH * SEQ;
constexpr int PJ = 3136;
constexpr int IN_COLS = 2888;
constexpr int C_RQ = 0, C_RK = 256, C_RV = 512, C_RG = 1024, C_AQ = 1536, C_AK = 2048, C_AV = 2176, C_IQ = 2304, C_IK = 2816, C_IW = 2880;
constexpr int NE = 32, TOPK = 4, MOE_ROWS = NTOK * TOPK + NE * 256;
constexpr int MOE_TILES = MOE_ROWS / 256;
constexpr float EPS = 1e-6f;
constexpr int NWAVES = 8, NTHR = 512;

constexpr size_t MiB = 1u << 20;
constexpr size_t WS_CTL = 0, CTL_ZERO_BYTES = 1 * MiB;
constexpr size_t WS_MOD = 1 * MiB;
constexpr size_t WS_TOPI = 2 * MiB;
constexpr size_t WS_TOPG = 2 * MiB + 512 * 1024;
constexpr size_t WS_BBASE = 3 * MiB;
constexpr size_t WS_ROWINFO = 4 * MiB;
constexpr size_t WS_ROWGATE = 5 * MiB;
constexpr size_t WS_WIN = 8 * MiB;
constexpr size_t WS_WO = 14 * MiB;
constexpr size_t WS_WGU = 16 * MiB;
constexpr size_t WS_WDN = 144 * MiB;
constexpr size_t WS_H0 = 208 * MiB;
constexpr size_t WS_PROJ = 272 * MiB;
constexpr size_t WS_XS = 208 * MiB;
constexpr size_t WS_Y = 208 * MiB;
constexpr size_t WS_KVT = 480 * MiB;
constexpr size_t WS_RPT = 512 * MiB;
constexpr size_t WS_SEL = 528 * MiB;
constexpr size_t WS_MIX = 544 * MiB;
constexpr size_t WS_H2 = 608 * MiB;
constexpr size_t WS_HB = 480 * MiB;
constexpr size_t WS_END = 752 * MiB;
constexpr int CW_GCNT = 1024;
constexpr int CW_BAR = 4096;

constexpr int LDS_BYTES = 147456;
constexpr int RING_BYTES = 131072;
constexpr int TILEE_OFF = 131072;
constexpr int MISC_OFF = 146432;
constexpr int PTR_OFF = MISC_OFF + 512;

__device__ __forceinline__ int hw_lane() { int l; asm volatile("v_mbcnt_lo_u32_b32 %0, -1, 0\n\tv_mbcnt_hi_u32_b32 %0, -1, %0" : "=v"(l)); return l; }
__device__ __forceinline__ unsigned cvtpk(float lo, float hi) { f32x2_t v = {lo, hi}; bf16x2_t b = __builtin_convertvector(v, bf16x2_t); return __builtin_bit_cast(unsigned, b); }
__device__ __forceinline__ float bflo(unsigned w) { return __builtin_bit_cast(float, w << 16); }
__device__ __forceinline__ float bfhi(unsigned w) { return __builtin_bit_cast(float, w & 0xffff0000u); }
__device__ __forceinline__ float bf2f(bf16 h) { return __builtin_bit_cast(float, (unsigned)h << 16); }
__device__ __forceinline__ bf16 f2bf(float f) { return (bf16)(cvtpk(f, 0.f) & 0xffffu); }
__device__ __forceinline__ float wave_sum(float v) {
#pragma unroll
    for (int o = 1; o < 64; o <<= 1) v += __shfl_xor(v, o);
    return v;
}
__device__ __forceinline__ int mbcnt64(unsigned long long m) { return (int)__builtin_amdgcn_mbcnt_hi((unsigned)(m >> 32), __builtin_amdgcn_mbcnt_lo((unsigned)m, 0u)); }
__device__ __forceinline__ s16x4 trread(const LAS void* p) { typedef short v4i16_t __attribute__((ext_vector_type(4))); return __builtin_bit_cast(s16x4, __builtin_amdgcn_ds_read_tr16_b64_v4i16((LAS v4i16_t*)p)); }
__device__ __forceinline__ bf16x8 cat8(s16x4 lo, s16x4 hi) { return (bf16x8){lo[0], lo[1], lo[2], lo[3], hi[0], hi[1], hi[2], hi[3]}; }
#define MFMA16(a, b, c) __builtin_amdgcn_mfma_f32_16x16x32_bf16((a), (b), (c), 0, 0, 0)
#define MFMA32(a, b, c) __builtin_amdgcn_mfma_f32_32x32x16_bf16((a), (b), (c), 0, 0, 0)

namespace pg8 {
#define PG8_LAS __attribute__((address_space(3)))
typedef unsigned short bf16_t;
typedef short bf16x8 __attribute__((ext_vector_type(8)));
typedef float f32x4 __attribute__((ext_vector_type(4)));
typedef unsigned u32x4 __attribute__((ext_vector_type(4)));
constexpr int BM = 256, BK = 64, HALF = 128, HTB = HALF * BK * 2  , STAGE_BYTES = 8 * HTB, NXCD = 8, WGM = 8;

__host__ __device__ __forceinline__ int lds_byte(int r, int c) { const int st = (r >> 4) * 2 + (c >> 5), rr = r & 15, cc = c & 31, ob = rr * 64 + cc * 2; return st * 1024 + (ob ^ (((ob >> 9) & 1) << 5)); }
__host__ __device__ __forceinline__ void stage_rc(int b, int& R, int& C) { const int st = b / 1024, sb = b % 1024, swz = sb ^ (((sb >> 9) & 1) << 5); R = (st >> 1) * 16 + swz / 64; C = (st & 1) * 32 + (swz % 64) / 2; }
__host__ __device__ __forceinline__ int perm32(int rho) { const int n = rho >> 4, i = rho & 15; return 8 * (i >> 2) + 4 * n + (i & 3); }

typedef int v8i32 __attribute__((ext_vector_type(8))); typedef int v4i32 __attribute__((ext_vector_type(4)));
__device__ __forceinline__ v8i32 pg8_cat(bf16x8 a, bf16x8 b) { return __builtin_shufflevector(__builtin_bit_cast(v4i32, a), __builtin_bit_cast(v4i32, b), 0, 1, 2, 3, 4, 5, 6, 7); }
struct Unit { int pm, pn, e; size_t bo; };
struct Gemm { const bf16_t* A; const bf16_t* Bt; int M, N, K; };

struct StaticOrder {
    int nM, nN, nwg, G, c;
    __host__ __device__ void init(int M, int N, int G_, int c_) { nM = M / BM; nN = N / BM; nwg = nM * nN; G = G_; c = c_; }
    __host__ __device__ bool next(int i, Unit& u) const {
        const long L = (long)i * G + c; if (L >= nwg) return false;
        int wgid = (int)L; { const int q = nwg / NXCD, r = nwg % NXCD, xcd = wgid % NXCD, off = wgid / NXCD; wgid = (xcd < r ? xcd * (q + 1) : r * (q + 1) + (xcd - r) * q) + off; }
        const int nig = WGM * nN, gid = wgid / nig, fm = gid * WGM, gsz = (nM - fm) < WGM ? (nM - fm) : WGM;
        u.pm = fm + ((wgid % nig) % gsz); u.pn = (wgid % nig) / gsz; u.e = 0; u.bo = 0; return true;
    }
    __device__ __forceinline__ void a_ready(const Unit&) const {}
    __device__ __forceinline__ void done(const Unit&) const {}
};

template <class Epi, class Sched, bool ALIGN_EPI = false, bool SP2 = false, bool F8 = false>
__device__ __forceinline__ void gemm_phase(PG8_LAS unsigned char* lds, const Gemm g, const Sched& S, const Epi& E, const int wid) {
    const int lane = hw_lane(), tid = wid * 64 + lane, wr = wid >> 2, wc = wid & 3, fr = lane & 15, fq = lane >> 4;
    constexpr int ESZ = F8 ? 1 : 2;
    const int K = g.K, nt = K * ESZ / (BK * 2);
    unsigned voffA[2], voffB[2];
#pragma unroll
    for (int i = 0; i < 2; ++i) { int R, C; stage_rc(tid * 16 + i * 8192, R, C); const int Rb = Epi::PERM ? ((R & ~31) + perm32(R & 31)) : R;
        voffA[i] = (unsigned)(R * K * ESZ + C * 2); voffB[i] = (unsigned)(Rb * K * ESZ + C * 2); }
    const size_t kstep = (size_t)(BK * 2);
    const size_t hstep = (size_t)HALF * K * ESZ;
    const size_t tstep = 2 * hstep;
    const unsigned ldsw = (unsigned)wid * 1024u;
    const int aoff = lds_byte(wr * 64 + fr, fq * 8), boff = lds_byte(wc * 32 + fr, fq * 8);
#define PG8_SA(b, h) (((b) * 2 + (h)) * HTB)
#define PG8_SB(b, h) ((4 + (b) * 2 + (h)) * HTB)
#define PG8_STAGE(bufoff, gbase, voff) do { _Pragma("unroll") for (int _i = 0; _i < 2; ++_i) { \
        if constexpr (F8) { unsigned _keep; const unsigned _l = (unsigned)(__UINTPTR_TYPE__)(lds + (bufoff) + ldsw + _i * 8192);   \
            asm volatile("s_mov_b32 %0, m0\n\ts_mov_b32 m0, %3\n\ts_nop 0\n\tglobal_load_lds_dwordx4 %1, %2\n\ts_mov_b32 m0, %0" : "=&s"(_keep) : "v"((voff)[_i]), "s"((const char*)(gbase)), "s"(_l) : "memory"); } \
        else __builtin_amdgcn_global_load_lds((const unsigned*)((const char*)(gbase) + (voff)[_i]), (PG8_LAS unsigned*)(lds + (bufoff) + ldsw + _i * 8192), 16, 0, 0); } } while (0)
#define PG8_LDA(dst, b, h) do { _Pragma("unroll") for (int m = 0; m < 4; ++m) _Pragma("unroll") for (int k = 0; k < 2; ++k) dst[m][k] = *(const PG8_LAS bf16x8*)(lds + PG8_SA(b, h) + aoff + m * 2048 + k * 1024); } while (0)
#define PG8_LDB(dst, b, h) do { _Pragma("unroll") for (int n = 0; n < 2; ++n) _Pragma("unroll") for (int k = 0; k < 2; ++k) dst[n][k] = *(const PG8_LAS bf16x8*)(lds + PG8_SB(b, h) + boff + n * 2048 + k * 1024); } while (0)
#define PG8_MMA(ai, bj, At, Bt) do { __builtin_amdgcn_s_setprio(1); _Pragma("unroll") for (int m = 0; m < 4; ++m) _Pragma("unroll") for (int n = 0; n < 2; ++n) { \
        if constexpr (F8) { acc[ai][bj][m][n] = __builtin_amdgcn_mfma_scale_f32_16x16x128_f8f6f4(pg8_cat(Bt[n][0], Bt[n][1]), pg8_cat(At[m][0], At[m][1]), acc[ai][bj][m][n], 0, 0, 0, 0, 0, 0); } \
        else { _Pragma("unroll") for (int k = 0; k < 2; ++k) acc[ai][bj][m][n] = __builtin_amdgcn_mfma_f32_16x16x32_bf16(Bt[n][k], At[m][k], acc[ai][bj][m][n], 0, 0, 0); } } __builtin_amdgcn_s_setprio(0); } while (0)
#define PG8_WAIT_V(n) asm volatile("s_waitcnt vmcnt(" #n ")" ::: "memory")
#define PG8_WAIT_L(n) asm volatile("s_waitcnt lgkmcnt(" #n ")" ::: "memory")
#define PG8_BAR __builtin_amdgcn_s_barrier()
#define PG8_SCHED __builtin_amdgcn_sched_barrier(0)
    Unit cur, nxt; int ui = 0;
    if (!S.next(0, cur)) return;
    f32x4 acc[2][2][4][2];
#pragma unroll
    for (int a = 0; a < 2; ++a)
#pragma unroll
        for (int b = 0; b < 2; ++b)
#pragma unroll
            for (int m = 0; m < 4; ++m)
#pragma unroll
                for (int n = 0; n < 2; ++n) acc[a][b][m][n] = (f32x4){0.f, 0.f, 0.f, 0.f};
    bf16x8 At[4][2], B0[2][2], B1[2][2];
    const char* cA = (const char*)g.A + (size_t)cur.pm * tstep; const char* cB = (const char*)g.Bt + (size_t)cur.pn * tstep + cur.bo;
    S.a_ready(cur);
    if constexpr (SP2) {
        PG8_STAGE(PG8_SB(0, 0), cB, voffB); PG8_STAGE(PG8_SB(0, 1), cB + hstep, voffB); PG8_STAGE(PG8_SA(0, 0), cA, voffA); PG8_STAGE(PG8_SA(0, 1), cA + hstep, voffA);
        if (wr == 1) PG8_BAR;
        PG8_WAIT_V(2); PG8_BAR;
        PG8_STAGE(PG8_SB(1, 0), cB + kstep, voffB); PG8_STAGE(PG8_SA(1, 0), cA + kstep, voffA); PG8_STAGE(PG8_SB(1, 1), cB + hstep + kstep, voffB);
        PG8_WAIT_V(6); PG8_BAR;
    } else {
        PG8_STAGE(PG8_SB(0, 0), cB, voffB); PG8_STAGE(PG8_SA(0, 0), cA, voffA); PG8_STAGE(PG8_SB(0, 1), cB + hstep, voffB); PG8_STAGE(PG8_SA(0, 1), cA + hstep, voffA);
        if (wr == 1) PG8_BAR;
        PG8_WAIT_V(4); PG8_BAR;
        PG8_STAGE(PG8_SB(1, 0), cB + kstep, voffB); PG8_STAGE(PG8_SA(1, 0), cA + kstep, voffA); PG8_STAGE(PG8_SB(1, 1), cB + hstep + kstep, voffB);
        PG8_WAIT_V(6); PG8_BAR;
    }
    for (;;) {
        const bool has_next = S.next(ui + 1, nxt);
        const char* nA = has_next ? (const char*)g.A + (size_t)nxt.pm * tstep : cA; const char* nB = has_next ? (const char*)g.Bt + (size_t)nxt.pn * tstep + nxt.bo : cB;
        for (int t = 0; t < nt; t += 2) {
            const bool last = (t == nt - 2);
            const char* a1 = cA + (size_t)(t + 1) * kstep;
            const char* a2 = last ? nA : cA + (size_t)(t + 2) * kstep; const char* b2 = last ? nB : cB + (size_t)(t + 2) * kstep;
            const char* a3 = a2 + kstep; const char* b3 = b2 + kstep;
            if (last && has_next) S.a_ready(nxt);
            if constexpr (SP2) {
            PG8_LDB(B0, 0, 0); PG8_LDB(B1, 0, 1); PG8_SCHED; PG8_LDA(At, 0, 0); PG8_STAGE(PG8_SA(1, 1), a1 + hstep, voffA);
            PG8_WAIT_V(8); PG8_WAIT_L(0); PG8_BAR; PG8_MMA(0, 0, At, B0); PG8_MMA(0, 1, At, B1); PG8_BAR; PG8_SCHED;
            PG8_LDA(At, 0, 1); PG8_STAGE(PG8_SB(0, 0), b2, voffB); PG8_STAGE(PG8_SB(0, 1), b2 + hstep, voffB); PG8_STAGE(PG8_SA(0, 0), a2, voffA);
            PG8_WAIT_V(8); PG8_WAIT_L(0); PG8_BAR; PG8_MMA(1, 0, At, B0); PG8_MMA(1, 1, At, B1); PG8_BAR; PG8_SCHED;
            PG8_LDB(B0, 1, 0); PG8_LDB(B1, 1, 1); PG8_SCHED; PG8_LDA(At, 1, 0); PG8_STAGE(PG8_SA(0, 1), a2 + hstep, voffA);
            PG8_WAIT_V(8); PG8_WAIT_L(0); PG8_BAR; PG8_MMA(0, 0, At, B0); PG8_MMA(0, 1, At, B1); PG8_BAR; PG8_SCHED;
            PG8_LDA(At, 1, 1); PG8_STAGE(PG8_SB(1, 0), b3, voffB); PG8_STAGE(PG8_SB(1, 1), b3 + hstep, voffB); PG8_STAGE(PG8_SA(1, 0), a3, voffA);
            PG8_WAIT_V(8); PG8_WAIT_L(0); PG8_BAR; PG8_MMA(1, 0, At, B0); PG8_MMA(1, 1, At, B1); PG8_BAR; PG8_SCHED;
            } else {
            PG8_LDB(B0, 0, 0); PG8_SCHED; PG8_LDA(At, 0, 0); PG8_STAGE(PG8_SA(1, 1), a1 + hstep, voffA);
            PG8_WAIT_L(8); PG8_BAR; PG8_WAIT_L(0); PG8_MMA(0, 0, At, B0); PG8_BAR; PG8_SCHED;
            PG8_LDB(B1, 0, 1); PG8_STAGE(PG8_SB(0, 0), b2, voffB);
            PG8_BAR; PG8_WAIT_L(0); PG8_MMA(0, 1, At, B1); PG8_BAR;
            PG8_LDA(At, 0, 1); PG8_STAGE(PG8_SA(0, 0), a2, voffA);
            PG8_BAR; PG8_WAIT_L(0); PG8_MMA(1, 0, At, B0); PG8_BAR; PG8_SCHED;
            PG8_STAGE(PG8_SB(0, 1), b2 + hstep, voffB);
            PG8_WAIT_V(6); PG8_BAR; PG8_MMA(1, 1, At, B1); PG8_BAR;
            PG8_LDB(B0, 1, 0); PG8_SCHED; PG8_LDA(At, 1, 0); PG8_STAGE(PG8_SA(0, 1), a2 + hstep, voffA);
            PG8_WAIT_L(8); PG8_BAR; PG8_WAIT_L(0); PG8_MMA(0, 0, At, B0); PG8_BAR; PG8_SCHED;
            PG8_LDB(B1, 1, 1); PG8_STAGE(PG8_SB(1, 0), b3, voffB);
            PG8_BAR; PG8_WAIT_L(0); PG8_MMA(0, 1, At, B1); PG8_BAR;
            PG8_LDA(At, 1, 1); PG8_STAGE(PG8_SA(1, 0), a3, voffA);
            PG8_BAR; PG8_WAIT_L(0); PG8_MMA(1, 0, At, B0); PG8_BAR; PG8_SCHED;
            PG8_STAGE(PG8_SB(1, 1), b3 + hstep, voffB);
            PG8_WAIT_V(6); PG8_BAR; PG8_MMA(1, 1, At, B1); PG8_BAR;
            }
        }
        if constexpr (ALIGN_EPI) { if (wr == 0) PG8_BAR; }
        if constexpr (!Epi::AFTER_DRAIN) { E(acc, cur, wr, wc, fr, fq); S.done(cur); }
        if (!has_next) break;
#pragma unroll
        for (int a = 0; a < 2; ++a)
#pragma unroll
            for (int b = 0; b < 2; ++b)
#pragma unroll
                for (int m = 0; m < 4; ++m)
#pragma unroll
                    for (int n = 0; n < 2; ++n) acc[a][b][m][n] = (f32x4){0.f, 0.f, 0.f, 0.f};
        cur = nxt; cA = nA; cB = nB; ++ui;
        if constexpr (ALIGN_EPI) { if (wr == 1) PG8_BAR; }
    }
    PG8_WAIT_V(0);
    if constexpr (!ALIGN_EPI) { if (wr == 0) PG8_BAR; }
    PG8_BAR;
    if constexpr (Epi::AFTER_DRAIN) { E.fused(acc, cur, wr, wc, fr, fq, lds, wid, lane); S.done(cur); }
#undef PG8_SA
#undef PG8_SB
#undef PG8_STAGE
#undef PG8_LDA
#undef PG8_LDB
#undef PG8_MMA
#undef PG8_WAIT_V
#undef PG8_WAIT_L
#undef PG8_BAR
#undef PG8_SCHED
}
}

struct EpiProj {
    static constexpr bool PERM = true, AFTER_DRAIN = false;
    bf16* O; int ldc;
    __device__ __forceinline__ void operator()(const f32x4 (&acc)[2][2][4][2], const pg8::Unit& u, int wr, int wc, int fr, int fq) const {
        const int row0 = u.pm * 256 + wr * 64 + fr; const int col0 = u.pn * 256 + wc * 32 + 8 * fq;
#pragma unroll
        for (int ai = 0; ai < 2; ++ai)
#pragma unroll
            for (int m = 0; m < 4; ++m) { bf16* rowp = O + (size_t)(row0 + ai * 128 + m * 16) * ldc + col0;
#pragma unroll
                for (int bj = 0; bj < 2; ++bj) { const f32x4 v0 = acc[ai][bj][m][0], v1 = acc[ai][bj][m][1];
                    u32x4 w; w.x = cvtpk(v0[0], v0[1]); w.y = cvtpk(v0[2], v0[3]); w.z = cvtpk(v1[0], v1[1]); w.w = cvtpk(v1[2], v1[3]);
                    *(u32x4*)(rowp + bj * 128) = w; } }
    }
};
struct EpiX1 {
    static constexpr bool PERM = false, AFTER_DRAIN = false;
    const float* x; const float* mod; float* out;
    __device__ __forceinline__ void operator()(const f32x4 (&acc)[2][2][4][2], const pg8::Unit& u, int wr, int wc, int fr, int fq) const {
        const int col0 = u.pn * 256 + wc * 32 + 4 * fq; const int b = (u.pm * 256) / SEQ;
        f32x4 g[2][2];
#pragma unroll
        for (int bj = 0; bj < 2; ++bj)
#pragma unroll
            for (int n = 0; n < 2; ++n) g[bj][n] = *(const f32x4*)(mod + (size_t)b * 6144 + 2 * 1024 + col0 + bj * 128 + n * 16);
#pragma unroll
        for (int ai = 0; ai < 2; ++ai)
#pragma unroll
            for (int m = 0; m < 4; ++m) { const size_t off = (size_t)(u.pm * 256 + ai * 128 + wr * 64 + m * 16 + fr) * DM + col0;
#pragma unroll
                for (int bj = 0; bj < 2; ++bj)
#pragma unroll
                    for (int n = 0; n < 2; ++n) { const f32x4 xv = *(const f32x4*)(x + off + bj * 128 + n * 16); *(f32x4*)(out + off + bj * 128 + n * 16) = xv + g[bj][n] * acc[ai][bj][m][n]; }
                if (m & 1) asm volatile("" ::: "memory"); }
    }
};
__device__ __forceinline__ float glu_f(float gate, float up) {
    gate = fminf(gate, 7.0f); up = fminf(fmaxf(up, -7.0f), 7.0f);
    const float sg = __builtin_amdgcn_rcpf(1.0f + __expf(-1.702f * gate));
    return (up + 1.0f) * (gate * sg);
}
__device__ __forceinline__ unsigned pk4_fp8(float a, float b, float c, float d) { int w = __builtin_amdgcn_cvt_pk_fp8_f32(a, b, 0, false); w = __builtin_amdgcn_cvt_pk_fp8_f32(c, d, w, true); return (unsigned)w; }
constexpr float W8_SCALE = 64.0f, W8_INV = 1.0f / 64.0f;
struct EpiGlu8 {
    static constexpr bool PERM = true, AFTER_DRAIN = false;
    unsigned char* H; const float* b_gu;
    __device__ __forceinline__ void operator()(const f32x4 (&acc)[2][2][4][2], const pg8::Unit& u, int wr, int wc, int fr, int fq) const {
        const int row0 = u.pm * 256 + wr * 64 + fr; const int c0 = u.pn * 128 + wc * 32 + 8 * fq;
        const float* bg = b_gu + (size_t)u.e * 2048 + c0; const float* bu = bg + 1024;
        const f32x4 bg0 = *(const f32x4*)bg, bg1 = *(const f32x4*)(bg + 4), bu0 = *(const f32x4*)bu, bu1 = *(const f32x4*)(bu + 4);
#pragma unroll
        for (int ai = 0; ai < 2; ++ai)
#pragma unroll
            for (int m = 0; m < 4; ++m) {
                const f32x4 g0 = acc[ai][0][m][0] * W8_INV + bg0, g1 = acc[ai][0][m][1] * W8_INV + bg1, u0 = acc[ai][1][m][0] * W8_INV + bu0, u1 = acc[ai][1][m][1] * W8_INV + bu1;
                u32x2 w; w.x = pk4_fp8(glu_f(g0[0], u0[0]), glu_f(g0[1], u0[1]), glu_f(g0[2], u0[2]), glu_f(g0[3], u0[3]));
                w.y = pk4_fp8(glu_f(g1[0], u1[0]), glu_f(g1[1], u1[1]), glu_f(g1[2], u1[2]), glu_f(g1[3], u1[3]));
                *(u32x2*)(H + (size_t)(row0 + ai * 128 + m * 16) * DM + c0) = w; }
    }
};
struct EpiGlu {
    static constexpr bool PERM = true, AFTER_DRAIN = false;
    bf16* H; const float* b_gu;
    __device__ __forceinline__ void operator()(const f32x4 (&acc)[2][2][4][2], const pg8::Unit& u, int wr, int wc, int fr, int fq) const {
        const int row0 = u.pm * 256 + wr * 64 + fr; const int c0 = u.pn * 128 + wc * 32 + 8 * fq;
        const float* bg = b_gu + (size_t)u.e * 2048 + c0; const float* bu = bg + 1024;
        const f32x4 bg0 = *(const f32x4*)bg, bg1 = *(const f32x4*)(bg + 4), bu0 = *(const f32x4*)bu, bu1 = *(const f32x4*)(bu + 4);
#pragma unroll
        for (int ai = 0; ai < 2; ++ai)
#pragma unroll
            for (int m = 0; m < 4; ++m) {
                const f32x4 g0 = acc[ai][0][m][0] + bg0, g1 = acc[ai][0][m][1] + bg1, u0 = acc[ai][1][m][0] + bu0, u1 = acc[ai][1][m][1] + bu1;
                u32x4 w; w.x = cvtpk(glu_f(g0[0], u0[0]), glu_f(g0[1], u0[1])); w.y = cvtpk(glu_f(g0[2], u0[2]), glu_f(g0[3], u0[3]));
                w.z = cvtpk(glu_f(g1[0], u1[0]), glu_f(g1[1], u1[1])); w.w = cvtpk(glu_f(g1[2], u1[2]), glu_f(g1[3], u1[3]));
                *(u32x4*)(H + (size_t)(row0 + ai * 128 + m * 16) * DM + c0) = w; }
    }
};
template <bool F8> struct EpiDownT {
    static constexpr bool PERM = true, AFTER_DRAIN = false;
    bf16* Y; const float* b_down; const int* rowinfo; const float* rowgate;
    __device__ __forceinline__ void operator()(const f32x4 (&acc)[2][2][4][2], const pg8::Unit& u, int wr, int wc, int fr, int fq) const {
        const int row0 = u.pm * 256 + wr * 64 + fr; const int col0 = u.pn * 256 + wc * 32 + 8 * fq;
        const float* bd = b_down + (size_t)u.e * 1024 + col0;
        f32x4 bv[2][2];
#pragma unroll
        for (int bj = 0; bj < 2; ++bj)
#pragma unroll
            for (int n = 0; n < 2; ++n) bv[bj][n] = *(const f32x4*)(bd + bj * 128 + 4 * n);
#pragma unroll
        for (int ai = 0; ai < 2; ++ai)
#pragma unroll
            for (int m = 0; m < 4; ++m) { const int row = row0 + ai * 128 + m * 16; const int dst = rowinfo[row]; const float gt = rowgate[row];
                if (dst >= 0) { bf16* rowp = Y + (size_t)dst * DM + col0;
#pragma unroll
                    for (int bj = 0; bj < 2; ++bj) { const float sa = F8 ? W8_INV : 1.0f; const f32x4 v0 = (acc[ai][bj][m][0] * sa + bv[bj][0]) * gt, v1 = (acc[ai][bj][m][1] * sa + bv[bj][1]) * gt;
                        u32x4 w; w.x = cvtpk(v0[0], v0[1]); w.y = cvtpk(v0[2], v0[3]); w.z = cvtpk(v1[0], v1[1]); w.w = cvtpk(v1[2], v1[3]);
                        *(u32x4*)(rowp + bj * 128) = w; } } }
    }
};
struct GroupedOrder {
    const LAS int* tile_e; int ntiles, nN, G, c; size_t estride;
    __device__ __forceinline__ bool next(int i, pg8::Unit& u) const {
        int pm, pn;
        if (G == 256) { const int x = c & 7, j = c >> 3, rpx = 32 / nN; pn = j % nN; pm = i * (8 * rpx) + x * rpx + j / nN; }
        else { const long L = (long)i * G + c; pm = (int)(L / nN); pn = (int)(L % nN); }
        if (pm >= ntiles) return false;
        u.pm = pm; u.pn = pn; u.e = __builtin_amdgcn_readfirstlane(tile_e[pm]); u.bo = (size_t)u.e * estride; return true;
    }
    __device__ __forceinline__ void a_ready(const pg8::Unit&) const {}
    __device__ __forceinline__ void done(const pg8::Unit&) const {}
};

#define XB_TMO      128
#define XB_XCNT(j)  (256  + 64 * (j))
#define XB_XSUB(j)  (1280 + 64 * (j))
#define XB_XGEN(j)  (2304 + 64 * (j))
#define XB_TOP      3328
#define XB_TOPGEN   3392
#define XCD_BAR_WORDS 3456
#define XB_SPIN_CAP (1u << 18)

__device__ __forceinline__ unsigned xb_ld(unsigned* p)              { return __hip_atomic_load(p, __ATOMIC_RELAXED, __HIP_MEMORY_SCOPE_AGENT); }
__device__ __forceinline__ unsigned xb_add(unsigned* p, unsigned v) { return __hip_atomic_fetch_add(p, v, __ATOMIC_RELAXED, __HIP_MEMORY_SCOPE_AGENT); }
__device__ __forceinline__ unsigned xb_xcc_id() { return (unsigned)__builtin_amdgcn_s_getreg((3 << 11) | 20) & 0xFu; }
#define XB_SPIN(cond, bar) do { unsigned _sp = 0; while (cond) { __builtin_amdgcn_s_sleep(1); \
    if ((++_sp & 255u) == 0u) { if (xb_ld(&(bar)[XB_TMO])) break; if (_sp > XB_SPIN_CAP) { atomicAdd(&(bar)[XB_TMO], 1u); break; } } } } while (0)

struct XcdBarrier {
    unsigned* bar; unsigned x; bool w0;
    volatile LAS unsigned* st;
};

__device__ __forceinline__ XcdBarrier xcd_barrier_post(unsigned* bar, volatile LAS unsigned* st, bool w0) {
    XcdBarrier b; b.bar = bar; b.x = xb_xcc_id(); b.st = st; b.w0 = w0;
    if (w0 && hw_lane() == 0) (void)xb_add(&bar[XB_XCNT(b.x)], 1u);
    return b;
}
__device__ __forceinline__ void xcd_barrier_complete(unsigned* bar, unsigned x, unsigned& nloc, unsigned& nx) {
    const unsigned G = gridDim.x * gridDim.y * gridDim.z;
    unsigned sum, cnt, mine, sp = 0u;
    for (;;) {
        sum = 0u; cnt = 0u; mine = 0u;
#pragma unroll
        for (unsigned j = 0; j < 16; ++j) { const unsigned c = xb_ld(&bar[XB_XCNT(j)]); sum += c; cnt += (c > 0u) ? 1u : 0u; mine = (j == x) ? c : mine; }
        if (sum == G) break;
        __builtin_amdgcn_s_sleep(1);
        if ((++sp & 255u) == 0u) { if (xb_ld(&bar[XB_TMO])) break; if (sp > XB_SPIN_CAP) { atomicAdd(&bar[XB_TMO], 1u); break; } }
    }
    nloc = mine > 0u ? mine : 1u; nx = cnt > 0u ? cnt : 1u;
}

__device__ __forceinline__ void xcd_barrier(const XcdBarrier& b) {
    asm volatile("s_waitcnt vmcnt(0)" ::: "memory");
    __syncthreads();
    if (b.w0 && hw_lane() == 0) {
        unsigned* bar = b.bar;
        __builtin_amdgcn_s_waitcnt(0);
        unsigned nloc = b.st[0], nx = b.st[1];
        if (nloc == 0u) { xcd_barrier_complete(bar, b.x, nloc, nx); b.st[0] = nloc; b.st[1] = nx; }
        const unsigned old = xb_add(&bar[XB_XSUB(b.x)], 1u);
        const unsigned gen = old / nloc;
        if (old + 1u == (gen + 1u) * nloc) {
            __builtin_amdgcn_fence(__ATOMIC_RELEASE, "agent");
            asm volatile("s_waitcnt vmcnt(0)" ::: "memory");
            const unsigned og = xb_add(&bar[XB_TOP], 1u);
            const unsigned tg = og / nx;
            if (og + 1u == (tg + 1u) * nx) xb_add(&bar[XB_TOPGEN], 1u);
            else XB_SPIN(xb_ld(&bar[XB_TOPGEN]) == tg, bar);
            __builtin_amdgcn_fence(__ATOMIC_ACQUIRE, "agent");
            xb_add(&bar[XB_XGEN(b.x)], 1u);
            asm volatile("s_waitcnt vmcnt(0)" ::: "memory");
        } else {
            XB_SPIN(xb_ld(&bar[XB_XGEN(b.x)]) == gen, bar);
            __builtin_amdgcn_fence(__ATOMIC_ACQUIRE, "agent");
            asm volatile("s_waitcnt vmcnt(0)" ::: "memory");
        }
    }
    __syncthreads();
}

struct Frame {
    LAS unsigned char* lds;
    volatile LAS unsigned* MISC;
    unsigned* ctl;
    int wave, G, bid;
    __device__ __forceinline__ int lane() const { return hw_lane(); }
    __device__ __forceinline__ int tid() const { return wave * 64 + hw_lane(); }
    __device__ __forceinline__ const float* in(int i) const { const LAS unsigned* p = (const LAS unsigned*)(lds + PTR_OFF) + 2 * i;
        const unsigned lo = __builtin_amdgcn_readfirstlane(p[0]), hi = __builtin_amdgcn_readfirstlane(p[1]); return (const float*)(((unsigned long long)hi << 32) | lo); }
    float* out; unsigned char* ws;
    unsigned long long tacc;
};
__device__ __forceinline__ float log2gamma(int h) { return log2f(1.0f - exp2f(-5.0f - (float)h)); }

template <bool F8, class RowMap>
__device__ __forceinline__ void transpose_item(const float* W, int N, bf16* WT, int K, const float* kscale, LAS float* scr, int kb, int nb, int lane, RowMap rm) {
    const int k0 = 64 * kb, n0 = 64 * nb;
#pragma unroll 4
    for (int i = 0; i < 16; ++i) {
        const int kk = 4 * i + (lane >> 4), nn = 4 * (lane & 15);
        f32x4 v = (f32x4){0.f, 0.f, 0.f, 0.f};
        if (n0 + nn < N) v = *(const f32x4*)(W + (size_t)(k0 + kk) * N + n0 + nn);
        if (kscale) v = v * kscale[k0 + kk];
        LAS float* s = scr + kk * 65 + nn; s[0] = v[0]; s[1] = v[1]; s[2] = v[2]; s[3] = v[3];
    }
    asm volatile("s_waitcnt lgkmcnt(0)" ::: "memory");
    const int cch = lane & 7;
#pragma unroll
    for (int j = 0; j < 8; ++j) {
        const int n = 8 * j + (lane >> 3); const LAS float* s = scr + (8 * cch) * 65 + n;
        if constexpr (F8) {
            u32x2 o; o.x = pk4_fp8(s[0 * 65] * W8_SCALE, s[1 * 65] * W8_SCALE, s[2 * 65] * W8_SCALE, s[3 * 65] * W8_SCALE); o.y = pk4_fp8(s[4 * 65] * W8_SCALE, s[5 * 65] * W8_SCALE, s[6 * 65] * W8_SCALE, s[7 * 65] * W8_SCALE);
            if (n0 + n < N) *(u32x2*)((unsigned char*)WT + (size_t)rm(n0 + n) * K + k0 + 8 * cch) = o;
        } else {
        const float cs = (N == IN_COLS && n0 + n >= C_AQ && n0 + n < C_AK) ? 0.125f : 1.0f;
        u32x4 o; o.x = cvtpk(s[0 * 65] * cs, s[1 * 65] * cs); o.y = cvtpk(s[2 * 65] * cs, s[3 * 65] * cs); o.z = cvtpk(s[4 * 65] * cs, s[5 * 65] * cs); o.w = cvtpk(s[6 * 65] * cs, s[7 * 65] * cs);
        if (n0 + n < N) *(u32x4*)(WT + (size_t)rm(n0 + n) * K + k0 + 8 * cch) = o; }
    }
    asm volatile("s_waitcnt lgkmcnt(0)" ::: "memory");
}
template <class RowMap>
__device__ __forceinline__ void transpose_item_f8(const float* W, int N, unsigned char* WT, int K, LAS float* scr, int kb, int nb, int lane, RowMap rm) {
    const int k0 = 128 * kb, n0 = 32 * nb;
#pragma unroll 4
    for (int i = 0; i < 16; ++i) {
        const int kk = 8 * i + (lane >> 3), nn = 4 * (lane & 7);
        const f32x4 v = *(const f32x4*)(W + (size_t)(k0 + kk) * N + n0 + nn);
        LAS float* s = scr + kk * 33 + nn; s[0] = v[0]; s[1] = v[1]; s[2] = v[2]; s[3] = v[3];
    }
    asm volatile("s_waitcnt lgkmcnt(0)" ::: "memory");
    const int cch = lane & 7;
#pragma unroll
    for (int j = 0; j < 4; ++j) {
        const int n = 8 * j + (lane >> 3); const LAS float* s = scr + (16 * cch) * 33 + n;
        u32x4 o; o.x = pk4_fp8(s[0 * 33] * W8_SCALE, s[1 * 33] * W8_SCALE, s[2 * 33] * W8_SCALE, s[3 * 33] * W8_SCALE); o.y = pk4_fp8(s[4 * 33] * W8_SCALE, s[5 * 33] * W8_SCALE, s[6 * 33] * W8_SCALE, s[7 * 33] * W8_SCALE);
        o.z = pk4_fp8(s[8 * 33] * W8_SCALE, s[9 * 33] * W8_SCALE, s[10 * 33] * W8_SCALE, s[11 * 33] * W8_SCALE); o.w = pk4_fp8(s[12 * 33] * W8_SCALE, s[13 * 33] * W8_SCALE, s[14 * 33] * W8_SCALE, s[15 * 33] * W8_SCALE);
        *(u32x4*)(WT + (size_t)rm(n0 + n) * K + k0 + 16 * cch) = o;
    }
    asm volatile("s_waitcnt lgkmcnt(0)" ::: "memory");
}
struct RmId { __device__ __forceinline__ int operator()(int n) const { return n; } };
struct RmGu { __device__ __forceinline__ int operator()(int n) const { const int j = n & 1023; return (j >> 7) * 256 + (n >> 10) * 128 + (j & 127); } };

__device__ __forceinline__ void phase_p0a(Frame& F) {
    const float* const c_in = F.in(1); const float* const ada_w = F.in(2); const float* const ada_b = F.in(3); const float* const w_in = F.in(5); const float* const mix_scale = F.in(6);
    const float* const w_o = F.in(7); const float* const w_gu = F.in(11); const float* const w_down = F.in(13);
    if (F.bid < 96) {
        LAS float* sc = (LAS float*)F.lds;
        LAS float* part = (LAS float*)(F.lds + 16384);
        for (int i = F.tid(); i < 1024; i += NTHR) {
#pragma unroll
            for (int b = 0; b < 4; ++b) { const float cv = c_in[b * 1024 + i]; sc[i * 4 + b] = cv / (1.0f + __expf(-cv)); }
        }
        __syncthreads();
        const int j0 = F.bid * 64;
        float a0 = 0.f, a1 = 0.f, a2 = 0.f, a3 = 0.f;
#pragma unroll 8
        for (int ii = 0; ii < 128; ++ii) {
            const int i = F.wave * 128 + ii; const float w = ada_w[(size_t)i * 6144 + j0 + F.lane()];
            const f32x4 s4 = *(const LAS f32x4*)(sc + i * 4);
            a0 += s4[0] * w; a1 += s4[1] * w; a2 += s4[2] * w; a3 += s4[3] * w;
        }
        part[(F.wave * 4 + 0) * 64 + F.lane()] = a0; part[(F.wave * 4 + 1) * 64 + F.lane()] = a1; part[(F.wave * 4 + 2) * 64 + F.lane()] = a2; part[(F.wave * 4 + 3) * 64 + F.lane()] = a3;
        __syncthreads();
        if (F.tid() < 256) { const int b = F.tid() >> 6, l = F.tid() & 63; float s = ada_b[j0 + l];
#pragma unroll
            for (int w = 0; w < 8; ++w) s += part[(w * 4 + b) * 64 + l];
            ((float*)(F.ws + WS_MOD))[b * 6144 + j0 + l] = s; }
        __syncthreads();
    }
    { int* ri = (int*)(F.ws + WS_ROWINFO); for (int i = F.bid * NTHR + F.tid(); i < MOE_ROWS; i += F.G * NTHR) ri[i] = -1; }
    LAS float* scr = (LAS float*)(F.lds + F.wave * 16896);
    const int gw = F.bid * NWAVES + F.wave, NGW = F.G * NWAVES;
    constexpr int I_IN = 16 * 46, I_O = 16 * 16, I_GU = 32 * 16 * 32, I_DN = 32 * 16 * 16, NITEMS = I_IN + I_O + I_GU + I_DN;
    for (int it = gw; it < NITEMS; it += NGW) {
        int r = it;
        if (r < I_GU) { const int e = r / 512, q = r % 512; transpose_item_f8(w_gu + (size_t)e * 1024 * 2048, 2048, F.ws + WS_WGU + (size_t)e * 2048 * 1024, 1024, scr, q / 64, q % 64, F.lane(), RmGu()); continue; } r -= I_GU;
        if (r < I_DN) { const int e = r / 256, q = r % 256; transpose_item_f8(w_down + (size_t)e * 1024 * 1024, 1024, F.ws + WS_WDN + (size_t)e * 1024 * 1024, 1024, scr, q / 32, q % 32, F.lane(), RmId()); continue; } r -= I_DN;
        if (r < I_IN) { transpose_item<false>(w_in, IN_COLS, (bf16*)(F.ws + WS_WIN), 1024, nullptr, scr, r / 46, r % 46, F.lane(), RmId()); continue; } r -= I_IN;
        transpose_item<false>(w_o, 1024, (bf16*)(F.ws + WS_WO), 1024, mix_scale, scr, r / 16, r % 16, F.lane(), RmId());
    }
}

__device__ __forceinline__ void phase_p0b(Frame& F) {
    const float* const x_in = F.in(0); const float* const norm1_g = F.in(4);
    const int gw = F.bid * NWAVES + F.wave, NGW = F.G * NWAVES;
    const float* mod = (const float*)(F.ws + WS_MOD); bf16* h0 = (bf16*)(F.ws + WS_H0);
    for (int m = gw; m < NTOK; m += NGW) {
        const int b = m / SEQ;
        const f32x4* xr = (const f32x4*)(x_in + (size_t)m * DM) + F.lane();
        f32x4 v[4]; float s = 0.f;
#pragma unroll
        for (int j = 0; j < 4; ++j) { v[j] = xr[64 * j]; s += (v[j][0] * v[j][0] + v[j][1] * v[j][1]) + (v[j][2] * v[j][2] + v[j][3] * v[j][3]); }
        const float rstd = rsqrtf(wave_sum(s) * (1.f / DM) + EPS);
        u32x2* o8 = (u32x2*)(h0 + (size_t)m * DM) + F.lane();
#pragma unroll
        for (int j = 0; j < 4; ++j) { const int col = 4 * F.lane() + 256 * j;
            const f32x4 g = *(const f32x4*)(norm1_g + col), sh = *(const f32x4*)(mod + b * 6144 + col), sc = *(const f32x4*)(mod + b * 6144 + 1024 + col);
            const f32x4 y = (v[j] * rstd) * g * (sc + 1.0f) + sh;
            u32x2 w; w.x = cvtpk(y[0], y[1]); w.y = cvtpk(y[2], y[3]); o8[64 * j] = w; }
    }
}

constexpr int VSTR = 144, KSTR = 80;
__device__ __forceinline__ void ret_stage_v(Frame& F, const bf16* proj, int tok0, int h, LAS bf16* Vs) {
    const int row = F.tid() >> 2, q = F.tid() & 3; const bf16* src = proj + (size_t)(tok0 + row) * PJ + C_RV + h * 128 + q * 32;
#pragma unroll
    for (int i = 0; i < 4; ++i) *(LAS u32x4*)(Vs + row * VSTR + q * 32 + 8 * i) = *(const u32x4*)(src + 8 * i);
}
__device__ __forceinline__ void ret_stage64(Frame& F, const bf16* src0, size_t pitch, LAS bf16* Ds) {
    const int row = F.tid() >> 2, q = F.tid() & 3; const bf16* src = src0 + (size_t)row * pitch + q * 16;
#pragma unroll
    for (int i = 0; i < 2; ++i) *(LAS u32x4*)(Ds + row * KSTR + q * 16 + 8 * i) = *(const u32x4*)(src + 8 * i);
}
__device__ __forceinline__ void ret_a_item(Frame& F, int item) {
    const bf16* proj = (const bf16*)(F.ws + WS_PROJ); float* kvt = (float*)(F.ws + WS_KVT) + (size_t)item * 8192;
    const int bh = item >> 6, n = item & 63, b = bh >> 2, h = bh & 3, tok0 = b * SEQ + n * 128;
    LAS bf16* Vs = (LAS bf16*)F.lds; LAS bf16* Ks = (LAS bf16*)(F.lds + 128 * VSTR * 2);
    const float lg = log2gamma(h);
    ret_stage_v(F, proj, tok0, h, Vs);
    { const int row = F.tid() >> 2, q = F.tid() & 3; const bf16* src = proj + (size_t)(tok0 + row) * PJ + C_RK + h * 64 + q * 16; const float dk = 0.125f * exp2f((float)(127 - row) * lg);
#pragma unroll
      for (int i = 0; i < 2; ++i) { const u32x4 w = *(const u32x4*)(src + 8 * i); u32x4 o;
          o.x = cvtpk(bflo(w.x) * dk, bfhi(w.x) * dk); o.y = cvtpk(bflo(w.y) * dk, bfhi(w.y) * dk); o.z = cvtpk(bflo(w.z) * dk, bfhi(w.z) * dk); o.w = cvtpk(bflo(w.w) * dk, bfhi(w.w) * dk);
          *(LAS u32x4*)(Ks + row * KSTR + q * 16 + 8 * i) = o; } }
    __syncthreads();
    const int lane = F.lane(), n16 = lane & 15, c = lane >> 4, q4 = n16 >> 2, p4 = lane & 3, e0 = 16 * F.wave;
    f32x4 acc[4];
#pragma unroll
    for (int dt = 0; dt < 4; ++dt) acc[dt] = (f32x4){0.f, 0.f, 0.f, 0.f};
#pragma unroll
    for (int s = 0; s < 4; ++s) {
        const LAS bf16* ap = Vs + (32 * s + 4 * c + q4) * VSTR + e0 + 4 * p4;
        const bf16x8 A = cat8(trread(ap), trread(ap + 16 * VSTR));
#pragma unroll
        for (int dt = 0; dt < 4; ++dt) { const LAS bf16* bp = Ks + (32 * s + 4 * c + q4) * KSTR + 16 * dt + 4 * p4;
            const bf16x8 B = cat8(trread(bp), trread(bp + 16 * KSTR)); acc[dt] = MFMA16(A, B, acc[dt]); }
    }
#pragma unroll
    for (int dt = 0; dt < 4; ++dt)
#pragma unroll
        for (int r = 0; r < 4; ++r) kvt[(e0 + 4 * c + r) * 64 + 16 * dt + n16] = acc[dt][r];
    __syncthreads();
}
__device__ __forceinline__ void ret_scan(Frame& F) {
    const float* kvt = (const float*)(F.ws + WS_KVT); bf16* rpt = (bf16*)(F.ws + WS_RPT);
    for (int g = F.bid * NTHR + F.tid(); g < 16 * 8192; g += F.G * NTHR) {
        const int bh = g >> 13, ed = g & 8191, h = bh & 3; const float gC = exp2f(128.0f * log2gamma(h));
        float R = 0.f; const size_t base = (size_t)bh * 64 * 8192 + ed;
#pragma unroll 8
        for (int n = 0; n < 64; ++n) { const float kv = kvt[base + (size_t)n * 8192]; rpt[base + (size_t)n * 8192] = f2bf(R); R = R * gC + kv; }
    }
}
__device__ __forceinline__ void ret_c_item(Frame& F, int item) {
    const bf16* proj = (const bf16*)(F.ws + WS_PROJ); const bf16* rpt = (const bf16*)(F.ws + WS_RPT) + (size_t)item * 8192; bf16* mix = (bf16*)(F.ws + WS_MIX);
    const int bh = item >> 6, n = item & 63, b = bh >> 2, h = bh & 3, tok0 = b * SEQ + n * 128;
    LAS bf16* Qs = (LAS bf16*)F.lds; LAS bf16* Ks = Qs + 128 * KSTR; LAS bf16* Vs = Ks + 128 * KSTR; LAS bf16* Rs = Vs + 128 * VSTR;
    const float lg = log2gamma(h);
    ret_stage64(F, proj + (size_t)tok0 * PJ + C_RQ + h * 64, PJ, Qs);
    ret_stage64(F, proj + (size_t)tok0 * PJ + C_RK + h * 64, PJ, Ks);
    ret_stage_v(F, proj, tok0, h, Vs);
    ret_stage64(F, rpt, 64, Rs);
    __syncthreads();
    const int lane = F.lane(), n16 = lane & 15, c = lane >> 4, q4 = n16 >> 2, p4 = lane & 3, w = F.wave, i0 = 16 * w, il = i0 + n16;
    bf16x8 qf[2];
#pragma unroll
    for (int s = 0; s < 2; ++s) qf[s] = *(const LAS bf16x8*)(Qs + il * KSTR + 32 * s + 8 * c);
    f32x4 oin[8], ocr[8];
#pragma unroll
    for (int et = 0; et < 8; ++et) { oin[et] = (f32x4){0.f, 0.f, 0.f, 0.f}; ocr[et] = (f32x4){0.f, 0.f, 0.f, 0.f}; }
    const int nsp = (w >> 1) + 1;
    for (int sp = 0; sp < nsp; ++sp) {
        unsigned pw[4];
#pragma unroll
        for (int t2 = 0; t2 < 2; ++t2) { const int jt = 2 * sp + t2;
            const bf16x8 k0 = *(const LAS bf16x8*)(Ks + (16 * jt + n16) * KSTR + 8 * c), k1 = *(const LAS bf16x8*)(Ks + (16 * jt + n16) * KSTR + 32 + 8 * c);
            f32x4 st = MFMA16(k0, qf[0], ((f32x4){0.f, 0.f, 0.f, 0.f})); st = MFMA16(k1, qf[1], st);
            float pv[4];
#pragma unroll
            for (int r = 0; r < 4; ++r) { const int j = 16 * jt + 4 * c + r; const float f = (il >= j) ? 0.125f * exp2f((float)(il - j) * lg) : 0.f; pv[r] = st[r] * f; }
            pw[2 * t2] = cvtpk(pv[0], pv[1]); pw[2 * t2 + 1] = cvtpk(pv[2], pv[3]); }
        const bf16x8 P = __builtin_bit_cast(bf16x8, ((u32x4){pw[0], pw[1], pw[2], pw[3]}));
#pragma unroll
        for (int et = 0; et < 8; ++et) { const LAS bf16* ap = Vs + (32 * sp + 4 * c + q4) * VSTR + 16 * et + 4 * p4;
            const bf16x8 A = cat8(trread(ap), trread(ap + 16 * VSTR)); oin[et] = MFMA16(A, P, oin[et]); }
    }
#pragma unroll
    for (int et = 0; et < 8; ++et)
#pragma unroll
        for (int s = 0; s < 2; ++s) { const bf16x8 rf = *(const LAS bf16x8*)(Rs + (16 * et + n16) * KSTR + 32 * s + 8 * c); ocr[et] = MFMA16(rf, qf[s], ocr[et]); }
    const float qd = exp2f((float)(il + 1) * lg);
    float ss = 0.f;
#pragma unroll
    for (int et = 0; et < 8; ++et) { oin[et] = oin[et] + ocr[et] * qd; ss += (oin[et][0] * oin[et][0] + oin[et][1] * oin[et][1]) + (oin[et][2] * oin[et][2] + oin[et][3] * oin[et][3]); }
    ss += __shfl_xor(ss, 16); ss += __shfl_xor(ss, 32);
    const float rstd = rsqrtf(ss * (1.f / 128.f) + EPS);
    const bf16* gp = proj + (size_t)(tok0 + il) * PJ + C_RG + h * 128 + 4 * c; bf16* op = mix + (size_t)(tok0 + il) * DM + h * 128 + 4 * c;
#pragma unroll
    for (int et = 0; et < 8; ++et) { const u32x2 gw = *(const u32x2*)(gp + 16 * et);
        const float g0 = bflo(gw.x), g1 = bfhi(gw.x), g2 = bflo(gw.y), g3 = bfhi(gw.y);
        const float y0 = g0 / (1.f + __expf(-g0)) * (oin[et][0] * rstd), y1 = g1 / (1.f + __expf(-g1)) * (oin[et][1] * rstd), y2 = g2 / (1.f + __expf(-g2)) * (oin[et][2] * rstd), y3 = g3 / (1.f + __expf(-g3)) * (oin[et][3] * rstd);
        u32x2 o; o.x = cvtpk(y0, y1); o.y = cvtpk(y2, y3); *(u32x2*)(op + 16 * et) = o; }
    __syncthreads();
}

constexpr int QT = 64, KT = 64, CAP = 512, CAP_TRIG = CAP - KT, NSEL = 256, NREG = CAP / 64;
constexpr int KTS = 72;
constexpr int CAND_BYTES = QT * CAP * 4, KTILE_BYTES = KT * KTS * 2;
constexpr float WSCALE = 0.125f * 0.35355339059327373f;
__device__ __forceinline__ unsigned fmap(float s) { const unsigned u = __builtin_bit_cast(unsigned, s); return (u & 0x80000000u) ? ~u : (u | 0x80000000u); }
__device__ __forceinline__ float funmap(unsigned m) { const unsigned u = (m & 0x80000000u) ? (m ^ 0x80000000u) : ~m; return __builtin_bit_cast(float, u); }
#define DPP_ROR(v, n) ((unsigned)__builtin_amdgcn_update_dpp(0, (int)(v), 0x120 + (n), 0xf, 0xf, false))
#define DPP_SHR0(v, n) ((unsigned)__builtin_amdgcn_update_dpp(0, (int)(v), 0x110 + (n), 0xf, 0xf, true))
__device__ __forceinline__ unsigned wave_umin(unsigned v) {
    v = min(v, DPP_ROR(v, 1)); v = min(v, DPP_ROR(v, 2)); v = min(v, DPP_ROR(v, 4)); v = min(v, DPP_ROR(v, 8));
    const unsigned a = __builtin_amdgcn_readlane(v, 0), b = __builtin_amdgcn_readlane(v, 16), c = __builtin_amdgcn_readlane(v, 32), d = __builtin_amdgcn_readlane(v, 48);
    return min(min(a, b), min(c, d));
}
__device__ __forceinline__ unsigned wave_umax(unsigned v) {
    v = max(v, DPP_ROR(v, 1)); v = max(v, DPP_ROR(v, 2)); v = max(v, DPP_ROR(v, 4)); v = max(v, DPP_ROR(v, 8));
    const unsigned a = __builtin_amdgcn_readlane(v, 0), b = __builtin_amdgcn_readlane(v, 16), c = __builtin_amdgcn_readlane(v, 32), d = __builtin_amdgcn_readlane(v, 48);
    return max(max(a, b), max(c, d));
}
__device__ __forceinline__ unsigned wave_scan_incl(unsigned v, int lane) {
    v += DPP_SHR0(v, 1); v += DPP_SHR0(v, 2); v += DPP_SHR0(v, 4); v += DPP_SHR0(v, 8);
    const unsigned t0 = __builtin_amdgcn_readlane(v, 15), t1 = __builtin_amdgcn_readlane(v, 31), t2 = __builtin_amdgcn_readlane(v, 47);
    const int rw = lane >> 4;
    return v + (rw == 1 ? t0 : rw == 2 ? t0 + t1 : rw == 3 ? t0 + t1 + t2 : 0u);
}
__device__ __forceinline__ int select_row(LAS unsigned* row, int cnt, int limit, LAS unsigned* hist, int lane, unsigned& minkey) {
    unsigned e[NREG]; unsigned act = 0u, keep = 0u;
#pragma unroll
    for (int j = 0; j < NREG; ++j) { const int p = 64 * j + lane; const bool v = p < cnt; e[j] = v ? row[p] : 0u; act |= v ? (1u << j) : 0u; }
    int need = NSEL; bool first = true;
    for (;;) {
        unsigned lo = 0xFFFFFFFFu, hi = 0u;
#pragma unroll
        for (int j = 0; j < NREG; ++j) { const bool a = (act >> j) & 1u; lo = min(lo, a ? e[j] : 0xFFFFFFFFu); hi = max(hi, a ? e[j] : 0u); }
        lo = wave_umin(lo); hi = wave_umax(hi);
        if (hi == lo) break;
        hist[lane] = 0u;
        int rb[NREG];
        if (first) {
            const float slo = funmap(lo & 0xFFFFE000u), shi = funmap(hi & 0xFFFFE000u);
            const float scale = (shi > slo) ? 63.999f / (shi - slo) : 0.f;
#pragma unroll
            for (int j = 0; j < NREG; ++j) { int bn = (int)((funmap(e[j] & 0xFFFFE000u) - slo) * scale); bn = bn > 63 ? 63 : (bn < 0 ? 0 : bn); rb[j] = 63 - bn; }
        } else {
            const float scale = 63.999f / (float)(hi - lo);
#pragma unroll
            for (int j = 0; j < NREG; ++j) { int bn = (int)((float)(e[j] - lo) * scale); bn = bn > 63 ? 63 : (bn < 0 ? 0 : bn); rb[j] = 63 - bn; }
        }
        first = false;
#pragma unroll
        for (int j = 0; j < NREG; ++j) __hip_atomic_fetch_add(hist + rb[j], (act >> j) & 1u, __ATOMIC_RELAXED, __HIP_MEMORY_SCOPE_WAVEFRONT);
        const unsigned h = hist[lane];
        const unsigned ps = wave_scan_incl(h, lane);
        const unsigned long long m = __ballot(ps >= (unsigned)need);
        const int ls = (int)__builtin_ctzll(m);
        const int cge = (int)__builtin_amdgcn_readlane(ps, ls), nb = (int)__builtin_amdgcn_readlane(h, ls);
#pragma unroll
        for (int j = 0; j < NREG; ++j) { const unsigned a = (act >> j) & 1u; const unsigned kp = a & (unsigned)(rb[j] < ls), dr = a & (unsigned)(rb[j] > ls); keep |= kp << j; act &= ~((kp | dr) << j); }
        need -= cge - nb;
        if ((NSEL - need) + nb <= limit) break;
    }
    keep |= act;
    int run = 0; unsigned mk = 0xFFFFFFFFu;
#pragma unroll
    for (int j = 0; j < NREG; ++j) { const bool k = (keep >> j) & 1u; const unsigned long long m = __ballot(k);
        if (k) row[run + mbcnt64(m)] = e[j];
        mk = min(mk, k ? e[j] : 0xFFFFFFFFu);
        run += __builtin_popcountll(m); }
    minkey = wave_umin(mk);
    return run;
}
__device__ __forceinline__ int compact_stream(LAS unsigned* row, int cnt, LAS unsigned* hist, int lane, float& thrf) {
    unsigned e[NREG];
#pragma unroll
    for (int j = 0; j < NREG; ++j) e[j] = row[64 * j + lane];
    const unsigned lo = wave_umin(min(e[0], e[1])), hi = wave_umax(max(e[0], e[1]));
    const float slo = funmap(lo & 0xFFFFE000u), shi = funmap(hi & 0xFFFFE000u);
    bool ok = shi > slo; int newcnt = 0, bstar = 0; int bn[NREG]; float scale = 0.f;
    if (ok) {
        scale = 63.999f / (shi - slo);
        hist[lane] = 0u;
#pragma unroll
        for (int j = 0; j < NREG; ++j) { int b = (int)((funmap(e[j] & 0xFFFFE000u) - slo) * scale); b = b > 63 ? 63 : (b < 0 ? 0 : b); bn[j] = b;
            __hip_atomic_fetch_add(hist + (63 - b), (64 * j + lane < cnt) ? 1u : 0u, __ATOMIC_RELAXED, __HIP_MEMORY_SCOPE_WAVEFRONT); }
        const unsigned h = hist[lane];
        const unsigned ps = wave_scan_incl(h, lane);
        const unsigned long long m = __ballot(ps >= (unsigned)NSEL);
        const int ls = (int)__builtin_ctzll(m);
        newcnt = (int)__builtin_amdgcn_readlane(ps, ls); bstar = 63 - ls;
        ok = newcnt <= NSEL + 96;
    }
    if (!ok) { unsigned P; const int nc = select_row(row, cnt, NSEL + 64, hist, lane, P); thrf = funmap(P & 0xFFFFE000u); return nc; }
    int run = 0;
#pragma unroll
    for (int j = 0; j < NREG; ++j) { const bool k = (64 * j + lane < cnt) && (bn[j] >= bstar); const unsigned long long m = __ballot(k);
        if (k) row[run + mbcnt64(m)] = e[j];
        run += __builtin_popcountll(m); }
    if (bstar > 0) thrf = slo + ((float)bstar - 0.01f) / scale;
    return run;
}
#if defined(PROBE_SUB)
#define PSUB_T(i) do { const unsigned long long _t = __builtin_amdgcn_s_memrealtime(); if ((i) == PROBE_SUB) F.tacc += _t - psub_last; psub_last = _t; } while (0)
#else
#define PSUB_T(i) do { } while (0)
#endif
__device__ __forceinline__ void dsa_a_unit(Frame& F, int b, int qt) {
#if defined(PROBE_SUB)
    unsigned long long psub_last = 0ull;
#endif
    const bf16* proj = (const bf16*)(F.ws + WS_PROJ); bf16* sel = (bf16*)(F.ws + WS_SEL);
    LAS unsigned* cand = (LAS unsigned*)F.lds; LAS bf16* ktile = (LAS bf16*)(F.lds + CAND_BYTES);
    LAS unsigned* hist = (LAS unsigned*)(F.lds + CAND_BYTES + KTILE_BYTES) + 64 * F.wave;
    LAS int* rowcnt = (LAS int*)(F.lds + CAND_BYTES + KTILE_BYTES + 2048); LAS float* rowthr = (LAS float*)(F.lds + CAND_BYTES + KTILE_BYTES + 2048 + 256);
    const int lane = F.lane(), w = F.wave, r32 = lane & 31, hi = lane >> 5;
    const int tokb = b * SEQ, q0 = qt * QT;
    bf16x8 af[2][4]; float wv[2][16];
    { const int qq = 2 * ((r32 >> 2) & 1) + (r32 >> 4), hd = ((r32 >> 3) & 1) * 4 + (r32 & 3);
#pragma unroll
      for (int mt = 0; mt < 2; ++mt) { const bf16* qp = proj + (size_t)(tokb + q0 + 8 * w + 4 * mt + qq) * PJ + C_IQ + hd * 64 + 8 * hi;
#pragma unroll
          for (int s = 0; s < 4; ++s) af[mt][s] = *(const bf16x8*)(qp + 16 * s);
#pragma unroll
          for (int u = 0; u < 2; ++u) { const u32x4 ww = *(const u32x4*)(proj + (size_t)(tokb + q0 + 8 * w + 4 * mt + 2 * hi + u) * PJ + C_IW);
              wv[mt][8 * u + 0] = bflo(ww.x) * WSCALE; wv[mt][8 * u + 1] = bfhi(ww.x) * WSCALE; wv[mt][8 * u + 2] = bflo(ww.y) * WSCALE; wv[mt][8 * u + 3] = bfhi(ww.y) * WSCALE;
              wv[mt][8 * u + 4] = bflo(ww.z) * WSCALE; wv[mt][8 * u + 5] = bfhi(ww.z) * WSCALE; wv[mt][8 * u + 6] = bflo(ww.w) * WSCALE; wv[mt][8 * u + 7] = bfhi(ww.w) * WSCALE; } } }
    float thrf[2][2]; int cntv[2][2];
#pragma unroll
    for (int mt = 0; mt < 2; ++mt)
#pragma unroll
        for (int u = 0; u < 2; ++u) { thrf[mt][u] = -INFINITY; cntv[mt][u] = 0; }
    if (lane < 8) { rowcnt[8 * w + lane] = 0; rowthr[8 * w + lane] = -INFINITY; }
    const int NT = qt + 1;
    const int skey = F.tid() >> 3, spc = F.tid() & 7;
    const bf16* ksrc = proj + (size_t)(tokb + skey) * PJ + C_IK + spc * 8;
    { const u32x4 v = *(const u32x4*)ksrc; *(LAS u32x4*)(ktile + skey * KTS + spc * 8) = v; }
    __syncthreads();
    for (int kt = 0; kt < NT; ++kt) {
        PSUB_T(0);
        u32x4 pre = (u32x4){0u, 0u, 0u, 0u};
        if (kt + 1 < NT) pre = *(const u32x4*)(ksrc + (size_t)(kt + 1) * KT * PJ);
        const LAS bf16* cur = ktile;
#pragma unroll
        for (int sub = 0; sub < 2; ++sub) {
            bf16x8 bfr[4];
#pragma unroll
            for (int s = 0; s < 4; ++s) bfr[s] = *(const LAS bf16x8*)(cur + (sub * 32 + r32) * KTS + 16 * s + 8 * hi);
            const int key = kt * KT + sub * 32 + r32;
#pragma unroll
            for (int mt = 0; mt < 2; ++mt) {
                f32x16 acc;
#pragma unroll
                for (int r = 0; r < 16; ++r) acc[r] = 0.f;
#pragma unroll
                for (int s = 0; s < 4; ++s) acc = MFMA32(af[mt][s], bfr[s], acc);
                float sc[2] = {0.f, 0.f};
#pragma unroll
                for (int r = 0; r < 16; ++r) sc[r >> 3] += wv[mt][r] * fmaxf(acc[r], 0.f);
#pragma unroll
                for (int u = 0; u < 2; ++u) {
                    const int ql = 8 * w + 4 * mt + 2 * hi + u;
                    const bool valid = (sc[u] >= thrf[mt][u]) && (key <= q0 + ql);
                    const unsigned long long m = __ballot(valid);
                    const int nlo = __builtin_popcount((unsigned)m), nhi = __builtin_popcount((unsigned)(m >> 32));
                    const int off = mbcnt64(m) - (hi ? nlo : 0);
                    if (valid) cand[ql * CAP + cntv[mt][u] + off] = (fmap(sc[u]) & 0xFFFFE000u) | (unsigned)(8191 - key);
                    cntv[mt][u] += hi ? nhi : nlo;
                }
            }
        }
        PSUB_T(1);
        int anyc = 0;
#pragma unroll
        for (int mt = 0; mt < 2; ++mt)
#pragma unroll
            for (int u = 0; u < 2; ++u) anyc |= (cntv[mt][u] > CAP_TRIG) ? 1 : 0;
        PSUB_T(2);
        const int doc = __syncthreads_or(anyc);
        if (kt + 1 < NT) *(LAS u32x4*)(ktile + skey * KTS + spc * 8) = pre;
        if (doc) {
            if ((lane & 31) == 0) {
#pragma unroll
                for (int mt = 0; mt < 2; ++mt)
#pragma unroll
                    for (int u = 0; u < 2; ++u) rowcnt[8 * w + 4 * mt + 2 * hi + u] = cntv[mt][u];
            }
#pragma unroll 1
            for (int rr = 0; rr < 8; ++rr) { const int rowi = 8 * w + rr; const int cq = __builtin_amdgcn_readfirstlane(rowcnt[rowi]);
                if (cq > NSEL + 64) { float tf = rowthr[rowi]; const int nc = compact_stream(cand + rowi * CAP, cq, hist, lane, tf);
                    if (lane == 0) { rowcnt[rowi] = nc; rowthr[rowi] = tf; } } }
#pragma unroll
            for (int mt = 0; mt < 2; ++mt)
#pragma unroll
                for (int u = 0; u < 2; ++u) { cntv[mt][u] = rowcnt[8 * w + 4 * mt + 2 * hi + u]; thrf[mt][u] = rowthr[8 * w + 4 * mt + 2 * hi + u]; }
        }
        __syncthreads();
        PSUB_T(3);
    }
    PSUB_T(5);
    if ((lane & 31) == 0) {
#pragma unroll
        for (int mt = 0; mt < 2; ++mt)
#pragma unroll
            for (int u = 0; u < 2; ++u) rowcnt[8 * w + 4 * mt + 2 * hi + u] = cntv[mt][u];
    }
#pragma unroll 1
    for (int rr = 0; rr < 8; ++rr) { const int ql = 8 * w + rr; LAS unsigned* row = cand + ql * CAP; int cq = __builtin_amdgcn_readfirstlane(rowcnt[ql]);
        if (cq > NSEL) { unsigned P; cq = select_row(row, cq, NSEL, hist, lane, P); }
        bf16* so = sel + (size_t)(tokb + q0 + ql) * NSEL;
#pragma unroll
        for (int j = 0; j < 4; ++j) { const int p = 64 * j + lane; const unsigned v = row[p]; so[p] = (p < cq) ? (bf16)(8191u - (v & 0x1FFFu)) : (bf16)0; } }
    PSUB_T(6);
    __syncthreads();
}

constexpr int VROW = 144;
constexpr int DSB_WAVE = 32 * VROW * 2 + 2 * 512;
static_assert(8 * DSB_WAVE <= MISC_OFF, "DSA-B LDS map");
__device__ __forceinline__ void dsb_gather(const char* kvbase, const LAS bf16* sl, int chunk, int colbyte, int c, int n16, u32x4 (&r)[8]) {
#pragma unroll
    for (int i = 0; i < 8; ++i) { const unsigned o = (unsigned)sl[32 * chunk + 4 * i + c] * (unsigned)(PJ * 2) + (unsigned)(colbyte + n16 * 16); r[i] = *(const u32x4*)(kvbase + o); }
}
__device__ __forceinline__ void phase_dsa_b(Frame& F) {
    const bf16* proj = (const bf16*)(F.ws + WS_PROJ); const bf16* sel = (const bf16*)(F.ws + WS_SEL); bf16* mix = (bf16*)(F.ws + WS_MIX);
    const int lane = F.lane(), n16 = lane & 15, c = lane >> 4, q4 = n16 >> 2, p4 = lane & 3, w = F.wave;
    LAS unsigned char* wl = F.lds + w * DSB_WAVE;
    LAS bf16* buf = (LAS bf16*)wl; LAS bf16* slb = (LAS bf16*)(wl + 32 * VROW * 2);
    const float nslope[2] = {-exp2f(-(float)((n16 & 3) + 1)), -exp2f(-(float)((n16 & 3) + 5))};
    constexpr float L2E = 1.4426950408889634f;
    for (int blk = F.bid; blk < NTOK / 128; blk += F.G) {
        int T0 = blk * 128;
        if (F.G == 256) { const int x = F.bid & 7, jj = F.bid >> 3; T0 = (x & 3) * SEQ + (jj * 2 + (x >> 2)) * 128; }
        const char* kvbase = (const char*)(proj + (size_t)(T0 / SEQ) * SEQ * PJ);
        int tok = T0 + w;
        u32x4 kr[8], vr[8]; bf16x8 qf[2][2]; u32x2 selnext;
        *(LAS u32x2*)(slb + 4 * lane) = *(const u32x2*)(sel + (size_t)tok * NSEL + 4 * lane);
        dsb_gather(kvbase, slb, 0, C_AK * 2, c, n16, kr); dsb_gather(kvbase, slb, 0, C_AV * 2, c, n16, vr);
#pragma unroll
        for (int g = 0; g < 2; ++g)
#pragma unroll
            for (int s = 0; s < 2; ++s) { bf16x8 v = (bf16x8){0, 0, 0, 0, 0, 0, 0, 0};
                if (n16 < 4) v = *(const bf16x8*)(proj + (size_t)tok * PJ + C_AQ + (g * 4 + n16) * 64 + 32 * s + 8 * c);
                qf[g][s] = v; }
        for (int qi = 0; qi < 16; ++qi) {
            const int t = tok % SEQ, nsel = (t + 1 < NSEL) ? t + 1 : NSEL; const int par = qi & 1;
            const LAS bf16* sl = slb + par * 256; LAS bf16* sln = slb + (par ^ 1) * 256;
            const bool more = qi + 1 < 16; const int tokn = tok + 8;
            if (more) selnext = *(const u32x2*)(sel + (size_t)tokn * NSEL + 4 * lane);
            float mrun[2] = {-INFINITY, -INFINITY}, lrun[2] = {0.f, 0.f};
            f32x4 O[2][4];
#pragma unroll
            for (int g = 0; g < 2; ++g)
#pragma unroll
                for (int dt = 0; dt < 4; ++dt) O[g][dt] = (f32x4){0.f, 0.f, 0.f, 0.f};
            bf16x8 qn[2][2];
#pragma unroll 1
            for (int ch = 0; ch < 8; ++ch) {
#pragma unroll
                for (int i = 0; i < 8; ++i) *(LAS u32x4*)(buf + (4 * i + c) * VROW + n16 * 8) = kr[i];
                if (ch == 3 && more) *(LAS u32x2*)(sln + 4 * lane) = selnext;
                asm volatile("" ::: "memory");
                if (ch < 7) dsb_gather(kvbase, sl, ch + 1, C_AK * 2, c, n16, kr);
                else if (more) dsb_gather(kvbase, sln, 0, C_AK * 2, c, n16, kr);
                if (ch == 6 && more) {
#pragma unroll
                    for (int g = 0; g < 2; ++g)
#pragma unroll
                        for (int s = 0; s < 2; ++s) { bf16x8 v = (bf16x8){0, 0, 0, 0, 0, 0, 0, 0};
                            if (n16 < 4) v = *(const bf16x8*)(proj + (size_t)tokn * PJ + C_AQ + (g * 4 + n16) * 64 + 32 * s + 8 * c);
                            qn[g][s] = v; } }
                f32x4 acc[2][2];
#pragma unroll
                for (int kt = 0; kt < 2; ++kt)
#pragma unroll
                    for (int g = 0; g < 2; ++g) { const LAS bf16* ap = buf + (16 * kt + n16) * VROW + g * 64 + 8 * c;
                        acc[kt][g] = MFMA16(*(const LAS bf16x8*)ap, qf[g][0], ((f32x4){0.f, 0.f, 0.f, 0.f})); acc[kt][g] = MFMA16(*(const LAS bf16x8*)(ap + 32), qf[g][1], acc[kt][g]); }
#pragma unroll
                for (int kt = 0; kt < 2; ++kt) { const u32x2 kk = *(const LAS u32x2*)(sl + 32 * ch + 16 * kt + 4 * c);
                    const float d4[4] = {(float)(t - (int)(kk.x & 0xffffu)), (float)(t - (int)(kk.x >> 16)), (float)(t - (int)(kk.y & 0xffffu)), (float)(t - (int)(kk.y >> 16))};
#pragma unroll
                    for (int r = 0; r < 4; ++r)
#pragma unroll
                        for (int g = 0; g < 2; ++g) acc[kt][g][r] = fmaf(nslope[g], d4[r], acc[kt][g][r]); }
                if (nsel < NSEL) {
#pragma unroll
                    for (int kt = 0; kt < 2; ++kt)
#pragma unroll
                        for (int r = 0; r < 4; ++r) { const bool dead = 32 * ch + 16 * kt + 4 * c + r >= nsel;
#pragma unroll
                            for (int g = 0; g < 2; ++g) acc[kt][g][r] = dead ? -INFINITY : acc[kt][g][r]; }
                }
                bf16x8 pf[2]; float alpha[2]; bool grow = false;
#pragma unroll
                for (int g = 0; g < 2; ++g) {
                    float mx = fmaxf(fmaxf(fmaxf(acc[0][g][0], acc[0][g][1]), fmaxf(acc[0][g][2], acc[0][g][3])), fmaxf(fmaxf(acc[1][g][0], acc[1][g][1]), fmaxf(acc[1][g][2], acc[1][g][3])));
                    mx = fmaxf(mx, __shfl_xor(mx, 16)); mx = fmaxf(mx, __shfl_xor(mx, 32));
                    const float mnew = fmaxf(mrun[g], mx);
                    alpha[g] = (mnew == -INFINITY) ? 1.f : __builtin_amdgcn_exp2f((mrun[g] - mnew) * L2E);
                    grow = grow || (mnew > mrun[g]);
                    mrun[g] = mnew;
                    const float mm2 = (mnew == -INFINITY) ? 0.f : -mnew * L2E; float s = 0.f;
#pragma unroll
                    for (int kt = 0; kt < 2; ++kt)
#pragma unroll
                        for (int r = 0; r < 4; ++r) { const float e = __builtin_amdgcn_exp2f(fmaf(acc[kt][g][r], L2E, mm2)); acc[kt][g][r] = e; s += e; }
                    s += __shfl_xor(s, 16); s += __shfl_xor(s, 32);
                    lrun[g] = lrun[g] * alpha[g] + s;
                    u32x4 pw; pw.x = cvtpk(acc[0][g][0], acc[0][g][1]); pw.y = cvtpk(acc[0][g][2], acc[0][g][3]); pw.z = cvtpk(acc[1][g][0], acc[1][g][1]); pw.w = cvtpk(acc[1][g][2], acc[1][g][3]);
                    pf[g] = __builtin_bit_cast(bf16x8, pw); }
#pragma unroll
                for (int i = 0; i < 8; ++i) *(LAS u32x4*)(buf + (4 * i + c) * VROW + n16 * 8) = vr[i];
                asm volatile("" ::: "memory");
                if (ch < 7) dsb_gather(kvbase, sl, ch + 1, C_AV * 2, c, n16, vr);
                else if (more) dsb_gather(kvbase, sln, 0, C_AV * 2, c, n16, vr);
                if (__any(grow)) {
#pragma unroll
                    for (int g = 0; g < 2; ++g)
#pragma unroll
                        for (int r = 0; r < 4; ++r) { const float a = __builtin_bit_cast(float, __builtin_amdgcn_readlane(__builtin_bit_cast(int, alpha[g]), r));
#pragma unroll
                            for (int dt = 0; dt < 4; ++dt) O[g][dt][r] *= a; }
                }
#pragma unroll
                for (int dt = 0; dt < 4; ++dt) { const LAS bf16* vp = buf + (4 * c + q4) * VROW + dt * 16 + 4 * p4;
                    O[0][dt] = MFMA16(pf[0], cat8(trread(vp), trread(vp + 16 * VROW)), O[0][dt]);
                    O[1][dt] = MFMA16(pf[1], cat8(trread(vp + 64), trread(vp + 64 + 16 * VROW)), O[1][dt]); }
            }
            {
#pragma unroll
                for (int g = 0; g < 2; ++g)
#pragma unroll
                    for (int r = 0; r < 4; ++r) { const float li = __builtin_amdgcn_rcpf(__builtin_bit_cast(float, __builtin_amdgcn_readlane(__builtin_bit_cast(int, lrun[g]), r)));
                        if (lane < 16) {
#pragma unroll
                            for (int dt = 0; dt < 4; ++dt) buf[(g * 4 + r) * 64 + 16 * dt + lane] = f2bf(O[g][dt][r] * li); } }
                const u32x4 ov = *(const LAS u32x4*)(buf + 8 * lane);
                *(u32x4*)(mix + (size_t)tok * DM + 512 + 8 * lane) = ov;
            }
            if (more) {
#pragma unroll
                for (int g = 0; g < 2; ++g)
#pragma unroll
                    for (int s = 0; s < 2; ++s) qf[g][s] = qn[g][s];
            }
            tok = tokn;
        }
    }
}

constexpr int HSTR = 1028;
__device__ __forceinline__ void phase_router(Frame& F) {
    const float* const norm2_g = F.in(8); const float* const router_w = F.in(9); const float* const router_b = F.in(10);
    const float* x1 = F.out; const float* mod = (const float*)(F.ws + WS_MOD); unsigned char* h2 = (unsigned char*)(F.ws + WS_H2);
    int* topi = (int*)(F.ws + WS_TOPI); float* topg = (float*)(F.ws + WS_TOPG); int* bbase = (int*)(F.ws + WS_BBASE);
    LAS float* hs = (LAS float*)F.lds; LAS float* part = (LAS float*)(F.lds + 16 * HSTR * 4); LAS int* hist = (LAS int*)(F.lds + 16 * HSTR * 4 + 8 * 16 * 32 * 4);
    const int lane = F.lane(), w = F.wave;
    for (int blk = F.bid; blk < NTOK / 128; blk += F.G) {
        const int T0 = blk * 128, b = T0 / SEQ;
        if (F.tid() < 32) hist[F.tid()] = 0;
        f32x4 ca[4], cb[4];
#pragma unroll
        for (int j = 0; j < 4; ++j) { const int col = 4 * lane + 256 * j;
            ca[j] = *(const f32x4*)(norm2_g + col) * (*(const f32x4*)(mod + b * 6144 + 4 * 1024 + col) + 1.0f); cb[j] = *(const f32x4*)(mod + b * 6144 + 3 * 1024 + col); }
        __syncthreads();
        for (int pass = 0; pass < 8; ++pass) {
#pragma unroll
            for (int tt = 0; tt < 2; ++tt) { const int tl = 2 * w + tt, tok = T0 + pass * 16 + tl;
                const f32x4* xr = (const f32x4*)(x1 + (size_t)tok * DM) + lane; f32x4 v[4]; float s = 0.f;
#pragma unroll
                for (int j = 0; j < 4; ++j) { v[j] = xr[64 * j]; s += (v[j][0] * v[j][0] + v[j][1] * v[j][1]) + (v[j][2] * v[j][2] + v[j][3] * v[j][3]); }
                const float rstd = rsqrtf(wave_sum(s) * (1.f / DM) + EPS);
                unsigned* o4 = (unsigned*)(h2 + (size_t)tok * DM) + lane;
#pragma unroll
                for (int j = 0; j < 4; ++j) { const f32x4 y = (v[j] * rstd) * ca[j] + cb[j];
                    o4[64 * j] = pk4_fp8(y[0], y[1], y[2], y[3]);
                    *(LAS f32x4*)(hs + tl * HSTR + 4 * lane + 256 * j) = y; } }
            __syncthreads();
            { const int ti = lane & 15, kk = lane >> 5, e = lane & 31; f32x16 acc;
#pragma unroll
              for (int r = 0; r < 16; ++r) acc[r] = 0.f;
              const LAS float* hp = hs + ti * HSTR + 128 * w + 64 * kk; const float* rwp = router_w + (size_t)(128 * w + 64 * kk) * NE + e;
#pragma unroll 4
              for (int s4 = 0; s4 < 16; ++s4) { const f32x4 a4 = *(const LAS f32x4*)(hp + 4 * s4);
#pragma unroll
                  for (int q = 0; q < 4; ++q) acc = __builtin_amdgcn_mfma_f32_32x32x2f32(a4[q], rwp[(4 * s4 + q) * NE], acc, 0, 0, 0); }
#pragma unroll
              for (int r = 0; r < 8; ++r) part[(w * 16 + (r & 3) + 8 * (r >> 2) + 4 * kk) * 32 + e] = acc[r]; }
            __syncthreads();
            { const int tl = F.tid() >> 5, e = F.tid() & 31, tok = T0 + pass * 16 + tl; float lg = router_b[e];
#pragma unroll
              for (int ww = 0; ww < 8; ++ww) lg += part[(ww * 16 + tl) * 32 + e];
              float myv = lg; float tv[4]; int ti4[4]; bool mine = false;
#pragma unroll
              for (int k = 0; k < 4; ++k) { float bv = myv; int bi = e;
#pragma unroll
                  for (int o = 16; o >= 1; o >>= 1) { const float ov = __shfl_xor(bv, o); const int oi = __shfl_xor(bi, o); if (ov > bv || (ov == bv && oi < bi)) { bv = ov; bi = oi; } }
                  tv[k] = bv; ti4[k] = bi; if (bi == e) { myv = -INFINITY; mine = true; } }
              if (mine) atomicAdd((int*)hist + e, 1);
              if (e == 0) { const float e0 = 1.0f, e1 = __expf(tv[1] - tv[0]), e2 = __expf(tv[2] - tv[0]), e3 = __expf(tv[3] - tv[0]); const float inv = 1.0f / (e0 + e1 + e2 + e3);
                  *(int4*)(topi + (size_t)tok * 4) = make_int4(ti4[0], ti4[1], ti4[2], ti4[3]); *(f32x4*)(topg + (size_t)tok * 4) = (f32x4){e0 * inv, e1 * inv, e2 * inv, e3 * inv}; } }
            __syncthreads();
        }
        if (F.tid() < 32) { const int base = atomicAdd((int*)(F.ctl + CW_GCNT) + F.tid(), hist[F.tid()]); bbase[blk * 32 + F.tid()] = base; }
        __syncthreads();
    }
}
__device__ __forceinline__ int moe_layout(Frame& F, LAS int* offs, LAS int* tile_e) {
    if (F.tid() == 0) { int o = 0;
        for (int e = 0; e < NE; ++e) { const int cnt = (int)__hip_atomic_load(F.ctl + CW_GCNT + e, __ATOMIC_RELAXED, __HIP_MEMORY_SCOPE_AGENT); const int nt = (cnt + 255) >> 8;
            offs[e] = o; if (tile_e) for (int t = 0; t < nt; ++t) tile_e[(o >> 8) + t] = e; o += nt << 8; }
        offs[NE] = o >> 8; }
    __syncthreads();
    return offs[NE];
}
__device__ __forceinline__ void phase_place(Frame& F) {
    const unsigned char* h2 = (const unsigned char*)(F.ws + WS_H2); unsigned char* xs = (unsigned char*)(F.ws + WS_XS);
    const int* topi = (const int*)(F.ws + WS_TOPI); const float* topg = (const float*)(F.ws + WS_TOPG); const int* bbase = (const int*)(F.ws + WS_BBASE);
    int* rowinfo = (int*)(F.ws + WS_ROWINFO); float* rowgate = (float*)(F.ws + WS_ROWGATE);
    LAS int* offs = (LAS int*)F.lds; LAS int* lcur = offs + 64; LAS int* posl = offs + 128;
    (void)moe_layout(F, offs, nullptr);
    for (int blk = F.bid; blk < NTOK / 128; blk += F.G) {
        const int T0 = blk * 128;
        if (F.tid() < 32) lcur[F.tid()] = 0;
        __syncthreads();
        { const int i = F.tid(), tok = T0 + (i >> 2); const int e = topi[(size_t)tok * 4 + (i & 3)];
          const int rank = atomicAdd((int*)lcur + e, 1); const int pos = offs[e] + bbase[blk * 32 + e] + rank;
          rowinfo[pos] = tok * 4 + (i & 3); rowgate[pos] = topg[(size_t)tok * 4 + (i & 3)]; posl[i] = pos; }
        __syncthreads();
        for (int jj = 0; jj < 64; ++jj) { const int i = F.wave * 64 + jj; const int pos = posl[i]; const int tok = T0 + (i >> 2);
            const u32x4* src = (const u32x4*)(h2 + (size_t)tok * DM) + F.lane(); u32x4* dst = (u32x4*)(xs + (size_t)pos * DM) + F.lane();
            dst[0] = src[0]; }
        __syncthreads();
    }
}
__device__ __forceinline__ void phase_final(Frame& F) {
    const float* const final_g = F.in(15);
    const float* mod = (const float*)(F.ws + WS_MOD); const bf16* Y = (const bf16*)(F.ws + WS_Y);
    const int gw = F.bid * NWAVES + F.wave, NGW = F.G * NWAVES;
    for (int m = gw; m < NTOK; m += NGW) {
        const int b = m / SEQ; f32x4* xr = (f32x4*)(F.out + (size_t)m * DM) + F.lane(); f32x4 v[4]; float s = 0.f;
#pragma unroll
        for (int j = 0; j < 4; ++j) { const int col = 4 * F.lane() + 256 * j; f32x4 y = (f32x4){0.f, 0.f, 0.f, 0.f};
#pragma unroll
            for (int k = 0; k < 4; ++k) { const u32x2 w = *((const u32x2*)(Y + ((size_t)m * 4 + k) * DM) + F.lane() + 64 * j); y[0] += bflo(w.x); y[1] += bfhi(w.x); y[2] += bflo(w.y); y[3] += bfhi(w.y); }
            v[j] = xr[64 * j] + *(const f32x4*)(mod + b * 6144 + 5 * 1024 + col) * y;
            s += (v[j][0] * v[j][0] + v[j][1] * v[j][1]) + (v[j][2] * v[j][2] + v[j][3] * v[j][3]); }
        const float rstd = rsqrtf(wave_sum(s) * (1.f / DM) + EPS);
#pragma unroll
        for (int j = 0; j < 4; ++j) xr[64 * j] = (v[j] * rstd) * *(const f32x4*)(final_g + 4 * F.lane() + 256 * j);
    }
}

#ifndef MK_N_LAUNCHES
#define MK_N_LAUNCHES 1
#endif
constexpr int N_PHASES = 12;
struct Args { const float* in[16]; float* out; unsigned char* ws; int ph_lo, ph_hi; };
static_assert(sizeof(Args) == 16 * 8 + 8 + 8 + 8, "Args has no padding");

__global__ void __launch_bounds__(NTHR, 2) mk_fwd(Args args) {
    extern __shared__ __attribute__((aligned(16))) unsigned char lds_raw[];
    Frame F;
    F.lds = (LAS unsigned char*)lds_raw;
    F.MISC = (volatile LAS unsigned*)(F.lds + MISC_OFF);
    F.wave = __builtin_amdgcn_readfirstlane((int)threadIdx.x >> 6);
    F.G = gridDim.x; F.bid = blockIdx.x; F.tacc = 0ull;
    F.ws = args.ws; F.ctl = (unsigned*)(args.ws + WS_CTL); F.out = args.out;
    for (int u = F.tid(); u < (LDS_BYTES - MISC_OFF) / 4; u += NTHR) ((LAS unsigned*)(F.lds + MISC_OFF))[u] = 0u;
    __syncthreads();
    if (F.tid() < 16) *(LAS unsigned long long*)(F.lds + PTR_OFF + 8 * F.tid()) = (unsigned long long)args.in[F.tid()];
    __syncthreads();
    const int lo = args.ph_lo, hi = args.ph_hi;
    XcdBarrier bar; bar.bar = (unsigned*)(F.ctl + CW_BAR); bar.x = 0; bar.st = nullptr; bar.w0 = (F.wave == 0);
    if (hi - lo > 1) bar = xcd_barrier_post((unsigned*)(F.ctl + CW_BAR), F.MISC + 8, F.wave == 0);
#define IN(k) (lo <= (k) && (k) < hi)
#if defined(PROBE_PHASE)
    unsigned long long tp0 = 0ull, tp1 = 0ull;
#define STAMP(k) do { if ((k) == PROBE_PHASE) tp0 = __builtin_amdgcn_s_memrealtime(); if ((k) == PROBE_PHASE + 1) tp1 = __builtin_amdgcn_s_memrealtime(); } while (0)
#else
#define STAMP(k) do { } while (0)
#endif
#define SEAM(k) do { if (IN(k) && IN((k) + 1)) xcd_barrier(bar); } while (0)

    STAMP(0); if (IN(0)) { phase_p0a(F); } SEAM(0);
    STAMP(1); if (IN(1)) { phase_p0b(F); } SEAM(1);
    STAMP(2); if (IN(2)) {
        pg8::Gemm g{(const bf16*)(F.ws + WS_H0), (const bf16*)(F.ws + WS_WIN), NTOK, 3072, DM}; pg8::StaticOrder S; S.init(NTOK, 3072, F.G, F.bid);
        EpiProj E{(bf16*)(F.ws + WS_PROJ), PJ};
        pg8::gemm_phase<EpiProj, pg8::StaticOrder, true, true>(F.lds, g, S, E, F.wave);
    } SEAM(2);
    STAMP(3); if (IN(3)) {
#if defined(PROBE_SUB)
        const unsigned long long tra0 = __builtin_amdgcn_s_memrealtime();
#endif
        for (int it = F.bid; it < 1024; it += F.G) ret_a_item(F, it);
#if defined(PROBE_SUB)
        if (PROBE_SUB == 4) F.tacc += __builtin_amdgcn_s_memrealtime() - tra0;
#endif
        for (int u = F.bid; u < 256; u += F.G) { int b = u >> 6, j = u & 63;
            if (F.G == 256) { const int x = u & 7, jj = u >> 3; b = x & 3; j = (x >> 2) * 32 + jj; }
            dsa_a_unit(F, b, j); dsa_a_unit(F, b, 127 - j); }
    } SEAM(3);
    STAMP(4); if (IN(4)) {
#if defined(PROBE_SUB)
        const unsigned long long tsc0 = __builtin_amdgcn_s_memrealtime();
#endif
        ret_scan(F);
#if defined(PROBE_SUB)
        if (PROBE_SUB == 5) F.tacc += __builtin_amdgcn_s_memrealtime() - tsc0;
#endif
        __syncthreads();
        phase_dsa_b(F);
    } SEAM(4);
    STAMP(5); if (IN(5)) { for (int it = F.bid; it < 1024; it += F.G) ret_c_item(F, it); } SEAM(5);
    STAMP(6); if (IN(6)) {
        pg8::Gemm g{(const bf16*)(F.ws + WS_MIX), (const bf16*)(F.ws + WS_WO), NTOK, DM, DM}; pg8::StaticOrder S; S.init(NTOK, DM, F.G, F.bid);
        EpiX1 E{F.in(0), (const float*)(F.ws + WS_MOD), F.out};
        pg8::gemm_phase<EpiX1, pg8::StaticOrder, true, true>(F.lds, g, S, E, F.wave);
    } SEAM(6);
    STAMP(7); if (IN(7)) { phase_router(F); } SEAM(7);
    STAMP(8); if (IN(8)) { phase_place(F); } SEAM(8);
    STAMP(9); if (IN(9)) {
        LAS int* tile_e = (LAS int*)(F.lds + TILEE_OFF); const int nt = moe_layout(F, (LAS int*)(F.lds + TILEE_OFF + 4096), tile_e);
        pg8::Gemm g{(const bf16*)(F.ws + WS_XS), (const bf16*)(F.ws + WS_WGU), MOE_ROWS, 2048, DM};
        GroupedOrder S{tile_e, nt, 8, F.G, F.bid, (size_t)2048 * 1024};
        EpiGlu8 E{(unsigned char*)(F.ws + WS_HB), F.in(12)};
        pg8::gemm_phase<EpiGlu8, GroupedOrder, true, true, true>(F.lds, g, S, E, F.wave);
    } SEAM(9);
    STAMP(10); if (IN(10)) {
        LAS int* tile_e = (LAS int*)(F.lds + TILEE_OFF); const int nt = moe_layout(F, (LAS int*)(F.lds + TILEE_OFF + 4096), tile_e);
        pg8::Gemm g{(const bf16*)(F.ws + WS_HB), (const bf16*)(F.ws + WS_WDN), MOE_ROWS, DM, DM};
        GroupedOrder S{tile_e, nt, 4, F.G, F.bid, (size_t)1024 * 1024};
        EpiDownT<true> E{(bf16*)(F.ws + WS_Y), F.in(14), (const int*)(F.ws + WS_ROWINFO), (const float*)(F.ws + WS_ROWGATE)};
        pg8::gemm_phase<EpiDownT<true>, GroupedOrder, true, true, true>(F.lds, g, S, E, F.wave);
    } SEAM(10);
    STAMP(11); if (IN(11)) { phase_final(F); }
    STAMP(12);
#if defined(PROBE_SUB)
    if (F.bid == 0 && F.tid() == 0) { const unsigned long long te = __builtin_amdgcn_s_memrealtime(); while (__builtin_amdgcn_s_memrealtime() - te < F.tacc) __builtin_amdgcn_s_sleep(8); }
#elif defined(PROBE_PHASE)
    if (F.bid == 0 && F.tid() == 0) { const unsigned long long te = __builtin_amdgcn_s_memrealtime(), dur = tp1 - tp0; while (__builtin_amdgcn_s_memrealtime() - te < dur) __builtin_amdgcn_s_sleep(8); }
#endif
#undef IN
#undef SEAM
}

extern "C" void kernel_launch(void* const* d_in, const int* in_sizes, int n_in, void* d_out, int out_size, void* d_ws, size_t ws_size, hipStream_t stream) {
    static int grid = 0;
    if (grid == 0) {
        if (n_in != 16 || out_size != NTOK * DM || ws_size < WS_END) { fprintf(stderr, "kernel_launch: unexpected problem (n_in %d out %d ws %zu); nothing launched\n", n_in, out_size, ws_size); grid = -1; return; }
        int dev = 0, cus = 0;
        if (hipGetDevice(&dev) != hipSuccess || hipDeviceGetAttribute(&cus, hipDeviceAttributeMultiprocessorCount, dev) != hipSuccess) { grid = -1; return; }
        if (hipFuncSetAttribute((const void*)mk_fwd, hipFuncAttributeMaxDynamicSharedMemorySize, LDS_BYTES) != hipSuccess) { fprintf(stderr, "kernel_launch: hipFuncSetAttribute failed\n"); grid = -1; return; }
        int per_cu = 0;
        if (hipOccupancyMaxActiveBlocksPerMultiprocessor(&per_cu, (const void*)mk_fwd, NTHR, LDS_BYTES) != hipSuccess || per_cu < 1) fprintf(stderr, "kernel_launch: occupancy query reports %d workgroups per CU\n", per_cu);
        (void)hipGetLastError();
        grid = cus;
    }
    if (grid < 0) return;
    (void)hipMemsetAsync((char*)d_ws + WS_CTL, 0, CTL_ZERO_BYTES, stream);
    Args a{};
    for (int i = 0; i < 16; ++i) a.in[i] = (const float*)d_in[i];
    a.out = (float*)d_out; a.ws = (unsigned char*)d_ws;
#if MK_N_LAUNCHES == 1
    a.ph_lo = 0; a.ph_hi = N_PHASES;
    hipLaunchKernelGGL(mk_fwd, dim3(grid), dim3(NTHR), LDS_BYTES, stream, a);
#else
    for (int p = 0; p < N_PHASES; ++p) { a.ph_lo = p; a.ph_hi = p + 1; hipLaunchKernelGGL(mk_fwd, dim3(grid), dim3(NTHR), LDS_BYTES, stream, a); }
#endif
}
```

```cpp
#include <hip/hip_runtime.h>
#include <cstdio>
#include <cstdint>

#define LAS __attribute__((address_space(3)))
#define GAS __attribute__((address_space(1)))
typedef unsigned short bf16;
typedef short bf16x8 __attribute__((ext_vector_type(8)));
typedef short s16x4 __attribute__((ext_vector_type(4)));
typedef float f32x4 __attribute__((ext_vector_type(4)));
typedef float f32x16 __attribute__((ext_vector_type(16)));
typedef unsigned u32x4 __attribute__((ext_vector_type(4)));
typedef unsigned u32x2 __attribute__((ext_vector_type(2)));
typedef float f32x2_t __attribute__((ext_vector_type(2)));
typedef __bf16 bf16x2_t __attribute__((ext_vector_type(2)));

constexpr int DM = 1024, NBATCH = 4, SEQ = 8192, NTOK = NBATCH * SEQ;
constexpr int PJ = 3136;
constexpr int IN_COLS = 2888;
constexpr int C_RQ = 0, C_RK = 256, C_RV = 512, C_RG = 1024, C_AQ = 1536, C_AK = 2048, C_AV = 2176, C_IQ = 2304, C_IK = 2816, C_IW = 2880;
constexpr int NE = 32, TOPK = 4, MOE_ROWS = NTOK * TOPK + NE * 256;
constexpr int MOE_TILES = MOE_ROWS / 256;
constexpr float EPS = 1e-6f;
constexpr int NWAVES = 8, NTHR = 512;

constexpr size_t MiB = 1u << 20;
constexpr size_t WS_CTL = 0, CTL_ZERO_BYTES = 1 * MiB;
constexpr size_t WS_MOD = 1 * MiB;
constexpr size_t WS_TOPI = 2 * MiB;
constexpr size_t WS_TOPG = 2 * MiB + 512 * 1024;
constexpr size_t WS_BBASE = 3 * MiB;
constexpr size_t WS_ROWINFO = 4 * MiB;
constexpr size_t WS_ROWGATE = 5 * MiB;
constexpr size_t WS_WIN = 8 * MiB;
constexpr size_t WS_WO = 14 * MiB;
constexpr size_t WS_WGU = 16 * MiB;
constexpr size_t WS_WDN = 144 * MiB;
constexpr size_t WS_H0 = 208 * MiB;
constexpr size_t WS_PROJ = 272 * MiB;
constexpr size_t WS_XS = 208 * MiB;
constexpr size_t WS_Y = 208 * MiB;
constexpr size_t WS_KVT = 480 * MiB;
constexpr size_t WS_RPT = 512 * MiB;
constexpr size_t WS_SEL = 528 * MiB;
constexpr size_t WS_MIX = 544 * MiB;
constexpr size_t WS_H2 = 608 * MiB;
constexpr size_t WS_HB = 480 * MiB;
constexpr size_t WS_END = 752 * MiB;
constexpr int CW_GCNT = 1024;
constexpr int CW_BAR = 4096;

constexpr int LDS_BYTES = 153600;
constexpr int RING_BYTES = 131072;
constexpr int TILEE_OFF = 131072;
constexpr int MISC_OFF = 152576;
constexpr int PTR_OFF = MISC_OFF + 512;

__device__ __forceinline__ int hw_lane() { int l; asm volatile("v_mbcnt_lo_u32_b32 %0, -1, 0\n\tv_mbcnt_hi_u32_b32 %0, -1, %0" : "=v"(l)); return l; }
__device__ __forceinline__ unsigned cvtpk(float lo, float hi) { f32x2_t v = {lo, hi}; bf16x2_t b = __builtin_convertvector(v, bf16x2_t); return __builtin_bit_cast(unsigned, b); }
__device__ __forceinline__ float bflo(unsigned w) { return __builtin_bit_cast(float, w << 16); }
__device__ __forceinline__ float bfhi(unsigned w) { return __builtin_bit_cast(float, w & 0xffff0000u); }
__device__ __forceinline__ float bf2f(bf16 h) { return __builtin_bit_cast(float, (unsigned)h << 16); }
__device__ __forceinline__ bf16 f2bf(float f) { return (bf16)(cvtpk(f, 0.f) & 0xffffu); }
__device__ __forceinline__ float wave_sum(float v) {
#pragma unroll
    for (int o = 1; o < 64; o <<= 1) v += __shfl_xor(v, o);
    return v;
}
__device__ __forceinline__ int mbcnt64(unsigned long long m) { return (int)__builtin_amdgcn_mbcnt_hi((unsigned)(m >> 32), __builtin_amdgcn_mbcnt_lo((unsigned)m, 0u)); }
__device__ __forceinline__ s16x4 trread(const LAS void* p) { typedef short v4i16_t __attribute__((ext_vector_type(4))); return __builtin_bit_cast(s16x4, __builtin_amdgcn_ds_read_tr16_b64_v4i16((LAS v4i16_t*)p)); }
__device__ __forceinline__ bf16x8 cat8(s16x4 lo, s16x4 hi) { return (bf16x8){lo[0], lo[1], lo[2], lo[3], hi[0], hi[1], hi[2], hi[3]}; }
#define MFMA16(a, b, c) __builtin_amdgcn_mfma_f32_16x16x32_bf16((a), (b), (c), 0, 0, 0)
#define MFMA32(a, b, c) __builtin_amdgcn_mfma_f32_32x32x16_bf16((a), (b), (c), 0, 0, 0)

namespace pg8 {
#define PG8_LAS __attribute__((address_space(3)))
typedef unsigned short bf16_t;
typedef short bf16x8 __attribute__((ext_vector_type(8)));
typedef float f32x4 __attribute__((ext_vector_type(4)));
typedef unsigned u32x4 __attribute__((ext_vector_type(4)));
constexpr int BM = 256, BK = 64, HALF = 128, HTB = HALF * BK * 2  , STAGE_BYTES = 8 * HTB, NXCD = 8, WGM = 8;

__host__ __device__ __forceinline__ int lds_byte(int r, int c) { const int st = (r >> 4) * 2 + (c >> 5), rr = r & 15, cc = c & 31, ob = rr * 64 + cc * 2; return st * 1024 + (ob ^ (((ob >> 9) & 1) << 5)); }
__host__ __device__ __forceinline__ void stage_rc(int b, int& R, int& C) { const int st = b / 1024, sb = b % 1024, swz = sb ^ (((sb >> 9) & 1) << 5); R = (st >> 1) * 16 + swz / 64; C = (st & 1) * 32 + (swz % 64) / 2; }
__host__ __device__ __forceinline__ int perm32(int rho) { const int n = rho >> 4, i = rho & 15; return 8 * (i >> 2) + 4 * n + (i & 3); }

typedef int v8i32 __attribute__((ext_vector_type(8))); typedef int v4i32 __attribute__((ext_vector_type(4)));
__device__ __forceinline__ v8i32 pg8_cat(bf16x8 a, bf16x8 b) { return __builtin_shufflevector(__builtin_bit_cast(v4i32, a), __builtin_bit_cast(v4i32, b), 0, 1, 2, 3, 4, 5, 6, 7); }
struct Unit { int pm, pn, e; size_t bo; };
struct Gemm { const bf16_t* A; const bf16_t* Bt; int M, N, K; };

struct StaticOrder {
    int nM, nN, nwg, G, c;
    __host__ __device__ void init(int M, int N, int G_, int c_) { nM = M / BM; nN = N / BM; nwg = nM * nN; G = G_; c = c_; }
    __host__ __device__ bool next(int i, Unit& u) const {
        const long L = (long)i * G + c; if (L >= nwg) return false;
        int wgid = (int)L; { const int q = nwg / NXCD, r = nwg % NXCD, xcd = wgid % NXCD, off = wgid / NXCD; wgid = (xcd < r ? xcd * (q + 1) : r * (q + 1) + (xcd - r) * q) + off; }
        const int nig = WGM * nN, gid = wgid / nig, fm = gid * WGM, gsz = (nM - fm) < WGM ? (nM - fm) : WGM;
        u.pm = fm + ((wgid % nig) % gsz); u.pn = (wgid % nig) / gsz; u.e = 0; u.bo = 0; return true;
    }
    __device__ __forceinline__ void a_ready(const Unit&) const {}
    __device__ __forceinline__ void done(const Unit&) const {}
};

template <class Epi, class Sched, bool ALIGN_EPI = false, bool SP2 = false, bool F8 = false>
__device__ __forceinline__ void gemm_phase(PG8_LAS unsigned char* lds, const Gemm g, const Sched& S, const Epi& E, const int wid) {
    const int lane = hw_lane(), tid = wid * 64 + lane, wr = wid >> 2, wc = wid & 3, fr = lane & 15, fq = lane >> 4;
    constexpr int ESZ = F8 ? 1 : 2;
    const int K = g.K, nt = K * ESZ / (BK * 2);
    unsigned voffA[2], voffB[2];
#pragma unroll
    for (int i = 0; i < 2; ++i) { int R, C; stage_rc(tid * 16 + i * 8192, R, C); const int Rb = Epi::PERM ? ((R & ~31) + perm32(R & 31)) : R;
        voffA[i] = (unsigned)(R * K * ESZ + C * 2); voffB[i] = (unsigned)(Rb * K * ESZ + C * 2); }
    const size_t kstep = (size_t)(BK * 2);
    const size_t hstep = (size_t)HALF * K * ESZ;
    const size_t tstep = 2 * hstep;
    const unsigned ldsw = (unsigned)wid * 1024u;
    const int aoff = lds_byte(wr * 64 + fr, fq * 8), boff = lds_byte(wc * 32 + fr, fq * 8);
#define PG8_SA(b, h) (((b) * 2 + (h)) * HTB)
#define PG8_SB(b, h) ((4 + (b) * 2 + (h)) * HTB)
#define PG8_STAGE(bufoff, gbase, voff) do { _Pragma("unroll") for (int _i = 0; _i < 2; ++_i) { \
        if constexpr (F8) { unsigned _keep; const unsigned _l = (unsigned)(__UINTPTR_TYPE__)(lds + (bufoff) + ldsw + _i * 8192);   \
            asm volatile("s_mov_b32 %0, m0\n\ts_mov_b32 m0, %3\n\ts_nop 0\n\tglobal_load_lds_dwordx4 %1, %2\n\ts_mov_b32 m0, %0" : "=&s"(_keep) : "v"((voff)[_i]), "s"((const char*)(gbase)), "s"(_l) : "memory"); } \
        else __builtin_amdgcn_global_load_lds((const unsigned*)((const char*)(gbase) + (voff)[_i]), (PG8_LAS unsigned*)(lds + (bufoff) + ldsw + _i * 8192), 16, 0, 0); } } while (0)
#define PG8_LDA(dst, b, h) do { _Pragma("unroll") for (int m = 0; m < 4; ++m) _Pragma("unroll") for (int k = 0; k < 2; ++k) dst[m][k] = *(const PG8_LAS bf16x8*)(lds + PG8_SA(b, h) + aoff + m * 2048 + k * 1024); } while (0)
#define PG8_LDB(dst, b, h) do { _Pragma("unroll") for (int n = 0; n < 2; ++n) _Pragma("unroll") for (int k = 0; k < 2; ++k) dst[n][k] = *(const PG8_LAS bf16x8*)(lds + PG8_SB(b, h) + boff + n * 2048 + k * 1024); } while (0)
#define PG8_MMA(ai, bj, At, Bt) do { __builtin_amdgcn_s_setprio(1); _Pragma("unroll") for (int m = 0; m < 4; ++m) _Pragma("unroll") for (int n = 0; n < 2; ++n) { \
        if constexpr (F8) { acc[ai][bj][m][n] = __builtin_amdgcn_mfma_scale_f32_16x16x128_f8f6f4(pg8_cat(Bt[n][0], Bt[n][1]), pg8_cat(At[m][0], At[m][1]), acc[ai][bj][m][n], 0, 0, 0, 0, 0, 0); } \
        else { _Pragma("unroll") for (int k = 0; k < 2; ++k) acc[ai][bj][m][n] = __builtin_amdgcn_mfma_f32_16x16x32_bf16(Bt[n][k], At[m][k], acc[ai][bj][m][n], 0, 0, 0); } } __builtin_amdgcn_s_setprio(0); } while (0)
#define PG8_WAIT_V(n) asm volatile("s_waitcnt vmcnt(" #n ")" ::: "memory")
#define PG8_WAIT_L(n) asm volatile("s_waitcnt lgkmcnt(" #n ")" ::: "memory")
#define PG8_BAR __builtin_amdgcn_s_barrier()
#define PG8_SCHED __builtin_amdgcn_sched_barrier(0)
    Unit cur, nxt; int ui = 0;
    if (!S.next(0, cur)) return;
    f32x4 acc[2][2][4][2];
#pragma unroll
    for (int a = 0; a < 2; ++a)
#pragma unroll
        for (int b = 0; b < 2; ++b)
#pragma unroll
            for (int m = 0; m < 4; ++m)
#pragma unroll
                for (int n = 0; n < 2; ++n) acc[a][b][m][n] = (f32x4){0.f, 0.f, 0.f, 0.f};
    bf16x8 At[4][2], B0[2][2], B1[2][2];
    const char* cA = (const char*)g.A + (size_t)cur.pm * tstep; const char* cB = (const char*)g.Bt + (size_t)cur.pn * tstep + cur.bo;
    S.a_ready(cur);
    if constexpr (SP2) {
        PG8_STAGE(PG8_SB(0, 0), cB, voffB); PG8_STAGE(PG8_SB(0, 1), cB + hstep, voffB); PG8_STAGE(PG8_SA(0, 0), cA, voffA); PG8_STAGE(PG8_SA(0, 1), cA + hstep, voffA);
        if (wr == 1) PG8_BAR;
        PG8_WAIT_V(2); PG8_BAR;
        PG8_STAGE(PG8_SB(1, 0), cB + kstep, voffB); PG8_STAGE(PG8_SA(1, 0), cA + kstep, voffA); PG8_STAGE(PG8_SB(1, 1), cB + hstep + kstep, voffB);
        PG8_WAIT_V(6); PG8_BAR;
    } else {
        PG8_STAGE(PG8_SB(0, 0), cB, voffB); PG8_STAGE(PG8_SA(0, 0), cA, voffA); PG8_STAGE(PG8_SB(0, 1), cB + hstep, voffB); PG8_STAGE(PG8_SA(0, 1), cA + hstep, voffA);
        if (wr == 1) PG8_BAR;
        PG8_WAIT_V(4); PG8_BAR;
        PG8_STAGE(PG8_SB(1, 0), cB + kstep, voffB); PG8_STAGE(PG8_SA(1, 0), cA + kstep, voffA); PG8_STAGE(PG8_SB(1, 1), cB + hstep + kstep, voffB);
        PG8_WAIT_V(6); PG8_BAR;
    }
    for (;;) {
        const bool has_next = S.next(ui + 1, nxt);
        const char* nA = has_next ? (const char*)g.A + (size_t)nxt.pm * tstep : cA; const char* nB = has_next ? (const char*)g.Bt + (size_t)nxt.pn * tstep + nxt.bo : cB;
        for (int t = 0; t < nt; t += 2) {
            const bool last = (t == nt - 2);
            const char* a1 = cA + (size_t)(t + 1) * kstep;
            const char* a2 = last ? nA : cA + (size_t)(t + 2) * kstep; const char* b2 = last ? nB : cB + (size_t)(t + 2) * kstep;
            const char* a3 = a2 + kstep; const char* b3 = b2 + kstep;
            if (last && has_next) S.a_ready(nxt);
            if constexpr (SP2) {
            PG8_LDB(B0, 0, 0); PG8_LDB(B1, 0, 1); PG8_SCHED; PG8_LDA(At, 0, 0); PG8_STAGE(PG8_SA(1, 1), a1 + hstep, voffA);
            PG8_WAIT_V(8); PG8_WAIT_L(0); PG8_BAR; PG8_MMA(0, 0, At, B0); PG8_MMA(0, 1, At, B1); PG8_BAR; PG8_SCHED;
            PG8_LDA(At, 0, 1); PG8_STAGE(PG8_SB(0, 0), b2, voffB); PG8_STAGE(PG8_SB(0, 1), b2 + hstep, voffB); PG8_STAGE(PG8_SA(0, 0), a2, voffA);
            PG8_WAIT_V(8); PG8_WAIT_L(0); PG8_BAR; PG8_MMA(1, 0, At, B0); PG8_MMA(1, 1, At, B1); PG8_BAR; PG8_SCHED;
            PG8_LDB(B0, 1, 0); PG8_LDB(B1, 1, 1); PG8_SCHED; PG8_LDA(At, 1, 0); PG8_STAGE(PG8_SA(0, 1), a2 + hstep, voffA);
            PG8_WAIT_V(8); PG8_WAIT_L(0); PG8_BAR; PG8_MMA(0, 0, At, B0); PG8_MMA(0, 1, At, B1); PG8_BAR; PG8_SCHED;
            PG8_LDA(At, 1, 1); PG8_STAGE(PG8_SB(1, 0), b3, voffB); PG8_STAGE(PG8_SB(1, 1), b3 + hstep, voffB); PG8_STAGE(PG8_SA(1, 0), a3, voffA);
            PG8_WAIT_V(8); PG8_WAIT_L(0); PG8_BAR; PG8_MMA(1, 0, At, B0); PG8_MMA(1, 1, At, B1); PG8_BAR; PG8_SCHED;
            } else {
            PG8_LDB(B0, 0, 0); PG8_SCHED; PG8_LDA(At, 0, 0); PG8_STAGE(PG8_SA(1, 1), a1 + hstep, voffA);
            PG8_WAIT_L(8); PG8_BAR; PG8_WAIT_L(0); PG8_MMA(0, 0, At, B0); PG8_BAR; PG8_SCHED;
            PG8_LDB(B1, 0, 1); PG8_STAGE(PG8_SB(0, 0), b2, voffB);
            PG8_BAR; PG8_WAIT_L(0); PG8_MMA(0, 1, At, B1); PG8_BAR;
            PG8_LDA(At, 0, 1); PG8_STAGE(PG8_SA(0, 0), a2, voffA);
            PG8_BAR; PG8_WAIT_L(0); PG8_MMA(1, 0, At, B0); PG8_BAR; PG8_SCHED;
            PG8_STAGE(PG8_SB(0, 1), b2 + hstep, voffB);
            PG8_WAIT_V(6); PG8_BAR; PG8_MMA(1, 1, At, B1); PG8_BAR;
            PG8_LDB(B0, 1, 0); PG8_SCHED; PG8_LDA(At, 1, 0); PG8_STAGE(PG8_SA(0, 1), a2 + hstep, voffA);
            PG8_WAIT_L(8); PG8_BAR; PG8_WAIT_L(0); PG8_MMA(0, 0, At, B0); PG8_BAR; PG8_SCHED;
            PG8_LDB(B1, 1, 1); PG8_STAGE(PG8_SB(1, 0), b3, voffB);
            PG8_BAR; PG8_WAIT_L(0); PG8_MMA(0, 1, At, B1); PG8_BAR;
            PG8_LDA(At, 1, 1); PG8_STAGE(PG8_SA(1, 0), a3, voffA);
            PG8_BAR; PG8_WAIT_L(0); PG8_MMA(1, 0, At, B0); PG8_BAR; PG8_SCHED;
            PG8_STAGE(PG8_SB(1, 1), b3 + hstep, voffB);
            PG8_WAIT_V(6); PG8_BAR; PG8_MMA(1, 1, At, B1); PG8_BAR;
            }
        }
        if constexpr (ALIGN_EPI) { if (wr == 0) PG8_BAR; }
        if constexpr (!Epi::AFTER_DRAIN) { E(acc, cur, wr, wc, fr, fq); S.done(cur); }
        if (!has_next) break;
#pragma unroll
        for (int a = 0; a < 2; ++a)
#pragma unroll
            for (int b = 0; b < 2; ++b)
#pragma unroll
                for (int m = 0; m < 4; ++m)
#pragma unroll
                    for (int n = 0; n < 2; ++n) acc[a][b][m][n] = (f32x4){0.f, 0.f, 0.f, 0.f};
        cur = nxt; cA = nA; cB = nB; ++ui;
        if constexpr (ALIGN_EPI) { if (wr == 1) PG8_BAR; }
    }
    PG8_WAIT_V(0);
    if constexpr (!ALIGN_EPI) { if (wr == 0) PG8_BAR; }
    PG8_BAR;
    if constexpr (Epi::AFTER_DRAIN) { E.fused(acc, cur, wr, wc, fr, fq, lds, wid, lane); S.done(cur); }
#undef PG8_SA
#undef PG8_SB
#undef PG8_STAGE
#undef PG8_LDA
#undef PG8_LDB
#undef PG8_MMA
#undef PG8_WAIT_V
#undef PG8_WAIT_L
#undef PG8_BAR
#undef PG8_SCHED
}
}

struct EpiProj {
    static constexpr bool PERM = true, AFTER_DRAIN = false;
    bf16* O; int ldc;
    __device__ __forceinline__ void operator()(const f32x4 (&acc)[2][2][4][2], const pg8::Unit& u, int wr, int wc, int fr, int fq) const {
        const int row0 = u.pm * 256 + wr * 64 + fr; const int col0 = u.pn * 256 + wc * 32 + 8 * fq;
#pragma unroll
        for (int ai = 0; ai < 2; ++ai)
#pragma unroll
            for (int m = 0; m < 4; ++m) { bf16* rowp = O + (size_t)(row0 + ai * 128 + m * 16) * ldc + col0;
#pragma unroll
                for (int bj = 0; bj < 2; ++bj) { const f32x4 v0 = acc[ai][bj][m][0], v1 = acc[ai][bj][m][1];
                    u32x4 w; w.x = cvtpk(v0[0], v0[1]); w.y = cvtpk(v0[2], v0[3]); w.z = cvtpk(v1[0], v1[1]); w.w = cvtpk(v1[2], v1[3]);
                    *(u32x4*)(rowp + bj * 128) = w; } }
    }
};
struct EpiX1 {
    static constexpr bool PERM = false, AFTER_DRAIN = false;
    const float* x; const float* mod; float* out;
    __device__ __forceinline__ void operator()(const f32x4 (&acc)[2][2][4][2], const pg8::Unit& u, int wr, int wc, int fr, int fq) const {
        const int col0 = u.pn * 256 + wc * 32 + 4 * fq; const int b = (u.pm * 256) / SEQ;
        f32x4 g[2][2];
#pragma unroll
        for (int bj = 0; bj < 2; ++bj)
#pragma unroll
            for (int n = 0; n < 2; ++n) g[bj][n] = *(const f32x4*)(mod + (size_t)b * 6144 + 2 * 1024 + col0 + bj * 128 + n * 16);
#pragma unroll
        for (int ai = 0; ai < 2; ++ai)
#pragma unroll
            for (int m = 0; m < 4; ++m) { const size_t off = (size_t)(u.pm * 256 + ai * 128 + wr * 64 + m * 16 + fr) * DM + col0;
#pragma unroll
                for (int bj = 0; bj < 2; ++bj)
#pragma unroll
                    for (int n = 0; n < 2; ++n) { const f32x4 xv = *(const f32x4*)(x + off + bj * 128 + n * 16); *(f32x4*)(out + off + bj * 128 + n * 16) = xv + g[bj][n] * acc[ai][bj][m][n]; }
                if (m & 1) asm volatile("" ::: "memory"); }
    }
};
__device__ __forceinline__ float glu_f(float gate, float up) {
    gate = fminf(gate, 7.0f); up = fminf(fmaxf(up, -7.0f), 7.0f);
    const float sg = __builtin_amdgcn_rcpf(1.0f + __expf(-1.702f * gate));
    return (up + 1.0f) * (gate * sg);
}
__device__ __forceinline__ unsigned pk4_fp8(float a, float b, float c, float d) { int w = __builtin_amdgcn_cvt_pk_fp8_f32(a, b, 0, false); w = __builtin_amdgcn_cvt_pk_fp8_f32(c, d, w, true); return (unsigned)w; }
constexpr float W8_SCALE = 64.0f, W8_INV = 1.0f / 64.0f;
struct EpiGlu8 {
    static constexpr bool PERM = true, AFTER_DRAIN = false;
    unsigned char* H; const float* b_gu;
    __device__ __forceinline__ void operator()(const f32x4 (&acc)[2][2][4][2], const pg8::Unit& u, int wr, int wc, int fr, int fq) const {
        const int row0 = u.pm * 256 + wr * 64 + fr; const int c0 = u.pn * 128 + wc * 32 + 8 * fq;
        const float* bg = b_gu + (size_t)u.e * 2048 + c0; const float* bu = bg + 1024;
        const f32x4 bg0 = *(const f32x4*)bg, bg1 = *(const f32x4*)(bg + 4), bu0 = *(const f32x4*)bu, bu1 = *(const f32x4*)(bu + 4);
#pragma unroll
        for (int ai = 0; ai < 2; ++ai)
#pragma unroll
            for (int m = 0; m < 4; ++m) {
                const f32x4 g0 = acc[ai][0][m][0] * W8_INV + bg0, g1 = acc[ai][0][m][1] * W8_INV + bg1, u0 = acc[ai][1][m][0] * W8_INV + bu0, u1 = acc[ai][1][m][1] * W8_INV + bu1;
                u32x2 w; w.x = pk4_fp8(glu_f(g0[0], u0[0]), glu_f(g0[1], u0[1]), glu_f(g0[2], u0[2]), glu_f(g0[3], u0[3]));
                w.y = pk4_fp8(glu_f(g1[0], u1[0]), glu_f(g1[1], u1[1]), glu_f(g1[2], u1[2]), glu_f(g1[3], u1[3]));
                *(u32x2*)(H + (size_t)(row0 + ai * 128 + m * 16) * DM + c0) = w; }
    }
};
struct EpiGlu {
    static constexpr bool PERM = true, AFTER_DRAIN = false;
    bf16* H; const float* b_gu;
    __device__ __forceinline__ void operator()(const f32x4 (&acc)[2][2][4][2], const pg8::Unit& u, int wr, int wc, int fr, int fq) const {
        const int row0 = u.pm * 256 + wr * 64 + fr; const int c0 = u.pn * 128 + wc * 32 + 8 * fq;
        const float* bg = b_gu + (size_t)u.e * 2048 + c0; const float* bu = bg + 1024;
        const f32x4 bg0 = *(const f32x4*)bg, bg1 = *(const f32x4*)(bg + 4), bu0 = *(const f32x4*)bu, bu1 = *(const f32x4*)(bu + 4);
#pragma unroll
        for (int ai = 0; ai < 2; ++ai)
#pragma unroll
            for (int m = 0; m < 4; ++m) {
                const f32x4 g0 = acc[ai][0][m][0] + bg0, g1 = acc[ai][0][m][1] + bg1, u0 = acc[ai][1][m][0] + bu0, u1 = acc[ai][1][m][1] + bu1;
                u32x4 w; w.x = cvtpk(glu_f(g0[0], u0[0]), glu_f(g0[1], u0[1])); w.y = cvtpk(glu_f(g0[2], u0[2]), glu_f(g0[3], u0[3]));
                w.z = cvtpk(glu_f(g1[0], u1[0]), glu_f(g1[1], u1[1])); w.w = cvtpk(glu_f(g1[2], u1[2]), glu_f(g1[3], u1[3]));
                *(u32x4*)(H + (size_t)(row0 + ai * 128 + m * 16) * DM + c0) = w; }
    }
};
template <bool F8> struct EpiDownT {
    static constexpr bool PERM = true, AFTER_DRAIN = false;
    bf16* Y; const float* b_down; const int* rowinfo; const float* rowgate;
    __device__ __forceinline__ void operator()(const f32x4 (&acc)[2][2][4][2], const pg8::Unit& u, int wr, int wc, int fr, int fq) const {
        const int row0 = u.pm * 256 + wr * 64 + fr; const int col0 = u.pn * 256 + wc * 32 + 8 * fq;
        const float* bd = b_down + (size_t)u.e * 1024 + col0;
        f32x4 bv[2][2];
#pragma unroll
        for (int bj = 0; bj < 2; ++bj)
#pragma unroll
            for (int n = 0; n < 2; ++n) bv[bj][n] = *(const f32x4*)(bd + bj * 128 + 4 * n);
#pragma unroll
        for (int ai = 0; ai < 2; ++ai)
#pragma unroll
            for (int m = 0; m < 4; ++m) { const int row = row0 + ai * 128 + m * 16; const int dst = rowinfo[row]; const float gt = rowgate[row];
                if (dst >= 0) { bf16* rowp = Y + (size_t)dst * DM + col0;
#pragma unroll
                    for (int bj = 0; bj < 2; ++bj) { const float sa = F8 ? W8_INV : 1.0f; const f32x4 v0 = (acc[ai][bj][m][0] * sa + bv[bj][0]) * gt, v1 = (acc[ai][bj][m][1] * sa + bv[bj][1]) * gt;
                        u32x4 w; w.x = cvtpk(v0[0], v0[1]); w.y = cvtpk(v0[2], v0[3]); w.z = cvtpk(v1[0], v1[1]); w.w = cvtpk(v1[2], v1[3]);
                        *(u32x4*)(rowp + bj * 128) = w; } } }
    }
};
struct GroupedOrder {
    const LAS int* tile_e; int ntiles, nN, G, c; size_t estride;
    __device__ __forceinline__ bool next(int i, pg8::Unit& u) const {
        int pm, pn;
        if (G == 256) { const int x = c & 7, j = c >> 3, rpx = 32 / nN; pn = j % nN; pm = i * (8 * rpx) + x * rpx + j / nN; }
        else { const long L = (long)i * G + c; pm = (int)(L / nN); pn = (int)(L % nN); }
        if (pm >= ntiles) return false;
        u.pm = pm; u.pn = pn; u.e = __builtin_amdgcn_readfirstlane(tile_e[pm]); u.bo = (size_t)u.e * estride; return true;
    }
    __device__ __forceinline__ void a_ready(const pg8::Unit&) const {}
    __device__ __forceinline__ void done(const pg8::Unit&) const {}
};

#define XB_TMO      128
#define XB_XCNT(j)  (256  + 64 * (j))
#define XB_XSUB(j)  (1280 + 64 * (j))
#define XB_XGEN(j)  (2304 + 64 * (j))
#define XB_TOP      3328
#define XB_TOPGEN   3392
#define XCD_BAR_WORDS 3456
#define XB_SPIN_CAP (1u << 18)

__device__ __forceinline__ unsigned xb_ld(unsigned* p)              { return __hip_atomic_load(p, __ATOMIC_RELAXED, __HIP_MEMORY_SCOPE_AGENT); }
__device__ __forceinline__ unsigned xb_add(unsigned* p, unsigned v) { return __hip_atomic_fetch_add(p, v, __ATOMIC_RELAXED, __HIP_MEMORY_SCOPE_AGENT); }
__device__ __forceinline__ unsigned xb_xcc_id() { return (unsigned)__builtin_amdgcn_s_getreg((3 << 11) | 20) & 0xFu; }
#define XB_SPIN(cond, bar) do { unsigned _sp = 0; while (cond) { __builtin_amdgcn_s_sleep(1); \
    if ((++_sp & 255u) == 0u) { if (xb_ld(&(bar)[XB_TMO])) break; if (_sp > XB_SPIN_CAP) { atomicAdd(&(bar)[XB_TMO], 1u); break; } } } } while (0)

struct XcdBarrier {
    unsigned* bar; unsigned x; bool w0;
    volatile LAS unsigned* st;
};

__device__ __forceinline__ XcdBarrier xcd_barrier_post(unsigned* bar, volatile LAS unsigned* st, bool w0) {
    XcdBarrier b; b.bar = bar; b.x = xb_xcc_id(); b.st = st; b.w0 = w0;
    if (w0 && hw_lane() == 0) (void)xb_add(&bar[XB_XCNT(b.x)], 1u);
    return b;
}
__device__ __forceinline__ void xcd_barrier_complete(unsigned* bar, unsigned x, unsigned& nloc, unsigned& nx) {
    const unsigned G = gridDim.x * gridDim.y * gridDim.z;
    unsigned sum, cnt, mine, sp = 0u;
    for (;;) {
        sum = 0u; cnt = 0u; mine = 0u;
#pragma unroll
        for (unsigned j = 0; j < 16; ++j) { const unsigned c = xb_ld(&bar[XB_XCNT(j)]); sum += c; cnt += (c > 0u) ? 1u : 0u; mine = (j == x) ? c : mine; }
        if (sum == G) break;
        __builtin_amdgcn_s_sleep(1);
        if ((++sp & 255u) == 0u) { if (xb_ld(&bar[XB_TMO])) break; if (sp > XB_SPIN_CAP) { atomicAdd(&bar[XB_TMO], 1u); break; } }
    }
    nloc = mine > 0u ? mine : 1u; nx = cnt > 0u ? cnt : 1u;
}

__device__ __forceinline__ void xcd_barrier(const XcdBarrier& b) {
    asm volatile("s_waitcnt vmcnt(0)" ::: "memory");
    __syncthreads();
    if (b.w0 && hw_lane() == 0) {
        unsigned* bar = b.bar;
        __builtin_amdgcn_s_waitcnt(0);
        unsigned nloc = b.st[0], nx = b.st[1];
        if (nloc == 0u) { xcd_barrier_complete(bar, b.x, nloc, nx); b.st[0] = nloc; b.st[1] = nx; }
        const unsigned old = xb_add(&bar[XB_XSUB(b.x)], 1u);
        const unsigned gen = old / nloc;
        if (old + 1u == (gen + 1u) * nloc) {
            __builtin_amdgcn_fence(__ATOMIC_RELEASE, "agent");
            asm volatile("s_waitcnt vmcnt(0)" ::: "memory");
            const unsigned og = xb_add(&bar[XB_TOP], 1u);
            const unsigned tg = og / nx;
            if (og + 1u == (tg + 1u) * nx) xb_add(&bar[XB_TOPGEN], 1u);
            else XB_SPIN(xb_ld(&bar[XB_TOPGEN]) == tg, bar);
            __builtin_amdgcn_fence(__ATOMIC_ACQUIRE, "agent");
            xb_add(&bar[XB_XGEN(b.x)], 1u);
            asm volatile("s_waitcnt vmcnt(0)" ::: "memory");
        } else {
            XB_SPIN(xb_ld(&bar[XB_XGEN(b.x)]) == gen, bar);
            __builtin_amdgcn_fence(__ATOMIC_ACQUIRE, "agent");
            asm volatile("s_waitcnt vmcnt(0)" ::: "memory");
        }
    }
    __syncthreads();
}

struct Frame {
    LAS unsigned char* lds;
    volatile LAS unsigned* MISC;
    unsigned* ctl;
    int wave, G, bid;
    __device__ __forceinline__ int lane() const { return hw_lane(); }
    __device__ __forceinline__ int tid() const { return wave * 64 + hw_lane(); }
    __device__ __forceinline__ const float* in(int i) const { const LAS unsigned* p = (const LAS unsigned*)(lds + PTR_OFF) + 2 * i;
        const unsigned lo = __builtin_amdgcn_readfirstlane(p[0]), hi = __builtin_amdgcn_readfirstlane(p[1]); return (const float*)(((unsigned long long)hi << 32) | lo); }
    float* out; unsigned char* ws;
    unsigned long long tacc; int xpass;
};
__device__ __forceinline__ float log2gamma(int h) { return log2f(1.0f - exp2f(-5.0f - (float)h)); }

template <bool F8, class RowMap>
__device__ __forceinline__ void transpose_item(const float* W, int N, bf16* WT, int K, const float* kscale, LAS float* scr, int kb, int nb, int lane, RowMap rm) {
    const int k0 = 64 * kb, n0 = 64 * nb;
#pragma unroll 4
    for (int i = 0; i < 16; ++i) {
        const int kk = 4 * i + (lane >> 4), nn = 4 * (lane & 15);
        f32x4 v = (f32x4){0.f, 0.f, 0.f, 0.f};
        if (n0 + nn < N) v = *(const f32x4*)(W + (size_t)(k0 + kk) * N + n0 + nn);
        if (kscale) v = v * kscale[k0 + kk];
        LAS float* s = scr + kk * 65 + nn; s[0] = v[0]; s[1] = v[1]; s[2] = v[2]; s[3] = v[3];
    }
    asm volatile("s_waitcnt lgkmcnt(0)" ::: "memory");
    const int cch = lane & 7;
#pragma unroll
    for (int j = 0; j < 8; ++j) {
        const int n = 8 * j + (lane >> 3); const LAS float* s = scr + (8 * cch) * 65 + n;
        if constexpr (F8) {
            u32x2 o; o.x = pk4_fp8(s[0 * 65] * W8_SCALE, s[1 * 65] * W8_SCALE, s[2 * 65] * W8_SCALE, s[3 * 65] * W8_SCALE); o.y = pk4_fp8(s[4 * 65] * W8_SCALE, s[5 * 65] * W8_SCALE, s[6 * 65] * W8_SCALE, s[7 * 65] * W8_SCALE);
            if (n0 + n < N) *(u32x2*)((unsigned char*)WT + (size_t)rm(n0 + n) * K + k0 + 8 * cch) = o;
        } else {
        const float cs = (N == IN_COLS && n0 + n >= C_AQ && n0 + n < C_AK) ? 0.125f : 1.0f;
        u32x4 o; o.x = cvtpk(s[0 * 65] * cs, s[1 * 65] * cs); o.y = cvtpk(s[2 * 65] * cs, s[3 * 65] * cs); o.z = cvtpk(s[4 * 65] * cs, s[5 * 65] * cs); o.w = cvtpk(s[6 * 65] * cs, s[7 * 65] * cs);
        if (n0 + n < N) *(u32x4*)(WT + (size_t)rm(n0 + n) * K + k0 + 8 * cch) = o; }
    }
    asm volatile("s_waitcnt lgkmcnt(0)" ::: "memory");
}
__device__ __forceinline__ void f8_item_load(const float* W, int N, int kb, int nb, int lane, f32x4 (&v)[16]) {
    const int k0 = 128 * kb, n0 = 32 * nb;
#pragma unroll
    for (int i = 0; i < 16; ++i) v[i] = *(const f32x4*)(W + (size_t)(k0 + 8 * i + (lane >> 3)) * N + n0 + 4 * (lane & 7));
}
template <class RowMap>
__device__ __forceinline__ void f8_item_store(const f32x4 (&v)[16], unsigned char* WT, int K, LAS float* scr, int kb, int nb, int lane, RowMap rm) {
    const int k0 = 128 * kb, n0 = 32 * nb;
#pragma unroll
    for (int i = 0; i < 16; ++i) { LAS float* s = scr + (8 * i + (lane >> 3)) * 33 + 4 * (lane & 7); s[0] = v[i][0]; s[1] = v[i][1]; s[2] = v[i][2]; s[3] = v[i][3]; }
    asm volatile("s_waitcnt lgkmcnt(0)" ::: "memory");
    const int cch = lane & 7;
#pragma unroll
    for (int j = 0; j < 4; ++j) {
        const int n = 8 * j + (lane >> 3); const LAS float* s = scr + (16 * cch) * 33 + n;
        u32x4 o; o.x = pk4_fp8(s[0 * 33] * W8_SCALE, s[1 * 33] * W8_SCALE, s[2 * 33] * W8_SCALE, s[3 * 33] * W8_SCALE); o.y = pk4_fp8(s[4 * 33] * W8_SCALE, s[5 * 33] * W8_SCALE, s[6 * 33] * W8_SCALE, s[7 * 33] * W8_SCALE);
        o.z = pk4_fp8(s[8 * 33] * W8_SCALE, s[9 * 33] * W8_SCALE, s[10 * 33] * W8_SCALE, s[11 * 33] * W8_SCALE); o.w = pk4_fp8(s[12 * 33] * W8_SCALE, s[13 * 33] * W8_SCALE, s[14 * 33] * W8_SCALE, s[15 * 33] * W8_SCALE);
        *(u32x4*)(WT + (size_t)rm(n0 + n) * K + k0 + 16 * cch) = o;
    }
    asm volatile("s_waitcnt lgkmcnt(0)" ::: "memory");
}
struct RmId { __device__ __forceinline__ int operator()(int n) const { return n; } };
struct RmGu { __device__ __forceinline__ int operator()(int n) const { const int j = n & 1023; return (j >> 7) * 256 + (n >> 10) * 128 + (j & 127); } };

__device__ __forceinline__ void phase_p0a(Frame& F) {
    const float* const c_in = F.in(1); const float* const ada_w = F.in(2); const float* const ada_b = F.in(3); const float* const w_in = F.in(5); const float* const mix_scale = F.in(6);
    const float* const w_o = F.in(7); const float* const w_gu = F.in(11); const float* const w_down = F.in(13);
    if (F.bid < 96) {
        LAS float* sc = (LAS float*)F.lds;
        LAS float* part = (LAS float*)(F.lds + 16384);
        for (int i = F.tid(); i < 1024; i += NTHR) {
#pragma unroll
            for (int b = 0; b < 4; ++b) { const float cv = c_in[b * 1024 + i]; sc[i * 4 + b] = cv / (1.0f + __expf(-cv)); }
        }
        __syncthreads();
        const int j0 = F.bid * 64;
        float a0 = 0.f, a1 = 0.f, a2 = 0.f, a3 = 0.f;
#pragma unroll 8
        for (int ii = 0; ii < 128; ++ii) {
            const int i = F.wave * 128 + ii; const float w = ada_w[(size_t)i * 6144 + j0 + F.lane()];
            const f32x4 s4 = *(const LAS f32x4*)(sc + i * 4);
            a0 += s4[0] * w; a1 += s4[1] * w; a2 += s4[2] * w; a3 += s4[3] * w;
        }
        part[(F.wave * 4 + 0) * 64 + F.lane()] = a0; part[(F.wave * 4 + 1) * 64 + F.lane()] = a1; part[(F.wave * 4 + 2) * 64 + F.lane()] = a2; part[(F.wave * 4 + 3) * 64 + F.lane()] = a3;
        __syncthreads();
        if (F.tid() < 256) { const int b = F.tid() >> 6, l = F.tid() & 63; float s = ada_b[j0 + l];
#pragma unroll
            for (int w = 0; w < 8; ++w) s += part[(w * 4 + b) * 64 + l];
            ((float*)(F.ws + WS_MOD))[b * 6144 + j0 + l] = s; }
        __syncthreads();
    }
    { int* ri = (int*)(F.ws + WS_ROWINFO); for (int i = F.bid * NTHR + F.tid(); i < MOE_ROWS; i += F.G * NTHR) ri[i] = -1; }
    LAS float* scr = (LAS float*)(F.lds + F.wave * 16896);
    const int gw = F.bid * NWAVES + F.wave, NGW = F.G * NWAVES;
    constexpr int I_IN = 16 * 46, I_O = 16 * 16, I_GU = 32 * 16 * 32, I_DN = 32 * 16 * 16, NITEMS = I_IN + I_O + I_GU + I_DN;
    { auto item_src = [&](int r, const float*& W, int& N, int& kb, int& nb) { if (r < I_GU) { const int e = r / 512, q = r % 512; W = w_gu + (size_t)e * 1024 * 2048; N = 2048; kb = q / 64; nb = q % 64; }
                                                                               else { r -= I_GU; const int e = r / 256, q = r % 256; W = w_down + (size_t)e * 1024 * 1024; N = 1024; kb = q / 32; nb = q % 32; } };
      f32x4 va[16], vb[16]; int it = gw;
      const float* W; int N, kb, nb;
      if (it < I_GU + I_DN) { item_src(it, W, N, kb, nb); f8_item_load(W, N, kb, nb, F.lane(), va); }
      while (it < I_GU + I_DN) {
          const int itn = it + NGW; const float* Wn = nullptr; int Nn = 0, kbn = 0, nbn = 0;
          if (itn < I_GU + I_DN) { item_src(itn, Wn, Nn, kbn, nbn); f8_item_load(Wn, Nn, kbn, nbn, F.lane(), vb); }
          if (it < I_GU) f8_item_store(va, F.ws + WS_WGU + (size_t)(it / 512) * 2048 * 1024, 1024, scr, kb, nb, F.lane(), RmGu());
          else f8_item_store(va, F.ws + WS_WDN + (size_t)((it - I_GU) / 256) * 1024 * 1024, 1024, scr, kb, nb, F.lane(), RmId());
#pragma unroll
          for (int i = 0; i < 16; ++i) va[i] = vb[i];
          it = itn; kb = kbn; nb = nbn;
      } }
    for (int it = gw; it < I_IN + I_O; it += NGW) {
        int r = it;
        if (r < I_IN) { transpose_item<false>(w_in, IN_COLS, (bf16*)(F.ws + WS_WIN), 1024, nullptr, scr, r / 46, r % 46, F.lane(), RmId()); continue; } r -= I_IN;
        transpose_item<false>(w_o, 1024, (bf16*)(F.ws + WS_WO), 1024, mix_scale, scr, r / 16, r % 16, F.lane(), RmId());
    }
}

__device__ __forceinline__ void phase_p0b(Frame& F) {
    const float* const x_in = F.in(0); const float* const norm1_g = F.in(4);
    const int gw = F.bid * NWAVES + F.wave, NGW = F.G * NWAVES;
    const float* mod = (const float*)(F.ws + WS_MOD); bf16* h0 = (bf16*)(F.ws + WS_H0);
    for (int m = gw; m < NTOK; m += NGW) {
        const int b = m / SEQ;
        const f32x4* xr = (const f32x4*)(x_in + (size_t)m * DM) + F.lane();
        f32x4 v[4]; float s = 0.f;
#pragma unroll
        for (int j = 0; j < 4; ++j) { v[j] = xr[64 * j]; s += (v[j][0] * v[j][0] + v[j][1] * v[j][1]) + (v[j][2] * v[j][2] + v[j][3] * v[j][3]); }
        const float rstd = rsqrtf(wave_sum(s) * (1.f / DM) + EPS);
        u32x2* o8 = (u32x2*)(h0 + (size_t)m * DM) + F.lane();
#pragma unroll
        for (int j = 0; j < 4; ++j) { const int col = 4 * F.lane() + 256 * j;
            const f32x4 g = *(const f32x4*)(norm1_g + col), sh = *(const f32x4*)(mod + b * 6144 + col), sc = *(const f32x4*)(mod + b * 6144 + 1024 + col);
            const f32x4 y = (v[j] * rstd) * g * (sc + 1.0f) + sh;
            u32x2 w; w.x = cvtpk(y[0], y[1]); w.y = cvtpk(y[2], y[3]); o8[64 * j] = w; }
    }
}

constexpr int VSTR = 144, KSTR = 80;
__device__ __forceinline__ void ret_stage_v(Frame& F, const bf16* proj, int tok0, int h, LAS bf16* Vs) {
    const int row = F.tid() >> 2, q = F.tid() & 3; const bf16* src = proj + (size_t)(tok0 + row) * PJ + C_RV + h * 128 + q * 32;
#pragma unroll
    for (int i = 0; i < 4; ++i) *(LAS u32x4*)(Vs + row * VSTR + q * 32 + 8 * i) = *(const u32x4*)(src + 8 * i);
}
__device__ __forceinline__ void ret_stage64(Frame& F, const bf16* src0, size_t pitch, LAS bf16* Ds) {
    const int row = F.tid() >> 2, q = F.tid() & 3; const bf16* src = src0 + (size_t)row * pitch + q * 16;
#pragma unroll
    for (int i = 0; i < 2; ++i) *(LAS u32x4*)(Ds + row * KSTR + q * 16 + 8 * i) = *(const u32x4*)(src + 8 * i);
}
__device__ __forceinline__ void ret_a_item(Frame& F, int item) {
    const bf16* proj = (const bf16*)(F.ws + WS_PROJ); float* kvt = (float*)(F.ws + WS_KVT) + (size_t)item * 8192;
    const int bh = item >> 6, n = item & 63, b = bh >> 2, h = bh & 3, tok0 = b * SEQ + n * 128;
    LAS bf16* Vs = (LAS bf16*)F.lds; LAS bf16* Ks = (LAS bf16*)(F.lds + 128 * VSTR * 2);
    const float lg = log2gamma(h);
    ret_stage_v(F, proj, tok0, h, Vs);
    { const int row = F.tid() >> 2, q = F.tid() & 3; const bf16* src = proj + (size_t)(tok0 + row) * PJ + C_RK + h * 64 + q * 16; const float dk = 0.125f * exp2f((float)(127 - row) * lg);
#pragma unroll
      for (int i = 0; i < 2; ++i) { const u32x4 w = *(const u32x4*)(src + 8 * i); u32x4 o;
          o.x = cvtpk(bflo(w.x) * dk, bfhi(w.x) * dk); o.y = cvtpk(bflo(w.y) * dk, bfhi(w.y) * dk); o.z = cvtpk(bflo(w.z) * dk, bfhi(w.z) * dk); o.w = cvtpk(bflo(w.w) * dk, bfhi(w.w) * dk);
          *(LAS u32x4*)(Ks + row * KSTR + q * 16 + 8 * i) = o; } }
    __syncthreads();
    const int lane = F.lane(), n16 = lane & 15, c = lane >> 4, q4 = n16 >> 2, p4 = lane & 3, e0 = 16 * F.wave;
    f32x4 acc[4];
#pragma unroll
    for (int dt = 0; dt < 4; ++dt) acc[dt] = (f32x4){0.f, 0.f, 0.f, 0.f};
#pragma unroll
    for (int s = 0; s < 4; ++s) {
        const LAS bf16* ap = Vs + (32 * s + 4 * c + q4) * VSTR + e0 + 4 * p4;
        const bf16x8 A = cat8(trread(ap), trread(ap + 16 * VSTR));
#pragma unroll
        for (int dt = 0; dt < 4; ++dt) { const LAS bf16* bp = Ks + (32 * s + 4 * c + q4) * KSTR + 16 * dt + 4 * p4;
            const bf16x8 B = cat8(trread(bp), trread(bp + 16 * KSTR)); acc[dt] = MFMA16(A, B, acc[dt]); }
    }
#pragma unroll
    for (int dt = 0; dt < 4; ++dt)
#pragma unroll
        for (int r = 0; r < 4; ++r) kvt[(e0 + 4 * c + r) * 64 + 16 * dt + n16] = acc[dt][r];
    __syncthreads();
}
__device__ __forceinline__ void ret_scan(Frame& F) {
    const float* kvt = (const float*)(F.ws + WS_KVT); bf16* rpt = (bf16*)(F.ws + WS_RPT);
    for (int g = F.bid * NTHR + F.tid(); g < 16 * 8192; g += F.G * NTHR) {
        const int bh = g >> 13, ed = g & 8191, h = bh & 3; const float gC = exp2f(128.0f * log2gamma(h));
        float R = 0.f; const size_t base = (size_t)bh * 64 * 8192 + ed;
#pragma unroll 8
        for (int n = 0; n < 64; ++n) { const float kv = kvt[base + (size_t)n * 8192]; rpt[base + (size_t)n * 8192] = f2bf(R); R = R * gC + kv; }
    }
}
__device__ __forceinline__ void ret_c_item(Frame& F, int item) {
    const bf16* proj = (const bf16*)(F.ws + WS_PROJ); const bf16* rpt = (const bf16*)(F.ws + WS_RPT) + (size_t)item * 8192; bf16* mix = (bf16*)(F.ws + WS_MIX);
    const int bh = item >> 6, n = item & 63, b = bh >> 2, h = bh & 3, tok0 = b * SEQ + n * 128;
    LAS bf16* Qs = (LAS bf16*)F.lds; LAS bf16* Ks = Qs + 128 * KSTR; LAS bf16* Vs = Ks + 128 * KSTR; LAS bf16* Rs = Vs + 128 * VSTR;
    const float lg = log2gamma(h);
    ret_stage64(F, proj + (size_t)tok0 * PJ + C_RQ + h * 64, PJ, Qs);
    ret_stage64(F, proj + (size_t)tok0 * PJ + C_RK + h * 64, PJ, Ks);
    ret_stage_v(F, proj, tok0, h, Vs);
    ret_stage64(F, rpt, 64, Rs);
    __syncthreads();
    const int lane = F.lane(), n16 = lane & 15, c = lane >> 4, q4 = n16 >> 2, p4 = lane & 3, w = F.wave, i0 = 16 * w, il = i0 + n16;
    bf16x8 qf[2];
#pragma unroll
    for (int s = 0; s < 2; ++s) qf[s] = *(const LAS bf16x8*)(Qs + il * KSTR + 32 * s + 8 * c);
    f32x4 oin[8], ocr[8];
#pragma unroll
    for (int et = 0; et < 8; ++et) { oin[et] = (f32x4){0.f, 0.f, 0.f, 0.f}; ocr[et] = (f32x4){0.f, 0.f, 0.f, 0.f}; }
    const int nsp = (w >> 1) + 1;
    for (int sp = 0; sp < nsp; ++sp) {
        unsigned pw[4];
#pragma unroll
        for (int t2 = 0; t2 < 2; ++t2) { const int jt = 2 * sp + t2;
            const bf16x8 k0 = *(const LAS bf16x8*)(Ks + (16 * jt + n16) * KSTR + 8 * c), k1 = *(const LAS bf16x8*)(Ks + (16 * jt + n16) * KSTR + 32 + 8 * c);
            f32x4 st = MFMA16(k0, qf[0], ((f32x4){0.f, 0.f, 0.f, 0.f})); st = MFMA16(k1, qf[1], st);
            float pv[4];
#pragma unroll
            for (int r = 0; r < 4; ++r) { const int j = 16 * jt + 4 * c + r; const float f = (il >= j) ? 0.125f * exp2f((float)(il - j) * lg) : 0.f; pv[r] = st[r] * f; }
            pw[2 * t2] = cvtpk(pv[0], pv[1]); pw[2 * t2 + 1] = cvtpk(pv[2], pv[3]); }
        const bf16x8 P = __builtin_bit_cast(bf16x8, ((u32x4){pw[0], pw[1], pw[2], pw[3]}));
#pragma unroll
        for (int et = 0; et < 8; ++et) { const LAS bf16* ap = Vs + (32 * sp + 4 * c + q4) * VSTR + 16 * et + 4 * p4;
            const bf16x8 A = cat8(trread(ap), trread(ap + 16 * VSTR)); oin[et] = MFMA16(A, P, oin[et]); }
    }
#pragma unroll
    for (int et = 0; et < 8; ++et)
#pragma unroll
        for (int s = 0; s < 2; ++s) { const bf16x8 rf = *(const LAS bf16x8*)(Rs + (16 * et + n16) * KSTR + 32 * s + 8 * c); ocr[et] = MFMA16(rf, qf[s], ocr[et]); }
    const float qd = exp2f((float)(il + 1) * lg);
    float ss = 0.f;
#pragma unroll
    for (int et = 0; et < 8; ++et) { oin[et] = oin[et] + ocr[et] * qd; ss += (oin[et][0] * oin[et][0] + oin[et][1] * oin[et][1]) + (oin[et][2] * oin[et][2] + oin[et][3] * oin[et][3]); }
    ss += __shfl_xor(ss, 16); ss += __shfl_xor(ss, 32);
    const float rstd = rsqrtf(ss * (1.f / 128.f) + EPS);
    const bf16* gp = proj + (size_t)(tok0 + il) * PJ + C_RG + h * 128 + 4 * c; bf16* op = mix + (size_t)(tok0 + il) * DM + h * 128 + 4 * c;
#pragma unroll
    for (int et = 0; et < 8; ++et) { const u32x2 gw = *(const u32x2*)(gp + 16 * et);
        const float g0 = bflo(gw.x), g1 = bfhi(gw.x), g2 = bflo(gw.y), g3 = bfhi(gw.y);
        const float y0 = g0 / (1.f + __expf(-g0)) * (oin[et][0] * rstd), y1 = g1 / (1.f + __expf(-g1)) * (oin[et][1] * rstd), y2 = g2 / (1.f + __expf(-g2)) * (oin[et][2] * rstd), y3 = g3 / (1.f + __expf(-g3)) * (oin[et][3] * rstd);
        u32x2 o; o.x = cvtpk(y0, y1); o.y = cvtpk(y2, y3); *(u32x2*)(op + 16 * et) = o; }
    __syncthreads();
}

constexpr int MTW = 2;
constexpr int RPW = 4 * MTW, QT = 8 * RPW, KT = 64, CAP = 131072 / (QT * 4), CAP_TRIG = CAP - KT, NSEL = 256, NREG = CAP / 64;
constexpr int KTS = 72;
constexpr int CAND_BYTES = QT * CAP * 4, KTILE_BYTES = KT * KTS * 2;
constexpr float WSCALE = 0.125f * 0.35355339059327373f;
__device__ __forceinline__ unsigned fmap(float s) { const unsigned u = __builtin_bit_cast(unsigned, s); return (u & 0x80000000u) ? ~u : (u | 0x80000000u); }
__device__ __forceinline__ float funmap(unsigned m) { const unsigned u = (m & 0x80000000u) ? (m ^ 0x80000000u) : ~m; return __builtin_bit_cast(float, u); }
#define DPP_ROR(v, n) ((unsigned)__builtin_amdgcn_update_dpp(0, (int)(v), 0x120 + (n), 0xf, 0xf, false))
#define DPP_SHR0(v, n) ((unsigned)__builtin_amdgcn_update_dpp(0, (int)(v), 0x110 + (n), 0xf, 0xf, true))
__device__ __forceinline__ unsigned wave_umin(unsigned v) {
    v = min(v, DPP_ROR(v, 1)); v = min(v, DPP_ROR(v, 2)); v = min(v, DPP_ROR(v, 4)); v = min(v, DPP_ROR(v, 8));
    const unsigned a = __builtin_amdgcn_readlane(v, 0), b = __builtin_amdgcn_readlane(v, 16), c = __builtin_amdgcn_readlane(v, 32), d = __builtin_amdgcn_readlane(v, 48);
    return min(min(a, b), min(c, d));
}
__device__ __forceinline__ unsigned wave_umax(unsigned v) {
    v = max(v, DPP_ROR(v, 1)); v = max(v, DPP_ROR(v, 2)); v = max(v, DPP_ROR(v, 4)); v = max(v, DPP_ROR(v, 8));
    const unsigned a = __builtin_amdgcn_readlane(v, 0), b = __builtin_amdgcn_readlane(v, 16), c = __builtin_amdgcn_readlane(v, 32), d = __builtin_amdgcn_readlane(v, 48);
    return max(max(a, b), max(c, d));
}
__device__ __forceinline__ unsigned wave_scan_incl(unsigned v, int lane) {
    v += DPP_SHR0(v, 1); v += DPP_SHR0(v, 2); v += DPP_SHR0(v, 4); v += DPP_SHR0(v, 8);
    const unsigned t0 = __builtin_amdgcn_readlane(v, 15), t1 = __builtin_amdgcn_readlane(v, 31), t2 = __builtin_amdgcn_readlane(v, 47);
    const int rw = lane >> 4;
    return v + (rw == 1 ? t0 : rw == 2 ? t0 + t1 : rw == 3 ? t0 + t1 + t2 : 0u);
}
__device__ __forceinline__ unsigned lt01(int a, int b) { unsigned r; asm("v_sub_u32 %0, %1, %2\n\tv_lshrrev_b32 %0, 31, %0" : "=&v"(r) : "v"(a), "v"(b)); return r; }
#define BIT01(m, j) ({ unsigned _r; asm("v_bfe_u32 %0, %1, %2, 1" : "=v"(_r) : "v"(m), "n"(j)); _r; })
#define LT01(a, b) lt01((int)(a), (int)(b))
__device__ __forceinline__ int select_row(LAS unsigned* row, int cnt, int limit, LAS unsigned* hist, LAS unsigned* trashp, int lane, unsigned& minkey) {
    unsigned e[NREG]; unsigned act = 0u, keep = 0u;
#pragma unroll
    for (int j = 0; j < NREG; ++j) { const unsigned v = LT01(64 * j + lane, cnt); e[j] = row[64 * j + lane] & (0u - v); act |= v << j; }
    int need = NSEL; bool first = true;
    for (;;) {
        unsigned lo = 0xFFFFFFFFu, hi = 0u;
#pragma unroll
        for (int j = 0; j < NREG; ++j) { const unsigned a = BIT01(act, j); lo = min(lo, e[j] | (a - 1u)); hi = max(hi, e[j] & (0u - a)); }
        lo = wave_umin(lo); hi = wave_umax(hi);
        if (hi == lo) break;
        hist[lane] = 0u;
        int rb[NREG];
        if (first) {
            const float slo = funmap(lo & 0xFFFFE000u), shi = funmap(hi & 0xFFFFE000u);
            const float scale = (shi > slo) ? 63.999f / (shi - slo) : 0.f;
#pragma unroll
            for (int j = 0; j < NREG; ++j) { const int bn = (int)((funmap(e[j] & 0xFFFFE000u) - slo) * scale); rb[j] = 63 - min(max(bn, 0), 63); }
        } else {
            const float scale = 63.999f / (float)(hi - lo);
#pragma unroll
            for (int j = 0; j < NREG; ++j) { const int bn = (int)((float)(e[j] - lo) * scale); rb[j] = 63 - min(max(bn, 0), 63); }
        }
        first = false;
#pragma unroll
        for (int j = 0; j < NREG; ++j) __hip_atomic_fetch_add(hist + rb[j], BIT01(act, j), __ATOMIC_RELAXED, __HIP_MEMORY_SCOPE_WAVEFRONT);
        const unsigned h = hist[lane];
        const unsigned ps = wave_scan_incl(h, lane);
        const unsigned long long m = __ballot(ps >= (unsigned)need);
        const int ls = (int)__builtin_ctzll(m);
        const int cge = (int)__builtin_amdgcn_readlane(ps, ls), nb = (int)__builtin_amdgcn_readlane(h, ls);
#pragma unroll
        for (int j = 0; j < NREG; ++j) { const unsigned a = BIT01(act, j), kp = a & LT01(rb[j], ls), dr = a & LT01(ls, rb[j]); keep |= kp << j; act &= ~((kp | dr) << j); }
        need -= cge - nb;
        if ((NSEL - need) + nb <= limit) break;
    }
    keep |= act;
    const unsigned kcnt = (unsigned)__builtin_popcount(keep); const unsigned incl = wave_scan_incl(kcnt, lane);
    int pos = (int)(incl - kcnt); const int run = (int)__builtin_amdgcn_readlane(incl, 63); unsigned mk = 0xFFFFFFFFu;
#pragma unroll
    for (int j = 0; j < NREG; ++j) { const unsigned k = BIT01(keep, j);
        *(trashp + ((int)((row + pos) - trashp) & -(int)k)) = e[j];
        mk = min(mk, e[j] | (k - 1u)); pos += (int)k; }
    minkey = wave_umin(mk);
    return run;
}
__device__ __forceinline__ int compact_stream(LAS unsigned* row, int cnt, LAS unsigned* hist, LAS unsigned* trashp, int lane, float& thrf) {
    unsigned e[NREG];
#pragma unroll
    for (int j = 0; j < NREG; ++j) e[j] = row[64 * j + lane];
    const unsigned lo = wave_umin(min(e[0], e[1])), hi = wave_umax(max(e[0], e[1]));
    const float slo = funmap(lo & 0xFFFFE000u), shi = funmap(hi & 0xFFFFE000u);
    bool ok = shi > slo; int newcnt = 0, bstar = 0; int bn[NREG]; float scale = 0.f;
    if (ok) {
        scale = 63.999f / (shi - slo);
        hist[lane] = 0u;
#pragma unroll
        for (int j = 0; j < NREG; ++j) { const int b = (int)((funmap(e[j] & 0xFFFFE000u) - slo) * scale); bn[j] = min(max(b, 0), 63);
            __hip_atomic_fetch_add(hist + (63 - bn[j]), LT01(64 * j + lane, cnt), __ATOMIC_RELAXED, __HIP_MEMORY_SCOPE_WAVEFRONT); }
        const unsigned h = hist[lane];
        const unsigned ps = wave_scan_incl(h, lane);
        const unsigned long long m = __ballot(ps >= (unsigned)NSEL);
        const int ls = (int)__builtin_ctzll(m);
        newcnt = (int)__builtin_amdgcn_readlane(ps, ls); bstar = 63 - ls;
        ok = newcnt <= NSEL + 96;
    }
    if (!ok) { unsigned P; const int nc = select_row(row, cnt, NSEL + 64, hist, trashp, lane, P); thrf = funmap(P & 0xFFFFE000u); return nc; }
    unsigned keep = 0u;
#pragma unroll
    for (int j = 0; j < NREG; ++j) keep |= (LT01(64 * j + lane, cnt) & LT01(bstar - 1, bn[j])) << j;
    const unsigned kcnt = (unsigned)__builtin_popcount(keep); const unsigned incl = wave_scan_incl(kcnt, lane);
    int pos = (int)(incl - kcnt); const int run = (int)__builtin_amdgcn_readlane(incl, 63);
#pragma unroll
    for (int j = 0; j < NREG; ++j) { const unsigned k = BIT01(keep, j);
        *(trashp + ((int)((row + pos) - trashp) & -(int)k)) = e[j];
        pos += (int)k; }
    if (bstar > 0) thrf = slo + ((float)bstar - 0.01f) / scale;
    return run;
}
#if defined(PROBE_SUB)
#define PSUB_T(i) do { const unsigned long long _t = __builtin_amdgcn_s_memrealtime(); if ((i) == PROBE_SUB) F.tacc += _t - psub_last; psub_last = _t; } while (0)
#else
#define PSUB_T(i) do { } while (0)
#endif
__device__ __forceinline__ void dsa_a_unit(Frame& F, int b, int qt) {
#if defined(PROBE_SUB)
    unsigned long long psub_last = 0ull;
#endif
    const bf16* proj = (const bf16*)(F.ws + WS_PROJ); bf16* sel = (bf16*)(F.ws + WS_SEL);
    LAS unsigned* cand = (LAS unsigned*)F.lds;
    LAS unsigned* hist = (LAS unsigned*)(F.lds + CAND_BYTES) + 64 * F.wave;
    LAS int* rowcnt = (LAS int*)(F.lds + CAND_BYTES + 2048); LAS float* rowthr = (LAS float*)(F.lds + CAND_BYTES + 2048 + 256);
    const int lane = F.lane(), w = F.wave, r32 = lane & 31, hi = lane >> 5;
    const int trash = (CAND_BYTES + 2048 + 512) / 4 + w;
    const int tokb = b * SEQ, q0 = qt * QT;
    bf16x8 af[MTW][4]; float wv[MTW][16];
    { const int qq = 2 * ((r32 >> 2) & 1) + (r32 >> 4), hd = ((r32 >> 3) & 1) * 4 + (r32 & 3);
#pragma unroll
      for (int mt = 0; mt < MTW; ++mt) { const bf16* qp = proj + (size_t)(tokb + q0 + RPW * w + 4 * mt + qq) * PJ + C_IQ + hd * 64 + 32 * hi;
#pragma unroll
          for (int s = 0; s < 4; ++s) af[mt][s] = *(const bf16x8*)(qp + 8 * s);
#pragma unroll
          for (int u = 0; u < 2; ++u) { const u32x4 ww = *(const u32x4*)(proj + (size_t)(tokb + q0 + RPW * w + 4 * mt + 2 * hi + u) * PJ + C_IW);
              wv[mt][8 * u + 0] = bflo(ww.x) * WSCALE; wv[mt][8 * u + 1] = bfhi(ww.x) * WSCALE; wv[mt][8 * u + 2] = bflo(ww.y) * WSCALE; wv[mt][8 * u + 3] = bfhi(ww.y) * WSCALE;
              wv[mt][8 * u + 4] = bflo(ww.z) * WSCALE; wv[mt][8 * u + 5] = bfhi(ww.z) * WSCALE; wv[mt][8 * u + 6] = bflo(ww.w) * WSCALE; wv[mt][8 * u + 7] = bfhi(ww.w) * WSCALE; } } }
    float thrf[MTW][2]; int cntv[MTW][2];
#pragma unroll
    for (int mt = 0; mt < MTW; ++mt)
#pragma unroll
        for (int u = 0; u < 2; ++u) { thrf[mt][u] = -INFINITY; cntv[mt][u] = 0; }
    if (lane < RPW) { rowcnt[RPW * w + lane] = 0; rowthr[RPW * w + lane] = -INFINITY; }
    const int NT = (q0 + QT + KT - 1) / KT;
    const char* kbase = (const char*)(proj + (size_t)tokb * PJ + C_IK + 32 * hi);
    const unsigned koff = (unsigned)r32 * (unsigned)(PJ * 2);
    bf16x8 kc[2][4], kn[2][4];
#pragma unroll
    for (int sub = 0; sub < 2; ++sub)
#pragma unroll
        for (int s = 0; s < 4; ++s) kc[sub][s] = *(const bf16x8*)(kbase + koff + (unsigned)(sub * 32) * (unsigned)(PJ * 2) + 16 * s);
    for (int kt = 0; kt < NT; ++kt) {
        PSUB_T(0);
        if (kt + 1 < NT) { const char* kb1 = kbase + (size_t)(kt + 1) * KT * (PJ * 2);
#pragma unroll
            for (int sub = 0; sub < 2; ++sub)
#pragma unroll
                for (int s = 0; s < 4; ++s) kn[sub][s] = *(const bf16x8*)(kb1 + koff + (unsigned)(sub * 32) * (unsigned)(PJ * 2) + 16 * s); }
#pragma unroll
        for (int sub = 0; sub < 2; ++sub) {
            const int key = kt * KT + sub * 32 + r32;
            f32x16 accs[MTW];
#pragma unroll
            for (int mt = 0; mt < MTW; ++mt) {
                accs[mt] = MFMA32(af[mt][0], kc[sub][0], ((f32x16){0.f, 0.f, 0.f, 0.f, 0.f, 0.f, 0.f, 0.f, 0.f, 0.f, 0.f, 0.f, 0.f, 0.f, 0.f, 0.f}));
#pragma unroll
                for (int s = 1; s < 4; ++s) accs[mt] = MFMA32(af[mt][s], kc[sub][s], accs[mt]);
            }
#pragma unroll
            for (int mt = 0; mt < MTW; ++mt) {
                float sc[2] = {0.f, 0.f};
#pragma unroll
                for (int r = 0; r < 16; ++r) sc[r >> 3] += wv[mt][r] * fmaxf(accs[mt][r], 0.f);
#pragma unroll
                for (int u = 0; u < 2; ++u) {
                    const int ql = RPW * w + 4 * mt + 2 * hi + u;
                    const bool valid = (sc[u] >= thrf[mt][u]) && (key <= q0 + ql);
                    const unsigned long long m = __ballot(valid);
                    const int nlo = __builtin_popcount((unsigned)m), nhi = __builtin_popcount((unsigned)(m >> 32));
                    const int off = mbcnt64(m) - (hi ? nlo : 0);
                    cand[valid ? ql * CAP + cntv[mt][u] + off : trash] = (fmap(sc[u]) & 0xFFFFE000u) | (unsigned)(8191 - key);
                    cntv[mt][u] += hi ? nhi : nlo;
                }
            }
        }
        PSUB_T(1);
        bool anyc = false;
#pragma unroll
        for (int mt = 0; mt < MTW; ++mt)
#pragma unroll
            for (int u = 0; u < 2; ++u) anyc = anyc || (cntv[mt][u] > CAP_TRIG);
        if (__any(anyc)) {
            if ((lane & 31) == 0) {
#pragma unroll
                for (int mt = 0; mt < MTW; ++mt)
#pragma unroll
                    for (int u = 0; u < 2; ++u) rowcnt[RPW * w + 4 * mt + 2 * hi + u] = cntv[mt][u];
            }
#pragma unroll 1
            for (int rr = 0; rr < RPW; ++rr) { const int rowi = RPW * w + rr; const int cq = __builtin_amdgcn_readfirstlane(rowcnt[rowi]);
                if (cq > NSEL + 64) { float tf = rowthr[rowi]; const int nc = compact_stream(cand + rowi * CAP, cq, hist, cand + trash, lane, tf);
                    if (lane == 0) { rowcnt[rowi] = nc; rowthr[rowi] = tf; } } }
#pragma unroll
            for (int mt = 0; mt < MTW; ++mt)
#pragma unroll
                for (int u = 0; u < 2; ++u) { cntv[mt][u] = rowcnt[RPW * w + 4 * mt + 2 * hi + u]; thrf[mt][u] = rowthr[RPW * w + 4 * mt + 2 * hi + u]; }
        }
        PSUB_T(7);
#pragma unroll
        for (int sub = 0; sub < 2; ++sub)
#pragma unroll
            for (int s = 0; s < 4; ++s) kc[sub][s] = kn[sub][s];
    }
    PSUB_T(5);
    if ((lane & 31) == 0) {
#pragma unroll
        for (int mt = 0; mt < MTW; ++mt)
#pragma unroll
            for (int u = 0; u < 2; ++u) rowcnt[RPW * w + 4 * mt + 2 * hi + u] = cntv[mt][u];
    }
#pragma unroll 1
    for (int rr = 0; rr < RPW; ++rr) { const int ql = RPW * w + rr; LAS unsigned* row = cand + ql * CAP; int cq = __builtin_amdgcn_readfirstlane(rowcnt[ql]);
        if (cq > NSEL) { unsigned P; cq = select_row(row, cq, NSEL, hist, cand + trash, lane, P); }
        bf16* so = sel + (size_t)(tokb + q0 + ql) * NSEL;
#pragma unroll
        for (int j = 0; j < 4; ++j) { const int p = 64 * j + lane; const unsigned v = row[p]; so[p] = (p < cq) ? (bf16)(8191u - (v & 0x1FFFu)) : (bf16)0; } }
    PSUB_T(6);
}

constexpr int VROW = 144;
constexpr int DSB_WAVE = 32 * VROW * 2 + 2 * 2048;
static_assert(8 * DSB_WAVE <= MISC_OFF, "DSA-B LDS map");
__device__ __forceinline__ void dsb_gather(const char* kvbase, const LAS unsigned* sl, int chunk, int colbyte, int c, int n16, u32x4 (&r)[8]) {
#pragma unroll
    for (int i = 0; i < 8; ++i) { const unsigned o = sl[32 * chunk + 4 * i + c] + (unsigned)(colbyte + n16 * 16); r[i] = *(const u32x4*)(kvbase + o); }
}
__device__ __forceinline__ void dsb_put_list(LAS unsigned* sl, u32x2 kk, int t, int lane) {
    const unsigned k0 = kk.x & 0xffffu, k1 = kk.x >> 16, k2 = kk.y & 0xffffu, k3 = kk.y >> 16;
    *(LAS u32x4*)(sl + 4 * lane) = (u32x4){k0 * (unsigned)(PJ * 2), k1 * (unsigned)(PJ * 2), k2 * (unsigned)(PJ * 2), k3 * (unsigned)(PJ * 2)};
    *(LAS f32x4*)((LAS float*)(sl + 256) + 4 * lane) = (f32x4){(float)(t - (int)k0), (float)(t - (int)k1), (float)(t - (int)k2), (float)(t - (int)k3)};
}
__device__ __forceinline__ void phase_dsa_b(Frame& F) {
    const bf16* proj = (const bf16*)(F.ws + WS_PROJ); const bf16* sel = (const bf16*)(F.ws + WS_SEL); bf16* mix = (bf16*)(F.ws + WS_MIX);
    const int lane = F.lane(), n16 = lane & 15, c = lane >> 4, q4 = n16 >> 2, p4 = lane & 3, w = F.wave;
    LAS unsigned char* wl = F.lds + w * DSB_WAVE;
    LAS bf16* buf = (LAS bf16*)wl; LAS unsigned* slb = (LAS unsigned*)(wl + 32 * VROW * 2);
    const float nslope[2] = {-exp2f(-(float)((n16 & 3) + 1)), -exp2f(-(float)((n16 & 3) + 5))};
    constexpr float L2E = 1.4426950408889634f;
    for (int blk = F.bid; blk < NTOK / 128; blk += F.G) {
        int T0 = blk * 128;
        if (F.G == 256) { const int x = F.bid & 7, jj = F.bid >> 3; T0 = (x & 3) * SEQ + (jj * 2 + (x >> 2)) * 128; }
        const char* kvbase = (const char*)(proj + (size_t)(T0 / SEQ) * SEQ * PJ);
        int tok = T0 + w;
        u32x4 kr[8], vr[8]; bf16x8 qf[2][2]; u32x2 selnext;
        dsb_put_list(slb, *(const u32x2*)(sel + (size_t)tok * NSEL + 4 * lane), tok % SEQ, lane);
        dsb_gather(kvbase, slb, 0, C_AK * 2, c, n16, kr); dsb_gather(kvbase, slb, 0, C_AV * 2, c, n16, vr);
#pragma unroll
        for (int g = 0; g < 2; ++g)
#pragma unroll
            for (int s = 0; s < 2; ++s) { bf16x8 v = (bf16x8){0, 0, 0, 0, 0, 0, 0, 0};
                if (n16 < 4) v = *(const bf16x8*)(proj + (size_t)tok * PJ + C_AQ + (g * 4 + n16) * 64 + 32 * s + 8 * c);
                qf[g][s] = v; }
        for (int qi = 0; qi < 16; ++qi) {
            const int t = tok % SEQ, nsel = (t + 1 < NSEL) ? t + 1 : NSEL; const int par = qi & 1;
            const LAS unsigned* sl = slb + par * 512; LAS unsigned* sln = slb + (par ^ 1) * 512;
            const bool more = qi + 1 < 16; const int tokn = tok + 8;
            if (more) selnext = *(const u32x2*)(sel + (size_t)tokn * NSEL + 4 * lane);
            float mrun[2] = {-INFINITY, -INFINITY}, lrun[2] = {0.f, 0.f};
            f32x4 O[2][4];
#pragma unroll
            for (int g = 0; g < 2; ++g)
#pragma unroll
                for (int dt = 0; dt < 4; ++dt) O[g][dt] = (f32x4){0.f, 0.f, 0.f, 0.f};
            bf16x8 qn[2][2];
#pragma unroll 4
            for (int ch = 0; ch < 8; ++ch) {
#pragma unroll
                for (int i = 0; i < 8; ++i) *(LAS u32x4*)(buf + (4 * i + c) * VROW + n16 * 8) = kr[i];
                if (ch == 3 && more) dsb_put_list(sln, selnext, tokn % SEQ, lane);
                asm volatile("" ::: "memory");
                if (ch < 7) dsb_gather(kvbase, sl, ch + 1, C_AK * 2, c, n16, kr);
                else if (more) dsb_gather(kvbase, sln, 0, C_AK * 2, c, n16, kr);
                if (ch == 6 && more) {
#pragma unroll
                    for (int g = 0; g < 2; ++g)
#pragma unroll
                        for (int s = 0; s < 2; ++s) { bf16x8 v = (bf16x8){0, 0, 0, 0, 0, 0, 0, 0};
                            if (n16 < 4) v = *(const bf16x8*)(proj + (size_t)tokn * PJ + C_AQ + (g * 4 + n16) * 64 + 32 * s + 8 * c);
                            qn[g][s] = v; } }
                f32x4 acc[2][2];
#pragma unroll
                for (int kt = 0; kt < 2; ++kt)
#pragma unroll
                    for (int g = 0; g < 2; ++g) { const LAS bf16* ap = buf + (16 * kt + n16) * VROW + g * 64 + 8 * c;
                        acc[kt][g] = MFMA16(*(const LAS bf16x8*)ap, qf[g][0], ((f32x4){0.f, 0.f, 0.f, 0.f})); acc[kt][g] = MFMA16(*(const LAS bf16x8*)(ap + 32), qf[g][1], acc[kt][g]); }
#pragma unroll
                for (int kt = 0; kt < 2; ++kt) { const f32x4 d4 = *(const LAS f32x4*)((const LAS float*)(sl + 256) + 32 * ch + 16 * kt + 4 * c);
#pragma unroll
                    for (int r = 0; r < 4; ++r)
#pragma unroll
                        for (int g = 0; g < 2; ++g) acc[kt][g][r] = fmaf(nslope[g], d4[r], acc[kt][g][r]); }
                if (nsel < NSEL) {
#pragma unroll
                    for (int kt = 0; kt < 2; ++kt)
#pragma unroll
                        for (int r = 0; r < 4; ++r) { const bool dead = 32 * ch + 16 * kt + 4 * c + r >= nsel;
#pragma unroll
                            for (int g = 0; g < 2; ++g) acc[kt][g][r] = dead ? -INFINITY : acc[kt][g][r]; }
                }
                bf16x8 pf[2]; float alpha[2]; bool grow = false;
#pragma unroll
                for (int g = 0; g < 2; ++g) {
                    float mx = fmaxf(fmaxf(fmaxf(acc[0][g][0], acc[0][g][1]), fmaxf(acc[0][g][2], acc[0][g][3])), fmaxf(fmaxf(acc[1][g][0], acc[1][g][1]), fmaxf(acc[1][g][2], acc[1][g][3])));
                    mx = fmaxf(mx, __shfl_xor(mx, 16)); mx = fmaxf(mx, __shfl_xor(mx, 32));
                    const float mnew = fmaxf(mrun[g], mx);
                    alpha[g] = (mnew == -INFINITY) ? 1.f : __builtin_amdgcn_exp2f((mrun[g] - mnew) * L2E);
                    grow = grow || (mnew > mrun[g]);
                    mrun[g] = mnew;
                    const float mm2 = (mnew == -INFINITY) ? 0.f : -mnew * L2E; float s = 0.f;
#pragma unroll
                    for (int kt = 0; kt < 2; ++kt)
#pragma unroll
                        for (int r = 0; r < 4; ++r) { const float e = __builtin_amdgcn_exp2f(fmaf(acc[kt][g][r], L2E, mm2)); acc[kt][g][r] = e; s += e; }
                    s += __shfl_xor(s, 16); s += __shfl_xor(s, 32);
                    lrun[g] = lrun[g] * alpha[g] + s;
                    u32x4 pw; pw.x = cvtpk(acc[0][g][0], acc[0][g][1]); pw.y = cvtpk(acc[0][g][2], acc[0][g][3]); pw.z = cvtpk(acc[1][g][0], acc[1][g][1]); pw.w = cvtpk(acc[1][g][2], acc[1][g][3]);
                    pf[g] = __builtin_bit_cast(bf16x8, pw); }
#pragma unroll
                for (int i = 0; i < 8; ++i) *(LAS u32x4*)(buf + (4 * i + c) * VROW + n16 * 8) = vr[i];
                asm volatile("" ::: "memory");
                if (ch < 7) dsb_gather(kvbase, sl, ch + 1, C_AV * 2, c, n16, vr);
                else if (more) dsb_gather(kvbase, sln, 0, C_AV * 2, c, n16, vr);
                if (__any(grow)) {
#pragma unroll
                    for (int g = 0; g < 2; ++g)
#pragma unroll
                        for (int r = 0; r < 4; ++r) { const float a = __builtin_bit_cast(float, __builtin_amdgcn_readlane(__builtin_bit_cast(int, alpha[g]), r));
#pragma unroll
                            for (int dt = 0; dt < 4; ++dt) O[g][dt][r] *= a; }
                }
#pragma unroll
                for (int dt = 0; dt < 4; ++dt) { const LAS bf16* vp = buf + (4 * c + q4) * VROW + dt * 16 + 4 * p4;
                    O[0][dt] = MFMA16(pf[0], cat8(trread(vp), trread(vp + 16 * VROW)), O[0][dt]);
                    O[1][dt] = MFMA16(pf[1], cat8(trread(vp + 64), trread(vp + 64 + 16 * VROW)), O[1][dt]); }
            }
            {
#pragma unroll
                for (int g = 0; g < 2; ++g)
#pragma unroll
                    for (int r = 0; r < 4; ++r) { const float li = __builtin_amdgcn_rcpf(__builtin_bit_cast(float, __builtin_amdgcn_readlane(__builtin_bit_cast(int, lrun[g]), r)));
                        if (lane < 16) {
#pragma unroll
                            for (int dt = 0; dt < 4; ++dt) buf[(g * 4 + r) * 64 + 16 * dt + lane] = f2bf(O[g][dt][r] * li); } }
                const u32x4 ov = *(const LAS u32x4*)(buf + 8 * lane);
                *(u32x4*)(mix + (size_t)tok * DM + 512 + 8 * lane) = ov;
            }
            if (more) {
#pragma unroll
                for (int g = 0; g < 2; ++g)
#pragma unroll
                    for (int s = 0; s < 2; ++s) qf[g][s] = qn[g][s];
            }
            tok = tokn;
        }
    }
}

constexpr int HSTR = 1028;
__device__ __forceinline__ void phase_router(Frame& F) {
    const float* const norm2_g = F.in(8); const float* const router_w = F.in(9); const float* const router_b = F.in(10);
    const float* x1 = F.out; const float* mod = (const float*)(F.ws + WS_MOD); unsigned char* h2 = (unsigned char*)(F.ws + WS_H2);
    int* topi = (int*)(F.ws + WS_TOPI); float* topg = (float*)(F.ws + WS_TOPG); int* bbase = (int*)(F.ws + WS_BBASE);
    LAS float* hs = (LAS float*)F.lds; LAS float* part = (LAS float*)(F.lds + 16 * HSTR * 4); LAS int* hist = (LAS int*)(F.lds + 16 * HSTR * 4 + 8 * 16 * 32 * 4);
    const int lane = F.lane(), w = F.wave;
    for (int blk = F.bid; blk < NTOK / 128; blk += F.G) {
        const int T0 = blk * 128, b = T0 / SEQ;
        if (F.tid() < 32) hist[F.tid()] = 0;
        f32x4 ca[4], cb[4];
#pragma unroll
        for (int j = 0; j < 4; ++j) { const int col = 4 * lane + 256 * j;
            ca[j] = *(const f32x4*)(norm2_g + col) * (*(const f32x4*)(mod + b * 6144 + 4 * 1024 + col) + 1.0f); cb[j] = *(const f32x4*)(mod + b * 6144 + 3 * 1024 + col); }
        __syncthreads();
        for (int pass = 0; pass < 8; ++pass) {
#pragma unroll
            for (int tt = 0; tt < 2; ++tt) { const int tl = 2 * w + tt, tok = T0 + pass * 16 + tl;
                const f32x4* xr = (const f32x4*)(x1 + (size_t)tok * DM) + lane; f32x4 v[4]; float s = 0.f;
#pragma unroll
                for (int j = 0; j < 4; ++j) { v[j] = xr[64 * j]; s += (v[j][0] * v[j][0] + v[j][1] * v[j][1]) + (v[j][2] * v[j][2] + v[j][3] * v[j][3]); }
                const float rstd = rsqrtf(wave_sum(s) * (1.f / DM) + EPS);
                unsigned* o4 = (unsigned*)(h2 + (size_t)tok * DM) + lane;
#pragma unroll
                for (int j = 0; j < 4; ++j) { const f32x4 y = (v[j] * rstd) * ca[j] + cb[j];
                    o4[64 * j] = pk4_fp8(y[0], y[1], y[2], y[3]);
                    *(LAS f32x4*)(hs + tl * HSTR + 4 * lane + 256 * j) = y; } }
            __syncthreads();
            { const int ti = lane & 15, kk = lane >> 5, e = lane & 31; f32x16 acc;
#pragma unroll
              for (int r = 0; r < 16; ++r) acc[r] = 0.f;
              const LAS float* hp = hs + ti * HSTR + 128 * w + 64 * kk; const float* rwp = router_w + (size_t)(128 * w + 64 * kk) * NE + e;
#pragma unroll 4
              for (int s4 = 0; s4 < 16; ++s4) { const f32x4 a4 = *(const LAS f32x4*)(hp + 4 * s4);
#pragma unroll
                  for (int q = 0; q < 4; ++q) acc = __builtin_amdgcn_mfma_f32_32x32x2f32(a4[q], rwp[(4 * s4 + q) * NE], acc, 0, 0, 0); }
#pragma unroll
              for (int r = 0; r < 8; ++r) part[(w * 16 + (r & 3) + 8 * (r >> 2) + 4 * kk) * 32 + e] = acc[r]; }
            __syncthreads();
            { const int tl = F.tid() >> 5, e = F.tid() & 31, tok = T0 + pass * 16 + tl; float lg = router_b[e];
#pragma unroll
              for (int ww = 0; ww < 8; ++ww) lg += part[(ww * 16 + tl) * 32 + e];
              float myv = lg; float tv[4]; int ti4[4]; bool mine = false;
#pragma unroll
              for (int k = 0; k < 4; ++k) { float bv = myv; int bi = e;
#pragma unroll
                  for (int o = 16; o >= 1; o >>= 1) { const float ov = __shfl_xor(bv, o); const int oi = __shfl_xor(bi, o); if (ov > bv || (ov == bv && oi < bi)) { bv = ov; bi = oi; } }
                  tv[k] = bv; ti4[k] = bi; if (bi == e) { myv = -INFINITY; mine = true; } }
              if (mine) atomicAdd((int*)hist + e, 1);
              if (e == 0) { const float e0 = 1.0f, e1 = __expf(tv[1] - tv[0]), e2 = __expf(tv[2] - tv[0]), e3 = __expf(tv[3] - tv[0]); const float inv = 1.0f / (e0 + e1 + e2 + e3);
                  *(int4*)(topi + (size_t)tok * 4) = make_int4(ti4[0], ti4[1], ti4[2], ti4[3]); *(f32x4*)(topg + (size_t)tok * 4) = (f32x4){e0 * inv, e1 * inv, e2 * inv, e3 * inv}; } }
            __syncthreads();
        }
        if (F.tid() < 32) { const int base = atomicAdd((int*)(F.ctl + CW_GCNT) + F.tid(), hist[F.tid()]); bbase[blk * 32 + F.tid()] = base; }
        __syncthreads();
    }
}
__device__ __forceinline__ int moe_layout(Frame& F, LAS int* offs, LAS int* tile_e) {
    if (F.tid() == 0) { int o = 0;
        for (int e = 0; e < NE; ++e) { const int cnt = (int)__hip_atomic_load(F.ctl + CW_GCNT + e, __ATOMIC_RELAXED, __HIP_MEMORY_SCOPE_AGENT); const int nt = (cnt + 255) >> 8;
            offs[e] = o; if (tile_e) for (int t = 0; t < nt; ++t) tile_e[(o >> 8) + t] = e; o += nt << 8; }
        offs[NE] = o >> 8; }
    __syncthreads();
    return offs[NE];
}
__device__ __forceinline__ void phase_place(Frame& F) {
    const unsigned char* h2 = (const unsigned char*)(F.ws + WS_H2); unsigned char* xs = (unsigned char*)(F.ws + WS_XS);
    const int* topi = (const int*)(F.ws + WS_TOPI); const float* topg = (const float*)(F.ws + WS_TOPG); const int* bbase = (const int*)(F.ws + WS_BBASE);
    int* rowinfo = (int*)(F.ws + WS_ROWINFO); float* rowgate = (float*)(F.ws + WS_ROWGATE);
    LAS int* offs = (LAS int*)F.lds; LAS int* lcur = offs + 64; LAS int* posl = offs + 128;
    (void)moe_layout(F, offs, nullptr);
    for (int blk = F.bid; blk < NTOK / 128; blk += F.G) {
        const int T0 = blk * 128;
        if (F.tid() < 32) lcur[F.tid()] = 0;
        __syncthreads();
        { const int i = F.tid(), tok = T0 + (i >> 2); const int e = topi[(size_t)tok * 4 + (i & 3)];
          const int rank = atomicAdd((int*)lcur + e, 1); const int pos = offs[e] + bbase[blk * 32 + e] + rank;
          rowinfo[pos] = tok * 4 + (i & 3); rowgate[pos] = topg[(size_t)tok * 4 + (i & 3)]; posl[i] = pos; }
        __syncthreads();
        for (int jj = 0; jj < 64; ++jj) { const int i = F.wave * 64 + jj; const int pos = posl[i]; const int tok = T0 + (i >> 2);
            const u32x4* src = (const u32x4*)(h2 + (size_t)tok * DM) + F.lane(); u32x4* dst = (u32x4*)(xs + (size_t)pos * DM) + F.lane();
            dst[0] = src[0]; }
        __syncthreads();
    }
}
__device__ __forceinline__ void phase_final(Frame& F) {
    const float* const final_g = F.in(15);
    const float* mod = (const float*)(F.ws + WS_MOD); const bf16* Y = (const bf16*)(F.ws + WS_Y);
    const int gw = F.bid * NWAVES + F.wave, NGW = F.G * NWAVES;
    for (int m = gw; m < NTOK; m += NGW) {
        const int b = m / SEQ; f32x4* xr = (f32x4*)(F.out + (size_t)m * DM) + F.lane(); f32x4 v[4]; float s = 0.f;
#pragma unroll
        for (int j = 0; j < 4; ++j) { const int col = 4 * F.lane() + 256 * j; f32x4 y = (f32x4){0.f, 0.f, 0.f, 0.f};
#pragma unroll
            for (int k = 0; k < 4; ++k) { const u32x2 w = *((const u32x2*)(Y + ((size_t)m * 4 + k) * DM) + F.lane() + 64 * j); y[0] += bflo(w.x); y[1] += bfhi(w.x); y[2] += bflo(w.y); y[3] += bfhi(w.y); }
            v[j] = xr[64 * j] + *(const f32x4*)(mod + b * 6144 + 5 * 1024 + col) * y;
            s += (v[j][0] * v[j][0] + v[j][1] * v[j][1]) + (v[j][2] * v[j][2] + v[j][3] * v[j][3]); }
        const float rstd = rsqrtf(wave_sum(s) * (1.f / DM) + EPS);
#pragma unroll
        for (int j = 0; j < 4; ++j) xr[64 * j] = (v[j] * rstd) * *(const f32x4*)(final_g + 4 * F.lane() + 256 * j);
    }
}

#ifndef MK_N_LAUNCHES
#define MK_N_LAUNCHES 1
#endif
constexpr int N_PHASES = 12;
struct Args { const float* in[16]; float* out; unsigned char* ws; int ph_lo, ph_hi; };
static_assert(sizeof(Args) == 16 * 8 + 8 + 8 + 8, "Args has no padding");

__global__ void __launch_bounds__(NTHR, 2) mk_fwd(Args args) {
    extern __shared__ __attribute__((aligned(16))) unsigned char lds_raw[];
    Frame F;
    F.lds = (LAS unsigned char*)lds_raw;
    F.MISC = (volatile LAS unsigned*)(F.lds + MISC_OFF);
    F.wave = __builtin_amdgcn_readfirstlane((int)threadIdx.x >> 6);
    F.G = gridDim.x; F.bid = blockIdx.x; F.tacc = 0ull; F.xpass = 0;
    F.ws = args.ws; F.ctl = (unsigned*)(args.ws + WS_CTL); F.out = args.out;
    for (int u = F.tid(); u < (LDS_BYTES - MISC_OFF) / 4; u += NTHR) ((LAS unsigned*)(F.lds + MISC_OFF))[u] = 0u;
    __syncthreads();
    if (F.tid() < 16) *(LAS unsigned long long*)(F.lds + PTR_OFF + 8 * F.tid()) = (unsigned long long)args.in[F.tid()];
    __syncthreads();
    const int lo = args.ph_lo, hi = args.ph_hi;
    XcdBarrier bar; bar.bar = (unsigned*)(F.ctl + CW_BAR); bar.x = 0; bar.st = nullptr; bar.w0 = (F.wave == 0);
    if (hi - lo > 1) bar = xcd_barrier_post((unsigned*)(F.ctl + CW_BAR), F.MISC + 8, F.wave == 0);
#define IN(k) (lo <= (k) && (k) < hi)
#if defined(PROBE_PHASE)
    unsigned long long tp0 = 0ull, tp1 = 0ull;
#define STAMP(k) do { if ((k) == PROBE_PHASE) tp0 = __builtin_amdgcn_s_memrealtime(); if ((k) == PROBE_PHASE + 1) tp1 = __builtin_amdgcn_s_memrealtime(); } while (0)
#else
#define STAMP(k) do { } while (0)
#endif
#define SEAM(k) do { if (IN(k) && IN((k) + 1)) xcd_barrier(bar); } while (0)

    STAMP(0); if (IN(0)) { phase_p0a(F); } SEAM(0);
    STAMP(1); if (IN(1)) { phase_p0b(F); } SEAM(1);
    STAMP(2); if (IN(2)) {
        pg8::Gemm g{(const bf16*)(F.ws + WS_H0), (const bf16*)(F.ws + WS_WIN), NTOK, 3072, DM}; pg8::StaticOrder S; S.init(NTOK, 3072, F.G, F.bid);
        EpiProj E{(bf16*)(F.ws + WS_PROJ), PJ};
        pg8::gemm_phase<EpiProj, pg8::StaticOrder, true, true>(F.lds, g, S, E, F.wave);
    } SEAM(2);
    STAMP(3); if (IN(3)) {
#if defined(PROBE_SUB)
        const unsigned long long tra0 = __builtin_amdgcn_s_memrealtime();
#endif
        for (int it = F.bid; it < 1024; it += F.G) ret_a_item(F, it);
#if defined(PROBE_SUB)
        if (PROBE_SUB == 4) F.tacc += __builtin_amdgcn_s_memrealtime() - tra0;
#endif
        { constexpr int NQT = SEQ / QT, NPAIR = NBATCH * NQT / 2;
          for (int u = F.bid; u < NPAIR; u += F.G) { int b = u / (NQT / 2), j = u % (NQT / 2);
              if (F.G == 256 && NPAIR % 256 == 0) { const int x = F.bid & 7, jj = (u >> 3); b = x & 3; j = (x >> 2) * (NQT / 4) + jj; }
              dsa_a_unit(F, b, j); dsa_a_unit(F, b, NQT - 1 - j); } }
    } SEAM(3);
    STAMP(4); if (IN(4)) {
#if defined(PROBE_SUB)
        const unsigned long long tsc0 = __builtin_amdgcn_s_memrealtime();
#endif
        ret_scan(F);
#if defined(PROBE_SUB)
        if (PROBE_SUB == 5) F.tacc += __builtin_amdgcn_s_memrealtime() - tsc0;
#endif
        __syncthreads();
        phase_dsa_b(F);
    } SEAM(4);
    STAMP(5); if (IN(5)) { for (int it = F.bid; it < 1024; it += F.G) ret_c_item(F, it); } SEAM(5);
    STAMP(6); if (IN(6)) {
        pg8::Gemm g{(const bf16*)(F.ws + WS_MIX), (const bf16*)(F.ws + WS_WO), NTOK, DM, DM}; pg8::StaticOrder S; S.init(NTOK, DM, F.G, F.bid);
        EpiX1 E{F.in(0), (const float*)(F.ws + WS_MOD), F.out};
        pg8::gemm_phase<EpiX1, pg8::StaticOrder, true, true>(F.lds, g, S, E, F.wave);
    } SEAM(6);
    STAMP(7); if (IN(7)) { phase_router(F); } SEAM(7);
    STAMP(8); if (IN(8)) { phase_place(F); } SEAM(8);
    STAMP(9); if (IN(9)) {
        LAS int* tile_e = (LAS int*)(F.lds + TILEE_OFF); const int nt = moe_layout(F, (LAS int*)(F.lds + TILEE_OFF + 4096), tile_e);
        pg8::Gemm g{(const bf16*)(F.ws + WS_XS), (const bf16*)(F.ws + WS_WGU), MOE_ROWS, 2048, DM};
        GroupedOrder S{tile_e, nt, 8, F.G, F.bid, (size_t)2048 * 1024};
        EpiGlu8 E{(unsigned char*)(F.ws + WS_HB), F.in(12)};
        pg8::gemm_phase<EpiGlu8, GroupedOrder, true, true, true>(F.lds, g, S, E, F.wave);
    } SEAM(9);
    STAMP(10); if (IN(10)) {
        LAS int* tile_e = (LAS int*)(F.lds + TILEE_OFF); const int nt = moe_layout(F, (LAS int*)(F.lds + TILEE_OFF + 4096), tile_e);
        pg8::Gemm g{(const bf16*)(F.ws + WS_HB), (const bf16*)(F.ws + WS_WDN), MOE_ROWS, DM, DM};
        GroupedOrder S{tile_e, nt, 4, F.G, F.bid, (size_t)1024 * 1024};
        EpiDownT<true> E{(bf16*)(F.ws + WS_Y), F.in(14), (const int*)(F.ws + WS_ROWINFO), (const float*)(F.ws + WS_ROWGATE)};
        pg8::gemm_phase<EpiDownT<true>, GroupedOrder, true, true, true>(F.lds, g, S, E, F.wave);
    } SEAM(10);
    STAMP(11); if (IN(11)) { phase_final(F); }
    STAMP(12);
#if defined(PROBE_SUB)
    if (F.bid == 0 && F.tid() == 0) { const unsigned long long te = __builtin_amdgcn_s_memrealtime(); while (__builtin_amdgcn_s_memrealtime() - te < F.tacc) __builtin_amdgcn_s_sleep(8); }
#elif defined(PROBE_PHASE)
    if (F.bid == 0 && F.tid() == 0) { const unsigned long long te = __builtin_amdgcn_s_memrealtime(), dur = tp1 - tp0; while (__builtin_amdgcn_s_memrealtime() - te < dur) __builtin_amdgcn_s_sleep(8); }
#endif
#undef IN
#undef SEAM
}

extern "C" void kernel_launch(void* const* d_in, const int* in_sizes, int n_in, void* d_out, int out_size, void* d_ws, size_t ws_size, hipStream_t stream) {
    static int grid = 0;
    if (grid == 0) {
        if (n_in != 16 || out_size != NTOK * DM || ws_size < WS_END) { fprintf(stderr, "kernel_launch: unexpected problem (n_in %d out %d ws %zu); nothing launched\n", n_in, out_size, ws_size); grid = -1; return; }
        int dev = 0, cus = 0;
        if (hipGetDevice(&dev) != hipSuccess || hipDeviceGetAttribute(&cus, hipDeviceAttributeMultiprocessorCount, dev) != hipSuccess) { grid = -1; return; }
        if (hipFuncSetAttribute((const void*)mk_fwd, hipFuncAttributeMaxDynamicSharedMemorySize, LDS_BYTES) != hipSuccess) { fprintf(stderr, "kernel_launch: hipFuncSetAttribute failed\n"); grid = -1; return; }
        int per_cu = 0;
        if (hipOccupancyMaxActiveBlocksPerMultiprocessor(&per_cu, (const void*)mk_fwd, NTHR, LDS_BYTES) != hipSuccess || per_cu < 1) fprintf(stderr, "kernel_launch: occupancy query reports %d workgroups per CU\n", per_cu);
        (void)hipGetLastError();
        grid = cus;
    }
    if (grid < 0) return;
    (void)hipMemsetAsync((char*)d_ws + WS_CTL, 0, CTL_ZERO_BYTES, stream);
    Args a{};
    for (int i = 0; i < 16; ++i) a.in[i] = (const float*)d_in[i];
    a.out = (float*)d_out; a.ws = (unsigned char*)d_ws;
#if MK_N_LAUNCHES == 1
    a.ph_lo = 0; a.ph_hi = N_PHASES;
    hipLaunchKernelGGL(mk_fwd, dim3(grid), dim3(NTHR), LDS_BYTES, stream, a);
#else
    for (int p = 0; p < N_PHASES; ++p) { a.ph_lo = p; a.ph_hi = p + 1; hipLaunchKernelGGL(mk_fwd, dim3(grid), dim3(NTHR), LDS_BYTES, stream, a); }
#endif
}
```

```cpp
#include <hip/hip_runtime.h>
#include <cstdio>
#include <cstdint>

#define LAS __attribute__((address_space(3)))
#define GAS __attribute__((address_space(1)))
typedef unsigned short bf16;
typedef short bf16x8 __attribute__((ext_vector_type(8)));
typedef short s16x4 __attribute__((ext_vector_type(4)));
typedef float f32x4 __attribute__((ext_vector_type(4)));
typedef float f32x16 __attribute__((ext_vector_type(16)));
typedef unsigned u32x4 __attribute__((ext_vector_type(4)));
typedef unsigned u32x2 __attribute__((ext_vector_type(2)));
typedef float f32x2_t __attribute__((ext_vector_type(2)));
typedef __bf16 bf16x2_t __attribute__((ext_vector_type(2)));

constexpr int DM = 1024, NBATCH = 4, SEQ = 8192, NTOK = NBATCH * SEQ;
constexpr int PJ = 3136;
constexpr int IN_COLS = 2888;
constexpr int C_RQ = 0, C_RK = 256, C_RV = 512, C_RG = 1024, C_AQ = 1536, C_AK = 2048, C_AV = 2176, C_IQ = 2304, C_IK = 2816, C_IW = 2880;
constexpr int NE = 32, TOPK = 4, MOE_ROWS = NTOK * TOPK + NE * 256;
constexpr int MOE_TILES = MOE_ROWS / 256;
constexpr float EPS = 1e-6f;
constexpr int NWAVES = 8, NTHR = 512;

constexpr size_t MiB = 1u << 20;
constexpr size_t WS_CTL = 0, CTL_ZERO_BYTES = 1 * MiB;
constexpr size_t WS_MOD = 1 * MiB;
constexpr size_t WS_TOPI = 2 * MiB;
constexpr size_t WS_TOPG = 2 * MiB + 512 * 1024;
constexpr size_t WS_BBASE = 3 * MiB;
constexpr size_t WS_ROWINFO = 4 * MiB;
constexpr size_t WS_ROWGATE = 5 * MiB;
constexpr size_t WS_WIN = 8 * MiB;
constexpr size_t WS_WO = 14 * MiB;
constexpr size_t WS_WGU = 16 * MiB;
constexpr size_t WS_WDN = 144 * MiB;
constexpr size_t WS_H0 = 208 * MiB;
constexpr size_t WS_PROJ = 272 * MiB;
constexpr size_t WS_XS = 208 * MiB;
constexpr size_t WS_Y = 208 * MiB;
constexpr size_t WS_KVT = 480 * MiB;
constexpr size_t WS_RPT = 512 * MiB;
constexpr size_t WS_SEL = 528 * MiB;
constexpr size_t WS_MIX = 544 * MiB;
constexpr size_t WS_H2 = 608 * MiB;
constexpr size_t WS_HB = 480 * MiB;
constexpr size_t WS_END = 752 * MiB;
constexpr int CW_GCNT = 1024;
constexpr int CW_Q1 = 2048;
constexpr int CW_Q3 = 2112;
constexpr int CW_BAR = 4096;

constexpr int LDS_BYTES = 153600;
constexpr int RING_BYTES = 131072;
constexpr int TILEE_OFF = 131072;
constexpr int MISC_OFF = 152576;
constexpr int PTR_OFF = MISC_OFF + 512;

__device__ __forceinline__ int hw_lane() { int l; asm volatile("v_mbcnt_lo_u32_b32 %0, -1, 0\n\tv_mbcnt_hi_u32_b32 %0, -1, %0" : "=v"(l)); return l; }
__device__ __forceinline__ unsigned cvtpk(float lo, float hi) { f32x2_t v = {lo, hi}; bf16x2_t b = __builtin_convertvector(v, bf16x2_t); return __builtin_bit_cast(unsigned, b); }
__device__ __forceinline__ float bflo(unsigned w) { return __builtin_bit_cast(float, w << 16); }
__device__ __forceinline__ float bfhi(unsigned w) { return __builtin_bit_cast(float, w & 0xffff0000u); }
__device__ __forceinline__ float bf2f(bf16 h) { return __builtin_bit_cast(float, (unsigned)h << 16); }
__device__ __forceinline__ bf16 f2bf(float f) { return (bf16)(cvtpk(f, 0.f) & 0xffffu); }
__device__ __forceinline__ float wave_sum(float v) {
#pragma unroll
    for (int o = 1; o < 64; o <<= 1) v += __shfl_xor(v, o);
    return v;
}
__device__ __forceinline__ int mbcnt64(unsigned long long m) { return (int)__builtin_amdgcn_mbcnt_hi((unsigned)(m >> 32), __builtin_amdgcn_mbcnt_lo((unsigned)m, 0u)); }
__device__ __forceinline__ s16x4 trread(const LAS void* p) { typedef short v4i16_t __attribute__((ext_vector_type(4))); return __builtin_bit_cast(s16x4, __builtin_amdgcn_ds_read_tr16_b64_v4i16((LAS v4i16_t*)p)); }
__device__ __forceinline__ bf16x8 cat8(s16x4 lo, s16x4 hi) { return (bf16x8){lo[0], lo[1], lo[2], lo[3], hi[0], hi[1], hi[2], hi[3]}; }
#define MFMA16(a, b, c) __builtin_amdgcn_mfma_f32_16x16x32_bf16((a), (b), (c), 0, 0, 0)
#define MFMA32(a, b, c) __builtin_amdgcn_mfma_f32_32x32x16_bf16((a), (b), (c), 0, 0, 0)

namespace pg8 {
#define PG8_LAS __attribute__((address_space(3)))
typedef unsigned short bf16_t;
typedef short bf16x8 __attribute__((ext_vector_type(8)));
typedef float f32x4 __attribute__((ext_vector_type(4)));
typedef unsigned u32x4 __attribute__((ext_vector_type(4)));
constexpr int BM = 256, BK = 64, HALF = 128, HTB = HALF * BK * 2  , STAGE_BYTES = 8 * HTB, NXCD = 8, WGM = 8;

__host__ __device__ __forceinline__ int lds_byte(int r, int c) { const int st = (r >> 4) * 2 + (c >> 5), rr = r & 15, cc = c & 31, ob = rr * 64 + cc * 2; return st * 1024 + (ob ^ (((ob >> 9) & 1) << 5)); }
__host__ __device__ __forceinline__ void stage_rc(int b, int& R, int& C) { const int st = b / 1024, sb = b % 1024, swz = sb ^ (((sb >> 9) & 1) << 5); R = (st >> 1) * 16 + swz / 64; C = (st & 1) * 32 + (swz % 64) / 2; }
__host__ __device__ __forceinline__ int perm32(int rho) { const int n = rho >> 4, i = rho & 15; return 8 * (i >> 2) + 4 * n + (i & 3); }

typedef int v8i32 __attribute__((ext_vector_type(8))); typedef int v4i32 __attribute__((ext_vector_type(4)));
__device__ __forceinline__ v8i32 pg8_cat(bf16x8 a, bf16x8 b) { return __builtin_shufflevector(__builtin_bit_cast(v4i32, a), __builtin_bit_cast(v4i32, b), 0, 1, 2, 3, 4, 5, 6, 7); }
struct Unit { int pm, pn, e; size_t bo; };
struct Gemm { const bf16_t* A; const bf16_t* Bt; int M, N, K; };

struct StaticOrder {
    int nM, nN, nwg, G, c;
    __host__ __device__ void init(int M, int N, int G_, int c_) { nM = M / BM; nN = N / BM; nwg = nM * nN; G = G_; c = c_; }
    __host__ __device__ bool next(int i, Unit& u) const {
        const long L = (long)i * G + c; if (L >= nwg) return false;
        int wgid = (int)L; { const int q = nwg / NXCD, r = nwg % NXCD, xcd = wgid % NXCD, off = wgid / NXCD; wgid = (xcd < r ? xcd * (q + 1) : r * (q + 1) + (xcd - r) * q) + off; }
        const int nig = WGM * nN, gid = wgid / nig, fm = gid * WGM, gsz = (nM - fm) < WGM ? (nM - fm) : WGM;
        u.pm = fm + ((wgid % nig) % gsz); u.pn = (wgid % nig) / gsz; u.e = 0; u.bo = 0; return true;
    }
    __device__ __forceinline__ void a_ready(const Unit&) const {}
    __device__ __forceinline__ void done(const Unit&) const {}
};

template <class Epi, class Sched, bool ALIGN_EPI = false, bool SP2 = false, bool F8 = false>
__device__ __forceinline__ void gemm_phase(PG8_LAS unsigned char* lds, const Gemm g, const Sched& S, const Epi& E, const int wid) {
    const int lane = hw_lane(), tid = wid * 64 + lane, wr = wid >> 2, wc = wid & 3, fr = lane & 15, fq = lane >> 4;
    constexpr int ESZ = F8 ? 1 : 2;
    const int K = g.K, nt = K * ESZ / (BK * 2);
    unsigned voffA[2], voffB[2];
#pragma unroll
    for (int i = 0; i < 2; ++i) { int R, C; stage_rc(tid * 16 + i * 8192, R, C); const int Rb = Epi::PERM ? ((R & ~31) + perm32(R & 31)) : R;
        voffA[i] = (unsigned)(R * K * ESZ + C * 2); voffB[i] = (unsigned)(Rb * K * ESZ + C * 2); }
    const size_t kstep = (size_t)(BK * 2);
    const size_t hstep = (size_t)HALF * K * ESZ;
    const size_t tstep = 2 * hstep;
    const unsigned ldsw = (unsigned)wid * 1024u;
    const int aoff = lds_byte(wr * 64 + fr, fq * 8), boff = lds_byte(wc * 32 + fr, fq * 8);
#define PG8_SA(b, h) (((b) * 2 + (h)) * HTB)
#define PG8_SB(b, h) ((4 + (b) * 2 + (h)) * HTB)
#define PG8_STAGE(bufoff, gbase, voff) do { _Pragma("unroll") for (int _i = 0; _i < 2; ++_i) { \
        if constexpr (F8) { unsigned _keep; const unsigned _l = (unsigned)(__UINTPTR_TYPE__)(lds + (bufoff) + ldsw + _i * 8192);   \
            asm volatile("s_mov_b32 %0, m0\n\ts_mov_b32 m0, %3\n\ts_nop 0\n\tglobal_load_lds_dwordx4 %1, %2\n\ts_mov_b32 m0, %0" : "=&s"(_keep) : "v"((voff)[_i]), "s"((const char*)(gbase)), "s"(_l) : "memory"); } \
        else __builtin_amdgcn_global_load_lds((const unsigned*)((const char*)(gbase) + (voff)[_i]), (PG8_LAS unsigned*)(lds + (bufoff) + ldsw + _i * 8192), 16, 0, 0); } } while (0)
#define PG8_LDA(dst, b, h) do { _Pragma("unroll") for (int m = 0; m < 4; ++m) _Pragma("unroll") for (int k = 0; k < 2; ++k) dst[m][k] = *(const PG8_LAS bf16x8*)(lds + PG8_SA(b, h) + aoff + m * 2048 + k * 1024); } while (0)
#define PG8_LDB(dst, b, h) do { _Pragma("unroll") for (int n = 0; n < 2; ++n) _Pragma("unroll") for (int k = 0; k < 2; ++k) dst[n][k] = *(const PG8_LAS bf16x8*)(lds + PG8_SB(b, h) + boff + n * 2048 + k * 1024); } while (0)
#define PG8_MMA(ai, bj, At, Bt) do { __builtin_amdgcn_s_setprio(1); _Pragma("unroll") for (int m = 0; m < 4; ++m) _Pragma("unroll") for (int n = 0; n < 2; ++n) { \
        if constexpr (F8) { acc[ai][bj][m][n] = __builtin_amdgcn_mfma_scale_f32_16x16x128_f8f6f4(pg8_cat(Bt[n][0], Bt[n][1]), pg8_cat(At[m][0], At[m][1]), acc[ai][bj][m][n], 0, 0, 0, 0, 0, 0); } \
        else { _Pragma("unroll") for (int k = 0; k < 2; ++k) acc[ai][bj][m][n] = __builtin_amdgcn_mfma_f32_16x16x32_bf16(Bt[n][k], At[m][k], acc[ai][bj][m][n], 0, 0, 0); } } __builtin_amdgcn_s_setprio(0); } while (0)
#define PG8_WAIT_V(n) asm volatile("s_waitcnt vmcnt(" #n ")" ::: "memory")
#define PG8_WAIT_L(n) asm volatile("s_waitcnt lgkmcnt(" #n ")" ::: "memory")
#define PG8_BAR __builtin_amdgcn_s_barrier()
#define PG8_SCHED __builtin_amdgcn_sched_barrier(0)
    Unit cur, nxt; int ui = 0;
    if (!S.next(0, cur)) return;
    f32x4 acc[2][2][4][2];
#pragma unroll
    for (int a = 0; a < 2; ++a)
#pragma unroll
        for (int b = 0; b < 2; ++b)
#pragma unroll
            for (int m = 0; m < 4; ++m)
#pragma unroll
                for (int n = 0; n < 2; ++n) acc[a][b][m][n] = (f32x4){0.f, 0.f, 0.f, 0.f};
    bf16x8 At[4][2], B0[2][2], B1[2][2];
    const char* cA = (const char*)g.A + (size_t)cur.pm * tstep; const char* cB = (const char*)g.Bt + (size_t)cur.pn * tstep + cur.bo;
    S.a_ready(cur);
    if constexpr (SP2) {
        PG8_STAGE(PG8_SB(0, 0), cB, voffB); PG8_STAGE(PG8_SB(0, 1), cB + hstep, voffB); PG8_STAGE(PG8_SA(0, 0), cA, voffA); PG8_STAGE(PG8_SA(0, 1), cA + hstep, voffA);
        if (wr == 1) PG8_BAR;
        PG8_WAIT_V(2); PG8_BAR;
        PG8_STAGE(PG8_SB(1, 0), cB + kstep, voffB); PG8_STAGE(PG8_SA(1, 0), cA + kstep, voffA); PG8_STAGE(PG8_SB(1, 1), cB + hstep + kstep, voffB);
        PG8_WAIT_V(6); PG8_BAR;
    } else {
        PG8_STAGE(PG8_SB(0, 0), cB, voffB); PG8_STAGE(PG8_SA(0, 0), cA, voffA); PG8_STAGE(PG8_SB(0, 1), cB + hstep, voffB); PG8_STAGE(PG8_SA(0, 1), cA + hstep, voffA);
        if (wr == 1) PG8_BAR;
        PG8_WAIT_V(4); PG8_BAR;
        PG8_STAGE(PG8_SB(1, 0), cB + kstep, voffB); PG8_STAGE(PG8_SA(1, 0), cA + kstep, voffA); PG8_STAGE(PG8_SB(1, 1), cB + hstep + kstep, voffB);
        PG8_WAIT_V(6); PG8_BAR;
    }
    for (;;) {
        const bool has_next = S.next(ui + 1, nxt);
        const char* nA = has_next ? (const char*)g.A + (size_t)nxt.pm * tstep : cA; const char* nB = has_next ? (const char*)g.Bt + (size_t)nxt.pn * tstep + nxt.bo : cB;
        for (int t = 0; t < nt; t += 2) {
            const bool last = (t == nt - 2);
            const char* a1 = cA + (size_t)(t + 1) * kstep;
            const char* a2 = last ? nA : cA + (size_t)(t + 2) * kstep; const char* b2 = last ? nB : cB + (size_t)(t + 2) * kstep;
            const char* a3 = a2 + kstep; const char* b3 = b2 + kstep;
            if (last && has_next) S.a_ready(nxt);
            if constexpr (SP2) {
            PG8_LDB(B0, 0, 0); PG8_LDB(B1, 0, 1); PG8_SCHED; PG8_LDA(At, 0, 0); PG8_STAGE(PG8_SA(1, 1), a1 + hstep, voffA);
            PG8_WAIT_V(8); PG8_WAIT_L(0); PG8_BAR; PG8_MMA(0, 0, At, B0); PG8_MMA(0, 1, At, B1); PG8_BAR; PG8_SCHED;
            PG8_LDA(At, 0, 1); PG8_STAGE(PG8_SB(0, 0), b2, voffB); PG8_STAGE(PG8_SB(0, 1), b2 + hstep, voffB); PG8_STAGE(PG8_SA(0, 0), a2, voffA);
            PG8_WAIT_V(8); PG8_WAIT_L(0); PG8_BAR; PG8_MMA(1, 0, At, B0); PG8_MMA(1, 1, At, B1); PG8_BAR; PG8_SCHED;
            PG8_LDB(B0, 1, 0); PG8_LDB(B1, 1, 1); PG8_SCHED; PG8_LDA(At, 1, 0); PG8_STAGE(PG8_SA(0, 1), a2 + hstep, voffA);
            PG8_WAIT_V(8); PG8_WAIT_L(0); PG8_BAR; PG8_MMA(0, 0, At, B0); PG8_MMA(0, 1, At, B1); PG8_BAR; PG8_SCHED;
            PG8_LDA(At, 1, 1); PG8_STAGE(PG8_SB(1, 0), b3, voffB); PG8_STAGE(PG8_SB(1, 1), b3 + hstep, voffB); PG8_STAGE(PG8_SA(1, 0), a3, voffA);
            PG8_WAIT_V(8); PG8_WAIT_L(0); PG8_BAR; PG8_MMA(1, 0, At, B0); PG8_MMA(1, 1, At, B1); PG8_BAR; PG8_SCHED;
            } else {
            PG8_LDB(B0, 0, 0); PG8_SCHED; PG8_LDA(At, 0, 0); PG8_STAGE(PG8_SA(1, 1), a1 + hstep, voffA);
            PG8_WAIT_L(8); PG8_BAR; PG8_WAIT_L(0); PG8_MMA(0, 0, At, B0); PG8_BAR; PG8_SCHED;
            PG8_LDB(B1, 0, 1); PG8_STAGE(PG8_SB(0, 0), b2, voffB);
            PG8_BAR; PG8_WAIT_L(0); PG8_MMA(0, 1, At, B1); PG8_BAR;
            PG8_LDA(At, 0, 1); PG8_STAGE(PG8_SA(0, 0), a2, voffA);
            PG8_BAR; PG8_WAIT_L(0); PG8_MMA(1, 0, At, B0); PG8_BAR; PG8_SCHED;
            PG8_STAGE(PG8_SB(0, 1), b2 + hstep, voffB);
            PG8_WAIT_V(6); PG8_BAR; PG8_MMA(1, 1, At, B1); PG8_BAR;
            PG8_LDB(B0, 1, 0); PG8_SCHED; PG8_LDA(At, 1, 0); PG8_STAGE(PG8_SA(0, 1), a2 + hstep, voffA);
            PG8_WAIT_L(8); PG8_BAR; PG8_WAIT_L(0); PG8_MMA(0, 0, At, B0); PG8_BAR; PG8_SCHED;
            PG8_LDB(B1, 1, 1); PG8_STAGE(PG8_SB(1, 0), b3, voffB);
            PG8_BAR; PG8_WAIT_L(0); PG8_MMA(0, 1, At, B1); PG8_BAR;
            PG8_LDA(At, 1, 1); PG8_STAGE(PG8_SA(1, 0), a3, voffA);
            PG8_BAR; PG8_WAIT_L(0); PG8_MMA(1, 0, At, B0); PG8_BAR; PG8_SCHED;
            PG8_STAGE(PG8_SB(1, 1), b3 + hstep, voffB);
            PG8_WAIT_V(6); PG8_BAR; PG8_MMA(1, 1, At, B1); PG8_BAR;
            }
        }
        if constexpr (ALIGN_EPI) { if (wr == 0) PG8_BAR; }
        if constexpr (!Epi::AFTER_DRAIN) { E(acc, cur, wr, wc, fr, fq); S.done(cur); }
        if (!has_next) break;
#pragma unroll
        for (int a = 0; a < 2; ++a)
#pragma unroll
            for (int b = 0; b < 2; ++b)
#pragma unroll
                for (int m = 0; m < 4; ++m)
#pragma unroll
                    for (int n = 0; n < 2; ++n) acc[a][b][m][n] = (f32x4){0.f, 0.f, 0.f, 0.f};
        cur = nxt; cA = nA; cB = nB; ++ui;
        if constexpr (ALIGN_EPI) { if (wr == 1) PG8_BAR; }
    }
    PG8_WAIT_V(0);
    if constexpr (!ALIGN_EPI) { if (wr == 0) PG8_BAR; }
    PG8_BAR;
    if constexpr (Epi::AFTER_DRAIN) { E.fused(acc, cur, wr, wc, fr, fq, lds, wid, lane); S.done(cur); }
#undef PG8_SA
#undef PG8_SB
#undef PG8_STAGE
#undef PG8_LDA
#undef PG8_LDB
#undef PG8_MMA
#undef PG8_WAIT_V
#undef PG8_WAIT_L
#undef PG8_BAR
#undef PG8_SCHED
}
}

struct EpiProj {
    static constexpr bool PERM = true, AFTER_DRAIN = false;
    bf16* O; int ldc;
    __device__ __forceinline__ void operator()(const f32x4 (&acc)[2][2][4][2], const pg8::Unit& u, int wr, int wc, int fr, int fq) const {
        const int row0 = u.pm * 256 + wr * 64 + fr; const int col0 = u.pn * 256 + wc * 32 + 8 * fq;
#pragma unroll
        for (int ai = 0; ai < 2; ++ai)
#pragma unroll
            for (int m = 0; m < 4; ++m) { bf16* rowp = O + (size_t)(row0 + ai * 128 + m * 16) * ldc + col0;
#pragma unroll
                for (int bj = 0; bj < 2; ++bj) { const f32x4 v0 = acc[ai][bj][m][0], v1 = acc[ai][bj][m][1];
                    u32x4 w; w.x = cvtpk(v0[0], v0[1]); w.y = cvtpk(v0[2], v0[3]); w.z = cvtpk(v1[0], v1[1]); w.w = cvtpk(v1[2], v1[3]);
                    *(u32x4*)(rowp + bj * 128) = w; } }
    }
};
struct EpiX1 {
    static constexpr bool PERM = false, AFTER_DRAIN = false;
    const float* x; const float* mod; float* out;
    __device__ __forceinline__ void operator()(const f32x4 (&acc)[2][2][4][2], const pg8::Unit& u, int wr, int wc, int fr, int fq) const {
        const int col0 = u.pn * 256 + wc * 32 + 4 * fq; const int b = (u.pm * 256) / SEQ;
        f32x4 g[2][2];
#pragma unroll
        for (int bj = 0; bj < 2; ++bj)
#pragma unroll
            for (int n = 0; n < 2; ++n) g[bj][n] = *(const f32x4*)(mod + (size_t)b * 6144 + 2 * 1024 + col0 + bj * 128 + n * 16);
#pragma unroll
        for (int ai = 0; ai < 2; ++ai)
#pragma unroll
            for (int m = 0; m < 4; ++m) { const size_t off = (size_t)(u.pm * 256 + ai * 128 + wr * 64 + m * 16 + fr) * DM + col0;
#pragma unroll
                for (int bj = 0; bj < 2; ++bj)
#pragma unroll
                    for (int n = 0; n < 2; ++n) { const f32x4 xv = *(const f32x4*)(x + off + bj * 128 + n * 16); *(f32x4*)(out + off + bj * 128 + n * 16) = xv + g[bj][n] * acc[ai][bj][m][n]; }
                if (m & 1) asm volatile("" ::: "memory"); }
    }
};
__device__ __forceinline__ float glu_f(float gate, float up) {
    gate = fminf(gate, 7.0f); up = fminf(fmaxf(up, -7.0f), 7.0f);
    const float sg = __builtin_amdgcn_rcpf(1.0f + __expf(-1.702f * gate));
    return (up + 1.0f) * (gate * sg);
}
__device__ __forceinline__ unsigned pk4_fp8(float a, float b, float c, float d) { int w = __builtin_amdgcn_cvt_pk_fp8_f32(a, b, 0, false); w = __builtin_amdgcn_cvt_pk_fp8_f32(c, d, w, true); return (unsigned)w; }
constexpr float W8_SCALE = 64.0f, W8_INV = 1.0f / 64.0f;
struct EpiGlu8 {
    static constexpr bool PERM = true, AFTER_DRAIN = false;
    unsigned char* H; const float* b_gu;
    __device__ __forceinline__ void operator()(const f32x4 (&acc)[2][2][4][2], const pg8::Unit& u, int wr, int wc, int fr, int fq) const {
        const int row0 = u.pm * 256 + wr * 64 + fr; const int c0 = u.pn * 128 + wc * 32 + 8 * fq;
        const float* bg = b_gu + (size_t)u.e * 2048 + c0; const float* bu = bg + 1024;
        const f32x4 bg0 = *(const f32x4*)bg, bg1 = *(const f32x4*)(bg + 4), bu0 = *(const f32x4*)bu, bu1 = *(const f32x4*)(bu + 4);
#pragma unroll
        for (int ai = 0; ai < 2; ++ai)
#pragma unroll
            for (int m = 0; m < 4; ++m) {
                const f32x4 g0 = acc[ai][0][m][0] * W8_INV + bg0, g1 = acc[ai][0][m][1] * W8_INV + bg1, u0 = acc[ai][1][m][0] * W8_INV + bu0, u1 = acc[ai][1][m][1] * W8_INV + bu1;
                u32x2 w; w.x = pk4_fp8(glu_f(g0[0], u0[0]), glu_f(g0[1], u0[1]), glu_f(g0[2], u0[2]), glu_f(g0[3], u0[3]));
                w.y = pk4_fp8(glu_f(g1[0], u1[0]), glu_f(g1[1], u1[1]), glu_f(g1[2], u1[2]), glu_f(g1[3], u1[3]));
                *(u32x2*)(H + (size_t)(row0 + ai * 128 + m * 16) * DM + c0) = w; }
    }
};
struct EpiGlu {
    static constexpr bool PERM = true, AFTER_DRAIN = false;
    bf16* H; const float* b_gu;
    __device__ __forceinline__ void operator()(const f32x4 (&acc)[2][2][4][2], const pg8::Unit& u, int wr, int wc, int fr, int fq) const {
        const int row0 = u.pm * 256 + wr * 64 + fr; const int c0 = u.pn * 128 + wc * 32 + 8 * fq;
        const float* bg = b_gu + (size_t)u.e * 2048 + c0; const float* bu = bg + 1024;
        const f32x4 bg0 = *(const f32x4*)bg, bg1 = *(const f32x4*)(bg + 4), bu0 = *(const f32x4*)bu, bu1 = *(const f32x4*)(bu + 4);
#pragma unroll
        for (int ai = 0; ai < 2; ++ai)
#pragma unroll
            for (int m = 0; m < 4; ++m) {
                const f32x4 g0 = acc[ai][0][m][0] + bg0, g1 = acc[ai][0][m][1] + bg1, u0 = acc[ai][1][m][0] + bu0, u1 = acc[ai][1][m][1] + bu1;
                u32x4 w; w.x = cvtpk(glu_f(g0[0], u0[0]), glu_f(g0[1], u0[1])); w.y = cvtpk(glu_f(g0[2], u0[2]), glu_f(g0[3], u0[3]));
                w.z = cvtpk(glu_f(g1[0], u1[0]), glu_f(g1[1], u1[1])); w.w = cvtpk(glu_f(g1[2], u1[2]), glu_f(g1[3], u1[3]));
                *(u32x4*)(H + (size_t)(row0 + ai * 128 + m * 16) * DM + c0) = w; }
    }
};
template <bool F8> struct EpiDownT {
    static constexpr bool PERM = true, AFTER_DRAIN = false;
    bf16* Y; const float* b_down; const int* rowinfo; const float* rowgate;
    __device__ __forceinline__ void operator()(const f32x4 (&acc)[2][2][4][2], const pg8::Unit& u, int wr, int wc, int fr, int fq) const {
        const int row0 = u.pm * 256 + wr * 64 + fr; const int col0 = u.pn * 256 + wc * 32 + 8 * fq;
        const float* bd = b_down + (size_t)u.e * 1024 + col0;
        f32x4 bv[2][2];
#pragma unroll
        for (int bj = 0; bj < 2; ++bj)
#pragma unroll
            for (int n = 0; n < 2; ++n) bv[bj][n] = *(const f32x4*)(bd + bj * 128 + 4 * n);
#pragma unroll
        for (int ai = 0; ai < 2; ++ai)
#pragma unroll
            for (int m = 0; m < 4; ++m) { const int row = row0 + ai * 128 + m * 16; const int dst = rowinfo[row]; const float gt = rowgate[row];
                if (dst >= 0) { bf16* rowp = Y + (size_t)dst * DM + col0;
#pragma unroll
                    for (int bj = 0; bj < 2; ++bj) { const float sa = F8 ? W8_INV : 1.0f; const f32x4 v0 = (acc[ai][bj][m][0] * sa + bv[bj][0]) * gt, v1 = (acc[ai][bj][m][1] * sa + bv[bj][1]) * gt;
                        u32x4 w; w.x = cvtpk(v0[0], v0[1]); w.y = cvtpk(v0[2], v0[3]); w.z = cvtpk(v1[0], v1[1]); w.w = cvtpk(v1[2], v1[3]);
                        *(u32x4*)(rowp + bj * 128) = w; } } }
    }
};
struct GroupedOrder {
    const LAS int* tile_e; int ntiles, nN, G, c; size_t estride;
    __device__ __forceinline__ bool next(int i, pg8::Unit& u) const {
        int pm, pn;
        if (G == 256) { const int x = c & 7, j = c >> 3, rpx = 32 / nN; pn = j % nN; pm = i * (8 * rpx) + x * rpx + j / nN; }
        else { const long L = (long)i * G + c; pm = (int)(L / nN); pn = (int)(L % nN); }
        if (pm >= ntiles) return false;
        u.pm = pm; u.pn = pn; u.e = __builtin_amdgcn_readfirstlane(tile_e[pm]); u.bo = (size_t)u.e * estride; return true;
    }
    __device__ __forceinline__ void a_ready(const pg8::Unit&) const {}
    __device__ __forceinline__ void done(const pg8::Unit&) const {}
};

#define XB_TMO      128
#define XB_XCNT(j)  (256  + 64 * (j))
#define XB_XSUB(j)  (1280 + 64 * (j))
#define XB_XGEN(j)  (2304 + 64 * (j))
#define XB_TOP      3328
#define XB_TOPGEN   3392
#define XCD_BAR_WORDS 3456
#define XB_SPIN_CAP (1u << 18)

__device__ __forceinline__ unsigned xb_ld(unsigned* p)              { return __hip_atomic_load(p, __ATOMIC_RELAXED, __HIP_MEMORY_SCOPE_AGENT); }
__device__ __forceinline__ unsigned xb_add(unsigned* p, unsigned v) { return __hip_atomic_fetch_add(p, v, __ATOMIC_RELAXED, __HIP_MEMORY_SCOPE_AGENT); }
__device__ __forceinline__ unsigned xb_xcc_id() { return (unsigned)__builtin_amdgcn_s_getreg((3 << 11) | 20) & 0xFu; }
#define XB_SPIN(cond, bar) do { unsigned _sp = 0; while (cond) { __builtin_amdgcn_s_sleep(1); \
    if ((++_sp & 255u) == 0u) { if (xb_ld(&(bar)[XB_TMO])) break; if (_sp > XB_SPIN_CAP) { atomicAdd(&(bar)[XB_TMO], 1u); break; } } } } while (0)

struct XcdBarrier {
    unsigned* bar; unsigned x; bool w0;
    volatile LAS unsigned* st;
};

__device__ __forceinline__ XcdBarrier xcd_barrier_post(unsigned* bar, volatile LAS unsigned* st, bool w0) {
    XcdBarrier b; b.bar = bar; b.x = xb_xcc_id(); b.st = st; b.w0 = w0;
    if (w0 && hw_lane() == 0) (void)xb_add(&bar[XB_XCNT(b.x)], 1u);
    return b;
}
__device__ __forceinline__ void xcd_barrier_complete(unsigned* bar, unsigned x, unsigned& nloc, unsigned& nx) {
    const unsigned G = gridDim.x * gridDim.y * gridDim.z;
    unsigned sum, cnt, mine, sp = 0u;
    for (;;) {
        sum = 0u; cnt = 0u; mine = 0u;
#pragma unroll
        for (unsigned j = 0; j < 16; ++j) { const unsigned c = xb_ld(&bar[XB_XCNT(j)]); sum += c; cnt += (c > 0u) ? 1u : 0u; mine = (j == x) ? c : mine; }
        if (sum == G) break;
        __builtin_amdgcn_s_sleep(1);
        if ((++sp & 255u) == 0u) { if (xb_ld(&bar[XB_TMO])) break; if (sp > XB_SPIN_CAP) { atomicAdd(&bar[XB_TMO], 1u); break; } }
    }
    nloc = mine > 0u ? mine : 1u; nx = cnt > 0u ? cnt : 1u;
}

__device__ __forceinline__ void xcd_barrier(const XcdBarrier& b) {
    asm volatile("s_waitcnt vmcnt(0)" ::: "memory");
    __syncthreads();
    if (b.w0 && hw_lane() == 0) {
        unsigned* bar = b.bar;
        __builtin_amdgcn_s_waitcnt(0);
        unsigned nloc = b.st[0], nx = b.st[1];
        if (nloc == 0u) { xcd_barrier_complete(bar, b.x, nloc, nx); b.st[0] = nloc; b.st[1] = nx; }
        const unsigned old = xb_add(&bar[XB_XSUB(b.x)], 1u);
        const unsigned gen = old / nloc;
        if (old + 1u == (gen + 1u) * nloc) {
            __builtin_amdgcn_fence(__ATOMIC_RELEASE, "agent");
            asm volatile("s_waitcnt vmcnt(0)" ::: "memory");
            const unsigned og = xb_add(&bar[XB_TOP], 1u);
            const unsigned tg = og / nx;
            if (og + 1u == (tg + 1u) * nx) xb_add(&bar[XB_TOPGEN], 1u);
            else XB_SPIN(xb_ld(&bar[XB_TOPGEN]) == tg, bar);
            __builtin_amdgcn_fence(__ATOMIC_ACQUIRE, "agent");
            xb_add(&bar[XB_XGEN(b.x)], 1u);
            asm volatile("s_waitcnt vmcnt(0)" ::: "memory");
        } else {
            XB_SPIN(xb_ld(&bar[XB_XGEN(b.x)]) == gen, bar);
            __builtin_amdgcn_fence(__ATOMIC_ACQUIRE, "agent");
            asm volatile("s_waitcnt vmcnt(0)" ::: "memory");
        }
    }
    __syncthreads();
}

struct Frame {
    LAS unsigned char* lds;
    volatile LAS unsigned* MISC;
    unsigned* ctl;
    int wave, G, bid;
    __device__ __forceinline__ int lane() const { return hw_lane(); }
    __device__ __forceinline__ int tid() const { return wave * 64 + hw_lane(); }
    __device__ __forceinline__ const float* in(int i) const { const LAS unsigned* p = (const LAS unsigned*)(lds + PTR_OFF) + 2 * i;
        const unsigned lo = __builtin_amdgcn_readfirstlane(p[0]), hi = __builtin_amdgcn_readfirstlane(p[1]); return (const float*)(((unsigned long long)hi << 32) | lo); }
    float* out; unsigned char* ws;
    unsigned long long tacc; int xpass;
};
__device__ __forceinline__ float log2gamma(int h) { return log2f(1.0f - exp2f(-5.0f - (float)h)); }

template <bool F8, class RowMap>
__device__ __forceinline__ void transpose_item(const float* W, int N, bf16* WT, int K, const float* kscale, LAS float* scr, int kb, int nb, int lane, RowMap rm) {
    const int k0 = 64 * kb, n0 = 64 * nb;
#pragma unroll 4
    for (int i = 0; i < 16; ++i) {
        const int kk = 4 * i + (lane >> 4), nn = 4 * (lane & 15);
        f32x4 v = (f32x4){0.f, 0.f, 0.f, 0.f};
        if (n0 + nn < N) v = *(const f32x4*)(W + (size_t)(k0 + kk) * N + n0 + nn);
        if (kscale) v = v * kscale[k0 + kk];
        LAS float* s = scr + kk * 65 + nn; s[0] = v[0]; s[1] = v[1]; s[2] = v[2]; s[3] = v[3];
    }
    asm volatile("s_waitcnt lgkmcnt(0)" ::: "memory");
    const int cch = lane & 7;
#pragma unroll
    for (int j = 0; j < 8; ++j) {
        const int n = 8 * j + (lane >> 3); const LAS float* s = scr + (8 * cch) * 65 + n;
        if constexpr (F8) {
            u32x2 o; o.x = pk4_fp8(s[0 * 65] * W8_SCALE, s[1 * 65] * W8_SCALE, s[2 * 65] * W8_SCALE, s[3 * 65] * W8_SCALE); o.y = pk4_fp8(s[4 * 65] * W8_SCALE, s[5 * 65] * W8_SCALE, s[6 * 65] * W8_SCALE, s[7 * 65] * W8_SCALE);
            if (n0 + n < N) *(u32x2*)((unsigned char*)WT + (size_t)rm(n0 + n) * K + k0 + 8 * cch) = o;
        } else {
        const float cs = (N == IN_COLS && n0 + n >= C_AQ && n0 + n < C_AK) ? 0.125f : 1.0f;
        u32x4 o; o.x = cvtpk(s[0 * 65] * cs, s[1 * 65] * cs); o.y = cvtpk(s[2 * 65] * cs, s[3 * 65] * cs); o.z = cvtpk(s[4 * 65] * cs, s[5 * 65] * cs); o.w = cvtpk(s[6 * 65] * cs, s[7 * 65] * cs);
        if (n0 + n < N) *(u32x4*)(WT + (size_t)rm(n0 + n) * K + k0 + 8 * cch) = o; }
    }
    asm volatile("s_waitcnt lgkmcnt(0)" ::: "memory");
}
__device__ __forceinline__ void f8_item_load(const float* W, int N, int kb, int nb, int lane, f32x4 (&v)[16]) {
    const int k0 = 128 * kb, n0 = 32 * nb;
#pragma unroll
    for (int i = 0; i < 16; ++i) v[i] = *(const f32x4*)(W + (size_t)(k0 + 8 * i + (lane >> 3)) * N + n0 + 4 * (lane & 7));
}
template <class RowMap>
__device__ __forceinline__ void f8_item_store(const f32x4 (&v)[16], unsigned char* WT, int K, LAS float* scr, int kb, int nb, int lane, RowMap rm) {
    const int k0 = 128 * kb, n0 = 32 * nb;
#pragma unroll
    for (int i = 0; i < 16; ++i) { LAS float* s = scr + (8 * i + (lane >> 3)) * 33 + 4 * (lane & 7); s[0] = v[i][0]; s[1] = v[i][1]; s[2] = v[i][2]; s[3] = v[i][3]; }
    asm volatile("s_waitcnt lgkmcnt(0)" ::: "memory");
    const int cch = lane & 7;
#pragma unroll
    for (int j = 0; j < 4; ++j) {
        const int n = 8 * j + (lane >> 3); const LAS float* s = scr + (16 * cch) * 33 + n;
        u32x4 o; o.x = pk4_fp8(s[0 * 33] * W8_SCALE, s[1 * 33] * W8_SCALE, s[2 * 33] * W8_SCALE, s[3 * 33] * W8_SCALE); o.y = pk4_fp8(s[4 * 33] * W8_SCALE, s[5 * 33] * W8_SCALE, s[6 * 33] * W8_SCALE, s[7 * 33] * W8_SCALE);
        o.z = pk4_fp8(s[8 * 33] * W8_SCALE, s[9 * 33] * W8_SCALE, s[10 * 33] * W8_SCALE, s[11 * 33] * W8_SCALE); o.w = pk4_fp8(s[12 * 33] * W8_SCALE, s[13 * 33] * W8_SCALE, s[14 * 33] * W8_SCALE, s[15 * 33] * W8_SCALE);
        *(u32x4*)(WT + (size_t)rm(n0 + n) * K + k0 + 16 * cch) = o;
    }
    asm volatile("s_waitcnt lgkmcnt(0)" ::: "memory");
}
struct RmId { __device__ __forceinline__ int operator()(int n) const { return n; } };
struct RmGu { __device__ __forceinline__ int operator()(int n) const { const int j = n & 1023; return (j >> 7) * 256 + (n >> 10) * 128 + (j & 127); } };

__device__ __forceinline__ void phase_p0a(Frame& F) {
    const float* const c_in = F.in(1); const float* const ada_w = F.in(2); const float* const ada_b = F.in(3); const float* const w_in = F.in(5); const float* const mix_scale = F.in(6);
    const float* const w_o = F.in(7); const float* const w_gu = F.in(11); const float* const w_down = F.in(13);
    if (F.bid < 96) {
        LAS float* sc = (LAS float*)F.lds;
        LAS float* part = (LAS float*)(F.lds + 16384);
        for (int i = F.tid(); i < 1024; i += NTHR) {
#pragma unroll
            for (int b = 0; b < 4; ++b) { const float cv = c_in[b * 1024 + i]; sc[i * 4 + b] = cv / (1.0f + __expf(-cv)); }
        }
        __syncthreads();
        const int j0 = F.bid * 64;
        float a0 = 0.f, a1 = 0.f, a2 = 0.f, a3 = 0.f;
#pragma unroll 8
        for (int ii = 0; ii < 128; ++ii) {
            const int i = F.wave * 128 + ii; const float w = ada_w[(size_t)i * 6144 + j0 + F.lane()];
            const f32x4 s4 = *(const LAS f32x4*)(sc + i * 4);
            a0 += s4[0] * w; a1 += s4[1] * w; a2 += s4[2] * w; a3 += s4[3] * w;
        }
        part[(F.wave * 4 + 0) * 64 + F.lane()] = a0; part[(F.wave * 4 + 1) * 64 + F.lane()] = a1; part[(F.wave * 4 + 2) * 64 + F.lane()] = a2; part[(F.wave * 4 + 3) * 64 + F.lane()] = a3;
        __syncthreads();
        if (F.tid() < 256) { const int b = F.tid() >> 6, l = F.tid() & 63; float s = ada_b[j0 + l];
#pragma unroll
            for (int w = 0; w < 8; ++w) s += part[(w * 4 + b) * 64 + l];
            ((float*)(F.ws + WS_MOD))[b * 6144 + j0 + l] = s; }
        __syncthreads();
    }
    { int* ri = (int*)(F.ws + WS_ROWINFO); for (int i = F.bid * NTHR + F.tid(); i < MOE_ROWS; i += F.G * NTHR) ri[i] = -1; }
    LAS float* scr = (LAS float*)(F.lds + F.wave * 16896);
    const int gw = F.bid * NWAVES + F.wave, NGW = F.G * NWAVES;
    constexpr int I_IN = 16 * 46, I_O = 16 * 16, I_GU = 32 * 16 * 32, I_DN = 32 * 16 * 16, NITEMS = I_IN + I_O + I_GU + I_DN;
    { auto item_src = [&](int r, const float*& W, int& N, int& kb, int& nb) { if (r < I_GU) { const int e = r / 512, q = r % 512; W = w_gu + (size_t)e * 1024 * 2048; N = 2048; kb = q / 64; nb = q % 64; }
                                                                               else { r -= I_GU; const int e = r / 256, q = r % 256; W = w_down + (size_t)e * 1024 * 1024; N = 1024; kb = q / 32; nb = q % 32; } };
      f32x4 va[16], vb[16]; int it = gw;
      const float* W; int N, kb, nb;
      if (it < I_GU + I_DN) { item_src(it, W, N, kb, nb); f8_item_load(W, N, kb, nb, F.lane(), va); }
      while (it < I_GU + I_DN) {
          const int itn = it + NGW; const float* Wn = nullptr; int Nn = 0, kbn = 0, nbn = 0;
          if (itn < I_GU + I_DN) { item_src(itn, Wn, Nn, kbn, nbn); f8_item_load(Wn, Nn, kbn, nbn, F.lane(), vb); }
          if (it < I_GU) f8_item_store(va, F.ws + WS_WGU + (size_t)(it / 512) * 2048 * 1024, 1024, scr, kb, nb, F.lane(), RmGu());
          else f8_item_store(va, F.ws + WS_WDN + (size_t)((it - I_GU) / 256) * 1024 * 1024, 1024, scr, kb, nb, F.lane(), RmId());
#pragma unroll
          for (int i = 0; i < 16; ++i) va[i] = vb[i];
          it = itn; kb = kbn; nb = nbn;
      } }
    for (int it = gw; it < I_IN + I_O; it += NGW) {
        int r = it;
        if (r < I_IN) { transpose_item<false>(w_in, IN_COLS, (bf16*)(F.ws + WS_WIN), 1024, nullptr, scr, r / 46, r % 46, F.lane(), RmId()); continue; } r -= I_IN;
        transpose_item<false>(w_o, 1024, (bf16*)(F.ws + WS_WO), 1024, mix_scale, scr, r / 16, r % 16, F.lane(), RmId());
    }
}

__device__ __forceinline__ void phase_p0b(Frame& F) {
    const float* const x_in = F.in(0); const float* const norm1_g = F.in(4);
    const int gw = F.bid * NWAVES + F.wave, NGW = F.G * NWAVES;
    const float* mod = (const float*)(F.ws + WS_MOD); bf16* h0 = (bf16*)(F.ws + WS_H0);
    for (int m = gw; m < NTOK; m += NGW) {
        const int b = m / SEQ;
        const f32x4* xr = (const f32x4*)(x_in + (size_t)m * DM) + F.lane();
        f32x4 v[4]; float s = 0.f;
#pragma unroll
        for (int j = 0; j < 4; ++j) { v[j] = xr[64 * j]; s += (v[j][0] * v[j][0] + v[j][1] * v[j][1]) + (v[j][2] * v[j][2] + v[j][3] * v[j][3]); }
        const float rstd = rsqrtf(wave_sum(s) * (1.f / DM) + EPS);
        u32x2* o8 = (u32x2*)(h0 + (size_t)m * DM) + F.lane();
#pragma unroll
        for (int j = 0; j < 4; ++j) { const int col = 4 * F.lane() + 256 * j;
            const f32x4 g = *(const f32x4*)(norm1_g + col), sh = *(const f32x4*)(mod + b * 6144 + col), sc = *(const f32x4*)(mod + b * 6144 + 1024 + col);
            const f32x4 y = (v[j] * rstd) * g * (sc + 1.0f) + sh;
            u32x2 w; w.x = cvtpk(y[0], y[1]); w.y = cvtpk(y[2], y[3]); o8[64 * j] = w; }
    }
}

constexpr int VSTR = 144, KSTR = 80;
__device__ __forceinline__ void ret_stage_v(Frame& F, const bf16* proj, int tok0, int h, LAS bf16* Vs) {
    const int row = F.tid() >> 2, q = F.tid() & 3; const bf16* src = proj + (size_t)(tok0 + row) * PJ + C_RV + h * 128 + q * 32;
#pragma unroll
    for (int i = 0; i < 4; ++i) *(LAS u32x4*)(Vs + row * VSTR + q * 32 + 8 * i) = *(const u32x4*)(src + 8 * i);
}
__device__ __forceinline__ void ret_stage64(Frame& F, const bf16* src0, size_t pitch, LAS bf16* Ds) {
    const int row = F.tid() >> 2, q = F.tid() & 3; const bf16* src = src0 + (size_t)row * pitch + q * 16;
#pragma unroll
    for (int i = 0; i < 2; ++i) *(LAS u32x4*)(Ds + row * KSTR + q * 16 + 8 * i) = *(const u32x4*)(src + 8 * i);
}
__device__ __forceinline__ void ret_a_item(Frame& F, int item) {
    const bf16* proj = (const bf16*)(F.ws + WS_PROJ); float* kvt = (float*)(F.ws + WS_KVT) + (size_t)item * 8192;
    const int bh = item >> 6, n = item & 63, b = bh >> 2, h = bh & 3, tok0 = b * SEQ + n * 128;
    LAS bf16* Vs = (LAS bf16*)F.lds; LAS bf16* Ks = (LAS bf16*)(F.lds + 128 * VSTR * 2);
    const float lg = log2gamma(h);
    ret_stage_v(F, proj, tok0, h, Vs);
    { const int row = F.tid() >> 2, q = F.tid() & 3; const bf16* src = proj + (size_t)(tok0 + row) * PJ + C_RK + h * 64 + q * 16; const float dk = 0.125f * exp2f((float)(127 - row) * lg);
#pragma unroll
      for (int i = 0; i < 2; ++i) { const u32x4 w = *(const u32x4*)(src + 8 * i); u32x4 o;
          o.x = cvtpk(bflo(w.x) * dk, bfhi(w.x) * dk); o.y = cvtpk(bflo(w.y) * dk, bfhi(w.y) * dk); o.z = cvtpk(bflo(w.z) * dk, bfhi(w.z) * dk); o.w = cvtpk(bflo(w.w) * dk, bfhi(w.w) * dk);
          *(LAS u32x4*)(Ks + row * KSTR + q * 16 + 8 * i) = o; } }
    __syncthreads();
    const int lane = F.lane(), n16 = lane & 15, c = lane >> 4, q4 = n16 >> 2, p4 = lane & 3, e0 = 16 * F.wave;
    f32x4 acc[4];
#pragma unroll
    for (int dt = 0; dt < 4; ++dt) acc[dt] = (f32x4){0.f, 0.f, 0.f, 0.f};
#pragma unroll
    for (int s = 0; s < 4; ++s) {
        const LAS bf16* ap = Vs + (32 * s + 4 * c + q4) * VSTR + e0 + 4 * p4;
        const bf16x8 A = cat8(trread(ap), trread(ap + 16 * VSTR));
#pragma unroll
        for (int dt = 0; dt < 4; ++dt) { const LAS bf16* bp = Ks + (32 * s + 4 * c + q4) * KSTR + 16 * dt + 4 * p4;
            const bf16x8 B = cat8(trread(bp), trread(bp + 16 * KSTR)); acc[dt] = MFMA16(A, B, acc[dt]); }
    }
#pragma unroll
    for (int dt = 0; dt < 4; ++dt)
#pragma unroll
        for (int r = 0; r < 4; ++r) kvt[(e0 + 4 * c + r) * 64 + 16 * dt + n16] = acc[dt][r];
    __syncthreads();
}
__device__ __forceinline__ void ret_scan(Frame& F) {
    const float* kvt = (const float*)(F.ws + WS_KVT); bf16* rpt = (bf16*)(F.ws + WS_RPT);
    for (int g = F.bid * NTHR + F.tid(); g < 16 * 8192; g += F.G * NTHR) {
        const int bh = g >> 13, ed = g & 8191, h = bh & 3; const float gC = exp2f(128.0f * log2gamma(h));
        float R = 0.f; const size_t base = (size_t)bh * 64 * 8192 + ed;
#pragma unroll 8
        for (int n = 0; n < 64; ++n) { const float kv = kvt[base + (size_t)n * 8192]; rpt[base + (size_t)n * 8192] = f2bf(R); R = R * gC + kv; }
    }
}
__device__ __forceinline__ void ret_c_item(Frame& F, int item) {
    const bf16* proj = (const bf16*)(F.ws + WS_PROJ); const bf16* rpt = (const bf16*)(F.ws + WS_RPT) + (size_t)item * 8192; bf16* mix = (bf16*)(F.ws + WS_MIX);
    const int bh = item >> 6, n = item & 63, b = bh >> 2, h = bh & 3, tok0 = b * SEQ + n * 128;
    LAS bf16* Qs = (LAS bf16*)F.lds; LAS bf16* Ks = Qs + 128 * KSTR; LAS bf16* Vs = Ks + 128 * KSTR; LAS bf16* Rs = Vs + 128 * VSTR;
    const float lg = log2gamma(h);
    ret_stage64(F, proj + (size_t)tok0 * PJ + C_RQ + h * 64, PJ, Qs);
    ret_stage64(F, proj + (size_t)tok0 * PJ + C_RK + h * 64, PJ, Ks);
    ret_stage_v(F, proj, tok0, h, Vs);
    ret_stage64(F, rpt, 64, Rs);
    __syncthreads();
    const int lane = F.lane(), n16 = lane & 15, c = lane >> 4, q4 = n16 >> 2, p4 = lane & 3, w = F.wave, i0 = 16 * w, il = i0 + n16;
    bf16x8 qf[2];
#pragma unroll
    for (int s = 0; s < 2; ++s) qf[s] = *(const LAS bf16x8*)(Qs + il * KSTR + 32 * s + 8 * c);
    f32x4 oin[8], ocr[8];
#pragma unroll
    for (int et = 0; et < 8; ++et) { oin[et] = (f32x4){0.f, 0.f, 0.f, 0.f}; ocr[et] = (f32x4){0.f, 0.f, 0.f, 0.f}; }
    const int nsp = (w >> 1) + 1;
    for (int sp = 0; sp < nsp; ++sp) {
        unsigned pw[4];
#pragma unroll
        for (int t2 = 0; t2 < 2; ++t2) { const int jt = 2 * sp + t2;
            const bf16x8 k0 = *(const LAS bf16x8*)(Ks + (16 * jt + n16) * KSTR + 8 * c), k1 = *(const LAS bf16x8*)(Ks + (16 * jt + n16) * KSTR + 32 + 8 * c);
            f32x4 st = MFMA16(k0, qf[0], ((f32x4){0.f, 0.f, 0.f, 0.f})); st = MFMA16(k1, qf[1], st);
            float pv[4];
#pragma unroll
            for (int r = 0; r < 4; ++r) { const int j = 16 * jt + 4 * c + r; const float f = (il >= j) ? 0.125f * exp2f((float)(il - j) * lg) : 0.f; pv[r] = st[r] * f; }
            pw[2 * t2] = cvtpk(pv[0], pv[1]); pw[2 * t2 + 1] = cvtpk(pv[2], pv[3]); }
        const bf16x8 P = __builtin_bit_cast(bf16x8, ((u32x4){pw[0], pw[1], pw[2], pw[3]}));
#pragma unroll
        for (int et = 0; et < 8; ++et) { const LAS bf16* ap = Vs + (32 * sp + 4 * c + q4) * VSTR + 16 * et + 4 * p4;
            const bf16x8 A = cat8(trread(ap), trread(ap + 16 * VSTR)); oin[et] = MFMA16(A, P, oin[et]); }
    }
#pragma unroll
    for (int et = 0; et < 8; ++et)
#pragma unroll
        for (int s = 0; s < 2; ++s) { const bf16x8 rf = *(const LAS bf16x8*)(Rs + (16 * et + n16) * KSTR + 32 * s + 8 * c); ocr[et] = MFMA16(rf, qf[s], ocr[et]); }
    const float qd = exp2f((float)(il + 1) * lg);
    float ss = 0.f;
#pragma unroll
    for (int et = 0; et < 8; ++et) { oin[et] = oin[et] + ocr[et] * qd; ss += (oin[et][0] * oin[et][0] + oin[et][1] * oin[et][1]) + (oin[et][2] * oin[et][2] + oin[et][3] * oin[et][3]); }
    ss += __shfl_xor(ss, 16); ss += __shfl_xor(ss, 32);
    const float rstd = rsqrtf(ss * (1.f / 128.f) + EPS);
    const bf16* gp = proj + (size_t)(tok0 + il) * PJ + C_RG + h * 128 + 4 * c; bf16* op = mix + (size_t)(tok0 + il) * DM + h * 128 + 4 * c;
#pragma unroll
    for (int et = 0; et < 8; ++et) { const u32x2 gw = *(const u32x2*)(gp + 16 * et);
        const float g0 = bflo(gw.x), g1 = bfhi(gw.x), g2 = bflo(gw.y), g3 = bfhi(gw.y);
        const float y0 = g0 / (1.f + __expf(-g0)) * (oin[et][0] * rstd), y1 = g1 / (1.f + __expf(-g1)) * (oin[et][1] * rstd), y2 = g2 / (1.f + __expf(-g2)) * (oin[et][2] * rstd), y3 = g3 / (1.f + __expf(-g3)) * (oin[et][3] * rstd);
        u32x2 o; o.x = cvtpk(y0, y1); o.y = cvtpk(y2, y3); *(u32x2*)(op + 16 * et) = o; }
    __syncthreads();
}

constexpr int MTW = 2;
constexpr int RPW = 4 * MTW, QT = 8 * RPW, KT = 64, CAP = 131072 / (QT * 4), CAP_TRIG = CAP - KT, NSEL = 256, NREG = CAP / 64;
constexpr int KTS = 72;
constexpr int CAND_BYTES = QT * CAP * 4, KTILE_BYTES = KT * KTS * 2;
constexpr float WSCALE = 0.125f * 0.35355339059327373f;
__device__ __forceinline__ unsigned fmap(float s) { const unsigned u = __builtin_bit_cast(unsigned, s); return (u & 0x80000000u) ? ~u : (u | 0x80000000u); }
__device__ __forceinline__ float funmap(unsigned m) { const unsigned u = (m & 0x80000000u) ? (m ^ 0x80000000u) : ~m; return __builtin_bit_cast(float, u); }
#define DPP_ROR(v, n) ((unsigned)__builtin_amdgcn_update_dpp(0, (int)(v), 0x120 + (n), 0xf, 0xf, false))
#define DPP_SHR0(v, n) ((unsigned)__builtin_amdgcn_update_dpp(0, (int)(v), 0x110 + (n), 0xf, 0xf, true))
__device__ __forceinline__ unsigned wave_umin(unsigned v) {
    v = min(v, DPP_ROR(v, 1)); v = min(v, DPP_ROR(v, 2)); v = min(v, DPP_ROR(v, 4)); v = min(v, DPP_ROR(v, 8));
    const unsigned a = __builtin_amdgcn_readlane(v, 0), b = __builtin_amdgcn_readlane(v, 16), c = __builtin_amdgcn_readlane(v, 32), d = __builtin_amdgcn_readlane(v, 48);
    return min(min(a, b), min(c, d));
}
__device__ __forceinline__ unsigned wave_umax(unsigned v) {
    v = max(v, DPP_ROR(v, 1)); v = max(v, DPP_ROR(v, 2)); v = max(v, DPP_ROR(v, 4)); v = max(v, DPP_ROR(v, 8));
    const unsigned a = __builtin_amdgcn_readlane(v, 0), b = __builtin_amdgcn_readlane(v, 16), c = __builtin_amdgcn_readlane(v, 32), d = __builtin_amdgcn_readlane(v, 48);
    return max(max(a, b), max(c, d));
}
__device__ __forceinline__ unsigned wave_scan_incl(unsigned v, int lane) {
    v += DPP_SHR0(v, 1); v += DPP_SHR0(v, 2); v += DPP_SHR0(v, 4); v += DPP_SHR0(v, 8);
    const unsigned t0 = __builtin_amdgcn_readlane(v, 15), t1 = __builtin_amdgcn_readlane(v, 31), t2 = __builtin_amdgcn_readlane(v, 47);
    const int rw = lane >> 4;
    return v + (rw == 1 ? t0 : rw == 2 ? t0 + t1 : rw == 3 ? t0 + t1 + t2 : 0u);
}
__device__ __forceinline__ unsigned lt01(int a, int b) { unsigned r; asm("v_sub_u32 %0, %1, %2\n\tv_lshrrev_b32 %0, 31, %0" : "=&v"(r) : "v"(a), "v"(b)); return r; }
#define BIT01(m, j) ({ unsigned _r; asm("v_bfe_u32 %0, %1, %2, 1" : "=v"(_r) : "v"(m), "n"(j)); _r; })
#define LT01(a, b) lt01((int)(a), (int)(b))
__device__ __forceinline__ int select_row(LAS unsigned* row, int cnt, int limit, LAS unsigned* hist, LAS unsigned* trashp, int lane, unsigned& minkey, int need0 = NSEL) {
    unsigned e[NREG]; unsigned act = 0u, keep = 0u;
#pragma unroll
    for (int j = 0; j < NREG; ++j) { const unsigned v = LT01(64 * j + lane, cnt); e[j] = row[64 * j + lane] & (0u - v); act |= v << j; }
    int need = need0; bool first = true;
    for (;;) {
        unsigned lo = 0xFFFFFFFFu, hi = 0u;
#pragma unroll
        for (int j = 0; j < NREG; ++j) { const unsigned a = BIT01(act, j); lo = min(lo, e[j] | (a - 1u)); hi = max(hi, e[j] & (0u - a)); }
        lo = wave_umin(lo); hi = wave_umax(hi);
        if (hi == lo) break;
        hist[lane] = 0u;
        int rb[NREG];
        if (first) {
            const float slo = funmap(lo & 0xFFFFE000u), shi = funmap(hi & 0xFFFFE000u);
            const float scale = (shi > slo) ? 63.999f / (shi - slo) : 0.f;
#pragma unroll
            for (int j = 0; j < NREG; ++j) { const int bn = (int)((funmap(e[j] & 0xFFFFE000u) - slo) * scale); rb[j] = 63 - min(max(bn, 0), 63); }
        } else {
            const float scale = 63.999f / (float)(hi - lo);
#pragma unroll
            for (int j = 0; j < NREG; ++j) { const int bn = (int)((float)(e[j] - lo) * scale); rb[j] = 63 - min(max(bn, 0), 63); }
        }
        first = false;
#pragma unroll
        for (int j = 0; j < NREG; ++j) __hip_atomic_fetch_add(hist + rb[j], BIT01(act, j), __ATOMIC_RELAXED, __HIP_MEMORY_SCOPE_WAVEFRONT);
        const unsigned h = hist[lane];
        const unsigned ps = wave_scan_incl(h, lane);
        const unsigned long long m = __ballot(ps >= (unsigned)need);
        const int ls = (int)__builtin_ctzll(m);
        const int cge = (int)__builtin_amdgcn_readlane(ps, ls), nb = (int)__builtin_amdgcn_readlane(h, ls);
#pragma unroll
        for (int j = 0; j < NREG; ++j) { const unsigned a = BIT01(act, j), kp = a & LT01(rb[j], ls), dr = a & LT01(ls, rb[j]); keep |= kp << j; act &= ~((kp | dr) << j); }
        need -= cge - nb;
        if ((need0 - need) + nb <= limit) break;
    }
    keep |= act;
    const unsigned kcnt = (unsigned)__builtin_popcount(keep); const unsigned incl = wave_scan_incl(kcnt, lane);
    int pos = (int)(incl - kcnt); const int run = (int)__builtin_amdgcn_readlane(incl, 63); unsigned mk = 0xFFFFFFFFu;
#pragma unroll
    for (int j = 0; j < NREG; ++j) { const unsigned k = BIT01(keep, j);
        *(trashp + ((int)((row + pos) - trashp) & -(int)k)) = e[j];
        mk = min(mk, e[j] | (k - 1u)); pos += (int)k; }
    minkey = wave_umin(mk);
    return run;
}
__device__ __forceinline__ int compact_stream(LAS unsigned* row, int cnt, LAS unsigned* hist, LAS unsigned* trashp, int lane, float& thrf) {
    unsigned e[NREG];
#pragma unroll
    for (int j = 0; j < NREG; ++j) e[j] = row[64 * j + lane];
    const unsigned lo = wave_umin(min(e[0], e[1])), hi = wave_umax(max(e[0], e[1]));
    const float slo = funmap(lo & 0xFFFFE000u), shi = funmap(hi & 0xFFFFE000u);
    bool ok = shi > slo; int newcnt = 0, bstar = 0; int bn[NREG]; float scale = 0.f;
    if (ok) {
        scale = 63.999f / (shi - slo);
        hist[lane] = 0u;
#pragma unroll
        for (int j = 0; j < NREG; ++j) { const int b = (int)((funmap(e[j] & 0xFFFFE000u) - slo) * scale); bn[j] = min(max(b, 0), 63);
            __hip_atomic_fetch_add(hist + (63 - bn[j]), LT01(64 * j + lane, cnt), __ATOMIC_RELAXED, __HIP_MEMORY_SCOPE_WAVEFRONT); }
        const unsigned h = hist[lane];
        const unsigned ps = wave_scan_incl(h, lane);
        const unsigned long long m = __ballot(ps >= (unsigned)NSEL);
        const int ls = (int)__builtin_ctzll(m);
        newcnt = (int)__builtin_amdgcn_readlane(ps, ls); bstar = 63 - ls;
        ok = newcnt <= NSEL + 96;
    }
    if (!ok) { unsigned P; const int nc = select_row(row, cnt, NSEL + 64, hist, trashp, lane, P); thrf = funmap(P & 0xFFFFE000u); return nc; }
    unsigned keep = 0u;
#pragma unroll
    for (int j = 0; j < NREG; ++j) keep |= (LT01(64 * j + lane, cnt) & LT01(bstar - 1, bn[j])) << j;
    const unsigned kcnt = (unsigned)__builtin_popcount(keep); const unsigned incl = wave_scan_incl(kcnt, lane);
    int pos = (int)(incl - kcnt); const int run = (int)__builtin_amdgcn_readlane(incl, 63);
#pragma unroll
    for (int j = 0; j < NREG; ++j) { const unsigned k = BIT01(keep, j);
        *(trashp + ((int)((row + pos) - trashp) & -(int)k)) = e[j];
        pos += (int)k; }
    if (bstar > 0) thrf = slo + ((float)bstar - 0.01f) / scale;
    return run;
}
__device__ __forceinline__ int select_final(LAS unsigned* row, int cnt, LAS unsigned* hist, LAS unsigned* trashp, int lane) {
    unsigned e[NREG];
#pragma unroll
    for (int j = 0; j < NREG; ++j) e[j] = row[64 * j + lane] & (0u - LT01(64 * j + lane, cnt));
    const unsigned lo = wave_umin(min(e[0], e[1])), hi = wave_umax(max(e[0], e[1]));
    const float slo = funmap(lo & 0xFFFFE000u), shi = funmap(hi & 0xFFFFE000u);
    bool ok = shi > slo; int nb = 0, bstar = 0, cgt = 0; int bn[NREG];
    if (ok) {
        const float scale = 63.999f / (shi - slo);
        hist[lane] = 0u;
#pragma unroll
        for (int j = 0; j < NREG; ++j) { const int b = (int)((funmap(e[j] & 0xFFFFE000u) - slo) * scale); bn[j] = min(max(b, 0), 63);
            __hip_atomic_fetch_add(hist + (63 - bn[j]), LT01(64 * j + lane, cnt), __ATOMIC_RELAXED, __HIP_MEMORY_SCOPE_WAVEFRONT); }
        const unsigned h = hist[lane];
        const unsigned ps = wave_scan_incl(h, lane);
        const unsigned long long m = __ballot(ps >= (unsigned)NSEL);
        const int ls = (int)__builtin_ctzll(m);
        nb = (int)__builtin_amdgcn_readlane(h, ls); cgt = (int)__builtin_amdgcn_readlane(ps, ls) - nb; bstar = 63 - ls;
        ok = nb <= 64;
    }
    if (!ok) { unsigned P; return select_row(row, cnt, NSEL, hist, trashp, lane, P); }
    unsigned keepm = 0u, bndm = 0u;
#pragma unroll
    for (int j = 0; j < NREG; ++j) { const unsigned v = LT01(64 * j + lane, cnt); keepm |= (v & LT01(bstar, bn[j])) << j; bndm |= (v & (1u - LT01(bstar, bn[j])) & (1u - LT01(bn[j], bstar))) << j; }
    { const unsigned bc = (unsigned)__builtin_popcount(bndm); int bp = (int)(wave_scan_incl(bc, lane) - bc);
#pragma unroll
      for (int j = 0; j < NREG; ++j) { const unsigned k = BIT01(bndm, j); *(trashp + ((int)((hist + bp) - trashp) & -(int)k)) = e[j]; bp += (int)k; } }
    const unsigned x = hist[lane] & (0u - LT01(lane, nb));
    int rank = 0;
    for (int i = 0; i < nb; ++i) rank += (int)(hist[i] > x);
    const int needb = NSEL - cgt;
    { const unsigned kc = (unsigned)__builtin_popcount(keepm); int pos = (int)(wave_scan_incl(kc, lane) - kc);
#pragma unroll
      for (int j = 0; j < NREG; ++j) { const unsigned k = BIT01(keepm, j); *(trashp + ((int)((row + pos) - trashp) & -(int)k)) = e[j]; pos += (int)k; } }
    { const unsigned k = LT01(lane, nb) & LT01(rank, needb); *(trashp + ((int)((row + cgt + rank) - trashp) & -(int)k)) = x; }
    return NSEL;
}
__device__ __forceinline__ float sample_threshold(const LAS unsigned* row, int cnt, int rank, LAS unsigned* hist, int lane) {
    unsigned e[NREG];
#pragma unroll
    for (int j = 0; j < NREG; ++j) e[j] = row[64 * j + lane];
    unsigned lo = 0xFFFFFFFFu, hi = 0u;
#pragma unroll
    for (int j = 0; j < NREG; ++j) { const unsigned v = LT01(64 * j + lane, cnt); lo = min(lo, e[j] | (v - 1u)); hi = max(hi, e[j] & (0u - v)); }
    lo = wave_umin(lo); hi = wave_umax(hi);
    const float slo = funmap(lo & 0xFFFFE000u), shi = funmap(hi & 0xFFFFE000u);
    if (!(shi > slo)) return -INFINITY;
    const float scale = 63.999f / (shi - slo);
    hist[lane] = 0u;
#pragma unroll
    for (int j = 0; j < NREG; ++j) { const int b = (int)((funmap(e[j] & 0xFFFFE000u) - slo) * scale);
        __hip_atomic_fetch_add(hist + (63 - min(max(b, 0), 63)), LT01(64 * j + lane, cnt), __ATOMIC_RELAXED, __HIP_MEMORY_SCOPE_WAVEFRONT); }
    const unsigned ps = wave_scan_incl(hist[lane], lane);
    const int bstar = 63 - (int)__builtin_ctzll(__ballot(ps >= (unsigned)rank));
    return bstar > 0 ? slo + ((float)bstar - 0.01f) / scale : -INFINITY;
}
#if defined(PROBE_SUB)
#define PSUB_T(i) do { const unsigned long long _t = __builtin_amdgcn_s_memrealtime(); if ((i) == PROBE_SUB) F.tacc += _t - psub_last; psub_last = _t; } while (0)
#else
#define PSUB_T(i) do { } while (0)
#endif
#ifndef DSA_EXP
#define DSA_EXP 0
#endif
#define DSA_X(bit) (F.xpass != 0 && (DSA_EXP & (bit)))
__device__ __forceinline__ void dsa_a_wave(Frame& F, int b, int qt, int ws) {
#if defined(PROBE_SUB)
    unsigned long long psub_last = 0ull;
#endif
    const bf16* proj = (const bf16*)(F.ws + WS_PROJ); bf16* sel = (bf16*)(F.ws + WS_SEL);
    LAS unsigned* cand = (LAS unsigned*)F.lds;
    LAS unsigned* hist = (LAS unsigned*)(F.lds + CAND_BYTES) + 64 * F.wave;
    LAS int* rowcnt = (LAS int*)(F.lds + CAND_BYTES + 2048); LAS float* rowthr = (LAS float*)(F.lds + CAND_BYTES + 2048 + 256);
    const int lane = F.lane(), w = F.wave, r32 = lane & 31, hi = lane >> 5;
    const int trash = (CAND_BYTES + 2048 + 512) / 4 + 64 * w + lane;
    const int tokb = b * SEQ, q0 = qt * QT + RPW * ws;
    bf16x8 af[MTW][4]; float wv[MTW][16];
    { const int qq = 2 * ((r32 >> 2) & 1) + (r32 >> 4), hd = ((r32 >> 3) & 1) * 4 + (r32 & 3);
#pragma unroll
      for (int mt = 0; mt < MTW; ++mt) { const bf16* qp = proj + (size_t)(tokb + q0 + 4 * mt + qq) * PJ + C_IQ + hd * 64 + 32 * hi;
#pragma unroll
          for (int s = 0; s < 4; ++s) af[mt][s] = *(const bf16x8*)(qp + 8 * s);
#pragma unroll
          for (int u = 0; u < 2; ++u) { const u32x4 ww = *(const u32x4*)(proj + (size_t)(tokb + q0 + 4 * mt + 2 * hi + u) * PJ + C_IW);
              wv[mt][8 * u + 0] = bflo(ww.x) * WSCALE; wv[mt][8 * u + 1] = bfhi(ww.x) * WSCALE; wv[mt][8 * u + 2] = bflo(ww.y) * WSCALE; wv[mt][8 * u + 3] = bfhi(ww.y) * WSCALE;
              wv[mt][8 * u + 4] = bflo(ww.z) * WSCALE; wv[mt][8 * u + 5] = bfhi(ww.z) * WSCALE; wv[mt][8 * u + 6] = bflo(ww.w) * WSCALE; wv[mt][8 * u + 7] = bfhi(ww.w) * WSCALE; } } }
    float thrf[MTW][2]; int cntv[MTW][2];
    if (lane < RPW) { rowcnt[RPW * w + lane] = 0; rowthr[RPW * w + lane] = -INFINITY; }
    const int NT = (q0 + RPW + KT - 1) / KT;
    const char* kbase = (const char*)(proj + (size_t)tokb * PJ + C_IK + 32 * hi);
    const unsigned koff = (unsigned)r32 * (unsigned)(PJ * 2);
    constexpr int SSTR = 16, SOFF = 7, SRANK = 40;
    for (int pass = (NT >= 2 * SSTR ? 0 : 1); pass < 3; ++pass) {
        const int stride = pass == 0 ? SSTR : 1, kt0 = pass == 0 ? SOFF : 0;
#pragma unroll
        for (int mt = 0; mt < MTW; ++mt)
#pragma unroll
            for (int u = 0; u < 2; ++u) { cntv[mt][u] = 0; thrf[mt][u] = pass == 1 ? rowthr[RPW * w + 4 * mt + 2 * hi + u] : -INFINITY; }
        bf16x8 kc[2][4], kn[2][4];
        { const char* kb0 = kbase + (size_t)kt0 * KT * (PJ * 2);
#pragma unroll
          for (int sub = 0; sub < 2; ++sub)
#pragma unroll
              for (int s = 0; s < 4; ++s) kc[sub][s] = *(const bf16x8*)(kb0 + koff + (unsigned)(sub * 32) * (unsigned)(PJ * 2) + 16 * s); }
        auto tile_step = [&](int kt, bf16x8 (&kc)[2][4], bf16x8 (&kn)[2][4]) {
            PSUB_T(0);
            if (kt + stride < NT) { const char* kb1 = kbase + (size_t)(kt + stride) * KT * (PJ * 2);
#pragma unroll
                for (int sub = 0; sub < 2; ++sub)
#pragma unroll
                    for (int s = 0; s < 4; ++s) kn[sub][s] = *(const bf16x8*)(kb1 + koff + (unsigned)(sub * 32) * (unsigned)(PJ * 2) + 16 * s); }
#pragma unroll
            for (int sub = 0; sub < 2; ++sub) {
                const int key = kt * KT + sub * 32 + r32;
                f32x16 accs[MTW];
#pragma unroll
                for (int mt = 0; mt < MTW; ++mt) {
                    accs[mt] = MFMA32(af[mt][0], kc[sub][0], ((f32x16){0.f, 0.f, 0.f, 0.f, 0.f, 0.f, 0.f, 0.f, 0.f, 0.f, 0.f, 0.f, 0.f, 0.f, 0.f, 0.f}));
#pragma unroll
                    for (int s = 1; s < 4; ++s) accs[mt] = MFMA32(af[mt][s], kc[sub][s], accs[mt]);
                }
#pragma unroll
                for (int mt = 0; mt < MTW; ++mt) {
                    float sc[2] = {0.f, 0.f};
#pragma unroll
                    for (int r = 0; r < 16; ++r) sc[r >> 3] += wv[mt][r] * fmaxf(accs[mt][r], 0.f);
#pragma unroll
                    for (int u = 0; u < 2; ++u) {
                        const int ql = RPW * w + 4 * mt + 2 * hi + u;
                        const bool valid = (sc[u] >= thrf[mt][u]) && (key <= q0 + 4 * mt + 2 * hi + u);
                        const unsigned long long m = __ballot(valid);
                        const int nlo = __builtin_popcount((unsigned)m), nhi = __builtin_popcount((unsigned)(m >> 32));
                        const int off = mbcnt64(m) - (hi ? nlo : 0);
                        cand[valid ? ql * CAP + cntv[mt][u] + off : trash] = (fmap(sc[u]) & 0xFFFFE000u) | (unsigned)(8191 - key);
                        cntv[mt][u] += hi ? nhi : nlo;
                    }
                }
            }
            PSUB_T(1);
            bool anyc = false;
#pragma unroll
            for (int mt = 0; mt < MTW; ++mt)
#pragma unroll
                for (int u = 0; u < 2; ++u) anyc = anyc || (cntv[mt][u] > CAP_TRIG);
            if (__any(anyc)) {
                if ((lane & 31) == 0) {
#pragma unroll
                    for (int mt = 0; mt < MTW; ++mt)
#pragma unroll
                        for (int u = 0; u < 2; ++u) { rowcnt[RPW * w + 4 * mt + 2 * hi + u] = cntv[mt][u]; rowthr[RPW * w + 4 * mt + 2 * hi + u] = thrf[mt][u]; }
                }
#pragma unroll 1
                for (int rr = 0; rr < RPW; ++rr) { const int rowi = RPW * w + rr; const int cq = __builtin_amdgcn_readfirstlane(rowcnt[rowi]);
                    if (cq > NSEL + 64) { float tf = rowthr[rowi]; const int nc = compact_stream(cand + rowi * CAP, cq, hist, cand + trash, lane, tf);
                        if (lane == 0) { rowcnt[rowi] = nc; rowthr[rowi] = tf; } } }
#pragma unroll
                for (int mt = 0; mt < MTW; ++mt)
#pragma unroll
                    for (int u = 0; u < 2; ++u) { cntv[mt][u] = rowcnt[RPW * w + 4 * mt + 2 * hi + u]; thrf[mt][u] = rowthr[RPW * w + 4 * mt + 2 * hi + u]; }
            }
            PSUB_T(7);
        };
        for (int kt = kt0; kt < NT; kt += 2 * stride) { tile_step(kt, kc, kn); if (kt + stride < NT) tile_step(kt + stride, kn, kc); }
        if ((lane & 31) == 0) {
#pragma unroll
            for (int mt = 0; mt < MTW; ++mt)
#pragma unroll
                for (int u = 0; u < 2; ++u) rowcnt[RPW * w + 4 * mt + 2 * hi + u] = cntv[mt][u];
        }
        if (pass == 0) {
#pragma unroll 1
            for (int rr = 0; rr < RPW; ++rr) { const int rowi = RPW * w + rr; const int cq = __builtin_amdgcn_readfirstlane(rowcnt[rowi]); float tf = -INFINITY;
                if (cq > SRANK + 8) tf = sample_threshold(cand + rowi * CAP, cq, SRANK, hist, lane);
                if (lane == 0) rowthr[rowi] = tf; }
        } else {
            bool okall = true;
#pragma unroll 1
            for (int rr = 0; rr < RPW; ++rr) { const int cq = __builtin_amdgcn_readfirstlane(rowcnt[RPW * w + rr]); const int nrow = q0 + rr + 1; okall = okall && (cq >= (nrow < NSEL ? nrow : NSEL)); }
            if (okall) break;
        }
    }
    PSUB_T(5);
#pragma unroll 1
    for (int rr = 0; rr < RPW; ++rr) { const int ql = RPW * w + rr; LAS unsigned* row = cand + ql * CAP; int cq = __builtin_amdgcn_readfirstlane(rowcnt[ql]);
        if (cq > NSEL) cq = select_final(row, cq, hist, cand + trash, lane);
        bf16* so = sel + (size_t)(tokb + q0 + rr) * NSEL;
#pragma unroll
        for (int j = 0; j < 4; ++j) { const int p = 64 * j + lane; const unsigned v = row[p]; so[p] = (p < cq) ? (bf16)(8191u - (v & 0x1FFFu)) : (bf16)0; } }
    PSUB_T(6);
}

constexpr int VROW = 144;
constexpr int DSB_WAVE = 32 * VROW * 2 + 2 * 2048;
static_assert(8 * DSB_WAVE <= MISC_OFF, "DSA-B LDS map");
__device__ __forceinline__ void dsb_gather(const char* kvbase, const LAS unsigned* sl, int chunk, int colbyte, int c, int n16, u32x4 (&r)[8]) {
#pragma unroll
    for (int i = 0; i < 8; ++i) { const unsigned o = sl[32 * chunk + 4 * i + c] + (unsigned)(colbyte + n16 * 16); r[i] = *(const u32x4*)(kvbase + o); }
}
__device__ __forceinline__ void dsb_put_list(LAS unsigned* sl, u32x2 kk, int t, int lane) {
    const unsigned k0 = kk.x & 0xffffu, k1 = kk.x >> 16, k2 = kk.y & 0xffffu, k3 = kk.y >> 16;
    *(LAS u32x4*)(sl + 4 * lane) = (u32x4){k0 * (unsigned)(PJ * 2), k1 * (unsigned)(PJ * 2), k2 * (unsigned)(PJ * 2), k3 * (unsigned)(PJ * 2)};
    *(LAS f32x4*)((LAS float*)(sl + 256) + 4 * lane) = (f32x4){(float)(t - (int)k0), (float)(t - (int)k1), (float)(t - (int)k2), (float)(t - (int)k3)};
}
__device__ __forceinline__ void phase_dsa_b(Frame& F) {
    const bf16* proj = (const bf16*)(F.ws + WS_PROJ); const bf16* sel = (const bf16*)(F.ws + WS_SEL); bf16* mix = (bf16*)(F.ws + WS_MIX);
    const int lane = F.lane(), n16 = lane & 15, c = lane >> 4, q4 = n16 >> 2, p4 = lane & 3, w = F.wave;
    LAS unsigned char* wl = F.lds + w * DSB_WAVE;
    LAS bf16* buf = (LAS bf16*)wl; LAS unsigned* slb = (LAS unsigned*)(wl + 32 * VROW * 2);
    const float nslope[2] = {-exp2f(-(float)((n16 & 3) + 1)), -exp2f(-(float)((n16 & 3) + 5))};
    constexpr float L2E = 1.4426950408889634f;
    for (int blk = F.bid; blk < NTOK / 128; blk += F.G) {
        int T0 = blk * 128;
        if (F.G == 256) { const int x = F.bid & 7, jj = F.bid >> 3; T0 = (x & 3) * SEQ + (jj * 2 + (x >> 2)) * 128; }
        const char* kvbase = (const char*)(proj + (size_t)(T0 / SEQ) * SEQ * PJ);
        int tok = T0 + w;
        u32x4 kr[8], vr[8]; bf16x8 qf[2][2]; u32x2 selnext;
        dsb_put_list(slb, *(const u32x2*)(sel + (size_t)tok * NSEL + 4 * lane), tok % SEQ, lane);
        dsb_gather(kvbase, slb, 0, C_AK * 2, c, n16, kr); dsb_gather(kvbase, slb, 0, C_AV * 2, c, n16, vr);
#pragma unroll
        for (int g = 0; g < 2; ++g)
#pragma unroll
            for (int s = 0; s < 2; ++s) { bf16x8 v = (bf16x8){0, 0, 0, 0, 0, 0, 0, 0};
                if (n16 < 4) v = *(const bf16x8*)(proj + (size_t)tok * PJ + C_AQ + (g * 4 + n16) * 64 + 32 * s + 8 * c);
                qf[g][s] = v; }
        for (int qi = 0; qi < 16; ++qi) {
            const int t = tok % SEQ, nsel = (t + 1 < NSEL) ? t + 1 : NSEL; const int par = qi & 1;
            const LAS unsigned* sl = slb + par * 512; LAS unsigned* sln = slb + (par ^ 1) * 512;
            const bool more = qi + 1 < 16; const int tokn = tok + 8;
            if (more) selnext = *(const u32x2*)(sel + (size_t)tokn * NSEL + 4 * lane);
            float mrun[2] = {-INFINITY, -INFINITY}, lrun[2] = {0.f, 0.f};
            f32x4 O[2][4];
#pragma unroll
            for (int g = 0; g < 2; ++g)
#pragma unroll
                for (int dt = 0; dt < 4; ++dt) O[g][dt] = (f32x4){0.f, 0.f, 0.f, 0.f};
            bf16x8 qn[2][2];
#pragma unroll 4
            for (int ch = 0; ch < 8; ++ch) {
#pragma unroll
                for (int i = 0; i < 8; ++i) *(LAS u32x4*)(buf + (4 * i + c) * VROW + n16 * 8) = kr[i];
                if (ch == 3 && more) dsb_put_list(sln, selnext, tokn % SEQ, lane);
                asm volatile("" ::: "memory");
                if (ch < 7) dsb_gather(kvbase, sl, ch + 1, C_AK * 2, c, n16, kr);
                else if (more) dsb_gather(kvbase, sln, 0, C_AK * 2, c, n16, kr);
                if (ch == 6 && more) {
#pragma unroll
                    for (int g = 0; g < 2; ++g)
#pragma unroll
                        for (int s = 0; s < 2; ++s) { bf16x8 v = (bf16x8){0, 0, 0, 0, 0, 0, 0, 0};
                            if (n16 < 4) v = *(const bf16x8*)(proj + (size_t)tokn * PJ + C_AQ + (g * 4 + n16) * 64 + 32 * s + 8 * c);
                            qn[g][s] = v; } }
                f32x4 acc[2][2];
#pragma unroll
                for (int kt = 0; kt < 2; ++kt)
#pragma unroll
                    for (int g = 0; g < 2; ++g) { const LAS bf16* ap = buf + (16 * kt + n16) * VROW + g * 64 + 8 * c;
                        acc[kt][g] = MFMA16(*(const LAS bf16x8*)ap, qf[g][0], ((f32x4){0.f, 0.f, 0.f, 0.f})); acc[kt][g] = MFMA16(*(const LAS bf16x8*)(ap + 32), qf[g][1], acc[kt][g]); }
#pragma unroll
                for (int kt = 0; kt < 2; ++kt) { const f32x4 d4 = *(const LAS f32x4*)((const LAS float*)(sl + 256) + 32 * ch + 16 * kt + 4 * c);
#pragma unroll
                    for (int r = 0; r < 4; ++r)
#pragma unroll
                        for (int g = 0; g < 2; ++g) acc[kt][g][r] = fmaf(nslope[g], d4[r], acc[kt][g][r]); }
                if (nsel < NSEL) {
#pragma unroll
                    for (int kt = 0; kt < 2; ++kt)
#pragma unroll
                        for (int r = 0; r < 4; ++r) { const bool dead = 32 * ch + 16 * kt + 4 * c + r >= nsel;
#pragma unroll
                            for (int g = 0; g < 2; ++g) acc[kt][g][r] = dead ? -INFINITY : acc[kt][g][r]; }
                }
                bf16x8 pf[2]; float alpha[2]; bool grow = false;
#pragma unroll
                for (int g = 0; g < 2; ++g) {
                    float mx = fmaxf(fmaxf(fmaxf(acc[0][g][0], acc[0][g][1]), fmaxf(acc[0][g][2], acc[0][g][3])), fmaxf(fmaxf(acc[1][g][0], acc[1][g][1]), fmaxf(acc[1][g][2], acc[1][g][3])));
                    mx = fmaxf(mx, __shfl_xor(mx, 16)); mx = fmaxf(mx, __shfl_xor(mx, 32));
                    const float mnew = fmaxf(mrun[g], mx);
                    alpha[g] = (mnew == -INFINITY) ? 1.f : __builtin_amdgcn_exp2f((mrun[g] - mnew) * L2E);
                    grow = grow || (mnew > mrun[g]);
                    mrun[g] = mnew;
                    const float mm2 = (mnew == -INFINITY) ? 0.f : -mnew * L2E; float s = 0.f;
#pragma unroll
                    for (int kt = 0; kt < 2; ++kt)
#pragma unroll
                        for (int r = 0; r < 4; ++r) { const float e = __builtin_amdgcn_exp2f(fmaf(acc[kt][g][r], L2E, mm2)); acc[kt][g][r] = e; s += e; }
                    s += __shfl_xor(s, 16); s += __shfl_xor(s, 32);
                    lrun[g] = lrun[g] * alpha[g] + s;
                    u32x4 pw; pw.x = cvtpk(acc[0][g][0], acc[0][g][1]); pw.y = cvtpk(acc[0][g][2], acc[0][g][3]); pw.z = cvtpk(acc[1][g][0], acc[1][g][1]); pw.w = cvtpk(acc[1][g][2], acc[1][g][3]);
                    pf[g] = __builtin_bit_cast(bf16x8, pw); }
#pragma unroll
                for (int i = 0; i < 8; ++i) *(LAS u32x4*)(buf + (4 * i + c) * VROW + n16 * 8) = vr[i];
                asm volatile("" ::: "memory");
                if (ch < 7) dsb_gather(kvbase, sl, ch + 1, C_AV * 2, c, n16, vr);
                else if (more) dsb_gather(kvbase, sln, 0, C_AV * 2, c, n16, vr);
                if (__any(grow)) {
#pragma unroll
                    for (int g = 0; g < 2; ++g)
#pragma unroll
                        for (int r = 0; r < 4; ++r) { const float a = __builtin_bit_cast(float, __builtin_amdgcn_readlane(__builtin_bit_cast(int, alpha[g]), r));
#pragma unroll
                            for (int dt = 0; dt < 4; ++dt) O[g][dt][r] *= a; }
                }
#pragma unroll
                for (int dt = 0; dt < 4; ++dt) { const LAS bf16* vp = buf + (4 * c + q4) * VROW + dt * 16 + 4 * p4;
                    O[0][dt] = MFMA16(pf[0], cat8(trread(vp), trread(vp + 16 * VROW)), O[0][dt]);
                    O[1][dt] = MFMA16(pf[1], cat8(trread(vp + 64), trread(vp + 64 + 16 * VROW)), O[1][dt]); }
            }
            {
#pragma unroll
                for (int g = 0; g < 2; ++g)
#pragma unroll
                    for (int r = 0; r < 4; ++r) { const float li = __builtin_amdgcn_rcpf(__builtin_bit_cast(float, __builtin_amdgcn_readlane(__builtin_bit_cast(int, lrun[g]), r)));
                        if (lane < 16) {
#pragma unroll
                            for (int dt = 0; dt < 4; ++dt) buf[(g * 4 + r) * 64 + 16 * dt + lane] = f2bf(O[g][dt][r] * li); } }
                const u32x4 ov = *(const LAS u32x4*)(buf + 8 * lane);
                *(u32x4*)(mix + (size_t)tok * DM + 512 + 8 * lane) = ov;
            }
            if (more) {
#pragma unroll
                for (int g = 0; g < 2; ++g)
#pragma unroll
                    for (int s = 0; s < 2; ++s) qf[g][s] = qn[g][s];
            }
            tok = tokn;
        }
    }
}

constexpr int HSTR = 1028;
__device__ __forceinline__ void phase_router(Frame& F) {
    const float* const norm2_g = F.in(8); const float* const router_w = F.in(9); const float* const router_b = F.in(10);
    const float* x1 = F.out; const float* mod = (const float*)(F.ws + WS_MOD); unsigned char* h2 = (unsigned char*)(F.ws + WS_H2);
    int* topi = (int*)(F.ws + WS_TOPI); float* topg = (float*)(F.ws + WS_TOPG); int* bbase = (int*)(F.ws + WS_BBASE);
    LAS float* hs = (LAS float*)F.lds; LAS float* part = (LAS float*)(F.lds + 16 * HSTR * 4); LAS int* hist = (LAS int*)(F.lds + 16 * HSTR * 4 + 8 * 16 * 32 * 4);
    const int lane = F.lane(), w = F.wave;
    for (int blk = F.bid; blk < NTOK / 128; blk += F.G) {
        const int T0 = blk * 128, b = T0 / SEQ;
        if (F.tid() < 32) hist[F.tid()] = 0;
        f32x4 ca[4], cb[4];
#pragma unroll
        for (int j = 0; j < 4; ++j) { const int col = 4 * lane + 256 * j;
            ca[j] = *(const f32x4*)(norm2_g + col) * (*(const f32x4*)(mod + b * 6144 + 4 * 1024 + col) + 1.0f); cb[j] = *(const f32x4*)(mod + b * 6144 + 3 * 1024 + col); }
        __syncthreads();
        for (int pass = 0; pass < 8; ++pass) {
#pragma unroll
            for (int tt = 0; tt < 2; ++tt) { const int tl = 2 * w + tt, tok = T0 + pass * 16 + tl;
                const f32x4* xr = (const f32x4*)(x1 + (size_t)tok * DM) + lane; f32x4 v[4]; float s = 0.f;
#pragma unroll
                for (int j = 0; j < 4; ++j) { v[j] = xr[64 * j]; s += (v[j][0] * v[j][0] + v[j][1] * v[j][1]) + (v[j][2] * v[j][2] + v[j][3] * v[j][3]); }
                const float rstd = rsqrtf(wave_sum(s) * (1.f / DM) + EPS);
                unsigned* o4 = (unsigned*)(h2 + (size_t)tok * DM) + lane;
#pragma unroll
                for (int j = 0; j < 4; ++j) { const f32x4 y = (v[j] * rstd) * ca[j] + cb[j];
                    o4[64 * j] = pk4_fp8(y[0], y[1], y[2], y[3]);
                    *(LAS f32x4*)(hs + tl * HSTR + 4 * lane + 256 * j) = y; } }
            __syncthreads();
            { const int ti = lane & 15, kk = lane >> 5, e = lane & 31; f32x16 acc;
#pragma unroll
              for (int r = 0; r < 16; ++r) acc[r] = 0.f;
              const LAS float* hp = hs + ti * HSTR + 128 * w + 64 * kk; const float* rwp = router_w + (size_t)(128 * w + 64 * kk) * NE + e;
#pragma unroll 4
              for (int s4 = 0; s4 < 16; ++s4) { const f32x4 a4 = *(const LAS f32x4*)(hp + 4 * s4);
#pragma unroll
                  for (int q = 0; q < 4; ++q) acc = __builtin_amdgcn_mfma_f32_32x32x2f32(a4[q], rwp[(4 * s4 + q) * NE], acc, 0, 0, 0); }
#pragma unroll
              for (int r = 0; r < 8; ++r) part[(w * 16 + (r & 3) + 8 * (r >> 2) + 4 * kk) * 32 + e] = acc[r]; }
            __syncthreads();
            { const int tl = F.tid() >> 5, e = F.tid() & 31, tok = T0 + pass * 16 + tl; float lg = router_b[e];
#pragma unroll
              for (int ww = 0; ww < 8; ++ww) lg += part[(ww * 16 + tl) * 32 + e];
              float myv = lg; float tv[4]; int ti4[4]; bool mine = false;
#pragma unroll
              for (int k = 0; k < 4; ++k) { float bv = myv; int bi = e;
#pragma unroll
                  for (int o = 16; o >= 1; o >>= 1) { const float ov = __shfl_xor(bv, o); const int oi = __shfl_xor(bi, o); if (ov > bv || (ov == bv && oi < bi)) { bv = ov; bi = oi; } }
                  tv[k] = bv; ti4[k] = bi; if (bi == e) { myv = -INFINITY; mine = true; } }
              if (mine) atomicAdd((int*)hist + e, 1);
              if (e == 0) { const float e0 = 1.0f, e1 = __expf(tv[1] - tv[0]), e2 = __expf(tv[2] - tv[0]), e3 = __expf(tv[3] - tv[0]); const float inv = 1.0f / (e0 + e1 + e2 + e3);
                  *(int4*)(topi + (size_t)tok * 4) = make_int4(ti4[0], ti4[1], ti4[2], ti4[3]); *(f32x4*)(topg + (size_t)tok * 4) = (f32x4){e0 * inv, e1 * inv, e2 * inv, e3 * inv}; } }
            __syncthreads();
        }
        if (F.tid() < 32) { const int base = atomicAdd((int*)(F.ctl + CW_GCNT) + F.tid(), hist[F.tid()]); bbase[blk * 32 + F.tid()] = base; }
        __syncthreads();
    }
}
__device__ __forceinline__ int moe_layout(Frame& F, LAS int* offs, LAS int* tile_e) {
    if (F.tid() == 0) { int o = 0;
        for (int e = 0; e < NE; ++e) { const int cnt = (int)__hip_atomic_load(F.ctl + CW_GCNT + e, __ATOMIC_RELAXED, __HIP_MEMORY_SCOPE_AGENT); const int nt = (cnt + 255) >> 8;
            offs[e] = o; if (tile_e) for (int t = 0; t < nt; ++t) tile_e[(o >> 8) + t] = e; o += nt << 8; }
        offs[NE] = o >> 8; }
    __syncthreads();
    return offs[NE];
}
__device__ __forceinline__ void phase_place(Frame& F) {
    const unsigned char* h2 = (const unsigned char*)(F.ws + WS_H2); unsigned char* xs = (unsigned char*)(F.ws + WS_XS);
    const int* topi = (const int*)(F.ws + WS_TOPI); const float* topg = (const float*)(F.ws + WS_TOPG); const int* bbase = (const int*)(F.ws + WS_BBASE);
    int* rowinfo = (int*)(F.ws + WS_ROWINFO); float* rowgate = (float*)(F.ws + WS_ROWGATE);
    LAS int* offs = (LAS int*)F.lds; LAS int* lcur = offs + 64; LAS int* posl = offs + 128;
    (void)moe_layout(F, offs, nullptr);
    for (int blk = F.bid; blk < NTOK / 128; blk += F.G) {
        const int T0 = blk * 128;
        if (F.tid() < 32) lcur[F.tid()] = 0;
        __syncthreads();
        { const int i = F.tid(), tok = T0 + (i >> 2); const int e = topi[(size_t)tok * 4 + (i & 3)];
          const int rank = atomicAdd((int*)lcur + e, 1); const int pos = offs[e] + bbase[blk * 32 + e] + rank;
          rowinfo[pos] = tok * 4 + (i & 3); rowgate[pos] = topg[(size_t)tok * 4 + (i & 3)]; posl[i] = pos; }
        __syncthreads();
        for (int jj = 0; jj < 64; ++jj) { const int i = F.wave * 64 + jj; const int pos = posl[i]; const int tok = T0 + (i >> 2);
            const u32x4* src = (const u32x4*)(h2 + (size_t)tok * DM) + F.lane(); u32x4* dst = (u32x4*)(xs + (size_t)pos * DM) + F.lane();
            dst[0] = src[0]; }
        __syncthreads();
    }
}
__device__ __forceinline__ void phase_final(Frame& F) {
    const float* const final_g = F.in(15);
    const float* mod = (const float*)(F.ws + WS_MOD); const bf16* Y = (const bf16*)(F.ws + WS_Y);
    const int gw = F.bid * NWAVES + F.wave, NGW = F.G * NWAVES;
    for (int m = gw; m < NTOK; m += NGW) {
        const int b = m / SEQ; f32x4* xr = (f32x4*)(F.out + (size_t)m * DM) + F.lane(); f32x4 v[4]; float s = 0.f;
#pragma unroll
        for (int j = 0; j < 4; ++j) { const int col = 4 * F.lane() + 256 * j; f32x4 y = (f32x4){0.f, 0.f, 0.f, 0.f};
#pragma unroll
            for (int k = 0; k < 4; ++k) { const u32x2 w = *((const u32x2*)(Y + ((size_t)m * 4 + k) * DM) + F.lane() + 64 * j); y[0] += bflo(w.x); y[1] += bfhi(w.x); y[2] += bflo(w.y); y[3] += bfhi(w.y); }
            v[j] = xr[64 * j] + *(const f32x4*)(mod + b * 6144 + 5 * 1024 + col) * y;
            s += (v[j][0] * v[j][0] + v[j][1] * v[j][1]) + (v[j][2] * v[j][2] + v[j][3] * v[j][3]); }
        const float rstd = rsqrtf(wave_sum(s) * (1.f / DM) + EPS);
#pragma unroll
        for (int j = 0; j < 4; ++j) xr[64 * j] = (v[j] * rstd) * *(const f32x4*)(final_g + 4 * F.lane() + 256 * j);
    }
}

#ifndef MK_N_LAUNCHES
#define MK_N_LAUNCHES 1
#endif
constexpr int N_PHASES = 12;
struct Args { const float* in[16]; float* out; unsigned char* ws; int ph_lo, ph_hi; };
static_assert(sizeof(Args) == 16 * 8 + 8 + 8 + 8, "Args has no padding");

__global__ void __launch_bounds__(NTHR, 2) mk_fwd(Args args) {
    extern __shared__ __attribute__((aligned(16))) unsigned char lds_raw[];
    Frame F;
    F.lds = (LAS unsigned char*)lds_raw;
    F.MISC = (volatile LAS unsigned*)(F.lds + MISC_OFF);
    F.wave = __builtin_amdgcn_readfirstlane((int)threadIdx.x >> 6);
    F.G = gridDim.x; F.bid = blockIdx.x; F.tacc = 0ull; F.xpass = 0;
    F.ws = args.ws; F.ctl = (unsigned*)(args.ws + WS_CTL); F.out = args.out;
    for (int u = F.tid(); u < (LDS_BYTES - MISC_OFF) / 4; u += NTHR) ((LAS unsigned*)(F.lds + MISC_OFF))[u] = 0u;
    __syncthreads();
    if (F.tid() < 16) *(LAS unsigned long long*)(F.lds + PTR_OFF + 8 * F.tid()) = (unsigned long long)args.in[F.tid()];
    __syncthreads();
    const int lo = args.ph_lo, hi = args.ph_hi;
    XcdBarrier bar; bar.bar = (unsigned*)(F.ctl + CW_BAR); bar.x = 0; bar.st = nullptr; bar.w0 = (F.wave == 0);
    if (hi - lo > 1) bar = xcd_barrier_post((unsigned*)(F.ctl + CW_BAR), F.MISC + 8, F.wave == 0);
#define IN(k) (lo <= (k) && (k) < hi)
#if defined(PROBE_PHASE)
    unsigned long long tp0 = 0ull, tp1 = 0ull;
#define STAMP(k) do { if ((k) == PROBE_PHASE) tp0 = __builtin_amdgcn_s_memrealtime(); if ((k) == PROBE_PHASE + 1) tp1 = __builtin_amdgcn_s_memrealtime(); } while (0)
#else
#define STAMP(k) do { } while (0)
#endif
#define SEAM(k) do { if (IN(k) && IN((k) + 1)) xcd_barrier(bar); } while (0)

    STAMP(0); if (IN(0)) { phase_p0a(F); } SEAM(0);
    STAMP(1); if (IN(1)) { phase_p0b(F); } SEAM(1);
    STAMP(2); if (IN(2)) {
        pg8::Gemm g{(const bf16*)(F.ws + WS_H0), (const bf16*)(F.ws + WS_WIN), NTOK, 3072, DM}; pg8::StaticOrder S; S.init(NTOK, 3072, F.G, F.bid);
        EpiProj E{(bf16*)(F.ws + WS_PROJ), PJ};
        pg8::gemm_phase<EpiProj, pg8::StaticOrder, true, true>(F.lds, g, S, E, F.wave);
    } SEAM(2);
    STAMP(3); if (IN(3)) {
#if defined(PROBE_SUB)
        const unsigned long long tra0 = __builtin_amdgcn_s_memrealtime();
#endif
        for (int it = F.bid; it < 1024; it += F.G) ret_a_item(F, it);
#if defined(PROBE_SUB)
        if (PROBE_SUB == 4) F.tacc += __builtin_amdgcn_s_memrealtime() - tra0;
#endif
        { constexpr int NQT = SEQ / QT, NITEM = NBATCH * NQT * 8;
          for (;;) { int t = 0; if (F.lane() == 0) t = (int)__hip_atomic_fetch_add(F.ctl + CW_Q3, 1u, __ATOMIC_RELAXED, __HIP_MEMORY_SCOPE_AGENT);
              t = __builtin_amdgcn_readfirstlane(t); if (t >= NITEM) break;
              dsa_a_wave(F, (t >> 3) & 3, NQT - 1 - (t >> 5), t & 7); } }
    } SEAM(3);
    STAMP(4); if (IN(4)) {
#if defined(PROBE_SUB)
        const unsigned long long tsc0 = __builtin_amdgcn_s_memrealtime();
#endif
        ret_scan(F);
#if defined(PROBE_SUB)
        if (PROBE_SUB == 5) F.tacc += __builtin_amdgcn_s_memrealtime() - tsc0;
#endif
        __syncthreads();
        phase_dsa_b(F);
    } SEAM(4);
    STAMP(5); if (IN(5)) { for (int it = F.bid; it < 1024; it += F.G) ret_c_item(F, it); } SEAM(5);
    STAMP(6); if (IN(6)) {
        pg8::Gemm g{(const bf16*)(F.ws + WS_MIX), (const bf16*)(F.ws + WS_WO), NTOK, DM, DM}; pg8::StaticOrder S; S.init(NTOK, DM, F.G, F.bid);
        EpiX1 E{F.in(0), (const float*)(F.ws + WS_MOD), F.out};
        pg8::gemm_phase<EpiX1, pg8::StaticOrder, true, true>(F.lds, g, S, E, F.wave);
    } SEAM(6);
    STAMP(7); if (IN(7)) { phase_router(F); } SEAM(7);
    STAMP(8); if (IN(8)) { phase_place(F); } SEAM(8);
    STAMP(9); if (IN(9)) {
        LAS int* tile_e = (LAS int*)(F.lds + TILEE_OFF); const int nt = moe_layout(F, (LAS int*)(F.lds + TILEE_OFF + 4096), tile_e);
        pg8::Gemm g{(const bf16*)(F.ws + WS_XS), (const bf16*)(F.ws + WS_WGU), MOE_ROWS, 2048, DM};
        GroupedOrder S{tile_e, nt, 8, F.G, F.bid, (size_t)2048 * 1024};
        EpiGlu8 E{(unsigned char*)(F.ws + WS_HB), F.in(12)};
        pg8::gemm_phase<EpiGlu8, GroupedOrder, true, true, true>(F.lds, g, S, E, F.wave);
    } SEAM(9);
    STAMP(10); if (IN(10)) {
        LAS int* tile_e = (LAS int*)(F.lds + TILEE_OFF); const int nt = moe_layout(F, (LAS int*)(F.lds + TILEE_OFF + 4096), tile_e);
        pg8::Gemm g{(const bf16*)(F.ws + WS_HB), (const bf16*)(F.ws + WS_WDN), MOE_ROWS, DM, DM};
        GroupedOrder S{tile_e, nt, 4, F.G, F.bid, (size_t)1024 * 1024};
        EpiDownT<true> E{(bf16*)(F.ws + WS_Y), F.in(14), (const int*)(F.ws + WS_ROWINFO), (const float*)(F.ws + WS_ROWGATE)};
        pg8::gemm_phase<EpiDownT<true>, GroupedOrder, true, true, true>(F.lds, g, S, E, F.wave);
    } SEAM(10);
    STAMP(11); if (IN(11)) { phase_final(F); }
    STAMP(12);
#if defined(PROBE_SUB)
    if (F.bid == 0 && F.tid() == 0) { const unsigned long long te = __builtin_amdgcn_s_memrealtime(); while (__builtin_amdgcn_s_memrealtime() - te < F.tacc) __builtin_amdgcn_s_sleep(8); }
#elif defined(PROBE_PHASE)
    if (F.bid == 0 && F.tid() == 0) { const unsigned long long te = __builtin_amdgcn_s_memrealtime(), dur = tp1 - tp0; while (__builtin_amdgcn_s_memrealtime() - te < dur) __builtin_amdgcn_s_sleep(8); }
#endif
#undef IN
#undef SEAM
}

extern "C" void kernel_launch(void* const* d_in, const int* in_sizes, int n_in, void* d_out, int out_size, void* d_ws, size_t ws_size, hipStream_t stream) {
    static int grid = 0;
    if (grid == 0) {
        if (n_in != 16 || out_size != NTOK * DM || ws_size < WS_END) { fprintf(stderr, "kernel_launch: unexpected problem (n_in %d out %d ws %zu); nothing launched\n", n_in, out_size, ws_size); grid = -1; return; }
        int dev = 0, cus = 0;
        if (hipGetDevice(&dev) != hipSuccess || hipDeviceGetAttribute(&cus, hipDeviceAttributeMultiprocessorCount, dev) != hipSuccess) { grid = -1; return; }
        if (hipFuncSetAttribute((const void*)mk_fwd, hipFuncAttributeMaxDynamicSharedMemorySize, LDS_BYTES) != hipSuccess) { fprintf(stderr, "kernel_launch: hipFuncSetAttribute failed\n"); grid = -1; return; }
        int per_cu = 0;
        if (hipOccupancyMaxActiveBlocksPerMultiprocessor(&per_cu, (const void*)mk_fwd, NTHR, LDS_BYTES) != hipSuccess || per_cu < 1) fprintf(stderr, "kernel_launch: occupancy query reports %d workgroups per CU\n", per_cu);
        (void)hipGetLastError();
        grid = cus;
    }
    if (grid < 0) return;
    (void)hipMemsetAsync((char*)d_ws + WS_CTL, 0, CTL_ZERO_BYTES, stream);
    Args a{};
    for (int i = 0; i < 16; ++i) a.in[i] = (const float*)d_in[i];
    a.out = (float*)d_out; a.ws = (unsigned char*)d_ws;
#if MK_N_LAUNCHES == 1
    a.ph_lo = 0; a.ph_hi = N_PHASES;
    hipLaunchKernelGGL(mk_fwd, dim3(grid), dim3(NTHR), LDS_BYTES, stream, a);
#else
    for (int p = 0; p < N_PHASES; ++p) { a.ph_lo = p; a.ph_hi = p + 1; hipLaunchKernelGGL(mk_fwd, dim3(grid), dim3(NTHR), LDS_BYTES, stream, a); }
#endif
}
```

```cpp
#include <hip/hip_runtime.h>
#include <cstdio>
#include <cstdint>

#define LAS __attribute__((address_space(3)))
#define GAS __attribute__((address_space(1)))
typedef unsigned short bf16;
typedef short bf16x8 __attribute__((ext_vector_type(8)));
typedef short s16x4 __attribute__((ext_vector_type(4)));
typedef float f32x4 __attribute__((ext_vector_type(4)));
typedef float f32x16 __attribute__((ext_vector_type(16)));
typedef unsigned u32x4 __attribute__((ext_vector_type(4)));
typedef unsigned u32x2 __attribute__((ext_vector_type(2)));
typedef float f32x2_t __attribute__((ext_vector_type(2)));
typedef __bf16 bf16x2_t __attribute__((ext_vector_type(2)));

constexpr int DM = 1024, NBATCH = 4, SEQ = 8192, NTOK = NBATCH * SEQ;
constexpr int PJ = 3072;
constexpr int IN_COLS = 2888;
constexpr int C_RQ = 0, C_RK = 256, C_RV = 512, C_RG = 1024, C_AQ = 1536, C_AK = 2048, C_AV = 2176, C_IQ = 2304, C_IK = 2816, C_IW = 2880;
constexpr int NE = 32, TOPK = 4, MOE_ROWS = NTOK * TOPK + NE * 256;
constexpr int MOE_TILES = MOE_ROWS / 256;
constexpr float EPS = 1e-6f;
constexpr int NWAVES = 8, NTHR = 512;

constexpr size_t MiB = 1u << 20;
constexpr size_t WS_CTL = 0, CTL_ZERO_BYTES = 1 * MiB;
constexpr size_t WS_MOD = 1 * MiB;
constexpr size_t WS_TOPI = 2 * MiB;
constexpr size_t WS_TOPG = 2 * MiB + 512 * 1024;
constexpr size_t WS_BBASE = 3 * MiB;
constexpr size_t WS_ROWINFO = 4 * MiB;
constexpr size_t WS_ROWGATE = 5 * MiB;
constexpr size_t WS_WIN = 8 * MiB;
constexpr size_t WS_WO = 14 * MiB;
constexpr size_t WS_WGU = 16 * MiB;
constexpr size_t WS_WDN = 144 * MiB;
constexpr size_t WS_H0 = 208 * MiB;
constexpr size_t WS_PROJ = 272 * MiB;
constexpr size_t WS_XS = 208 * MiB;
constexpr size_t WS_Y = 208 * MiB;
constexpr size_t WS_KVT = 480 * MiB;
constexpr size_t WS_RPT = 512 * MiB;
constexpr size_t WS_SEL = 528 * MiB;
constexpr size_t WS_MIX = 544 * MiB;
constexpr size_t WS_H2 = 608 * MiB;
constexpr size_t WS_HB = 480 * MiB;
constexpr size_t WS_END = 752 * MiB;
constexpr int CW_GCNT = 1024;
constexpr int CW_Q1 = 2048;
constexpr int CW_Q3 = 2112;
constexpr int CW_BAR = 4096;

constexpr int LDS_BYTES = 153600;
constexpr int RING_BYTES = 131072;
constexpr int TILEE_OFF = 131072;
constexpr int MISC_OFF = 152576;
constexpr int PTR_OFF = MISC_OFF + 512;

__device__ __forceinline__ int hw_lane() { int l; asm volatile("v_mbcnt_lo_u32_b32 %0, -1, 0\n\tv_mbcnt_hi_u32_b32 %0, -1, %0" : "=v"(l)); return l; }
__device__ __forceinline__ unsigned cvtpk(float lo, float hi) { f32x2_t v = {lo, hi}; bf16x2_t b = __builtin_convertvector(v, bf16x2_t); return __builtin_bit_cast(unsigned, b); }
__device__ __forceinline__ float bflo(unsigned w) { return __builtin_bit_cast(float, w << 16); }
__device__ __forceinline__ float bfhi(unsigned w) { return __builtin_bit_cast(float, w & 0xffff0000u); }
__device__ __forceinline__ float bf2f(bf16 h) { return __builtin_bit_cast(float, (unsigned)h << 16); }
__device__ __forceinline__ bf16 f2bf(float f) { return (bf16)(cvtpk(f, 0.f) & 0xffffu); }
__device__ __forceinline__ float wave_sum(float v) {
#pragma unroll
    for (int o = 1; o < 64; o <<= 1) v += __shfl_xor(v, o);
    return v;
}
__device__ __forceinline__ int mbcnt64(unsigned long long m) { return (int)__builtin_amdgcn_mbcnt_hi((unsigned)(m >> 32), __builtin_amdgcn_mbcnt_lo((unsigned)m, 0u)); }
__device__ __forceinline__ s16x4 trread(const LAS void* p) { typedef short v4i16_t __attribute__((ext_vector_type(4))); return __builtin_bit_cast(s16x4, __builtin_amdgcn_ds_read_tr16_b64_v4i16((LAS v4i16_t*)p)); }
__device__ __forceinline__ bf16x8 cat8(s16x4 lo, s16x4 hi) { return (bf16x8){lo[0], lo[1], lo[2], lo[3], hi[0], hi[1], hi[2], hi[3]}; }
#define MFMA16(a, b, c) __builtin_amdgcn_mfma_f32_16x16x32_bf16((a), (b), (c), 0, 0, 0)
#define MFMA32(a, b, c) __builtin_amdgcn_mfma_f32_32x32x16_bf16((a), (b), (c), 0, 0, 0)

namespace pg8 {
#define PG8_LAS __attribute__((address_space(3)))
typedef unsigned short bf16_t;
typedef short bf16x8 __attribute__((ext_vector_type(8)));
typedef float f32x4 __attribute__((ext_vector_type(4)));
typedef unsigned u32x4 __attribute__((ext_vector_type(4)));
constexpr int BM = 256, BK = 64, HALF = 128, HTB = HALF * BK * 2  , STAGE_BYTES = 8 * HTB, NXCD = 8, WGM = 8;

__host__ __device__ __forceinline__ int lds_byte(int r, int c) { const int st = (r >> 4) * 2 + (c >> 5), rr = r & 15, cc = c & 31, ob = rr * 64 + cc * 2; return st * 1024 + (ob ^ (((ob >> 9) & 1) << 5)); }
__host__ __device__ __forceinline__ void stage_rc(int b, int& R, int& C) { const int st = b / 1024, sb = b % 1024, swz = sb ^ (((sb >> 9) & 1) << 5); R = (st >> 1) * 16 + swz / 64; C = (st & 1) * 32 + (swz % 64) / 2; }
__host__ __device__ __forceinline__ int perm32(int rho) { const int n = rho >> 4, i = rho & 15; return 8 * (i >> 2) + 4 * n + (i & 3); }

typedef int v8i32 __attribute__((ext_vector_type(8))); typedef int v4i32 __attribute__((ext_vector_type(4)));
__device__ __forceinline__ v8i32 pg8_cat(bf16x8 a, bf16x8 b) { return __builtin_shufflevector(__builtin_bit_cast(v4i32, a), __builtin_bit_cast(v4i32, b), 0, 1, 2, 3, 4, 5, 6, 7); }
struct Unit { int pm, pn, e; size_t bo; };
struct Gemm { const bf16_t* A; const bf16_t* Bt; int M, N, K; };

struct StaticOrder {
    int nM, nN, nwg, G, c;
    __host__ __device__ void init(int M, int N, int G_, int c_) { nM = M / BM; nN = N / BM; nwg = nM * nN; G = G_; c = c_; }
    __host__ __device__ bool next(int i, Unit& u) const {
        const long L = (long)i * G + c; if (L >= nwg) return false;
        int wgid = (int)L; { const int q = nwg / NXCD, r = nwg % NXCD, xcd = wgid % NXCD, off = wgid / NXCD; wgid = (xcd < r ? xcd * (q + 1) : r * (q + 1) + (xcd - r) * q) + off; }
        const int nig = WGM * nN, gid = wgid / nig, fm = gid * WGM, gsz = (nM - fm) < WGM ? (nM - fm) : WGM;
        u.pm = fm + ((wgid % nig) % gsz); u.pn = (wgid % nig) / gsz; u.e = 0; u.bo = 0; return true;
    }
    __device__ __forceinline__ void a_ready(const Unit&) const {}
    __device__ __forceinline__ void done(const Unit&) const {}
};

template <class Epi, class Sched, bool ALIGN_EPI = false, bool SP2 = false, bool F8 = false>
__device__ __forceinline__ void gemm_phase(PG8_LAS unsigned char* lds, const Gemm g, const Sched& S, const Epi& E, const int wid) {
    const int lane = hw_lane(), tid = wid * 64 + lane, wr = wid >> 2, wc = wid & 3, fr = lane & 15, fq = lane >> 4;
    constexpr int ESZ = F8 ? 1 : 2;
    const int K = g.K, nt = K * ESZ / (BK * 2);
    unsigned voffA[2], voffB[2];
#pragma unroll
    for (int i = 0; i < 2; ++i) { int R, C; stage_rc(tid * 16 + i * 8192, R, C); const int Rb = Epi::PERM ? ((R & ~31) + perm32(R & 31)) : R;
        voffA[i] = (unsigned)(R * K * ESZ + C * 2); voffB[i] = (unsigned)(Rb * K * ESZ + C * 2); }
    const size_t kstep = (size_t)(BK * 2);
    const size_t hstep = (size_t)HALF * K * ESZ;
    const size_t tstep = 2 * hstep;
    const unsigned ldsw = (unsigned)wid * 1024u;
    const int aoff = lds_byte(wr * 64 + fr, fq * 8), boff = lds_byte(wc * 32 + fr, fq * 8);
#define PG8_SA(b, h) (((b) * 2 + (h)) * HTB)
#define PG8_SB(b, h) ((4 + (b) * 2 + (h)) * HTB)
#define PG8_STAGE(bufoff, gbase, voff) do { _Pragma("unroll") for (int _i = 0; _i < 2; ++_i) { \
        if constexpr (F8) { unsigned _keep; const unsigned _l = (unsigned)(__UINTPTR_TYPE__)(lds + (bufoff) + ldsw + _i * 8192);   \
            asm volatile("s_mov_b32 %0, m0\n\ts_mov_b32 m0, %3\n\ts_nop 0\n\tglobal_load_lds_dwordx4 %1, %2\n\ts_mov_b32 m0, %0" : "=&s"(_keep) : "v"((voff)[_i]), "s"((const char*)(gbase)), "s"(_l) : "memory"); } \
        else __builtin_amdgcn_global_load_lds((const unsigned*)((const char*)(gbase) + (voff)[_i]), (PG8_LAS unsigned*)(lds + (bufoff) + ldsw + _i * 8192), 16, 0, 0); } } while (0)
#define PG8_LDA(dst, b, h) do { _Pragma("unroll") for (int m = 0; m < 4; ++m) _Pragma("unroll") for (int k = 0; k < 2; ++k) dst[m][k] = *(const PG8_LAS bf16x8*)(lds + PG8_SA(b, h) + aoff + m * 2048 + k * 1024); } while (0)
#define PG8_LDB(dst, b, h) do { _Pragma("unroll") for (int n = 0; n < 2; ++n) _Pragma("unroll") for (int k = 0; k < 2; ++k) dst[n][k] = *(const PG8_LAS bf16x8*)(lds + PG8_SB(b, h) + boff + n * 2048 + k * 1024); } while (0)
#define PG8_MMA(ai, bj, At, Bt) do { __builtin_amdgcn_s_setprio(1); _Pragma("unroll") for (int m = 0; m < 4; ++m) _Pragma("unroll") for (int n = 0; n < 2; ++n) { \
        if constexpr (F8) { acc[ai][bj][m][n] = __builtin_amdgcn_mfma_scale_f32_16x16x128_f8f6f4(pg8_cat(Bt[n][0], Bt[n][1]), pg8_cat(At[m][0], At[m][1]), acc[ai][bj][m][n], 0, 0, 0, 0, 0, 0); } \
        else { _Pragma("unroll") for (int k = 0; k < 2; ++k) acc[ai][bj][m][n] = __builtin_amdgcn_mfma_f32_16x16x32_bf16(Bt[n][k], At[m][k], acc[ai][bj][m][n], 0, 0, 0); } } __builtin_amdgcn_s_setprio(0); } while (0)
#define PG8_WAIT_V(n) asm volatile("s_waitcnt vmcnt(" #n ")" ::: "memory")
#define PG8_WAIT_L(n) asm volatile("s_waitcnt lgkmcnt(" #n ")" ::: "memory")
#define PG8_BAR __builtin_amdgcn_s_barrier()
#define PG8_SCHED __builtin_amdgcn_sched_barrier(0)
    Unit cur, nxt; int ui = 0;
    if (!S.next(0, cur)) return;
    f32x4 acc[2][2][4][2];
#pragma unroll
    for (int a = 0; a < 2; ++a)
#pragma unroll
        for (int b = 0; b < 2; ++b)
#pragma unroll
            for (int m = 0; m < 4; ++m)
#pragma unroll
                for (int n = 0; n < 2; ++n) acc[a][b][m][n] = (f32x4){0.f, 0.f, 0.f, 0.f};
    bf16x8 At[4][2], B0[2][2], B1[2][2];
    const char* cA = (const char*)g.A + (size_t)cur.pm * tstep; const char* cB = (const char*)g.Bt + (size_t)cur.pn * tstep + cur.bo;
    S.a_ready(cur);
    if constexpr (SP2) {
        PG8_STAGE(PG8_SB(0, 0), cB, voffB); PG8_STAGE(PG8_SB(0, 1), cB + hstep, voffB); PG8_STAGE(PG8_SA(0, 0), cA, voffA); PG8_STAGE(PG8_SA(0, 1), cA + hstep, voffA);
        if (wr == 1) PG8_BAR;
        PG8_WAIT_V(2); PG8_BAR;
        PG8_STAGE(PG8_SB(1, 0), cB + kstep, voffB); PG8_STAGE(PG8_SA(1, 0), cA + kstep, voffA); PG8_STAGE(PG8_SB(1, 1), cB + hstep + kstep, voffB);
        PG8_WAIT_V(6); PG8_BAR;
    } else {
        PG8_STAGE(PG8_SB(0, 0), cB, voffB); PG8_STAGE(PG8_SA(0, 0), cA, voffA); PG8_STAGE(PG8_SB(0, 1), cB + hstep, voffB); PG8_STAGE(PG8_SA(0, 1), cA + hstep, voffA);
        if (wr == 1) PG8_BAR;
        PG8_WAIT_V(4); PG8_BAR;
        PG8_STAGE(PG8_SB(1, 0), cB + kstep, voffB); PG8_STAGE(PG8_SA(1, 0), cA + kstep, voffA); PG8_STAGE(PG8_SB(1, 1), cB + hstep + kstep, voffB);
        PG8_WAIT_V(6); PG8_BAR;
    }
    for (;;) {
        const bool has_next = S.next(ui + 1, nxt);
        const char* nA = has_next ? (const char*)g.A + (size_t)nxt.pm * tstep : cA; const char* nB = has_next ? (const char*)g.Bt + (size_t)nxt.pn * tstep + nxt.bo : cB;
        for (int t = 0; t < nt; t += 2) {
            const bool last = (t == nt - 2);
            const char* a1 = cA + (size_t)(t + 1) * kstep;
            const char* a2 = last ? nA : cA + (size_t)(t + 2) * kstep; const char* b2 = last ? nB : cB + (size_t)(t + 2) * kstep;
            const char* a3 = a2 + kstep; const char* b3 = b2 + kstep;
            if (last && has_next) S.a_ready(nxt);
            if constexpr (SP2) {
            PG8_LDB(B0, 0, 0); PG8_LDB(B1, 0, 1); PG8_SCHED; PG8_LDA(At, 0, 0); PG8_STAGE(PG8_SA(1, 1), a1 + hstep, voffA);
            PG8_WAIT_V(8); PG8_WAIT_L(0); PG8_BAR; PG8_MMA(0, 0, At, B0); PG8_MMA(0, 1, At, B1); PG8_BAR; PG8_SCHED;
            PG8_LDA(At, 0, 1); PG8_STAGE(PG8_SB(0, 0), b2, voffB); PG8_STAGE(PG8_SB(0, 1), b2 + hstep, voffB); PG8_STAGE(PG8_SA(0, 0), a2, voffA);
            PG8_WAIT_V(8); PG8_WAIT_L(0); PG8_BAR; PG8_MMA(1, 0, At, B0); PG8_MMA(1, 1, At, B1); PG8_BAR; PG8_SCHED;
            PG8_LDB(B0, 1, 0); PG8_LDB(B1, 1, 1); PG8_SCHED; PG8_LDA(At, 1, 0); PG8_STAGE(PG8_SA(0, 1), a2 + hstep, voffA);
            PG8_WAIT_V(8); PG8_WAIT_L(0); PG8_BAR; PG8_MMA(0, 0, At, B0); PG8_MMA(0, 1, At, B1); PG8_BAR; PG8_SCHED;
            PG8_LDA(At, 1, 1); PG8_STAGE(PG8_SB(1, 0), b3, voffB); PG8_STAGE(PG8_SB(1, 1), b3 + hstep, voffB); PG8_STAGE(PG8_SA(1, 0), a3, voffA);
            PG8_WAIT_V(8); PG8_WAIT_L(0); PG8_BAR; PG8_MMA(1, 0, At, B0); PG8_MMA(1, 1, At, B1); PG8_BAR; PG8_SCHED;
            } else {
            PG8_LDB(B0, 0, 0); PG8_SCHED; PG8_LDA(At, 0, 0); PG8_STAGE(PG8_SA(1, 1), a1 + hstep, voffA);
            PG8_WAIT_L(8); PG8_BAR; PG8_WAIT_L(0); PG8_MMA(0, 0, At, B0); PG8_BAR; PG8_SCHED;
            PG8_LDB(B1, 0, 1); PG8_STAGE(PG8_SB(0, 0), b2, voffB);
            PG8_BAR; PG8_WAIT_L(0); PG8_MMA(0, 1, At, B1); PG8_BAR;
            PG8_LDA(At, 0, 1); PG8_STAGE(PG8_SA(0, 0), a2, voffA);
            PG8_BAR; PG8_WAIT_L(0); PG8_MMA(1, 0, At, B0); PG8_BAR; PG8_SCHED;
            PG8_STAGE(PG8_SB(0, 1), b2 + hstep, voffB);
            PG8_WAIT_V(6); PG8_BAR; PG8_MMA(1, 1, At, B1); PG8_BAR;
            PG8_LDB(B0, 1, 0); PG8_SCHED; PG8_LDA(At, 1, 0); PG8_STAGE(PG8_SA(0, 1), a2 + hstep, voffA);
            PG8_WAIT_L(8); PG8_BAR; PG8_WAIT_L(0); PG8_MMA(0, 0, At, B0); PG8_BAR; PG8_SCHED;
            PG8_LDB(B1, 1, 1); PG8_STAGE(PG8_SB(1, 0), b3, voffB);
            PG8_BAR; PG8_WAIT_L(0); PG8_MMA(0, 1, At, B1); PG8_BAR;
            PG8_LDA(At, 1, 1); PG8_STAGE(PG8_SA(1, 0), a3, voffA);
            PG8_BAR; PG8_WAIT_L(0); PG8_MMA(1, 0, At, B0); PG8_BAR; PG8_SCHED;
            PG8_STAGE(PG8_SB(1, 1), b3 + hstep, voffB);
            PG8_WAIT_V(6); PG8_BAR; PG8_MMA(1, 1, At, B1); PG8_BAR;
            }
        }
        if constexpr (ALIGN_EPI) { if (wr == 0) PG8_BAR; }
        if constexpr (!Epi::AFTER_DRAIN) { E(acc, cur, wr, wc, fr, fq); S.done(cur); }
        if (!has_next) break;
#pragma unroll
        for (int a = 0; a < 2; ++a)
#pragma unroll
            for (int b = 0; b < 2; ++b)
#pragma unroll
                for (int m = 0; m < 4; ++m)
#pragma unroll
                    for (int n = 0; n < 2; ++n) acc[a][b][m][n] = (f32x4){0.f, 0.f, 0.f, 0.f};
        cur = nxt; cA = nA; cB = nB; ++ui;
        if constexpr (ALIGN_EPI) { if (wr == 1) PG8_BAR; }
    }
    PG8_WAIT_V(0);
    if constexpr (!ALIGN_EPI) { if (wr == 0) PG8_BAR; }
    PG8_BAR;
    if constexpr (Epi::AFTER_DRAIN) { E.fused(acc, cur, wr, wc, fr, fq, lds, wid, lane); S.done(cur); }
#undef PG8_SA
#undef PG8_SB
#undef PG8_STAGE
#undef PG8_LDA
#undef PG8_LDB
#undef PG8_MMA
#undef PG8_WAIT_V
#undef PG8_WAIT_L
#undef PG8_BAR
#undef PG8_SCHED
}
}

struct EpiProj {
    static constexpr bool PERM = true, AFTER_DRAIN = false;
    bf16* O; int ldc;
    __device__ __forceinline__ void operator()(const f32x4 (&acc)[2][2][4][2], const pg8::Unit& u, int wr, int wc, int fr, int fq) const {
        const int row0 = u.pm * 256 + wr * 64 + fr; const int col0 = u.pn * 256 + wc * 32 + 8 * fq;
#pragma unroll
        for (int ai = 0; ai < 2; ++ai)
#pragma unroll
            for (int m = 0; m < 4; ++m) { bf16* rowp = O + (size_t)(row0 + ai * 128 + m * 16) * ldc + col0;
#pragma unroll
                for (int bj = 0; bj < 2; ++bj) { const f32x4 v0 = acc[ai][bj][m][0], v1 = acc[ai][bj][m][1];
                    u32x4 w; w.x = cvtpk(v0[0], v0[1]); w.y = cvtpk(v0[2], v0[3]); w.z = cvtpk(v1[0], v1[1]); w.w = cvtpk(v1[2], v1[3]);
                    *(u32x4*)(rowp + bj * 128) = w; } }
    }
};
struct EpiX1 {
    static constexpr bool PERM = false, AFTER_DRAIN = false;
    const float* x; const float* mod; float* out;
    __device__ __forceinline__ void operator()(const f32x4 (&acc)[2][2][4][2], const pg8::Unit& u, int wr, int wc, int fr, int fq) const {
        const int col0 = u.pn * 256 + wc * 32 + 4 * fq; const int b = (u.pm * 256) / SEQ;
        f32x4 g[2][2];
#pragma unroll
        for (int bj = 0; bj < 2; ++bj)
#pragma unroll
            for (int n = 0; n < 2; ++n) g[bj][n] = *(const f32x4*)(mod + (size_t)b * 6144 + 2 * 1024 + col0 + bj * 128 + n * 16);
#pragma unroll
        for (int ai = 0; ai < 2; ++ai)
#pragma unroll
            for (int m = 0; m < 4; ++m) { const size_t off = (size_t)(u.pm * 256 + ai * 128 + wr * 64 + m * 16 + fr) * DM + col0;
#pragma unroll
                for (int bj = 0; bj < 2; ++bj)
#pragma unroll
                    for (int n = 0; n < 2; ++n) { const f32x4 xv = *(const f32x4*)(x + off + bj * 128 + n * 16); *(f32x4*)(out + off + bj * 128 + n * 16) = xv + g[bj][n] * acc[ai][bj][m][n]; }
                if (m & 1) asm volatile("" ::: "memory"); }
    }
};
__device__ __forceinline__ float glu_f(float gate, float up) {
    gate = fminf(gate, 7.0f); up = fminf(fmaxf(up, -7.0f), 7.0f);
    const float sg = __builtin_amdgcn_rcpf(1.0f + __expf(-1.702f * gate));
    return (up + 1.0f) * (gate * sg);
}
__device__ __forceinline__ unsigned pk4_fp8(float a, float b, float c, float d) { int w = __builtin_amdgcn_cvt_pk_fp8_f32(a, b, 0, false); w = __builtin_amdgcn_cvt_pk_fp8_f32(c, d, w, true); return (unsigned)w; }
constexpr float W8_SCALE = 64.0f, W8_INV = 1.0f / 64.0f;
struct EpiGlu8 {
    static constexpr bool PERM = true, AFTER_DRAIN = false;
    unsigned char* H; const float* b_gu;
    __device__ __forceinline__ void operator()(const f32x4 (&acc)[2][2][4][2], const pg8::Unit& u, int wr, int wc, int fr, int fq) const {
        const int row0 = u.pm * 256 + wr * 64 + fr; const int c0 = u.pn * 128 + wc * 32 + 8 * fq;
        const float* bg = b_gu + (size_t)u.e * 2048 + c0; const float* bu = bg + 1024;
        const f32x4 bg0 = *(const f32x4*)bg, bg1 = *(const f32x4*)(bg + 4), bu0 = *(const f32x4*)bu, bu1 = *(const f32x4*)(bu + 4);
#pragma unroll
        for (int ai = 0; ai < 2; ++ai)
#pragma unroll
            for (int m = 0; m < 4; ++m) {
                const f32x4 g0 = acc[ai][0][m][0] * W8_INV + bg0, g1 = acc[ai][0][m][1] * W8_INV + bg1, u0 = acc[ai][1][m][0] * W8_INV + bu0, u1 = acc[ai][1][m][1] * W8_INV + bu1;
                u32x2 w; w.x = pk4_fp8(glu_f(g0[0], u0[0]), glu_f(g0[1], u0[1]), glu_f(g0[2], u0[2]), glu_f(g0[3], u0[3]));
                w.y = pk4_fp8(glu_f(g1[0], u1[0]), glu_f(g1[1], u1[1]), glu_f(g1[2], u1[2]), glu_f(g1[3], u1[3]));
                *(u32x2*)(H + (size_t)(row0 + ai * 128 + m * 16) * DM + c0) = w; }
    }
};
struct EpiGlu {
    static constexpr bool PERM = true, AFTER_DRAIN = false;
    bf16* H; const float* b_gu;
    __device__ __forceinline__ void operator()(const f32x4 (&acc)[2][2][4][2], const pg8::Unit& u, int wr, int wc, int fr, int fq) const {
        const int row0 = u.pm * 256 + wr * 64 + fr; const int c0 = u.pn * 128 + wc * 32 + 8 * fq;
        const float* bg = b_gu + (size_t)u.e * 2048 + c0; const float* bu = bg + 1024;
        const f32x4 bg0 = *(const f32x4*)bg, bg1 = *(const f32x4*)(bg + 4), bu0 = *(const f32x4*)bu, bu1 = *(const f32x4*)(bu + 4);
#pragma unroll
        for (int ai = 0; ai < 2; ++ai)
#pragma unroll
            for (int m = 0; m < 4; ++m) {
                const f32x4 g0 = acc[ai][0][m][0] + bg0, g1 = acc[ai][0][m][1] + bg1, u0 = acc[ai][1][m][0] + bu0, u1 = acc[ai][1][m][1] + bu1;
                u32x4 w; w.x = cvtpk(glu_f(g0[0], u0[0]), glu_f(g0[1], u0[1])); w.y = cvtpk(glu_f(g0[2], u0[2]), glu_f(g0[3], u0[3]));
                w.z = cvtpk(glu_f(g1[0], u1[0]), glu_f(g1[1], u1[1])); w.w = cvtpk(glu_f(g1[2], u1[2]), glu_f(g1[3], u1[3]));
                *(u32x4*)(H + (size_t)(row0 + ai * 128 + m * 16) * DM + c0) = w; }
    }
};
template <bool F8> struct EpiDownT {
    static constexpr bool PERM = true, AFTER_DRAIN = false;
    bf16* Y; const float* b_down; const int* rowinfo; const float* rowgate;
    __device__ __forceinline__ void operator()(const f32x4 (&acc)[2][2][4][2], const pg8::Unit& u, int wr, int wc, int fr, int fq) const {
        const int row0 = u.pm * 256 + wr * 64 + fr; const int col0 = u.pn * 256 + wc * 32 + 8 * fq;
        const float* bd = b_down + (size_t)u.e * 1024 + col0;
        f32x4 bv[2][2];
#pragma unroll
        for (int bj = 0; bj < 2; ++bj)
#pragma unroll
            for (int n = 0; n < 2; ++n) bv[bj][n] = *(const f32x4*)(bd + bj * 128 + 4 * n);
#pragma unroll
        for (int ai = 0; ai < 2; ++ai)
#pragma unroll
            for (int m = 0; m < 4; ++m) { const int row = row0 + ai * 128 + m * 16; const int dst = rowinfo[row]; const float gt = rowgate[row];
                if (dst >= 0) { bf16* rowp = Y + (size_t)dst * DM + col0;
#pragma unroll
                    for (int bj = 0; bj < 2; ++bj) { const float sa = F8 ? W8_INV : 1.0f; const f32x4 v0 = (acc[ai][bj][m][0] * sa + bv[bj][0]) * gt, v1 = (acc[ai][bj][m][1] * sa + bv[bj][1]) * gt;
                        u32x4 w; w.x = cvtpk(v0[0], v0[1]); w.y = cvtpk(v0[2], v0[3]); w.z = cvtpk(v1[0], v1[1]); w.w = cvtpk(v1[2], v1[3]);
                        *(u32x4*)(rowp + bj * 128) = w; } } }
    }
};
struct GroupedOrder {
    const LAS int* tile_e; int ntiles, nN, G, c; size_t estride;
    __device__ __forceinline__ bool next(int i, pg8::Unit& u) const {
        int pm, pn;
        if (G == 256) { const int x = c & 7, j = c >> 3, rpx = 32 / nN; pn = j % nN; pm = i * (8 * rpx) + x * rpx + j / nN; }
        else { const long L = (long)i * G + c; pm = (int)(L / nN); pn = (int)(L % nN); }
        if (pm >= ntiles) return false;
        u.pm = pm; u.pn = pn; u.e = __builtin_amdgcn_readfirstlane(tile_e[pm]); u.bo = (size_t)u.e * estride; return true;
    }
    __device__ __forceinline__ void a_ready(const pg8::Unit&) const {}
    __device__ __forceinline__ void done(const pg8::Unit&) const {}
};

#define XB_TMO      128
#define XB_XCNT(j)  (256  + 64 * (j))
#define XB_XSUB(j)  (1280 + 64 * (j))
#define XB_XGEN(j)  (2304 + 64 * (j))
#define XB_TOP      3328
#define XB_TOPGEN   3392
#define XCD_BAR_WORDS 3456
#define XB_SPIN_CAP (1u << 18)

__device__ __forceinline__ unsigned xb_ld(unsigned* p)              { return __hip_atomic_load(p, __ATOMIC_RELAXED, __HIP_MEMORY_SCOPE_AGENT); }
__device__ __forceinline__ unsigned xb_add(unsigned* p, unsigned v) { return __hip_atomic_fetch_add(p, v, __ATOMIC_RELAXED, __HIP_MEMORY_SCOPE_AGENT); }
__device__ __forceinline__ unsigned xb_xcc_id() { return (unsigned)__builtin_amdgcn_s_getreg((3 << 11) | 20) & 0xFu; }
#define XB_SPIN(cond, bar) do { unsigned _sp = 0; while (cond) { __builtin_amdgcn_s_sleep(1); \
    if ((++_sp & 255u) == 0u) { if (xb_ld(&(bar)[XB_TMO])) break; if (_sp > XB_SPIN_CAP) { atomicAdd(&(bar)[XB_TMO], 1u); break; } } } } while (0)

struct XcdBarrier {
    unsigned* bar; unsigned x; bool w0;
    volatile LAS unsigned* st;
};

__device__ __forceinline__ XcdBarrier xcd_barrier_post(unsigned* bar, volatile LAS unsigned* st, bool w0) {
    XcdBarrier b; b.bar = bar; b.x = xb_xcc_id(); b.st = st; b.w0 = w0;
    if (w0 && hw_lane() == 0) (void)xb_add(&bar[XB_XCNT(b.x)], 1u);
    return b;
}
__device__ __forceinline__ void xcd_barrier_complete(unsigned* bar, unsigned x, unsigned& nloc, unsigned& nx) {
    const unsigned G = gridDim.x * gridDim.y * gridDim.z;
    unsigned sum, cnt, mine, sp = 0u;
    for (;;) {
        sum = 0u; cnt = 0u; mine = 0u;
#pragma unroll
        for (unsigned j = 0; j < 16; ++j) { const unsigned c = xb_ld(&bar[XB_XCNT(j)]); sum += c; cnt += (c > 0u) ? 1u : 0u; mine = (j == x) ? c : mine; }
        if (sum == G) break;
        __builtin_amdgcn_s_sleep(1);
        if ((++sp & 255u) == 0u) { if (xb_ld(&bar[XB_TMO])) break; if (sp > XB_SPIN_CAP) { atomicAdd(&bar[XB_TMO], 1u); break; } }
    }
    nloc = mine > 0u ? mine : 1u; nx = cnt > 0u ? cnt : 1u;
}

__device__ __forceinline__ void xcd_barrier(const XcdBarrier& b) {
    asm volatile("s_waitcnt vmcnt(0)" ::: "memory");
    __syncthreads();
    if (b.w0 && hw_lane() == 0) {
        unsigned* bar = b.bar;
        __builtin_amdgcn_s_waitcnt(0);
        unsigned nloc = b.st[0], nx = b.st[1];
        if (nloc == 0u) { xcd_barrier_complete(bar, b.x, nloc, nx); b.st[0] = nloc; b.st[1] = nx; }
        const unsigned old = xb_add(&bar[XB_XSUB(b.x)], 1u);
        const unsigned gen = old / nloc;
        if (old + 1u == (gen + 1u) * nloc) {
            __builtin_amdgcn_fence(__ATOMIC_RELEASE, "agent");
            asm volatile("s_waitcnt vmcnt(0)" ::: "memory");
            const unsigned og = xb_add(&bar[XB_TOP], 1u);
            const unsigned tg = og / nx;
            if (og + 1u == (tg + 1u) * nx) xb_add(&bar[XB_TOPGEN], 1u);
            else XB_SPIN(xb_ld(&bar[XB_TOPGEN]) == tg, bar);
            __builtin_amdgcn_fence(__ATOMIC_ACQUIRE, "agent");
            xb_add(&bar[XB_XGEN(b.x)], 1u);
            asm volatile("s_waitcnt vmcnt(0)" ::: "memory");
        } else {
            XB_SPIN(xb_ld(&bar[XB_XGEN(b.x)]) == gen, bar);
            __builtin_amdgcn_fence(__ATOMIC_ACQUIRE, "agent");
            asm volatile("s_waitcnt vmcnt(0)" ::: "memory");
        }
    }
    __syncthreads();
}

struct Frame {
    LAS unsigned char* lds;
    volatile LAS unsigned* MISC;
    unsigned* ctl;
    int wave, G, bid;
    __device__ __forceinline__ int lane() const { return hw_lane(); }
    __device__ __forceinline__ int tid() const { return wave * 64 + hw_lane(); }
    __device__ __forceinline__ const float* in(int i) const { const LAS unsigned* p = (const LAS unsigned*)(lds + PTR_OFF) + 2 * i;
        const unsigned lo = __builtin_amdgcn_readfirstlane(p[0]), hi = __builtin_amdgcn_readfirstlane(p[1]); return (const float*)(((unsigned long long)hi << 32) | lo); }
    float* out; unsigned char* ws;
    unsigned long long tacc; int xpass;
};
__device__ __forceinline__ float log2gamma(int h) { return log2f(1.0f - exp2f(-5.0f - (float)h)); }

template <bool F8, class RowMap>
__device__ __forceinline__ void transpose_item(const float* W, int N, bf16* WT, int K, const float* kscale, LAS float* scr, int kb, int nb, int lane, RowMap rm) {
    const int k0 = 64 * kb, n0 = 64 * nb;
#pragma unroll 4
    for (int i = 0; i < 16; ++i) {
        const int kk = 4 * i + (lane >> 4), nn = 4 * (lane & 15);
        f32x4 v = (f32x4){0.f, 0.f, 0.f, 0.f};
        if (n0 + nn < N) v = *(const f32x4*)(W + (size_t)(k0 + kk) * N + n0 + nn);
        if (kscale) v = v * kscale[k0 + kk];
        LAS float* s = scr + kk * 65 + nn; s[0] = v[0]; s[1] = v[1]; s[2] = v[2]; s[3] = v[3];
    }
    asm volatile("s_waitcnt lgkmcnt(0)" ::: "memory");
    const int cch = lane & 7;
#pragma unroll
    for (int j = 0; j < 8; ++j) {
        const int n = 8 * j + (lane >> 3); const LAS float* s = scr + (8 * cch) * 65 + n;
        if constexpr (F8) {
            u32x2 o; o.x = pk4_fp8(s[0 * 65] * W8_SCALE, s[1 * 65] * W8_SCALE, s[2 * 65] * W8_SCALE, s[3 * 65] * W8_SCALE); o.y = pk4_fp8(s[4 * 65] * W8_SCALE, s[5 * 65] * W8_SCALE, s[6 * 65] * W8_SCALE, s[7 * 65] * W8_SCALE);
            if (n0 + n < N) *(u32x2*)((unsigned char*)WT + (size_t)rm(n0 + n) * K + k0 + 8 * cch) = o;
        } else {
        const float cs = (N == IN_COLS && n0 + n >= C_AQ && n0 + n < C_AK) ? 0.125f : 1.0f;
        u32x4 o; o.x = cvtpk(s[0 * 65] * cs, s[1 * 65] * cs); o.y = cvtpk(s[2 * 65] * cs, s[3 * 65] * cs); o.z = cvtpk(s[4 * 65] * cs, s[5 * 65] * cs); o.w = cvtpk(s[6 * 65] * cs, s[7 * 65] * cs);
        if (n0 + n < N) *(u32x4*)(WT + (size_t)rm(n0 + n) * K + k0 + 8 * cch) = o; }
    }
    asm volatile("s_waitcnt lgkmcnt(0)" ::: "memory");
}
__device__ __forceinline__ void f8_item_load(const float* W, int N, int kb, int nb, int lane, f32x4 (&v)[16]) {
    const int k0 = 128 * kb, n0 = 32 * nb;
#pragma unroll
    for (int i = 0; i < 16; ++i) v[i] = *(const f32x4*)(W + (size_t)(k0 + 8 * i + (lane >> 3)) * N + n0 + 4 * (lane & 7));
}
template <class RowMap>
__device__ __forceinline__ void f8_item_store(const f32x4 (&v)[16], unsigned char* WT, int K, LAS float* scr, int kb, int nb, int lane, RowMap rm) {
    const int k0 = 128 * kb, n0 = 32 * nb;
#pragma unroll
    for (int i = 0; i < 16; ++i) { const int kk = 8 * i + (lane >> 3), nn = 4 * (lane & 7); LAS float* s = scr + kk * 32;
        s[(nn + 0) ^ (kk & 31)] = v[i][0]; s[(nn + 1) ^ (kk & 31)] = v[i][1]; s[(nn + 2) ^ (kk & 31)] = v[i][2]; s[(nn + 3) ^ (kk & 31)] = v[i][3]; }
    asm volatile("s_waitcnt lgkmcnt(0)" ::: "memory");
    const int cch = lane & 7;
#pragma unroll
    for (int j = 0; j < 4; ++j) {
        const int n = 8 * j + (lane >> 3); float t[16];
#pragma unroll
        for (int i = 0; i < 16; ++i) { const int kk = 16 * cch + i; t[i] = scr[kk * 32 + (n ^ (kk & 31))] * W8_SCALE; }
        u32x4 o; o.x = pk4_fp8(t[0], t[1], t[2], t[3]); o.y = pk4_fp8(t[4], t[5], t[6], t[7]); o.z = pk4_fp8(t[8], t[9], t[10], t[11]); o.w = pk4_fp8(t[12], t[13], t[14], t[15]);
        *(u32x4*)(WT + (size_t)rm(n0 + n) * K + k0 + 16 * cch) = o;
    }
    asm volatile("s_waitcnt lgkmcnt(0)" ::: "memory");
}
struct RmId { __device__ __forceinline__ int operator()(int n) const { return n; } };
struct RmGu { __device__ __forceinline__ int operator()(int n) const { const int j = n & 1023; return (j >> 7) * 256 + (n >> 10) * 128 + (j & 127); } };

__device__ __forceinline__ void phase_p0a(Frame& F) {
    const float* const c_in = F.in(1); const float* const ada_w = F.in(2); const float* const ada_b = F.in(3); const float* const w_in = F.in(5); const float* const mix_scale = F.in(6);
    const float* const w_o = F.in(7); const float* const w_gu = F.in(11); const float* const w_down = F.in(13);
    if (F.bid < 96) {
        LAS float* sc = (LAS float*)F.lds;
        LAS float* part = (LAS float*)(F.lds + 16384);
        for (int i = F.tid(); i < 1024; i += NTHR) {
#pragma unroll
            for (int b = 0; b < 4; ++b) { const float cv = c_in[b * 1024 + i]; sc[i * 4 + b] = cv / (1.0f + __expf(-cv)); }
        }
        __syncthreads();
        const int j0 = F.bid * 64;
        float a0 = 0.f, a1 = 0.f, a2 = 0.f, a3 = 0.f;
#pragma unroll 8
        for (int ii = 0; ii < 128; ++ii) {
            const int i = F.wave * 128 + ii; const float w = ada_w[(size_t)i * 6144 + j0 + F.lane()];
            const f32x4 s4 = *(const LAS f32x4*)(sc + i * 4);
            a0 += s4[0] * w; a1 += s4[1] * w; a2 += s4[2] * w; a3 += s4[3] * w;
        }
        part[(F.wave * 4 + 0) * 64 + F.lane()] = a0; part[(F.wave * 4 + 1) * 64 + F.lane()] = a1; part[(F.wave * 4 + 2) * 64 + F.lane()] = a2; part[(F.wave * 4 + 3) * 64 + F.lane()] = a3;
        __syncthreads();
        if (F.tid() < 256) { const int b = F.tid() >> 6, l = F.tid() & 63; float s = ada_b[j0 + l];
#pragma unroll
            for (int w = 0; w < 8; ++w) s += part[(w * 4 + b) * 64 + l];
            ((float*)(F.ws + WS_MOD))[b * 6144 + j0 + l] = s; }
        __syncthreads();
    }
    { int* ri = (int*)(F.ws + WS_ROWINFO); for (int i = F.bid * NTHR + F.tid(); i < MOE_ROWS; i += F.G * NTHR) ri[i] = -1; }
    LAS float* scr = (LAS float*)(F.lds + F.wave * 16896);
    const int gw = F.bid * NWAVES + F.wave, NGW = F.G * NWAVES;
    constexpr int I_IN = 16 * 46, I_O = 16 * 16, I_GU = 32 * 16 * 32, I_DN = 32 * 16 * 16, NITEMS = I_IN + I_O + I_GU + I_DN;
    for (int it = (F.G >= 224 ? gw - 96 * NWAVES : gw); it >= 0 && it < I_IN + I_O; it += NGW) {
        int r = it;
        if (r < I_IN) { transpose_item<false>(w_in, IN_COLS, (bf16*)(F.ws + WS_WIN), 1024, nullptr, scr, r / 46, r % 46, F.lane(), RmId()); continue; } r -= I_IN;
        transpose_item<false>(w_o, 1024, (bf16*)(F.ws + WS_WO), 1024, mix_scale, scr, r / 16, r % 16, F.lane(), RmId());
    }
}

template <class RowMap>
__device__ __forceinline__ void f8_item_lowreg(const float* W, int N, unsigned char* WT, int K, LAS float* scr, int kb, int nb, int lane, RowMap rm) {
    const int k0 = 128 * kb, n0 = 32 * nb;
#pragma unroll 1
    for (int h = 0; h < 2; ++h) {
        f32x4 v[8];
#pragma unroll
        for (int i = 0; i < 8; ++i) v[i] = *(const f32x4*)(W + (size_t)(k0 + 64 * h + 8 * i + (lane >> 3)) * N + n0 + 4 * (lane & 7));
#pragma unroll
        for (int i = 0; i < 8; ++i) { const int kk = 64 * h + 8 * i + (lane >> 3), nn = 4 * (lane & 7); LAS float* s = scr + kk * 32;
            s[(nn + 0) ^ (kk & 31)] = v[i][0]; s[(nn + 1) ^ (kk & 31)] = v[i][1]; s[(nn + 2) ^ (kk & 31)] = v[i][2]; s[(nn + 3) ^ (kk & 31)] = v[i][3]; }
    }
    asm volatile("s_waitcnt lgkmcnt(0)" ::: "memory");
    const int cch = lane & 7;
#pragma unroll 1
    for (int j = 0; j < 4; ++j) {
        const int n = 8 * j + (lane >> 3); float t[16];
#pragma unroll
        for (int i = 0; i < 16; ++i) { const int kk = 16 * cch + i; t[i] = scr[kk * 32 + (n ^ (kk & 31))] * W8_SCALE; }
        u32x4 o; o.x = pk4_fp8(t[0], t[1], t[2], t[3]); o.y = pk4_fp8(t[4], t[5], t[6], t[7]); o.z = pk4_fp8(t[8], t[9], t[10], t[11]); o.w = pk4_fp8(t[12], t[13], t[14], t[15]);
        *(u32x4*)(WT + (size_t)rm(n0 + n) * K + k0 + 16 * cch) = o;
    }
    asm volatile("s_waitcnt lgkmcnt(0)" ::: "memory");
}
constexpr int F8_I_GU = 32 * 8 * 64, F8_I_DN = 32 * 8 * 32, F8_ITEMS = F8_I_GU + F8_I_DN;
__device__ __forceinline__ int f8_burst(Frame& F, LAS float* scr, int it, int count) {
    const float* const w_gu = F.in(11); const float* const w_down = F.in(13);
    const int NGW = F.G * NWAVES, lane = F.lane();
    auto item_src = [&](int r, const float*& W, int& N, int& kb, int& nb) { if (r < F8_I_GU) { const int e = r / 512, q = r % 512; W = w_gu + (size_t)e * 1024 * 2048; N = 2048; kb = q / 64; nb = q % 64; }
                                                                             else { r -= F8_I_GU; const int e = r / 256, q = r % 256; W = w_down + (size_t)e * 1024 * 1024; N = 1024; kb = q / 32; nb = q % 32; } };
    asm volatile("" ::: "memory");
    for (int c = 0; c < count && it < F8_ITEMS; ++c) {
        const float* W; int N, kb, nb;
        item_src(it, W, N, kb, nb);
        if (it < F8_I_GU) f8_item_lowreg(W, N, F.ws + WS_WGU + (size_t)(it / 512) * 2048 * 1024, 1024, scr, kb, nb, lane, RmGu());
        else f8_item_lowreg(W, N, F.ws + WS_WDN + (size_t)((it - F8_I_GU) / 256) * 1024 * 1024, 1024, scr, kb, nb, lane, RmId());
        it += NGW;
        asm volatile("" ::: "memory");
    }
    asm volatile("" ::: "memory");
    return it;
}

__device__ __forceinline__ void phase_p0b(Frame& F) {
    const float* const x_in = F.in(0); const float* const norm1_g = F.in(4);
    const int gw = F.bid * NWAVES + F.wave, NGW = F.G * NWAVES;
    const float* mod = (const float*)(F.ws + WS_MOD); bf16* h0 = (bf16*)(F.ws + WS_H0);
    for (int m = gw; m < NTOK; m += NGW) {
        const int b = m / SEQ;
        const f32x4* xr = (const f32x4*)(x_in + (size_t)m * DM) + F.lane();
        f32x4 v[4]; float s = 0.f;
#pragma unroll
        for (int j = 0; j < 4; ++j) { v[j] = xr[64 * j]; s += (v[j][0] * v[j][0] + v[j][1] * v[j][1]) + (v[j][2] * v[j][2] + v[j][3] * v[j][3]); }
        const float rstd = rsqrtf(wave_sum(s) * (1.f / DM) + EPS);
        u32x2* o8 = (u32x2*)(h0 + (size_t)m * DM) + F.lane();
#pragma unroll
        for (int j = 0; j < 4; ++j) { const int col = 4 * F.lane() + 256 * j;
            const f32x4 g = *(const f32x4*)(norm1_g + col), sh = *(const f32x4*)(mod + b * 6144 + col), sc = *(const f32x4*)(mod + b * 6144 + 1024 + col);
            const f32x4 y = (v[j] * rstd) * g * (sc + 1.0f) + sh;
            u32x2 w; w.x = cvtpk(y[0], y[1]); w.y = cvtpk(y[2], y[3]); o8[64 * j] = w; }
    }
}

constexpr int VSTR = 144, KSTR = 80;
__device__ __forceinline__ void ret_stage_v(Frame& F, const bf16* proj, int tok0, int h, LAS bf16* Vs) {
    const int row = F.tid() >> 2, q = F.tid() & 3; const bf16* src = proj + (size_t)(tok0 + row) * PJ + C_RV + h * 128 + q * 32;
#pragma unroll
    for (int i = 0; i < 4; ++i) *(LAS u32x4*)(Vs + row * VSTR + q * 32 + 8 * i) = *(const u32x4*)(src + 8 * i);
}
__device__ __forceinline__ void ret_stage64(Frame& F, const bf16* src0, size_t pitch, LAS bf16* Ds) {
    const int row = F.tid() >> 2, q = F.tid() & 3; const bf16* src = src0 + (size_t)row * pitch + q * 16;
#pragma unroll
    for (int i = 0; i < 2; ++i) *(LAS u32x4*)(Ds + row * KSTR + q * 16 + 8 * i) = *(const u32x4*)(src + 8 * i);
}
__device__ __forceinline__ void ret_a_item(Frame& F, int item) {
    const bf16* proj = (const bf16*)(F.ws + WS_PROJ); float* kvt = (float*)(F.ws + WS_KVT) + (size_t)item * 8192;
    const int bh = item >> 6, n = item & 63, b = bh >> 2, h = bh & 3, tok0 = b * SEQ + n * 128;
    LAS bf16* Vs = (LAS bf16*)F.lds; LAS bf16* Ks = (LAS bf16*)(F.lds + 128 * VSTR * 2);
    const float lg = log2gamma(h);
    ret_stage_v(F, proj, tok0, h, Vs);
    { const int row = F.tid() >> 2, q = F.tid() & 3; const bf16* src = proj + (size_t)(tok0 + row) * PJ + C_RK + h * 64 + q * 16; const float dk = 0.125f * exp2f((float)(127 - row) * lg);
#pragma unroll
      for (int i = 0; i < 2; ++i) { const u32x4 w = *(const u32x4*)(src + 8 * i); u32x4 o;
          o.x = cvtpk(bflo(w.x) * dk, bfhi(w.x) * dk); o.y = cvtpk(bflo(w.y) * dk, bfhi(w.y) * dk); o.z = cvtpk(bflo(w.z) * dk, bfhi(w.z) * dk); o.w = cvtpk(bflo(w.w) * dk, bfhi(w.w) * dk);
          *(LAS u32x4*)(Ks + row * KSTR + q * 16 + 8 * i) = o; } }
    __syncthreads();
    const int lane = F.lane(), n16 = lane & 15, c = lane >> 4, q4 = n16 >> 2, p4 = lane & 3, e0 = 16 * F.wave;
    f32x4 acc[4];
#pragma unroll
    for (int dt = 0; dt < 4; ++dt) acc[dt] = (f32x4){0.f, 0.f, 0.f, 0.f};
#pragma unroll
    for (int s = 0; s < 4; ++s) {
        const LAS bf16* ap = Vs + (32 * s + 4 * c + q4) * VSTR + e0 + 4 * p4;
        const bf16x8 A = cat8(trread(ap), trread(ap + 16 * VSTR));
#pragma unroll
        for (int dt = 0; dt < 4; ++dt) { const LAS bf16* bp = Ks + (32 * s + 4 * c + q4) * KSTR + 16 * dt + 4 * p4;
            const bf16x8 B = cat8(trread(bp), trread(bp + 16 * KSTR)); acc[dt] = MFMA16(A, B, acc[dt]); }
    }
#pragma unroll
    for (int dt = 0; dt < 4; ++dt)
#pragma unroll
        for (int r = 0; r < 4; ++r) kvt[(e0 + 4 * c + r) * 64 + 16 * dt + n16] = acc[dt][r];
    __syncthreads();
}
__device__ __forceinline__ void ret_scan(Frame& F) {
    const float* kvt = (const float*)(F.ws + WS_KVT); bf16* rpt = (bf16*)(F.ws + WS_RPT);
    for (int g = F.bid * NTHR + F.tid(); g < 16 * 8192; g += F.G * NTHR) {
        const int bh = g >> 13, ed = g & 8191, h = bh & 3; const float gC = exp2f(128.0f * log2gamma(h));
        float R = 0.f; const size_t base = (size_t)bh * 64 * 8192 + ed;
#pragma unroll 8
        for (int n = 0; n < 64; ++n) { const float kv = kvt[base + (size_t)n * 8192]; rpt[base + (size_t)n * 8192] = f2bf(R); R = R * gC + kv; }
    }
}
__device__ __forceinline__ void ret_c_item(Frame& F, int item) {
    const bf16* proj = (const bf16*)(F.ws + WS_PROJ); const bf16* rpt = (const bf16*)(F.ws + WS_RPT) + (size_t)item * 8192; bf16* mix = (bf16*)(F.ws + WS_MIX);
    const int bh = item >> 6, n = item & 63, b = bh >> 2, h = bh & 3, tok0 = b * SEQ + n * 128;
    LAS bf16* Qs = (LAS bf16*)F.lds; LAS bf16* Ks = Qs + 128 * KSTR; LAS bf16* Vs = Ks + 128 * KSTR; LAS bf16* Rs = Vs + 128 * VSTR;
    const float lg = log2gamma(h);
    ret_stage64(F, proj + (size_t)tok0 * PJ + C_RQ + h * 64, PJ, Qs);
    ret_stage64(F, proj + (size_t)tok0 * PJ + C_RK + h * 64, PJ, Ks);
    ret_stage_v(F, proj, tok0, h, Vs);
    ret_stage64(F, rpt, 64, Rs);
    __syncthreads();
    const int lane = F.lane(), n16 = lane & 15, c = lane >> 4, q4 = n16 >> 2, p4 = lane & 3, w = F.wave, i0 = 16 * w, il = i0 + n16;
    bf16x8 qf[2];
#pragma unroll
    for (int s = 0; s < 2; ++s) qf[s] = *(const LAS bf16x8*)(Qs + il * KSTR + 32 * s + 8 * c);
    f32x4 oin[8], ocr[8];
#pragma unroll
    for (int et = 0; et < 8; ++et) { oin[et] = (f32x4){0.f, 0.f, 0.f, 0.f}; ocr[et] = (f32x4){0.f, 0.f, 0.f, 0.f}; }
    const int nsp = (w >> 1) + 1;
    for (int sp = 0; sp < nsp; ++sp) {
        unsigned pw[4];
#pragma unroll
        for (int t2 = 0; t2 < 2; ++t2) { const int jt = 2 * sp + t2;
            const bf16x8 k0 = *(const LAS bf16x8*)(Ks + (16 * jt + n16) * KSTR + 8 * c), k1 = *(const LAS bf16x8*)(Ks + (16 * jt + n16) * KSTR + 32 + 8 * c);
            f32x4 st = MFMA16(k0, qf[0], ((f32x4){0.f, 0.f, 0.f, 0.f})); st = MFMA16(k1, qf[1], st);
            float pv[4];
#pragma unroll
            for (int r = 0; r < 4; ++r) { const int j = 16 * jt + 4 * c + r; const float f = (il >= j) ? 0.125f * exp2f((float)(il - j) * lg) : 0.f; pv[r] = st[r] * f; }
            pw[2 * t2] = cvtpk(pv[0], pv[1]); pw[2 * t2 + 1] = cvtpk(pv[2], pv[3]); }
        const bf16x8 P = __builtin_bit_cast(bf16x8, ((u32x4){pw[0], pw[1], pw[2], pw[3]}));
#pragma unroll
        for (int et = 0; et < 8; ++et) { const LAS bf16* ap = Vs + (32 * sp + 4 * c + q4) * VSTR + 16 * et + 4 * p4;
            const bf16x8 A = cat8(trread(ap), trread(ap + 16 * VSTR)); oin[et] = MFMA16(A, P, oin[et]); }
    }
#pragma unroll
    for (int et = 0; et < 8; ++et)
#pragma unroll
        for (int s = 0; s < 2; ++s) { const bf16x8 rf = *(const LAS bf16x8*)(Rs + (16 * et + n16) * KSTR + 32 * s + 8 * c); ocr[et] = MFMA16(rf, qf[s], ocr[et]); }
    const float qd = exp2f((float)(il + 1) * lg);
    float ss = 0.f;
#pragma unroll
    for (int et = 0; et < 8; ++et) { oin[et] = oin[et] + ocr[et] * qd; ss += (oin[et][0] * oin[et][0] + oin[et][1] * oin[et][1]) + (oin[et][2] * oin[et][2] + oin[et][3] * oin[et][3]); }
    ss += __shfl_xor(ss, 16); ss += __shfl_xor(ss, 32);
    const float rstd = rsqrtf(ss * (1.f / 128.f) + EPS);
    const bf16* gp = proj + (size_t)(tok0 + il) * PJ + C_RG + h * 128 + 4 * c; bf16* op = mix + (size_t)(tok0 + il) * DM + h * 128 + 4 * c;
#pragma unroll
    for (int et = 0; et < 8; ++et) { const u32x2 gw = *(const u32x2*)(gp + 16 * et);
        const float g0 = bflo(gw.x), g1 = bfhi(gw.x), g2 = bflo(gw.y), g3 = bfhi(gw.y);
        const float y0 = g0 / (1.f + __expf(-g0)) * (oin[et][0] * rstd), y1 = g1 / (1.f + __expf(-g1)) * (oin[et][1] * rstd), y2 = g2 / (1.f + __expf(-g2)) * (oin[et][2] * rstd), y3 = g3 / (1.f + __expf(-g3)) * (oin[et][3] * rstd);
        u32x2 o; o.x = cvtpk(y0, y1); o.y = cvtpk(y2, y3); *(u32x2*)(op + 16 * et) = o; }
    __syncthreads();
}

constexpr int MTW = 2;
constexpr int RPW = 4 * MTW, QT = 8 * RPW, KT = 64, CAP = 131072 / (QT * 4), CAP_TRIG = CAP - KT, NSEL = 256, NREG = CAP / 64;
constexpr int KTS = 72;
constexpr int CAND_BYTES = QT * CAP * 4, KTILE_BYTES = KT * KTS * 2;
constexpr float WSCALE = 0.125f * 0.35355339059327373f;
__device__ __forceinline__ unsigned fmap(float s) { const unsigned u = __builtin_bit_cast(unsigned, s); return (u & 0x80000000u) ? ~u : (u | 0x80000000u); }
__device__ __forceinline__ float funmap(unsigned m) { const unsigned u = (m & 0x80000000u) ? (m ^ 0x80000000u) : ~m; return __builtin_bit_cast(float, u); }
#define DPP_ROR(v, n) ((unsigned)__builtin_amdgcn_update_dpp(0, (int)(v), 0x120 + (n), 0xf, 0xf, false))
#define DPP_SHR0(v, n) ((unsigned)__builtin_amdgcn_update_dpp(0, (int)(v), 0x110 + (n), 0xf, 0xf, true))
__device__ __forceinline__ unsigned wave_umin(unsigned v) {
    v = min(v, DPP_ROR(v, 1)); v = min(v, DPP_ROR(v, 2)); v = min(v, DPP_ROR(v, 4)); v = min(v, DPP_ROR(v, 8));
    const unsigned a = __builtin_amdgcn_readlane(v, 0), b = __builtin_amdgcn_readlane(v, 16), c = __builtin_amdgcn_readlane(v, 32), d = __builtin_amdgcn_readlane(v, 48);
    return min(min(a, b), min(c, d));
}
__device__ __forceinline__ unsigned wave_umax(unsigned v) {
    v = max(v, DPP_ROR(v, 1)); v = max(v, DPP_ROR(v, 2)); v = max(v, DPP_ROR(v, 4)); v = max(v, DPP_ROR(v, 8));
    const unsigned a = __builtin_amdgcn_readlane(v, 0), b = __builtin_amdgcn_readlane(v, 16), c = __builtin_amdgcn_readlane(v, 32), d = __builtin_amdgcn_readlane(v, 48);
    return max(max(a, b), max(c, d));
}
__device__ __forceinline__ unsigned wave_scan_incl(unsigned v, int lane) {
    v += DPP_SHR0(v, 1); v += DPP_SHR0(v, 2); v += DPP_SHR0(v, 4); v += DPP_SHR0(v, 8);
    const unsigned t0 = __builtin_amdgcn_readlane(v, 15), t1 = __builtin_amdgcn_readlane(v, 31), t2 = __builtin_amdgcn_readlane(v, 47);
    const int rw = lane >> 4;
    return v + (rw == 1 ? t0 : rw == 2 ? t0 + t1 : rw == 3 ? t0 + t1 + t2 : 0u);
}
__device__ __forceinline__ unsigned lt01(int a, int b) { unsigned r; asm("v_sub_u32 %0, %1, %2\n\tv_lshrrev_b32 %0, 31, %0" : "=&v"(r) : "v"(a), "v"(b)); return r; }
#define BIT01(m, j) ({ unsigned _r; asm("v_bfe_u32 %0, %1, %2, 1" : "=v"(_r) : "v"(m), "n"(j)); _r; })
#define LT01(a, b) lt01((int)(a), (int)(b))
__device__ __forceinline__ int select_row(LAS unsigned* row, int cnt, int limit, LAS unsigned* hist, LAS unsigned* trashp, int lane, unsigned& minkey, int need0 = NSEL) {
    unsigned e[NREG]; unsigned act = 0u, keep = 0u;
#pragma unroll
    for (int j = 0; j < NREG; ++j) { const unsigned v = LT01(64 * j + lane, cnt); e[j] = row[64 * j + lane] & (0u - v); act |= v << j; }
    int need = need0; bool first = true;
    for (;;) {
        unsigned lo = 0xFFFFFFFFu, hi = 0u;
#pragma unroll
        for (int j = 0; j < NREG; ++j) { const unsigned a = BIT01(act, j); lo = min(lo, e[j] | (a - 1u)); hi = max(hi, e[j] & (0u - a)); }
        lo = wave_umin(lo); hi = wave_umax(hi);
        if (hi == lo) break;
        hist[lane] = 0u;
        int rb[NREG];
        if (first) {
            const float slo = funmap(lo & 0xFFFFE000u), shi = funmap(hi & 0xFFFFE000u);
            const float scale = (shi > slo) ? 63.999f / (shi - slo) : 0.f;
#pragma unroll
            for (int j = 0; j < NREG; ++j) { const int bn = (int)((funmap(e[j] & 0xFFFFE000u) - slo) * scale); rb[j] = 63 - min(max(bn, 0), 63); }
        } else {
            const float scale = 63.999f / (float)(hi - lo);
#pragma unroll
            for (int j = 0; j < NREG; ++j) { const int bn = (int)((float)(e[j] - lo) * scale); rb[j] = 63 - min(max(bn, 0), 63); }
        }
        first = false;
#pragma unroll
        for (int j = 0; j < NREG; ++j) __hip_atomic_fetch_add(hist + rb[j], BIT01(act, j), __ATOMIC_RELAXED, __HIP_MEMORY_SCOPE_WAVEFRONT);
        const unsigned h = hist[lane];
        const unsigned ps = wave_scan_incl(h, lane);
        const unsigned long long m = __ballot(ps >= (unsigned)need);
        const int ls = (int)__builtin_ctzll(m);
        const int cge = (int)__builtin_amdgcn_readlane(ps, ls), nb = (int)__builtin_amdgcn_readlane(h, ls);
#pragma unroll
        for (int j = 0; j < NREG; ++j) { const unsigned a = BIT01(act, j), kp = a & LT01(rb[j], ls), dr = a & LT01(ls, rb[j]); keep |= kp << j; act &= ~((kp | dr) << j); }
        need -= cge - nb;
        if ((need0 - need) + nb <= limit) break;
    }
    keep |= act;
    const unsigned kcnt = (unsigned)__builtin_popcount(keep); const unsigned incl = wave_scan_incl(kcnt, lane);
    int pos = (int)(incl - kcnt); const int run = (int)__builtin_amdgcn_readlane(incl, 63); unsigned mk = 0xFFFFFFFFu;
#pragma unroll
    for (int j = 0; j < NREG; ++j) { const unsigned k = BIT01(keep, j);
        *(trashp + ((int)((row + pos) - trashp) & -(int)k)) = e[j];
        mk = min(mk, e[j] | (k - 1u)); pos += (int)k; }
    minkey = wave_umin(mk);
    return run;
}
__device__ __forceinline__ int compact_stream(LAS unsigned* row, int cnt, LAS unsigned* hist, LAS unsigned* trashp, int lane, float& thrf) {
    unsigned e[NREG];
#pragma unroll
    for (int j = 0; j < NREG; ++j) e[j] = row[64 * j + lane];
    const unsigned lo = wave_umin(min(e[0], e[1])), hi = wave_umax(max(e[0], e[1]));
    const float slo = funmap(lo & 0xFFFFE000u), shi = funmap(hi & 0xFFFFE000u);
    bool ok = shi > slo; int newcnt = 0, bstar = 0; int bn[NREG]; float scale = 0.f;
    if (ok) {
        scale = 63.999f / (shi - slo);
        hist[lane] = 0u;
#pragma unroll
        for (int j = 0; j < NREG; ++j) { const int b = (int)((funmap(e[j] & 0xFFFFE000u) - slo) * scale); bn[j] = min(max(b, 0), 63);
            __hip_atomic_fetch_add(hist + (63 - bn[j]), LT01(64 * j + lane, cnt), __ATOMIC_RELAXED, __HIP_MEMORY_SCOPE_WAVEFRONT); }
        const unsigned h = hist[lane];
        const unsigned ps = wave_scan_incl(h, lane);
        const unsigned long long m = __ballot(ps >= (unsigned)NSEL);
        const int ls = (int)__builtin_ctzll(m);
        newcnt = (int)__builtin_amdgcn_readlane(ps, ls); bstar = 63 - ls;
        ok = newcnt <= NSEL + 96;
    }
    if (!ok) { unsigned P; const int nc = select_row(row, cnt, NSEL + 64, hist, trashp, lane, P); thrf = funmap(P & 0xFFFFE000u); return nc; }
    unsigned keep = 0u;
#pragma unroll
    for (int j = 0; j < NREG; ++j) keep |= (LT01(64 * j + lane, cnt) & LT01(bstar - 1, bn[j])) << j;
    const unsigned kcnt = (unsigned)__builtin_popcount(keep); const unsigned incl = wave_scan_incl(kcnt, lane);
    int pos = (int)(incl - kcnt); const int run = (int)__builtin_amdgcn_readlane(incl, 63);
#pragma unroll
    for (int j = 0; j < NREG; ++j) { const unsigned k = BIT01(keep, j);
        *(trashp + ((int)((row + pos) - trashp) & -(int)k)) = e[j];
        pos += (int)k; }
    if (bstar > 0) thrf = slo + ((float)bstar - 0.01f) / scale;
    return run;
}
__device__ __forceinline__ int select_final(LAS unsigned* row, int cnt, LAS unsigned* hist, LAS unsigned* trashp, int lane) {
    unsigned e[NREG];
#pragma unroll
    for (int j = 0; j < NREG; ++j) e[j] = row[64 * j + lane] & (0u - LT01(64 * j + lane, cnt));
    const unsigned lo = wave_umin(min(e[0], e[1])), hi = wave_umax(max(e[0], e[1]));
    const float slo = funmap(lo & 0xFFFFE000u), shi = funmap(hi & 0xFFFFE000u);
    bool ok = shi > slo; int nb = 0, bstar = 0, cgt = 0; int bn[NREG];
    if (ok) {
        const float scale = 63.999f / (shi - slo);
        hist[lane] = 0u;
#pragma unroll
        for (int j = 0; j < NREG; ++j) { const int b = (int)((funmap(e[j] & 0xFFFFE000u) - slo) * scale); bn[j] = min(max(b, 0), 63);
            __hip_atomic_fetch_add(hist + (63 - bn[j]), LT01(64 * j + lane, cnt), __ATOMIC_RELAXED, __HIP_MEMORY_SCOPE_WAVEFRONT); }
        const unsigned h = hist[lane];
        const unsigned ps = wave_scan_incl(h, lane);
        const unsigned long long m = __ballot(ps >= (unsigned)NSEL);
        const int ls = (int)__builtin_ctzll(m);
        nb = (int)__builtin_amdgcn_readlane(h, ls); cgt = (int)__builtin_amdgcn_readlane(ps, ls) - nb; bstar = 63 - ls;
        ok = nb <= 64;
    }
    if (!ok) { unsigned P; return select_row(row, cnt, NSEL, hist, trashp, lane, P); }
    unsigned keepm = 0u, bndm = 0u;
#pragma unroll
    for (int j = 0; j < NREG; ++j) { const unsigned v = LT01(64 * j + lane, cnt); keepm |= (v & LT01(bstar, bn[j])) << j; bndm |= (v & (1u - LT01(bstar, bn[j])) & (1u - LT01(bn[j], bstar))) << j; }
    { const unsigned bc = (unsigned)__builtin_popcount(bndm); int bp = (int)(wave_scan_incl(bc, lane) - bc);
#pragma unroll
      for (int j = 0; j < NREG; ++j) { const unsigned k = BIT01(bndm, j); *(trashp + ((int)((hist + bp) - trashp) & -(int)k)) = e[j]; bp += (int)k; } }
    const unsigned x = hist[lane] & (0u - LT01(lane, nb));
    int rank = 0;
    for (int i = 0; i < nb; ++i) rank += (int)(hist[i] > x);
    const int needb = NSEL - cgt;
    { const unsigned kc = (unsigned)__builtin_popcount(keepm); int pos = (int)(wave_scan_incl(kc, lane) - kc);
#pragma unroll
      for (int j = 0; j < NREG; ++j) { const unsigned k = BIT01(keepm, j); *(trashp + ((int)((row + pos) - trashp) & -(int)k)) = e[j]; pos += (int)k; } }
    { const unsigned k = LT01(lane, nb) & LT01(rank, needb); *(trashp + ((int)((row + cgt + rank) - trashp) & -(int)k)) = x; }
    return NSEL;
}
__device__ __forceinline__ float sample_threshold(const LAS unsigned* row, int cnt, int rank, LAS unsigned* hist, int lane) {
    unsigned e[NREG];
#pragma unroll
    for (int j = 0; j < NREG; ++j) e[j] = row[64 * j + lane];
    unsigned lo = 0xFFFFFFFFu, hi = 0u;
#pragma unroll
    for (int j = 0; j < NREG; ++j) { const unsigned v = LT01(64 * j + lane, cnt); lo = min(lo, e[j] | (v - 1u)); hi = max(hi, e[j] & (0u - v)); }
    lo = wave_umin(lo); hi = wave_umax(hi);
    const float slo = funmap(lo & 0xFFFFE000u), shi = funmap(hi & 0xFFFFE000u);
    if (!(shi > slo)) return -INFINITY;
    const float scale = 63.999f / (shi - slo);
    hist[lane] = 0u;
#pragma unroll
    for (int j = 0; j < NREG; ++j) { const int b = (int)((funmap(e[j] & 0xFFFFE000u) - slo) * scale);
        __hip_atomic_fetch_add(hist + (63 - min(max(b, 0), 63)), LT01(64 * j + lane, cnt), __ATOMIC_RELAXED, __HIP_MEMORY_SCOPE_WAVEFRONT); }
    const unsigned ps = wave_scan_incl(hist[lane], lane);
    const int bstar = 63 - (int)__builtin_ctzll(__ballot(ps >= (unsigned)rank));
    return bstar > 0 ? slo + ((float)bstar - 0.01f) / scale : -INFINITY;
}
#if defined(PROBE_SUB)
#define PSUB_T(i) do { const unsigned long long _t = __builtin_amdgcn_s_memrealtime(); if ((i) == PROBE_SUB) F.tacc += _t - psub_last; psub_last = _t; } while (0)
#else
#define PSUB_T(i) do { } while (0)
#endif
#ifndef DSA_EXP
#define DSA_EXP 0
#endif
#define DSA_X(bit) (F.xpass != 0 && (DSA_EXP & (bit)))
__device__ __forceinline__ void dsa_a_wave(Frame& F, int b, int qt, int ws) {
#if defined(PROBE_SUB)
    unsigned long long psub_last = 0ull;
#endif
    const bf16* proj = (const bf16*)(F.ws + WS_PROJ); bf16* sel = (bf16*)(F.ws + WS_SEL);
    LAS unsigned* cand = (LAS unsigned*)F.lds;
    LAS unsigned* hist = (LAS unsigned*)(F.lds + CAND_BYTES) + 64 * F.wave;
    LAS int* rowcnt = (LAS int*)(F.lds + CAND_BYTES + 2048); LAS float* rowthr = (LAS float*)(F.lds + CAND_BYTES + 2048 + 256);
    const int lane = F.lane(), w = F.wave, r32 = lane & 31, hi = lane >> 5;
    const int trash = (CAND_BYTES + 2048 + 512) / 4 + 64 * w + lane;
    const int tokb = b * SEQ, q0 = qt * QT + RPW * ws;
    bf16x8 af[MTW][4]; float wv[MTW][16];
    { const int qq = 2 * ((r32 >> 2) & 1) + (r32 >> 4), hd = ((r32 >> 3) & 1) * 4 + (r32 & 3);
#pragma unroll
      for (int mt = 0; mt < MTW; ++mt) { const bf16* qp = proj + (size_t)(tokb + q0 + 4 * mt + qq) * PJ + C_IQ + hd * 64 + 32 * hi;
#pragma unroll
          for (int s = 0; s < 4; ++s) af[mt][s] = *(const bf16x8*)(qp + 8 * s);
#pragma unroll
          for (int u = 0; u < 2; ++u) { const u32x4 ww = *(const u32x4*)(proj + (size_t)(tokb + q0 + 4 * mt + 2 * hi + u) * PJ + C_IW);
              wv[mt][8 * u + 0] = bflo(ww.x) * WSCALE; wv[mt][8 * u + 1] = bfhi(ww.x) * WSCALE; wv[mt][8 * u + 2] = bflo(ww.y) * WSCALE; wv[mt][8 * u + 3] = bfhi(ww.y) * WSCALE;
              wv[mt][8 * u + 4] = bflo(ww.z) * WSCALE; wv[mt][8 * u + 5] = bfhi(ww.z) * WSCALE; wv[mt][8 * u + 6] = bflo(ww.w) * WSCALE; wv[mt][8 * u + 7] = bfhi(ww.w) * WSCALE; } } }
    float thrf[MTW][2]; int cntv[MTW][2];
    if (lane < RPW) { rowcnt[RPW * w + lane] = 0; rowthr[RPW * w + lane] = -INFINITY; }
    const int NT = (q0 + RPW + KT - 1) / KT;
    const char* kbase = (const char*)(proj + (size_t)tokb * PJ + C_IK + 32 * hi);
    const unsigned koff = (unsigned)r32 * (unsigned)(PJ * 2);
    constexpr int SSTR = 16, SOFF = 7, SRANK = 40;
    for (int pass = (NT >= 2 * SSTR ? 0 : 1); pass < 3; ++pass) {
        const int stride = pass == 0 ? SSTR : 1, kt0 = pass == 0 ? SOFF : 0;
#pragma unroll
        for (int mt = 0; mt < MTW; ++mt)
#pragma unroll
            for (int u = 0; u < 2; ++u) { cntv[mt][u] = 0; thrf[mt][u] = pass == 1 ? rowthr[RPW * w + 4 * mt + 2 * hi + u] : -INFINITY; }
        bf16x8 kc[2][4], kn[2][4];
        { const char* kb0 = kbase + (size_t)kt0 * KT * (PJ * 2);
#pragma unroll
          for (int sub = 0; sub < 2; ++sub)
#pragma unroll
              for (int s = 0; s < 4; ++s) kc[sub][s] = *(const bf16x8*)(kb0 + koff + (unsigned)(sub * 32) * (unsigned)(PJ * 2) + 16 * s); }
        auto tile_step = [&](int kt, bf16x8 (&kc)[2][4], bf16x8 (&kn)[2][4]) {
            PSUB_T(0);
            const char* kb1 = kbase + (size_t)(kt + stride) * KT * (PJ * 2);
#pragma unroll
            for (int sub = 0; sub < 2; ++sub) {
                if (kt + stride < NT) {
#pragma unroll
                    for (int s = 0; s < 4; ++s) kn[sub][s] = *(const bf16x8*)(kb1 + koff + (unsigned)(sub * 32) * (unsigned)(PJ * 2) + 16 * s); }
                const int key = kt * KT + sub * 32 + r32;
                f32x16 accs[MTW];
#pragma unroll
                for (int mt = 0; mt < MTW; ++mt) {
                    accs[mt] = MFMA32(af[mt][0], kc[sub][0], ((f32x16){0.f, 0.f, 0.f, 0.f, 0.f, 0.f, 0.f, 0.f, 0.f, 0.f, 0.f, 0.f, 0.f, 0.f, 0.f, 0.f}));
#pragma unroll
                    for (int s = 1; s < 4; ++s) accs[mt] = MFMA32(af[mt][s], kc[sub][s], accs[mt]);
                }
#pragma unroll
                for (int mt = 0; mt < MTW; ++mt) {
                    float sc[2] = {0.f, 0.f};
#pragma unroll
                    for (int r = 0; r < 16; ++r) sc[r >> 3] += wv[mt][r] * fmaxf(accs[mt][r], 0.f);
#pragma unroll
                    for (int u = 0; u < 2; ++u) {
                        const int ql = RPW * w + 4 * mt + 2 * hi + u;
                        const bool valid = (sc[u] >= thrf[mt][u]) && (key <= q0 + 4 * mt + 2 * hi + u);
                        const unsigned long long m = __ballot(valid);
                        const int nlo = __builtin_popcount((unsigned)m), nhi = __builtin_popcount((unsigned)(m >> 32));
                        const int off = mbcnt64(m) - (hi ? nlo : 0);
                        cand[valid ? ql * CAP + cntv[mt][u] + off : trash] = (fmap(sc[u]) & 0xFFFFE000u) | (unsigned)(8191 - key);
                        cntv[mt][u] += hi ? nhi : nlo;
                    }
                }
            }
            PSUB_T(1);
            bool anyc = false;
#pragma unroll
            for (int mt = 0; mt < MTW; ++mt)
#pragma unroll
                for (int u = 0; u < 2; ++u) anyc = anyc || (cntv[mt][u] > CAP_TRIG);
            if (__any(anyc)) {
                if ((lane & 31) == 0) {
#pragma unroll
                    for (int mt = 0; mt < MTW; ++mt)
#pragma unroll
                        for (int u = 0; u < 2; ++u) { rowcnt[RPW * w + 4 * mt + 2 * hi + u] = cntv[mt][u]; rowthr[RPW * w + 4 * mt + 2 * hi + u] = thrf[mt][u]; }
                }
#pragma unroll 1
                for (int rr = 0; rr < RPW; ++rr) { const int rowi = RPW * w + rr; const int cq = __builtin_amdgcn_readfirstlane(rowcnt[rowi]);
                    if (cq > NSEL + 64) { float tf = rowthr[rowi]; const int nc = compact_stream(cand + rowi * CAP, cq, hist, cand + trash, lane, tf);
                        if (lane == 0) { rowcnt[rowi] = nc; rowthr[rowi] = tf; } } }
#pragma unroll
                for (int mt = 0; mt < MTW; ++mt)
#pragma unroll
                    for (int u = 0; u < 2; ++u) { cntv[mt][u] = rowcnt[RPW * w + 4 * mt + 2 * hi + u]; thrf[mt][u] = rowthr[RPW * w + 4 * mt + 2 * hi + u]; }
            }
            PSUB_T(7);
        };
        for (int kt = kt0; kt < NT; kt += 2 * stride) { tile_step(kt, kc, kn); if (kt + stride < NT) tile_step(kt + stride, kn, kc); }
        if ((lane & 31) == 0) {
#pragma unroll
            for (int mt = 0; mt < MTW; ++mt)
#pragma unroll
                for (int u = 0; u < 2; ++u) rowcnt[RPW * w + 4 * mt + 2 * hi + u] = cntv[mt][u];
        }
        if (pass == 0) {
#pragma unroll 1
            for (int rr = 0; rr < RPW; ++rr) { const int rowi = RPW * w + rr; const int cq = __builtin_amdgcn_readfirstlane(rowcnt[rowi]); float tf = -INFINITY;
                if (cq > SRANK + 8) tf = sample_threshold(cand + rowi * CAP, cq, SRANK, hist, lane);
                if (lane == 0) rowthr[rowi] = tf; }
        } else {
            bool okall = true;
#pragma unroll 1
            for (int rr = 0; rr < RPW; ++rr) { const int cq = __builtin_amdgcn_readfirstlane(rowcnt[RPW * w + rr]); const int nrow = q0 + rr + 1; okall = okall && (cq >= (nrow < NSEL ? nrow : NSEL)); }
            if (okall) break;
        }
    }
    PSUB_T(5);
#pragma unroll 1
    for (int rr = 0; rr < RPW; ++rr) { const int ql = RPW * w + rr; LAS unsigned* row = cand + ql * CAP; int cq = __builtin_amdgcn_readfirstlane(rowcnt[ql]);
        if (cq > NSEL) cq = select_final(row, cq, hist, cand + trash, lane);
        bf16* so = sel + (size_t)(tokb + q0 + rr) * NSEL;
#pragma unroll
        for (int j = 0; j < 4; ++j) { const int p = 64 * j + lane; const unsigned v = row[p]; so[p] = (p < cq) ? (bf16)(8191u - (v & 0x1FFFu)) : (bf16)0; } }
    PSUB_T(6);
}

constexpr int VROW = 144;
constexpr int DSB_WAVE = 32 * VROW * 2 + 2 * 2048;
static_assert(8 * DSB_WAVE <= MISC_OFF, "DSA-B LDS map");
__device__ __forceinline__ void dsb_gather(const char* kvbase, const LAS unsigned* sl, int chunk, int colbyte, int c, int n16, u32x4 (&r)[8]) {
#pragma unroll
    for (int i = 0; i < 8; ++i) { const unsigned o = sl[32 * chunk + 4 * i + c] + (unsigned)(colbyte + n16 * 16); r[i] = *(const u32x4*)(kvbase + o); }
}
__device__ __forceinline__ void dsb_put_list(LAS unsigned* sl, u32x2 kk, int t, int lane) {
    const unsigned k0 = kk.x & 0xffffu, k1 = kk.x >> 16, k2 = kk.y & 0xffffu, k3 = kk.y >> 16;
    *(LAS u32x4*)(sl + 4 * lane) = (u32x4){k0 * (unsigned)(PJ * 2), k1 * (unsigned)(PJ * 2), k2 * (unsigned)(PJ * 2), k3 * (unsigned)(PJ * 2)};
    *(LAS f32x4*)((LAS float*)(sl + 256) + 4 * lane) = (f32x4){(float)(t - (int)k0), (float)(t - (int)k1), (float)(t - (int)k2), (float)(t - (int)k3)};
}
__device__ __forceinline__ void phase_dsa_b(Frame& F) {
    const bf16* proj = (const bf16*)(F.ws + WS_PROJ); const bf16* sel = (const bf16*)(F.ws + WS_SEL); bf16* mix = (bf16*)(F.ws + WS_MIX);
    const int lane = F.lane(), n16 = lane & 15, c = lane >> 4, q4 = n16 >> 2, p4 = lane & 3, w = F.wave;
    LAS unsigned char* wl = F.lds + w * DSB_WAVE;
    LAS bf16* buf = (LAS bf16*)wl; LAS unsigned* slb = (LAS unsigned*)(wl + 32 * VROW * 2);
    const float nslope[2] = {-exp2f(-(float)((n16 & 3) + 1)), -exp2f(-(float)((n16 & 3) + 5))};
    constexpr float L2E = 1.4426950408889634f;
    for (int blk = F.bid; blk < NTOK / 128; blk += F.G) {
        int T0 = blk * 128;
        if (F.G == 256) { const int x = F.bid & 7, jj = F.bid >> 3; T0 = (x & 3) * SEQ + (jj * 2 + (x >> 2)) * 128; }
        const char* kvbase = (const char*)(proj + (size_t)(T0 / SEQ) * SEQ * PJ);
        int tok = T0 + w;
        u32x4 kr[8], vr[8]; bf16x8 qf[2][2]; u32x2 selnext;
        dsb_put_list(slb, *(const u32x2*)(sel + (size_t)tok * NSEL + 4 * lane), tok % SEQ, lane);
        dsb_gather(kvbase, slb, 0, C_AK * 2, c, n16, kr); dsb_gather(kvbase, slb, 0, C_AV * 2, c, n16, vr);
#pragma unroll
        for (int g = 0; g < 2; ++g)
#pragma unroll
            for (int s = 0; s < 2; ++s) { bf16x8 v = (bf16x8){0, 0, 0, 0, 0, 0, 0, 0};
                if (n16 < 4) v = *(const bf16x8*)(proj + (size_t)tok * PJ + C_AQ + (g * 4 + n16) * 64 + 32 * s + 8 * c);
                qf[g][s] = v; }
        for (int qi = 0; qi < 16; ++qi) {
            const int t = tok % SEQ, nsel = (t + 1 < NSEL) ? t + 1 : NSEL; const int par = qi & 1;
            const LAS unsigned* sl = slb + par * 512; LAS unsigned* sln = slb + (par ^ 1) * 512;
            const bool more = qi + 1 < 16; const int tokn = tok + 8;
            if (more) selnext = *(const u32x2*)(sel + (size_t)tokn * NSEL + 4 * lane);
            float mrun[2] = {-INFINITY, -INFINITY}, lrun[2] = {0.f, 0.f};
            f32x4 O[2][4];
#pragma unroll
            for (int g = 0; g < 2; ++g)
#pragma unroll
                for (int dt = 0; dt < 4; ++dt) O[g][dt] = (f32x4){0.f, 0.f, 0.f, 0.f};
            bf16x8 qn[2][2];
#pragma unroll 4
            for (int ch = 0; ch < 8; ++ch) {
#pragma unroll
                for (int i = 0; i < 8; ++i) *(LAS u32x4*)(buf + (4 * i + c) * VROW + n16 * 8) = kr[i];
                if (ch == 3 && more) dsb_put_list(sln, selnext, tokn % SEQ, lane);
                asm volatile("" ::: "memory");
                if (ch < 7) dsb_gather(kvbase, sl, ch + 1, C_AK * 2, c, n16, kr);
                else if (more) dsb_gather(kvbase, sln, 0, C_AK * 2, c, n16, kr);
                if (ch == 6 && more) {
#pragma unroll
                    for (int g = 0; g < 2; ++g)
#pragma unroll
                        for (int s = 0; s < 2; ++s) { bf16x8 v = (bf16x8){0, 0, 0, 0, 0, 0, 0, 0};
                            if (n16 < 4) v = *(const bf16x8*)(proj + (size_t)tokn * PJ + C_AQ + (g * 4 + n16) * 64 + 32 * s + 8 * c);
                            qn[g][s] = v; } }
                f32x4 acc[2][2];
#pragma unroll
                for (int kt = 0; kt < 2; ++kt)
#pragma unroll
                    for (int g = 0; g < 2; ++g) { const LAS bf16* ap = buf + (16 * kt + n16) * VROW + g * 64 + 8 * c;
                        acc[kt][g] = MFMA16(*(const LAS bf16x8*)ap, qf[g][0], ((f32x4){0.f, 0.f, 0.f, 0.f})); acc[kt][g] = MFMA16(*(const LAS bf16x8*)(ap + 32), qf[g][1], acc[kt][g]); }
#pragma unroll
                for (int kt = 0; kt < 2; ++kt) { const f32x4 d4 = *(const LAS f32x4*)((const LAS float*)(sl + 256) + 32 * ch + 16 * kt + 4 * c);
#pragma unroll
                    for (int r = 0; r < 4; ++r)
#pragma unroll
                        for (int g = 0; g < 2; ++g) acc[kt][g][r] = fmaf(nslope[g], d4[r], acc[kt][g][r]); }
                if (nsel < NSEL) {
#pragma unroll
                    for (int kt = 0; kt < 2; ++kt)
#pragma unroll
                        for (int r = 0; r < 4; ++r) { const bool dead = 32 * ch + 16 * kt + 4 * c + r >= nsel;
#pragma unroll
                            for (int g = 0; g < 2; ++g) acc[kt][g][r] = dead ? -INFINITY : acc[kt][g][r]; }
                }
                bf16x8 pf[2]; float alpha[2]; bool grow = false;
#pragma unroll
                for (int g = 0; g < 2; ++g) {
                    float mx = fmaxf(fmaxf(fmaxf(acc[0][g][0], acc[0][g][1]), fmaxf(acc[0][g][2], acc[0][g][3])), fmaxf(fmaxf(acc[1][g][0], acc[1][g][1]), fmaxf(acc[1][g][2], acc[1][g][3])));
                    mx = fmaxf(mx, __shfl_xor(mx, 16)); mx = fmaxf(mx, __shfl_xor(mx, 32));
                    const float mnew = fmaxf(mrun[g], mx);
                    alpha[g] = (mnew == -INFINITY) ? 1.f : __builtin_amdgcn_exp2f((mrun[g] - mnew) * L2E);
                    grow = grow || (mnew > mrun[g]);
                    mrun[g] = mnew;
                    const float mm2 = (mnew == -INFINITY) ? 0.f : -mnew * L2E; float s = 0.f;
#pragma unroll
                    for (int kt = 0; kt < 2; ++kt)
#pragma unroll
                        for (int r = 0; r < 4; ++r) { const float e = __builtin_amdgcn_exp2f(fmaf(acc[kt][g][r], L2E, mm2)); acc[kt][g][r] = e; s += e; }
                    s += __shfl_xor(s, 16); s += __shfl_xor(s, 32);
                    lrun[g] = lrun[g] * alpha[g] + s;
                    u32x4 pw; pw.x = cvtpk(acc[0][g][0], acc[0][g][1]); pw.y = cvtpk(acc[0][g][2], acc[0][g][3]); pw.z = cvtpk(acc[1][g][0], acc[1][g][1]); pw.w = cvtpk(acc[1][g][2], acc[1][g][3]);
                    pf[g] = __builtin_bit_cast(bf16x8, pw); }
#pragma unroll
                for (int i = 0; i < 8; ++i) *(LAS u32x4*)(buf + (4 * i + c) * VROW + n16 * 8) = vr[i];
                asm volatile("" ::: "memory");
                if (ch < 7) dsb_gather(kvbase, sl, ch + 1, C_AV * 2, c, n16, vr);
                else if (more) dsb_gather(kvbase, sln, 0, C_AV * 2, c, n16, vr);
                if (__any(grow)) {
#pragma unroll
                    for (int g = 0; g < 2; ++g)
#pragma unroll
                        for (int r = 0; r < 4; ++r) { const float a = __builtin_bit_cast(float, __builtin_amdgcn_readlane(__builtin_bit_cast(int, alpha[g]), r));
#pragma unroll
                            for (int dt = 0; dt < 4; ++dt) O[g][dt][r] *= a; }
                }
#pragma unroll
                for (int dt = 0; dt < 4; ++dt) { const LAS bf16* vp = buf + (4 * c + q4) * VROW + dt * 16 + 4 * p4;
                    O[0][dt] = MFMA16(pf[0], cat8(trread(vp), trread(vp + 16 * VROW)), O[0][dt]);
                    O[1][dt] = MFMA16(pf[1], cat8(trread(vp + 64), trread(vp + 64 + 16 * VROW)), O[1][dt]); }
            }
            {
#pragma unroll
                for (int g = 0; g < 2; ++g)
#pragma unroll
                    for (int r = 0; r < 4; ++r) { const float li = __builtin_amdgcn_rcpf(__builtin_bit_cast(float, __builtin_amdgcn_readlane(__builtin_bit_cast(int, lrun[g]), r)));
                        if (lane < 16) {
#pragma unroll
                            for (int dt = 0; dt < 4; ++dt) buf[(g * 4 + r) * 64 + 16 * dt + lane] = f2bf(O[g][dt][r] * li); } }
                const u32x4 ov = *(const LAS u32x4*)(buf + 8 * lane);
                *(u32x4*)(mix + (size_t)tok * DM + 512 + 8 * lane) = ov;
            }
            if (more) {
#pragma unroll
                for (int g = 0; g < 2; ++g)
#pragma unroll
                    for (int s = 0; s < 2; ++s) qf[g][s] = qn[g][s];
            }
            tok = tokn;
        }
    }
}

constexpr int HSTR = 1028;
__device__ __forceinline__ void phase_router(Frame& F) {
    const float* const norm2_g = F.in(8); const float* const router_w = F.in(9); const float* const router_b = F.in(10);
    const float* x1 = F.out; const float* mod = (const float*)(F.ws + WS_MOD); unsigned char* h2 = (unsigned char*)(F.ws + WS_H2);
    int* topi = (int*)(F.ws + WS_TOPI); float* topg = (float*)(F.ws + WS_TOPG); int* bbase = (int*)(F.ws + WS_BBASE);
    LAS float* hs = (LAS float*)F.lds; LAS float* part = (LAS float*)(F.lds + 16 * HSTR * 4); LAS int* hist = (LAS int*)(F.lds + 16 * HSTR * 4 + 8 * 16 * 32 * 4);
    const int lane = F.lane(), w = F.wave;
    for (int blk = F.bid; blk < NTOK / 128; blk += F.G) {
        const int T0 = blk * 128, b = T0 / SEQ;
        if (F.tid() < 32) hist[F.tid()] = 0;
        f32x4 ca[4], cb[4];
#pragma unroll
        for (int j = 0; j < 4; ++j) { const int col = 4 * lane + 256 * j;
            ca[j] = *(const f32x4*)(norm2_g + col) * (*(const f32x4*)(mod + b * 6144 + 4 * 1024 + col) + 1.0f); cb[j] = *(const f32x4*)(mod + b * 6144 + 3 * 1024 + col); }
        __syncthreads();
        for (int pass = 0; pass < 8; ++pass) {
#pragma unroll
            for (int tt = 0; tt < 2; ++tt) { const int tl = 2 * w + tt, tok = T0 + pass * 16 + tl;
                const f32x4* xr = (const f32x4*)(x1 + (size_t)tok * DM) + lane; f32x4 v[4]; float s = 0.f;
#pragma unroll
                for (int j = 0; j < 4; ++j) { v[j] = xr[64 * j]; s += (v[j][0] * v[j][0] + v[j][1] * v[j][1]) + (v[j][2] * v[j][2] + v[j][3] * v[j][3]); }
                const float rstd = rsqrtf(wave_sum(s) * (1.f / DM) + EPS);
                unsigned* o4 = (unsigned*)(h2 + (size_t)tok * DM) + lane;
#pragma unroll
                for (int j = 0; j < 4; ++j) { const f32x4 y = (v[j] * rstd) * ca[j] + cb[j];
                    o4[64 * j] = pk4_fp8(y[0], y[1], y[2], y[3]);
                    *(LAS f32x4*)(hs + tl * HSTR + 4 * lane + 256 * j) = y; } }
            __syncthreads();
            { const int ti = lane & 15, kk = lane >> 5, e = lane & 31; f32x16 acc;
#pragma unroll
              for (int r = 0; r < 16; ++r) acc[r] = 0.f;
              const LAS float* hp = hs + ti * HSTR + 128 * w + 64 * kk; const float* rwp = router_w + (size_t)(128 * w + 64 * kk) * NE + e;
#pragma unroll 4
              for (int s4 = 0; s4 < 16; ++s4) { const f32x4 a4 = *(const LAS f32x4*)(hp + 4 * s4);
#pragma unroll
                  for (int q = 0; q < 4; ++q) acc = __builtin_amdgcn_mfma_f32_32x32x2f32(a4[q], rwp[(4 * s4 + q) * NE], acc, 0, 0, 0); }
#pragma unroll
              for (int r = 0; r < 8; ++r) part[(w * 16 + (r & 3) + 8 * (r >> 2) + 4 * kk) * 32 + e] = acc[r]; }
            __syncthreads();
            { const int tl = F.tid() >> 5, e = F.tid() & 31, tok = T0 + pass * 16 + tl; float lg = router_b[e];
#pragma unroll
              for (int ww = 0; ww < 8; ++ww) lg += part[(ww * 16 + tl) * 32 + e];
              float myv = lg; float tv[4]; int ti4[4]; bool mine = false;
#pragma unroll
              for (int k = 0; k < 4; ++k) { float bv = myv; int bi = e;
#pragma unroll
                  for (int o = 16; o >= 1; o >>= 1) { const float ov = __shfl_xor(bv, o); const int oi = __shfl_xor(bi, o); if (ov > bv || (ov == bv && oi < bi)) { bv = ov; bi = oi; } }
                  tv[k] = bv; ti4[k] = bi; if (bi == e) { myv = -INFINITY; mine = true; } }
              if (mine) atomicAdd((int*)hist + e, 1);
              if (e == 0) { const float e0 = 1.0f, e1 = __expf(tv[1] - tv[0]), e2 = __expf(tv[2] - tv[0]), e3 = __expf(tv[3] - tv[0]); const float inv = 1.0f / (e0 + e1 + e2 + e3);
                  *(int4*)(topi + (size_t)tok * 4) = make_int4(ti4[0], ti4[1], ti4[2], ti4[3]); *(f32x4*)(topg + (size_t)tok * 4) = (f32x4){e0 * inv, e1 * inv, e2 * inv, e3 * inv}; } }
            __syncthreads();
        }
        if (F.tid() < 32) { const int base = atomicAdd((int*)(F.ctl + CW_GCNT) + F.tid(), hist[F.tid()]); bbase[blk * 32 + F.tid()] = base; }
        __syncthreads();
    }
}
__device__ __forceinline__ int moe_layout(Frame& F, LAS int* offs, LAS int* tile_e) {
    if (F.tid() == 0) { int o = 0;
        for (int e = 0; e < NE; ++e) { const int cnt = (int)__hip_atomic_load(F.ctl + CW_GCNT + e, __ATOMIC_RELAXED, __HIP_MEMORY_SCOPE_AGENT); const int nt = (cnt + 255) >> 8;
            offs[e] = o; if (tile_e) for (int t = 0; t < nt; ++t) tile_e[(o >> 8) + t] = e; o += nt << 8; }
        offs[NE] = o >> 8; }
    __syncthreads();
    return offs[NE];
}
__device__ __forceinline__ void phase_place(Frame& F) {
    const unsigned char* h2 = (const unsigned char*)(F.ws + WS_H2); unsigned char* xs = (unsigned char*)(F.ws + WS_XS);
    const int* topi = (const int*)(F.ws + WS_TOPI); const float* topg = (const float*)(F.ws + WS_TOPG); const int* bbase = (const int*)(F.ws + WS_BBASE);
    int* rowinfo = (int*)(F.ws + WS_ROWINFO); float* rowgate = (float*)(F.ws + WS_ROWGATE);
    LAS int* offs = (LAS int*)F.lds; LAS int* lcur = offs + 64; LAS int* posl = offs + 128;
    (void)moe_layout(F, offs, nullptr);
    for (int blk = F.bid; blk < NTOK / 128; blk += F.G) {
        const int T0 = blk * 128;
        if (F.tid() < 32) lcur[F.tid()] = 0;
        __syncthreads();
        { const int i = F.tid(), tok = T0 + (i >> 2); const int e = topi[(size_t)tok * 4 + (i & 3)];
          const int rank = atomicAdd((int*)lcur + e, 1); const int pos = offs[e] + bbase[blk * 32 + e] + rank;
          rowinfo[pos] = tok * 4 + (i & 3); rowgate[pos] = topg[(size_t)tok * 4 + (i & 3)]; posl[i] = pos; }
        __syncthreads();
        for (int jj = 0; jj < 64; ++jj) { const int i = F.wave * 64 + jj; const int pos = posl[i]; const int tok = T0 + (i >> 2);
            const u32x4* src = (const u32x4*)(h2 + (size_t)tok * DM) + F.lane(); u32x4* dst = (u32x4*)(xs + (size_t)pos * DM) + F.lane();
            dst[0] = src[0]; }
        __syncthreads();
    }
}
__device__ __forceinline__ void phase_final(Frame& F) {
    const float* const final_g = F.in(15);
    const float* mod = (const float*)(F.ws + WS_MOD); const bf16* Y = (const bf16*)(F.ws + WS_Y);
    const int gw = F.bid * NWAVES + F.wave, NGW = F.G * NWAVES;
    for (int m = gw; m < NTOK; m += NGW) {
        const int b = m / SEQ; f32x4* xr = (f32x4*)(F.out + (size_t)m * DM) + F.lane(); f32x4 v[4]; float s = 0.f;
#pragma unroll
        for (int j = 0; j < 4; ++j) { const int col = 4 * F.lane() + 256 * j; f32x4 y = (f32x4){0.f, 0.f, 0.f, 0.f};
#pragma unroll
            for (int k = 0; k < 4; ++k) { const u32x2 w = *((const u32x2*)(Y + ((size_t)m * 4 + k) * DM) + F.lane() + 64 * j); y[0] += bflo(w.x); y[1] += bfhi(w.x); y[2] += bflo(w.y); y[3] += bfhi(w.y); }
            v[j] = xr[64 * j] + *(const f32x4*)(mod + b * 6144 + 5 * 1024 + col) * y;
            s += (v[j][0] * v[j][0] + v[j][1] * v[j][1]) + (v[j][2] * v[j][2] + v[j][3] * v[j][3]); }
        const float rstd = rsqrtf(wave_sum(s) * (1.f / DM) + EPS);
#pragma unroll
        for (int j = 0; j < 4; ++j) xr[64 * j] = (v[j] * rstd) * *(const f32x4*)(final_g + 4 * F.lane() + 256 * j);
    }
}

#ifndef MK_N_LAUNCHES
#define MK_N_LAUNCHES 1
#endif
constexpr int N_PHASES = 12;
struct Args { const float* in[16]; float* out; unsigned char* ws; int ph_lo, ph_hi; };
static_assert(sizeof(Args) == 16 * 8 + 8 + 8 + 8, "Args has no padding");

__global__ void __launch_bounds__(NTHR, 2) mk_fwd(Args args) {
    extern __shared__ __attribute__((aligned(16))) unsigned char lds_raw[];
    Frame F;
    F.lds = (LAS unsigned char*)lds_raw;
    F.MISC = (volatile LAS unsigned*)(F.lds + MISC_OFF);
    F.wave = __builtin_amdgcn_readfirstlane((int)threadIdx.x >> 6);
    F.G = gridDim.x; F.bid = blockIdx.x; F.tacc = 0ull; F.xpass = 0;
    F.ws = args.ws; F.ctl = (unsigned*)(args.ws + WS_CTL); F.out = args.out;
    for (int u = F.tid(); u < (LDS_BYTES - MISC_OFF) / 4; u += NTHR) ((LAS unsigned*)(F.lds + MISC_OFF))[u] = 0u;
    __syncthreads();
    if (F.tid() < 16) *(LAS unsigned long long*)(F.lds + PTR_OFF + 8 * F.tid()) = (unsigned long long)args.in[F.tid()];
    __syncthreads();
    const int lo = args.ph_lo, hi = args.ph_hi;
    XcdBarrier bar; bar.bar = (unsigned*)(F.ctl + CW_BAR); bar.x = 0; bar.st = nullptr; bar.w0 = (F.wave == 0);
    if (hi - lo > 1) bar = xcd_barrier_post((unsigned*)(F.ctl + CW_BAR), F.MISC + 8, F.wave == 0);
#define IN(k) (lo <= (k) && (k) < hi)
#if defined(PROBE_PHASE)
    unsigned long long tp0 = 0ull, tp1 = 0ull;
#define STAMP(k) do { if ((k) == PROBE_PHASE) tp0 = __builtin_amdgcn_s_memrealtime(); if ((k) == PROBE_PHASE + 1) tp1 = __builtin_amdgcn_s_memrealtime(); } while (0)
#else
#define STAMP(k) do { } while (0)
#endif
#define SEAM(k) do { if (IN(k) && IN((k) + 1)) xcd_barrier(bar); } while (0)

    STAMP(0); if (IN(0)) { phase_p0a(F); } SEAM(0);
    STAMP(1); if (IN(1)) { phase_p0b(F); } SEAM(1);
    STAMP(2); if (IN(2)) {
        pg8::Gemm g{(const bf16*)(F.ws + WS_H0), (const bf16*)(F.ws + WS_WIN), NTOK, 3072, DM}; pg8::StaticOrder S; S.init(NTOK, 3072, F.G, F.bid);
        EpiProj E{(bf16*)(F.ws + WS_PROJ), PJ};
        pg8::gemm_phase<EpiProj, pg8::StaticOrder, true, true>(F.lds, g, S, E, F.wave);
    } SEAM(2);
    STAMP(3); if (IN(3)) {
#if defined(PROBE_SUB)
        const unsigned long long tra0 = __builtin_amdgcn_s_memrealtime();
#endif
        for (int it = F.bid; it < 1024; it += F.G) ret_a_item(F, it);
#if defined(PROBE_SUB)
        if (PROBE_SUB == 4) F.tacc += __builtin_amdgcn_s_memrealtime() - tra0;
#endif
        { constexpr int NQT = SEQ / QT, NITEM = NBATCH * NQT * 8;
          int cit = F.bid * NWAVES + F.wave;
          LAS float* scr = (LAS float*)(F.lds + F.wave * (RPW * CAP * 4));
          for (;;) { int t = 0; if (F.lane() == 0) t = (int)__hip_atomic_fetch_add(F.ctl + CW_Q3, 1u, __ATOMIC_RELAXED, __HIP_MEMORY_SCOPE_AGENT);
              t = __builtin_amdgcn_readfirstlane(t); const bool have = t < NITEM;
              if (have) dsa_a_wave(F, (t >> 3) & 3, NQT - 1 - (t >> 5), t & 7);
              cit = f8_burst(F, scr, cit, have ? 6 : (1 << 20));
              if (!have) break; } }
    } SEAM(3);
    STAMP(4); if (IN(4)) {
#if defined(PROBE_SUB)
        const unsigned long long tsc0 = __builtin_amdgcn_s_memrealtime();
#endif
        ret_scan(F);
#if defined(PROBE_SUB)
        if (PROBE_SUB == 5) F.tacc += __builtin_amdgcn_s_memrealtime() - tsc0;
#endif
        __syncthreads();
        phase_dsa_b(F);
    } SEAM(4);
    STAMP(5); if (IN(5)) { for (int it = F.bid; it < 1024; it += F.G) ret_c_item(F, it); } SEAM(5);
    STAMP(6); if (IN(6)) {
        pg8::Gemm g{(const bf16*)(F.ws + WS_MIX), (const bf16*)(F.ws + WS_WO), NTOK, DM, DM}; pg8::StaticOrder S; S.init(NTOK, DM, F.G, F.bid);
        EpiX1 E{F.in(0), (const float*)(F.ws + WS_MOD), F.out};
        pg8::gemm_phase<EpiX1, pg8::StaticOrder, true, true>(F.lds, g, S, E, F.wave);
    } SEAM(6);
    STAMP(7); if (IN(7)) { phase_router(F); } SEAM(7);
    STAMP(8); if (IN(8)) { phase_place(F); } SEAM(8);
    STAMP(9); if (IN(9)) {
        LAS int* tile_e = (LAS int*)(F.lds + TILEE_OFF); const int nt = moe_layout(F, (LAS int*)(F.lds + TILEE_OFF + 4096), tile_e);
        pg8::Gemm g{(const bf16*)(F.ws + WS_XS), (const bf16*)(F.ws + WS_WGU), MOE_ROWS, 2048, DM};
        GroupedOrder S{tile_e, nt, 8, F.G, F.bid, (size_t)2048 * 1024};
        EpiGlu8 E{(unsigned char*)(F.ws + WS_HB), F.in(12)};
        pg8::gemm_phase<EpiGlu8, GroupedOrder, true, true, true>(F.lds, g, S, E, F.wave);
    } SEAM(9);
    STAMP(10); if (IN(10)) {
        LAS int* tile_e = (LAS int*)(F.lds + TILEE_OFF); const int nt = moe_layout(F, (LAS int*)(F.lds + TILEE_OFF + 4096), tile_e);
        pg8::Gemm g{(const bf16*)(F.ws + WS_HB), (const bf16*)(F.ws + WS_WDN), MOE_ROWS, DM, DM};
        GroupedOrder S{tile_e, nt, 4, F.G, F.bid, (size_t)1024 * 1024};
        EpiDownT<true> E{(bf16*)(F.ws + WS_Y), F.in(14), (const int*)(F.ws + WS_ROWINFO), (const float*)(F.ws + WS_ROWGATE)};
        pg8::gemm_phase<EpiDownT<true>, GroupedOrder, true, true, true>(F.lds, g, S, E, F.wave);
    } SEAM(10);
    STAMP(11); if (IN(11)) { phase_final(F); }
    STAMP(12);
#if defined(PROBE_SUB)
    if (F.bid == 0 && F.tid() == 0) { const unsigned long long te = __builtin_amdgcn_s_memrealtime(); while (__builtin_amdgcn_s_memrealtime() - te < F.tacc) __builtin_amdgcn_s_sleep(8); }
#elif defined(PROBE_PHASE)
    if (F.bid == 0 && F.tid() == 0) { const unsigned long long te = __builtin_amdgcn_s_memrealtime(), dur = tp1 - tp0; while (__builtin_amdgcn_s_memrealtime() - te < dur) __builtin_amdgcn_s_sleep(8); }
#endif
#undef IN
#undef SEAM
}

extern "C" void kernel_launch(void* const* d_in, const int* in_sizes, int n_in, void* d_out, int out_size, void* d_ws, size_t ws_size, hipStream_t stream) {
    static int grid = 0;
    if (grid == 0) {
        if (n_in != 16 || out_size != NTOK * DM || ws_size < WS_END) { fprintf(stderr, "kernel_launch: unexpected problem (n_in %d out %d ws %zu); nothing launched\n", n_in, out_size, ws_size); grid = -1; return; }
        int dev = 0, cus = 0;
        if (hipGetDevice(&dev) != hipSuccess || hipDeviceGetAttribute(&cus, hipDeviceAttributeMultiprocessorCount, dev) != hipSuccess) { grid = -1; return; }
        if (hipFuncSetAttribute((const void*)mk_fwd, hipFuncAttributeMaxDynamicSharedMemorySize, LDS_BYTES) != hipSuccess) { fprintf(stderr, "kernel_launch: hipFuncSetAttribute failed\n"); grid = -1; return; }
        int per_cu = 0;
        if (hipOccupancyMaxActiveBlocksPerMultiprocessor(&per_cu, (const void*)mk_fwd, NTHR, LDS_BYTES) != hipSuccess || per_cu < 1) fprintf(stderr, "kernel_launch: occupancy query reports %d workgroups per CU\n", per_cu);
        (void)hipGetLastError();
        grid = cus;
    }
    if (grid < 0) return;
    (void)hipMemsetAsync((char*)d_ws + WS_CTL, 0, CTL_ZERO_BYTES, stream);
    Args a{};
    for (int i = 0; i < 16; ++i) a.in[i] = (const float*)d_in[i];
    a.out = (float*)d_out; a.ws = (unsigned char*)d_ws;
#if MK_N_LAUNCHES == 1
    a.ph_lo = 0; a.ph_hi = N_PHASES;
    hipLaunchKernelGGL(mk_fwd, dim3(grid), dim3(NTHR), LDS_BYTES, stream, a);
#else
    for (int p = 0; p < N_PHASES; ++p) { a.ph_lo = p; a.ph_hi = p + 1; hipLaunchKernelGGL(mk_fwd, dim3(grid), dim3(NTHR), LDS_BYTES, stream, a); }
#endif
}
```

```cpp
#include <hip/hip_runtime.h>
#include <cstdio>
#include <cstdint>

#define LAS __attribute__((address_space(3)))
#define GAS __attribute__((address_space(1)))
typedef unsigned short bf16;
typedef short bf16x8 __attribute__((ext_vector_type(8)));
typedef short s16x4 __attribute__((ext_vector_type(4)));
typedef float f32x4 __attribute__((ext_vector_type(4)));
typedef float f32x16 __attribute__((ext_vector_type(16)));
typedef unsigned u32x4 __attribute__((ext_vector_type(4)));
typedef unsigned u32x2 __attribute__((ext_vector_type(2)));
typedef float f32x2_t __attribute__((ext_vector_type(2)));
typedef __bf16 bf16x2_t __attribute__((ext_vector_type(2)));

constexpr int DM = 1024, NBATCH = 4, SEQ = 8192, NTOK = NBATCH * SEQ;
constexpr int PJ = 3072;
constexpr int IN_COLS = 2888;
constexpr int C_RQ = 0, C_RK = 256, C_RV = 512, C_RG = 1024, C_AQ = 1536, C_AK = 2048, C_AV = 2176, C_IQ = 2304, C_IK = 2816, C_IW = 2880;
constexpr int NE = 32, TOPK = 4, MOE_ROWS = NTOK * TOPK + NE * 256;
constexpr int MOE_TILES = MOE_ROWS / 256;
constexpr float EPS = 1e-6f;
constexpr int NWAVES = 8, NTHR = 512;

constexpr size_t MiB = 1u << 20;
constexpr size_t WS_CTL = 0, CTL_ZERO_BYTES = 1 * MiB;
constexpr size_t WS_MOD = 1 * MiB;
constexpr size_t WS_TOPI = 2 * MiB;
constexpr size_t WS_TOPG = 2 * MiB + 512 * 1024;
constexpr size_t WS_BBASE = 3 * MiB;
constexpr size_t WS_ROWINFO = 4 * MiB;
constexpr size_t WS_ROWGATE = 5 * MiB;
constexpr size_t WS_WIN = 8 * MiB;
constexpr size_t WS_WO = 14 * MiB;
constexpr size_t WS_WGU = 16 * MiB;
constexpr size_t WS_WDN = 144 * MiB;
constexpr size_t WS_H0 = 208 * MiB;
constexpr size_t WS_PROJ = 272 * MiB;
constexpr size_t WS_XS = 208 * MiB;
constexpr size_t WS_Y = 208 * MiB;
constexpr size_t WS_KVT = 480 * MiB;
constexpr size_t WS_RPT = 512 * MiB;
constexpr size_t WS_SEL = 528 * MiB;
constexpr size_t WS_MIX = 544 * MiB;
constexpr size_t WS_H2 = 608 * MiB;
constexpr size_t WS_HB = 480 * MiB;
constexpr size_t WS_END = 752 * MiB;
constexpr int CW_GCNT = 1024;
constexpr int CW_Q1 = 2048;
constexpr int CW_Q3 = 2112;
constexpr int CW_SCAN = 2176;
constexpr int CW_BAR = 4096;

constexpr int LDS_BYTES = 153600;
constexpr int RING_BYTES = 131072;
constexpr int TILEE_OFF = 131072;
constexpr int MISC_OFF = 152576;
constexpr int PTR_OFF = MISC_OFF + 512;

__device__ __forceinline__ int hw_lane() { int l; asm volatile("v_mbcnt_lo_u32_b32 %0, -1, 0\n\tv_mbcnt_hi_u32_b32 %0, -1, %0" : "=v"(l)); return l; }
__device__ __forceinline__ unsigned cvtpk(float lo, float hi) { f32x2_t v = {lo, hi}; bf16x2_t b = __builtin_convertvector(v, bf16x2_t); return __builtin_bit_cast(unsigned, b); }
__device__ __forceinline__ float bflo(unsigned w) { return __builtin_bit_cast(float, w << 16); }
__device__ __forceinline__ float bfhi(unsigned w) { return __builtin_bit_cast(float, w & 0xffff0000u); }
__device__ __forceinline__ float bf2f(bf16 h) { return __builtin_bit_cast(float, (unsigned)h << 16); }
__device__ __forceinline__ bf16 f2bf(float f) { return (bf16)(cvtpk(f, 0.f) & 0xffffu); }
__device__ __forceinline__ float wave_sum(float v) {
#pragma unroll
    for (int o = 1; o < 64; o <<= 1) v += __shfl_xor(v, o);
    return v;
}
__device__ __forceinline__ int mbcnt64(unsigned long long m) { return (int)__builtin_amdgcn_mbcnt_hi((unsigned)(m >> 32), __builtin_amdgcn_mbcnt_lo((unsigned)m, 0u)); }
__device__ __forceinline__ s16x4 trread(const LAS void* p) { typedef short v4i16_t __attribute__((ext_vector_type(4))); return __builtin_bit_cast(s16x4, __builtin_amdgcn_ds_read_tr16_b64_v4i16((LAS v4i16_t*)p)); }
__device__ __forceinline__ bf16x8 cat8(s16x4 lo, s16x4 hi) { return (bf16x8){lo[0], lo[1], lo[2], lo[3], hi[0], hi[1], hi[2], hi[3]}; }
#define MFMA16(a, b, c) __builtin_amdgcn_mfma_f32_16x16x32_bf16((a), (b), (c), 0, 0, 0)
#define MFMA32(a, b, c) __builtin_amdgcn_mfma_f32_32x32x16_bf16((a), (b), (c), 0, 0, 0)

namespace pg8 {
#define PG8_LAS __attribute__((address_space(3)))
typedef unsigned short bf16_t;
typedef short bf16x8 __attribute__((ext_vector_type(8)));
typedef float f32x4 __attribute__((ext_vector_type(4)));
typedef unsigned u32x4 __attribute__((ext_vector_type(4)));
constexpr int BM = 256, BK = 64, HALF = 128, HTB = HALF * BK * 2  , STAGE_BYTES = 8 * HTB, NXCD = 8, WGM = 8;

__host__ __device__ __forceinline__ int lds_byte(int r, int c) { const int st = (r >> 4) * 2 + (c >> 5), rr = r & 15, cc = c & 31, ob = rr * 64 + cc * 2; return st * 1024 + (ob ^ (((ob >> 9) & 1) << 5)); }
__host__ __device__ __forceinline__ void stage_rc(int b, int& R, int& C) { const int st = b / 1024, sb = b % 1024, swz = sb ^ (((sb >> 9) & 1) << 5); R = (st >> 1) * 16 + swz / 64; C = (st & 1) * 32 + (swz % 64) / 2; }
__host__ __device__ __forceinline__ int perm32(int rho) { const int n = rho >> 4, i = rho & 15; return 8 * (i >> 2) + 4 * n + (i & 3); }

typedef int v8i32 __attribute__((ext_vector_type(8))); typedef int v4i32 __attribute__((ext_vector_type(4)));
__device__ __forceinline__ v8i32 pg8_cat(bf16x8 a, bf16x8 b) { return __builtin_shufflevector(__builtin_bit_cast(v4i32, a), __builtin_bit_cast(v4i32, b), 0, 1, 2, 3, 4, 5, 6, 7); }
struct Unit { int pm, pn, e; size_t bo; };
struct Gemm { const bf16_t* A; const bf16_t* Bt; int M, N, K; };

struct StaticOrder {
    int nM, nN, nwg, G, c;
    __host__ __device__ void init(int M, int N, int G_, int c_) { nM = M / BM; nN = N / BM; nwg = nM * nN; G = G_; c = c_; }
    __host__ __device__ bool next(int i, Unit& u) const {
        const long L = (long)i * G + c; if (L >= nwg) return false;
        int wgid = (int)L; { const int q = nwg / NXCD, r = nwg % NXCD, xcd = wgid % NXCD, off = wgid / NXCD; wgid = (xcd < r ? xcd * (q + 1) : r * (q + 1) + (xcd - r) * q) + off; }
        const int nig = WGM * nN, gid = wgid / nig, fm = gid * WGM, gsz = (nM - fm) < WGM ? (nM - fm) : WGM;
        u.pm = fm + ((wgid % nig) % gsz); u.pn = (wgid % nig) / gsz; u.e = 0; u.bo = 0; return true;
    }
    __device__ __forceinline__ void a_ready(const Unit&) const {}
    __device__ __forceinline__ void done(const Unit&) const {}
};

template <class Epi, class Sched, bool ALIGN_EPI = false, bool SP2 = false, bool F8 = false>
__device__ __forceinline__ void gemm_phase(PG8_LAS unsigned char* lds, const Gemm g, const Sched& S, const Epi& E, const int wid) {
    const int lane = hw_lane(), tid = wid * 64 + lane, wr = wid >> 2, wc = wid & 3, fr = lane & 15, fq = lane >> 4;
    constexpr int ESZ = F8 ? 1 : 2;
    const int K = g.K, nt = K * ESZ / (BK * 2);
    unsigned voffA[2], voffB[2];
#pragma unroll
    for (int i = 0; i < 2; ++i) { int R, C; stage_rc(tid * 16 + i * 8192, R, C); const int Rb = Epi::PERM ? ((R & ~31) + perm32(R & 31)) : R;
        voffA[i] = (unsigned)(R * K * ESZ + C * 2); voffB[i] = (unsigned)(Rb * K * ESZ + C * 2); }
    const size_t kstep = (size_t)(BK * 2);
    const size_t hstep = (size_t)HALF * K * ESZ;
    const size_t tstep = 2 * hstep;
    const unsigned ldsw = (unsigned)wid * 1024u;
    const int aoff = lds_byte(wr * 64 + fr, fq * 8), boff = lds_byte(wc * 32 + fr, fq * 8);
#define PG8_SA(b, h) (((b) * 2 + (h)) * HTB)
#define PG8_SB(b, h) ((4 + (b) * 2 + (h)) * HTB)
#define PG8_STAGE(bufoff, gbase, voff) do { _Pragma("unroll") for (int _i = 0; _i < 2; ++_i) { \
        if constexpr (F8) { unsigned _keep; const unsigned _l = (unsigned)(__UINTPTR_TYPE__)(lds + (bufoff) + ldsw + _i * 8192);   \
            asm volatile("s_mov_b32 %0, m0\n\ts_mov_b32 m0, %3\n\ts_nop 0\n\tglobal_load_lds_dwordx4 %1, %2\n\ts_mov_b32 m0, %0" : "=&s"(_keep) : "v"((voff)[_i]), "s"((const char*)(gbase)), "s"(_l) : "memory"); } \
        else __builtin_amdgcn_global_load_lds((const unsigned*)((const char*)(gbase) + (voff)[_i]), (PG8_LAS unsigned*)(lds + (bufoff) + ldsw + _i * 8192), 16, 0, 0); } } while (0)
#define PG8_LDA(dst, b, h) do { _Pragma("unroll") for (int m = 0; m < 4; ++m) _Pragma("unroll") for (int k = 0; k < 2; ++k) dst[m][k] = *(const PG8_LAS bf16x8*)(lds + PG8_SA(b, h) + aoff + m * 2048 + k * 1024); } while (0)
#define PG8_LDB(dst, b, h) do { _Pragma("unroll") for (int n = 0; n < 2; ++n) _Pragma("unroll") for (int k = 0; k < 2; ++k) dst[n][k] = *(const PG8_LAS bf16x8*)(lds + PG8_SB(b, h) + boff + n * 2048 + k * 1024); } while (0)
#define PG8_MMA(ai, bj, At, Bt) do { __builtin_amdgcn_s_setprio(1); _Pragma("unroll") for (int m = 0; m < 4; ++m) _Pragma("unroll") for (int n = 0; n < 2; ++n) { \
        if constexpr (F8) { acc[ai][bj][m][n] = __builtin_amdgcn_mfma_scale_f32_16x16x128_f8f6f4(pg8_cat(Bt[n][0], Bt[n][1]), pg8_cat(At[m][0], At[m][1]), acc[ai][bj][m][n], 0, 0, 0, 0, 0, 0); } \
        else { _Pragma("unroll") for (int k = 0; k < 2; ++k) acc[ai][bj][m][n] = __builtin_amdgcn_mfma_f32_16x16x32_bf16(Bt[n][k], At[m][k], acc[ai][bj][m][n], 0, 0, 0); } } __builtin_amdgcn_s_setprio(0); } while (0)
#define PG8_WAIT_V(n) asm volatile("s_waitcnt vmcnt(" #n ")" ::: "memory")
#define PG8_WAIT_L(n) asm volatile("s_waitcnt lgkmcnt(" #n ")" ::: "memory")
#define PG8_BAR __builtin_amdgcn_s_barrier()
#define PG8_SCHED __builtin_amdgcn_sched_barrier(0)
    Unit cur, nxt; int ui = 0;
    if (!S.next(0, cur)) return;
    f32x4 acc[2][2][4][2];
#pragma unroll
    for (int a = 0; a < 2; ++a)
#pragma unroll
        for (int b = 0; b < 2; ++b)
#pragma unroll
            for (int m = 0; m < 4; ++m)
#pragma unroll
                for (int n = 0; n < 2; ++n) acc[a][b][m][n] = (f32x4){0.f, 0.f, 0.f, 0.f};
    bf16x8 At[4][2], B0[2][2], B1[2][2];
    const char* cA = (const char*)g.A + (size_t)cur.pm * tstep; const char* cB = (const char*)g.Bt + (size_t)cur.pn * tstep + cur.bo;
    S.a_ready(cur);
    if constexpr (SP2) {
        PG8_STAGE(PG8_SB(0, 0), cB, voffB); PG8_STAGE(PG8_SB(0, 1), cB + hstep, voffB); PG8_STAGE(PG8_SA(0, 0), cA, voffA); PG8_STAGE(PG8_SA(0, 1), cA + hstep, voffA);
        if (wr == 1) PG8_BAR;
        PG8_WAIT_V(2); PG8_BAR;
        PG8_STAGE(PG8_SB(1, 0), cB + kstep, voffB); PG8_STAGE(PG8_SA(1, 0), cA + kstep, voffA); PG8_STAGE(PG8_SB(1, 1), cB + hstep + kstep, voffB);
        PG8_WAIT_V(6); PG8_BAR;
    } else {
        PG8_STAGE(PG8_SB(0, 0), cB, voffB); PG8_STAGE(PG8_SA(0, 0), cA, voffA); PG8_STAGE(PG8_SB(0, 1), cB + hstep, voffB); PG8_STAGE(PG8_SA(0, 1), cA + hstep, voffA);
        if (wr == 1) PG8_BAR;
        PG8_WAIT_V(4); PG8_BAR;
        PG8_STAGE(PG8_SB(1, 0), cB + kstep, voffB); PG8_STAGE(PG8_SA(1, 0), cA + kstep, voffA); PG8_STAGE(PG8_SB(1, 1), cB + hstep + kstep, voffB);
        PG8_WAIT_V(6); PG8_BAR;
    }
    for (;;) {
        const bool has_next = S.next(ui + 1, nxt);
        const char* nA = has_next ? (const char*)g.A + (size_t)nxt.pm * tstep : cA; const char* nB = has_next ? (const char*)g.Bt + (size_t)nxt.pn * tstep + nxt.bo : cB;
        for (int t = 0; t < nt; t += 2) {
            const bool last = (t == nt - 2);
            const char* a1 = cA + (size_t)(t + 1) * kstep;
            const char* a2 = last ? nA : cA + (size_t)(t + 2) * kstep; const char* b2 = last ? nB : cB + (size_t)(t + 2) * kstep;
            const char* a3 = a2 + kstep; const char* b3 = b2 + kstep;
            if (last && has_next) S.a_ready(nxt);
            if constexpr (SP2) {
            PG8_LDB(B0, 0, 0); PG8_LDB(B1, 0, 1); PG8_SCHED; PG8_LDA(At, 0, 0); PG8_STAGE(PG8_SA(1, 1), a1 + hstep, voffA);
            PG8_WAIT_V(8); PG8_WAIT_L(0); PG8_BAR; PG8_MMA(0, 0, At, B0); PG8_MMA(0, 1, At, B1); PG8_BAR; PG8_SCHED;
            PG8_LDA(At, 0, 1); PG8_STAGE(PG8_SB(0, 0), b2, voffB); PG8_STAGE(PG8_SB(0, 1), b2 + hstep, voffB); PG8_STAGE(PG8_SA(0, 0), a2, voffA);
            PG8_WAIT_V(8); PG8_WAIT_L(0); PG8_BAR; PG8_MMA(1, 0, At, B0); PG8_MMA(1, 1, At, B1); PG8_BAR; PG8_SCHED;
            PG8_LDB(B0, 1, 0); PG8_LDB(B1, 1, 1); PG8_SCHED; PG8_LDA(At, 1, 0); PG8_STAGE(PG8_SA(0, 1), a2 + hstep, voffA);
            PG8_WAIT_V(8); PG8_WAIT_L(0); PG8_BAR; PG8_MMA(0, 0, At, B0); PG8_MMA(0, 1, At, B1); PG8_BAR; PG8_SCHED;
            PG8_LDA(At, 1, 1); PG8_STAGE(PG8_SB(1, 0), b3, voffB); PG8_STAGE(PG8_SB(1, 1), b3 + hstep, voffB); PG8_STAGE(PG8_SA(1, 0), a3, voffA);
            PG8_WAIT_V(8); PG8_WAIT_L(0); PG8_BAR; PG8_MMA(1, 0, At, B0); PG8_MMA(1, 1, At, B1); PG8_BAR; PG8_SCHED;
            } else {
            PG8_LDB(B0, 0, 0); PG8_SCHED; PG8_LDA(At, 0, 0); PG8_STAGE(PG8_SA(1, 1), a1 + hstep, voffA);
            PG8_WAIT_L(8); PG8_BAR; PG8_WAIT_L(0); PG8_MMA(0, 0, At, B0); PG8_BAR; PG8_SCHED;
            PG8_LDB(B1, 0, 1); PG8_STAGE(PG8_SB(0, 0), b2, voffB);
            PG8_BAR; PG8_WAIT_L(0); PG8_MMA(0, 1, At, B1); PG8_BAR;
            PG8_LDA(At, 0, 1); PG8_STAGE(PG8_SA(0, 0), a2, voffA);
            PG8_BAR; PG8_WAIT_L(0); PG8_MMA(1, 0, At, B0); PG8_BAR; PG8_SCHED;
            PG8_STAGE(PG8_SB(0, 1), b2 + hstep, voffB);
            PG8_WAIT_V(6); PG8_BAR; PG8_MMA(1, 1, At, B1); PG8_BAR;
            PG8_LDB(B0, 1, 0); PG8_SCHED; PG8_LDA(At, 1, 0); PG8_STAGE(PG8_SA(0, 1), a2 + hstep, voffA);
            PG8_WAIT_L(8); PG8_BAR; PG8_WAIT_L(0); PG8_MMA(0, 0, At, B0); PG8_BAR; PG8_SCHED;
            PG8_LDB(B1, 1, 1); PG8_STAGE(PG8_SB(1, 0), b3, voffB);
            PG8_BAR; PG8_WAIT_L(0); PG8_MMA(0, 1, At, B1); PG8_BAR;
            PG8_LDA(At, 1, 1); PG8_STAGE(PG8_SA(1, 0), a3, voffA);
            PG8_BAR; PG8_WAIT_L(0); PG8_MMA(1, 0, At, B0); PG8_BAR; PG8_SCHED;
            PG8_STAGE(PG8_SB(1, 1), b3 + hstep, voffB);
            PG8_WAIT_V(6); PG8_BAR; PG8_MMA(1, 1, At, B1); PG8_BAR;
            }
        }
        if constexpr (ALIGN_EPI) { if (wr == 0) PG8_BAR; }
        if constexpr (!Epi::AFTER_DRAIN) { E(acc, cur, wr, wc, fr, fq); S.done(cur); }
        if (!has_next) break;
#pragma unroll
        for (int a = 0; a < 2; ++a)
#pragma unroll
            for (int b = 0; b < 2; ++b)
#pragma unroll
                for (int m = 0; m < 4; ++m)
#pragma unroll
                    for (int n = 0; n < 2; ++n) acc[a][b][m][n] = (f32x4){0.f, 0.f, 0.f, 0.f};
        cur = nxt; cA = nA; cB = nB; ++ui;
        if constexpr (ALIGN_EPI) { if (wr == 1) PG8_BAR; }
    }
    PG8_WAIT_V(0);
    if constexpr (!ALIGN_EPI) { if (wr == 0) PG8_BAR; }
    PG8_BAR;
    if constexpr (Epi::AFTER_DRAIN) { E.fused(acc, cur, wr, wc, fr, fq, lds, wid, lane); S.done(cur); }
#undef PG8_SA
#undef PG8_SB
#undef PG8_STAGE
#undef PG8_LDA
#undef PG8_LDB
#undef PG8_MMA
#undef PG8_WAIT_V
#undef PG8_WAIT_L
#undef PG8_BAR
#undef PG8_SCHED
}
}

struct EpiProj {
    static constexpr bool PERM = true, AFTER_DRAIN = false;
    bf16* O; int ldc;
    __device__ __forceinline__ void operator()(const f32x4 (&acc)[2][2][4][2], const pg8::Unit& u, int wr, int wc, int fr, int fq) const {
        const int row0 = u.pm * 256 + wr * 64 + fr; const int col0 = u.pn * 256 + wc * 32 + 8 * fq;
#pragma unroll
        for (int ai = 0; ai < 2; ++ai)
#pragma unroll
            for (int m = 0; m < 4; ++m) { bf16* rowp = O + (size_t)(row0 + ai * 128 + m * 16) * ldc + col0;
#pragma unroll
                for (int bj = 0; bj < 2; ++bj) { const f32x4 v0 = acc[ai][bj][m][0], v1 = acc[ai][bj][m][1];
                    u32x4 w; w.x = cvtpk(v0[0], v0[1]); w.y = cvtpk(v0[2], v0[3]); w.z = cvtpk(v1[0], v1[1]); w.w = cvtpk(v1[2], v1[3]);
                    *(u32x4*)(rowp + bj * 128) = w; } }
    }
};
constexpr float W8_SCALE = 64.0f, W8_INV = 1.0f / 64.0f;
template <bool F8> struct EpiX1T {
    static constexpr bool PERM = false, AFTER_DRAIN = false;
    const float* x; const float* mod; float* out;
    __device__ __forceinline__ void operator()(const f32x4 (&acc)[2][2][4][2], const pg8::Unit& u, int wr, int wc, int fr, int fq) const {
        const int col0 = u.pn * 256 + wc * 32 + 4 * fq; const int b = (u.pm * 256) / SEQ;
        f32x4 g[2][2];
#pragma unroll
        for (int bj = 0; bj < 2; ++bj)
#pragma unroll
            for (int n = 0; n < 2; ++n) g[bj][n] = *(const f32x4*)(mod + (size_t)b * 6144 + 2 * 1024 + col0 + bj * 128 + n * 16);
#pragma unroll
        for (int ai = 0; ai < 2; ++ai)
#pragma unroll
            for (int m = 0; m < 4; ++m) { const size_t off = (size_t)(u.pm * 256 + ai * 128 + wr * 64 + m * 16 + fr) * DM + col0;
#pragma unroll
                for (int bj = 0; bj < 2; ++bj)
#pragma unroll
                    for (int n = 0; n < 2; ++n) { const f32x4 xv = *(const f32x4*)(x + off + bj * 128 + n * 16); *(f32x4*)(out + off + bj * 128 + n * 16) = xv + g[bj][n] * (acc[ai][bj][m][n] * (F8 ? W8_INV : 1.0f)); }
                if (m & 1) asm volatile("" ::: "memory"); }
    }
};
__device__ __forceinline__ float glu_f(float gate, float up) {
    gate = fminf(gate, 7.0f); up = fminf(fmaxf(up, -7.0f), 7.0f);
    const float sg = __builtin_amdgcn_rcpf(1.0f + __expf(-1.702f * gate));
    return (up + 1.0f) * (gate * sg);
}
__device__ __forceinline__ unsigned pk4_fp8(float a, float b, float c, float d) { int w = __builtin_amdgcn_cvt_pk_fp8_f32(a, b, 0, false); w = __builtin_amdgcn_cvt_pk_fp8_f32(c, d, w, true); return (unsigned)w; }
struct EpiGlu8 {
    static constexpr bool PERM = true, AFTER_DRAIN = false;
    unsigned char* H; const float* b_gu;
    __device__ __forceinline__ void operator()(const f32x4 (&acc)[2][2][4][2], const pg8::Unit& u, int wr, int wc, int fr, int fq) const {
        const int row0 = u.pm * 256 + wr * 64 + fr; const int c0 = u.pn * 128 + wc * 32 + 8 * fq;
        const float* bg = b_gu + (size_t)u.e * 2048 + c0; const float* bu = bg + 1024;
        const f32x4 bg0 = *(const f32x4*)bg, bg1 = *(const f32x4*)(bg + 4), bu0 = *(const f32x4*)bu, bu1 = *(const f32x4*)(bu + 4);
#pragma unroll
        for (int ai = 0; ai < 2; ++ai)
#pragma unroll
            for (int m = 0; m < 4; ++m) {
                const f32x4 g0 = acc[ai][0][m][0] * W8_INV + bg0, g1 = acc[ai][0][m][1] * W8_INV + bg1, u0 = acc[ai][1][m][0] * W8_INV + bu0, u1 = acc[ai][1][m][1] * W8_INV + bu1;
                u32x2 w; w.x = pk4_fp8(glu_f(g0[0], u0[0]), glu_f(g0[1], u0[1]), glu_f(g0[2], u0[2]), glu_f(g0[3], u0[3]));
                w.y = pk4_fp8(glu_f(g1[0], u1[0]), glu_f(g1[1], u1[1]), glu_f(g1[2], u1[2]), glu_f(g1[3], u1[3]));
                *(u32x2*)(H + (size_t)(row0 + ai * 128 + m * 16) * DM + c0) = w; }
    }
};
struct EpiGlu {
    static constexpr bool PERM = true, AFTER_DRAIN = false;
    bf16* H; const float* b_gu;
    __device__ __forceinline__ void operator()(const f32x4 (&acc)[2][2][4][2], const pg8::Unit& u, int wr, int wc, int fr, int fq) const {
        const int row0 = u.pm * 256 + wr * 64 + fr; const int c0 = u.pn * 128 + wc * 32 + 8 * fq;
        const float* bg = b_gu + (size_t)u.e * 2048 + c0; const float* bu = bg + 1024;
        const f32x4 bg0 = *(const f32x4*)bg, bg1 = *(const f32x4*)(bg + 4), bu0 = *(const f32x4*)bu, bu1 = *(const f32x4*)(bu + 4);
#pragma unroll
        for (int ai = 0; ai < 2; ++ai)
#pragma unroll
            for (int m = 0; m < 4; ++m) {
                const f32x4 g0 = acc[ai][0][m][0] + bg0, g1 = acc[ai][0][m][1] + bg1, u0 = acc[ai][1][m][0] + bu0, u1 = acc[ai][1][m][1] + bu1;
                u32x4 w; w.x = cvtpk(glu_f(g0[0], u0[0]), glu_f(g0[1], u0[1])); w.y = cvtpk(glu_f(g0[2], u0[2]), glu_f(g0[3], u0[3]));
                w.z = cvtpk(glu_f(g1[0], u1[0]), glu_f(g1[1], u1[1])); w.w = cvtpk(glu_f(g1[2], u1[2]), glu_f(g1[3], u1[3]));
                *(u32x4*)(H + (size_t)(row0 + ai * 128 + m * 16) * DM + c0) = w; }
    }
};
template <bool F8> struct EpiDownT {
    static constexpr bool PERM = true, AFTER_DRAIN = false;
    bf16* Y; const float* b_down; const int* rowinfo; const float* rowgate;
    __device__ __forceinline__ void operator()(const f32x4 (&acc)[2][2][4][2], const pg8::Unit& u, int wr, int wc, int fr, int fq) const {
        const int row0 = u.pm * 256 + wr * 64 + fr; const int col0 = u.pn * 256 + wc * 32 + 8 * fq;
        const float* bd = b_down + (size_t)u.e * 1024 + col0;
        f32x4 bv[2][2];
#pragma unroll
        for (int bj = 0; bj < 2; ++bj)
#pragma unroll
            for (int n = 0; n < 2; ++n) bv[bj][n] = *(const f32x4*)(bd + bj * 128 + 4 * n);
#pragma unroll
        for (int ai = 0; ai < 2; ++ai)
#pragma unroll
            for (int m = 0; m < 4; ++m) { const int row = row0 + ai * 128 + m * 16; const int dst = rowinfo[row]; const float gt = rowgate[row];
                if (dst >= 0) {
#pragma unroll
                    for (int bj = 0; bj < 2; ++bj) { const float sa = F8 ? W8_INV : 1.0f; const f32x4 v0 = (acc[ai][bj][m][0] * sa + bv[bj][0]) * gt, v1 = (acc[ai][bj][m][1] * sa + bv[bj][1]) * gt;
                        if constexpr (F8) {
                            u32x2 w; w.x = pk4_fp8(v0[0], v0[1], v0[2], v0[3]); w.y = pk4_fp8(v1[0], v1[1], v1[2], v1[3]);
                            *(u32x2*)((unsigned char*)Y + (size_t)dst * DM + col0 + bj * 128) = w;
                        } else {
                            u32x4 w; w.x = cvtpk(v0[0], v0[1]); w.y = cvtpk(v0[2], v0[3]); w.z = cvtpk(v1[0], v1[1]); w.w = cvtpk(v1[2], v1[3]);
                            *(u32x4*)(Y + (size_t)dst * DM + col0 + bj * 128) = w; } } } }
    }
};
struct GroupedOrder {
    const LAS int* tile_e; int ntiles, nN, G, c; size_t estride;
    __device__ __forceinline__ bool next(int i, pg8::Unit& u) const {
        int pm, pn;
        if (G == 256) { const int x = c & 7, j = c >> 3, rpx = 32 / nN; pn = j % nN; pm = i * (8 * rpx) + x * rpx + j / nN; }
        else { const long L = (long)i * G + c; pm = (int)(L / nN); pn = (int)(L % nN); }
        if (pm >= ntiles) return false;
        u.pm = pm; u.pn = pn; u.e = __builtin_amdgcn_readfirstlane(tile_e[pm]); u.bo = (size_t)u.e * estride; return true;
    }
    __device__ __forceinline__ void a_ready(const pg8::Unit&) const {}
    __device__ __forceinline__ void done(const pg8::Unit&) const {}
};

#define XB_TMO      128
#define XB_XCNT(j)  (256  + 64 * (j))
#define XB_XSUB(j)  (1280 + 64 * (j))
#define XB_XGEN(j)  (2304 + 64 * (j))
#define XB_TOP      3328
#define XB_TOPGEN   3392
#define XCD_BAR_WORDS 3456
#define XB_SPIN_CAP (1u << 18)

__device__ __forceinline__ unsigned xb_ld(unsigned* p)              { return __hip_atomic_load(p, __ATOMIC_RELAXED, __HIP_MEMORY_SCOPE_AGENT); }
__device__ __forceinline__ unsigned xb_add(unsigned* p, unsigned v) { return __hip_atomic_fetch_add(p, v, __ATOMIC_RELAXED, __HIP_MEMORY_SCOPE_AGENT); }
__device__ __forceinline__ unsigned xb_xcc_id() { return (unsigned)__builtin_amdgcn_s_getreg((3 << 11) | 20) & 0xFu; }
#define XB_SPIN(cond, bar) do { unsigned _sp = 0; while (cond) { __builtin_amdgcn_s_sleep(1); \
    if ((++_sp & 255u) == 0u) { if (xb_ld(&(bar)[XB_TMO])) break; if (_sp > XB_SPIN_CAP) { atomicAdd(&(bar)[XB_TMO], 1u); break; } } } } while (0)

struct XcdBarrier {
    unsigned* bar; unsigned x; bool w0;
    volatile LAS unsigned* st;
};

__device__ __forceinline__ XcdBarrier xcd_barrier_post(unsigned* bar, volatile LAS unsigned* st, bool w0) {
    XcdBarrier b; b.bar = bar; b.x = xb_xcc_id(); b.st = st; b.w0 = w0;
    if (w0 && hw_lane() == 0) (void)xb_add(&bar[XB_XCNT(b.x)], 1u);
    return b;
}
__device__ __forceinline__ void xcd_barrier_complete(unsigned* bar, unsigned x, unsigned& nloc, unsigned& nx) {
    const unsigned G = gridDim.x * gridDim.y * gridDim.z;
    unsigned sum, cnt, mine, sp = 0u;
    for (;;) {
        sum = 0u; cnt = 0u; mine = 0u;
#pragma unroll
        for (unsigned j = 0; j < 16; ++j) { const unsigned c = xb_ld(&bar[XB_XCNT(j)]); sum += c; cnt += (c > 0u) ? 1u : 0u; mine = (j == x) ? c : mine; }
        if (sum == G) break;
        __builtin_amdgcn_s_sleep(1);
        if ((++sp & 255u) == 0u) { if (xb_ld(&bar[XB_TMO])) break; if (sp > XB_SPIN_CAP) { atomicAdd(&bar[XB_TMO], 1u); break; } }
    }
    nloc = mine > 0u ? mine : 1u; nx = cnt > 0u ? cnt : 1u;
}

__device__ __forceinline__ void xcd_barrier(const XcdBarrier& b) {
    asm volatile("s_waitcnt vmcnt(0)" ::: "memory");
    __syncthreads();
    if (b.w0 && hw_lane() == 0) {
        unsigned* bar = b.bar;
        __builtin_amdgcn_s_waitcnt(0);
        unsigned nloc = b.st[0], nx = b.st[1];
        if (nloc == 0u) { xcd_barrier_complete(bar, b.x, nloc, nx); b.st[0] = nloc; b.st[1] = nx; }
        const unsigned old = xb_add(&bar[XB_XSUB(b.x)], 1u);
        const unsigned gen = old / nloc;
        if (old + 1u == (gen + 1u) * nloc) {
            __builtin_amdgcn_fence(__ATOMIC_RELEASE, "agent");
            asm volatile("s_waitcnt vmcnt(0)" ::: "memory");
            const unsigned og = xb_add(&bar[XB_TOP], 1u);
            const unsigned tg = og / nx;
            if (og + 1u == (tg + 1u) * nx) xb_add(&bar[XB_TOPGEN], 1u);
            else XB_SPIN(xb_ld(&bar[XB_TOPGEN]) == tg, bar);
            __builtin_amdgcn_fence(__ATOMIC_ACQUIRE, "agent");
            xb_add(&bar[XB_XGEN(b.x)], 1u);
            asm volatile("s_waitcnt vmcnt(0)" ::: "memory");
        } else {
            XB_SPIN(xb_ld(&bar[XB_XGEN(b.x)]) == gen, bar);
            __builtin_amdgcn_fence(__ATOMIC_ACQUIRE, "agent");
            asm volatile("s_waitcnt vmcnt(0)" ::: "memory");
        }
    }
    __syncthreads();
}

struct Frame {
    LAS unsigned char* lds;
    volatile LAS unsigned* MISC;
    unsigned* ctl;
    int wave, G, bid;
    __device__ __forceinline__ int lane() const { return hw_lane(); }
    __device__ __forceinline__ int tid() const { return wave * 64 + hw_lane(); }
    __device__ __forceinline__ const float* in(int i) const { const LAS unsigned* p = (const LAS unsigned*)(lds + PTR_OFF) + 2 * i;
        const unsigned lo = __builtin_amdgcn_readfirstlane(p[0]), hi = __builtin_amdgcn_readfirstlane(p[1]); return (const float*)(((unsigned long long)hi << 32) | lo); }
    float* out; unsigned char* ws;
    unsigned long long tacc; int xpass;
};
__device__ __forceinline__ float log2gamma(int h) { return log2f(1.0f - exp2f(-5.0f - (float)h)); }

template <bool F8, class RowMap>
__device__ __forceinline__ void transpose_item(const float* W, int N, bf16* WT, int K, const float* kscale, LAS float* scr, int kb, int nb, int lane, RowMap rm) {
    const int k0 = 64 * kb, n0 = 64 * nb;
#pragma unroll 4
    for (int i = 0; i < 16; ++i) {
        const int kk = 4 * i + (lane >> 4), nn = 4 * (lane & 15);
        f32x4 v = (f32x4){0.f, 0.f, 0.f, 0.f};
        if (n0 + nn < N) v = *(const f32x4*)(W + (size_t)(k0 + kk) * N + n0 + nn);
        if (kscale) v = v * kscale[k0 + kk];
        LAS float* s = scr + kk * 65 + nn; s[0] = v[0]; s[1] = v[1]; s[2] = v[2]; s[3] = v[3];
    }
    asm volatile("s_waitcnt lgkmcnt(0)" ::: "memory");
    const int cch = lane & 7;
#pragma unroll
    for (int j = 0; j < 8; ++j) {
        const int n = 8 * j + (lane >> 3); const LAS float* s = scr + (8 * cch) * 65 + n;
        if constexpr (F8) {
            u32x2 o; o.x = pk4_fp8(s[0 * 65] * W8_SCALE, s[1 * 65] * W8_SCALE, s[2 * 65] * W8_SCALE, s[3 * 65] * W8_SCALE); o.y = pk4_fp8(s[4 * 65] * W8_SCALE, s[5 * 65] * W8_SCALE, s[6 * 65] * W8_SCALE, s[7 * 65] * W8_SCALE);
            if (n0 + n < N) *(u32x2*)((unsigned char*)WT + (size_t)rm(n0 + n) * K + k0 + 8 * cch) = o;
        } else {
        const float cs = (N == IN_COLS && n0 + n >= C_AQ && n0 + n < C_AK) ? 0.125f : 1.0f;
        u32x4 o; o.x = cvtpk(s[0 * 65] * cs, s[1 * 65] * cs); o.y = cvtpk(s[2 * 65] * cs, s[3 * 65] * cs); o.z = cvtpk(s[4 * 65] * cs, s[5 * 65] * cs); o.w = cvtpk(s[6 * 65] * cs, s[7 * 65] * cs);
        if (n0 + n < N) *(u32x4*)(WT + (size_t)rm(n0 + n) * K + k0 + 8 * cch) = o; }
    }
    asm volatile("s_waitcnt lgkmcnt(0)" ::: "memory");
}
__device__ __forceinline__ void f8_item_load(const float* W, int N, int kb, int nb, int lane, f32x4 (&v)[16]) {
    const int k0 = 128 * kb, n0 = 32 * nb;
#pragma unroll
    for (int i = 0; i < 16; ++i) v[i] = *(const f32x4*)(W + (size_t)(k0 + 8 * i + (lane >> 3)) * N + n0 + 4 * (lane & 7));
}
template <class RowMap>
__device__ __forceinline__ void f8_item_store(const f32x4 (&v)[16], unsigned char* WT, int K, LAS float* scr, int kb, int nb, int lane, RowMap rm) {
    const int k0 = 128 * kb, n0 = 32 * nb;
#pragma unroll
    for (int i = 0; i < 16; ++i) { const int kk = 8 * i + (lane >> 3), nn = 4 * (lane & 7); LAS float* s = scr + kk * 32;
        s[(nn + 0) ^ (kk & 31)] = v[i][0]; s[(nn + 1) ^ (kk & 31)] = v[i][1]; s[(nn + 2) ^ (kk & 31)] = v[i][2]; s[(nn + 3) ^ (kk & 31)] = v[i][3]; }
    asm volatile("s_waitcnt lgkmcnt(0)" ::: "memory");
    const int cch = lane & 7;
#pragma unroll
    for (int j = 0; j < 4; ++j) {
        const int n = 8 * j + (lane >> 3); float t[16];
#pragma unroll
        for (int i = 0; i < 16; ++i) { const int kk = 16 * cch + i; t[i] = scr[kk * 32 + (n ^ (kk & 31))] * W8_SCALE; }
        u32x4 o; o.x = pk4_fp8(t[0], t[1], t[2], t[3]); o.y = pk4_fp8(t[4], t[5], t[6], t[7]); o.z = pk4_fp8(t[8], t[9], t[10], t[11]); o.w = pk4_fp8(t[12], t[13], t[14], t[15]);
        *(u32x4*)(WT + (size_t)rm(n0 + n) * K + k0 + 16 * cch) = o;
    }
    asm volatile("s_waitcnt lgkmcnt(0)" ::: "memory");
}
struct RmId { __device__ __forceinline__ int operator()(int n) const { return n; } };
struct RmGu { __device__ __forceinline__ int operator()(int n) const { const int j = n & 1023; return (j >> 7) * 256 + (n >> 10) * 128 + (j & 127); } };

template <class RowMap>
__device__ __forceinline__ void f8_item_lowreg(const float* W, int N, unsigned char* WT, int K, LAS float* scr, int kb, int nb, int lane, RowMap rm, const float* kscale = nullptr) {
    const int k0 = 128 * kb, n0 = 32 * nb;
#pragma unroll 1
    for (int h = 0; h < 2; ++h) {
        f32x4 v[8];
#pragma unroll
        for (int i = 0; i < 8; ++i) { v[i] = *(const f32x4*)(W + (size_t)(k0 + 64 * h + 8 * i + (lane >> 3)) * N + n0 + 4 * (lane & 7)); if (kscale) v[i] = v[i] * kscale[k0 + 64 * h + 8 * i + (lane >> 3)]; }
#pragma unroll
        for (int i = 0; i < 8; ++i) { const int kk = 64 * h + 8 * i + (lane >> 3), nn = 4 * (lane & 7); LAS float* s = scr + kk * 32;
            s[(nn + 0) ^ (kk & 31)] = v[i][0]; s[(nn + 1) ^ (kk & 31)] = v[i][1]; s[(nn + 2) ^ (kk & 31)] = v[i][2]; s[(nn + 3) ^ (kk & 31)] = v[i][3]; }
    }
    asm volatile("s_waitcnt lgkmcnt(0)" ::: "memory");
    const int cch = lane & 7;
#pragma unroll 1
    for (int j = 0; j < 4; ++j) {
        const int n = 8 * j + (lane >> 3); float t[16];
#pragma unroll
        for (int i = 0; i < 16; ++i) { const int kk = 16 * cch + i; t[i] = scr[kk * 32 + (n ^ (kk & 31))] * W8_SCALE; }
        u32x4 o; o.x = pk4_fp8(t[0], t[1], t[2], t[3]); o.y = pk4_fp8(t[4], t[5], t[6], t[7]); o.z = pk4_fp8(t[8], t[9], t[10], t[11]); o.w = pk4_fp8(t[12], t[13], t[14], t[15]);
        *(u32x4*)(WT + (size_t)rm(n0 + n) * K + k0 + 16 * cch) = o;
    }
    asm volatile("s_waitcnt lgkmcnt(0)" ::: "memory");
}
__device__ __forceinline__ void phase_p0a(Frame& F) {
    const float* const c_in = F.in(1); const float* const ada_w = F.in(2); const float* const ada_b = F.in(3); const float* const w_in = F.in(5); const float* const mix_scale = F.in(6);
    const float* const w_o = F.in(7); const float* const w_gu = F.in(11); const float* const w_down = F.in(13);
    if (F.bid < 96) {
        LAS float* sc = (LAS float*)F.lds;
        LAS float* part = (LAS float*)(F.lds + 16384);
        for (int i = F.tid(); i < 1024; i += NTHR) {
#pragma unroll
            for (int b = 0; b < 4; ++b) { const float cv = c_in[b * 1024 + i]; sc[i * 4 + b] = cv / (1.0f + __expf(-cv)); }
        }
        __syncthreads();
        const int j0 = F.bid * 64;
        float a0 = 0.f, a1 = 0.f, a2 = 0.f, a3 = 0.f;
#pragma unroll 8
        for (int ii = 0; ii < 128; ++ii) {
            const int i = F.wave * 128 + ii; const float w = ada_w[(size_t)i * 6144 + j0 + F.lane()];
            const f32x4 s4 = *(const LAS f32x4*)(sc + i * 4);
            a0 += s4[0] * w; a1 += s4[1] * w; a2 += s4[2] * w; a3 += s4[3] * w;
        }
        part[(F.wave * 4 + 0) * 64 + F.lane()] = a0; part[(F.wave * 4 + 1) * 64 + F.lane()] = a1; part[(F.wave * 4 + 2) * 64 + F.lane()] = a2; part[(F.wave * 4 + 3) * 64 + F.lane()] = a3;
        __syncthreads();
        if (F.tid() < 256) { const int b = F.tid() >> 6, l = F.tid() & 63; float s = ada_b[j0 + l];
#pragma unroll
            for (int w = 0; w < 8; ++w) s += part[(w * 4 + b) * 64 + l];
            ((float*)(F.ws + WS_MOD))[b * 6144 + j0 + l] = s; }
        __syncthreads();
    }
    { int* ri = (int*)(F.ws + WS_ROWINFO); for (int i = F.bid * NTHR + F.tid(); i < MOE_ROWS; i += F.G * NTHR) ri[i] = -1; }
    LAS float* scr = (LAS float*)(F.lds + F.wave * 16896);
    const int gw = F.bid * NWAVES + F.wave, NGW = F.G * NWAVES;
    constexpr int I_IN = 16 * 46, I_O = 16 * 16, I_GU = 32 * 16 * 32, I_DN = 32 * 16 * 16, NITEMS = I_IN + I_O + I_GU + I_DN;
    for (int it = (F.G >= 224 ? gw - 96 * NWAVES : gw); it >= 0 && it < I_IN + I_O; it += NGW) {
        int r = it;
        if (r < I_IN) { transpose_item<false>(w_in, IN_COLS, (bf16*)(F.ws + WS_WIN), 1024, nullptr, scr, r / 46, r % 46, F.lane(), RmId()); continue; } r -= I_IN;
        f8_item_lowreg(w_o, 1024, F.ws + WS_WO, 1024, scr, r / 32, r % 32, F.lane(), RmId(), mix_scale);
    }
}

constexpr int F8_I_GU = 32 * 8 * 64, F8_I_DN = 32 * 8 * 32, F8_ITEMS = F8_I_GU + F8_I_DN;
__device__ __forceinline__ int f8_burst(Frame& F, LAS float* scr, int it, int count) {
    const float* const w_gu = F.in(11); const float* const w_down = F.in(13);
    const int NGW = F.G * NWAVES, lane = F.lane();
    auto item_src = [&](int r, const float*& W, int& N, int& kb, int& nb) { if (r < F8_I_GU) { const int e = r / 512, q = r % 512; W = w_gu + (size_t)e * 1024 * 2048; N = 2048; kb = q / 64; nb = q % 64; }
                                                                             else { r -= F8_I_GU; const int e = r / 256, q = r % 256; W = w_down + (size_t)e * 1024 * 1024; N = 1024; kb = q / 32; nb = q % 32; } };
    asm volatile("" ::: "memory");
    for (int c = 0; c < count && it < F8_ITEMS; ++c) {
        const float* W; int N, kb, nb;
        item_src(it, W, N, kb, nb);
        if (it < F8_I_GU) f8_item_lowreg(W, N, F.ws + WS_WGU + (size_t)(it / 512) * 2048 * 1024, 1024, scr, kb, nb, lane, RmGu());
        else f8_item_lowreg(W, N, F.ws + WS_WDN + (size_t)((it - F8_I_GU) / 256) * 1024 * 1024, 1024, scr, kb, nb, lane, RmId());
        it += NGW;
        asm volatile("" ::: "memory");
    }
    asm volatile("" ::: "memory");
    return it;
}

__device__ __forceinline__ void phase_p0b(Frame& F) {
    const float* const x_in = F.in(0); const float* const norm1_g = F.in(4);
    const int gw = F.bid * NWAVES + F.wave, NGW = F.G * NWAVES;
    const float* mod = (const float*)(F.ws + WS_MOD); bf16* h0 = (bf16*)(F.ws + WS_H0);
    for (int m = gw; m < NTOK; m += NGW) {
        const int b = m / SEQ;
        const f32x4* xr = (const f32x4*)(x_in + (size_t)m * DM) + F.lane();
        f32x4 v[4]; float s = 0.f;
#pragma unroll
        for (int j = 0; j < 4; ++j) { v[j] = xr[64 * j]; s += (v[j][0] * v[j][0] + v[j][1] * v[j][1]) + (v[j][2] * v[j][2] + v[j][3] * v[j][3]); }
        const float rstd = rsqrtf(wave_sum(s) * (1.f / DM) + EPS);
        u32x2* o8 = (u32x2*)(h0 + (size_t)m * DM) + F.lane();
#pragma unroll
        for (int j = 0; j < 4; ++j) { const int col = 4 * F.lane() + 256 * j;
            const f32x4 g = *(const f32x4*)(norm1_g + col), sh = *(const f32x4*)(mod + b * 6144 + col), sc = *(const f32x4*)(mod + b * 6144 + 1024 + col);
            const f32x4 y = (v[j] * rstd) * g * (sc + 1.0f) + sh;
            u32x2 w; w.x = cvtpk(y[0], y[1]); w.y = cvtpk(y[2], y[3]); o8[64 * j] = w; }
    }
}

constexpr int VSTR = 144, KSTR = 80;
__device__ __forceinline__ void ret_stage_v(Frame& F, const bf16* proj, int tok0, int h, LAS bf16* Vs) {
    const int row = F.tid() >> 2, q = F.tid() & 3; const bf16* src = proj + (size_t)(tok0 + row) * PJ + C_RV + h * 128 + q * 32;
#pragma unroll
    for (int i = 0; i < 4; ++i) *(LAS u32x4*)(Vs + row * VSTR + q * 32 + 8 * i) = *(const u32x4*)(src + 8 * i);
}
__device__ __forceinline__ void ret_stage64(Frame& F, const bf16* src0, size_t pitch, LAS bf16* Ds) {
    const int row = F.tid() >> 2, q = F.tid() & 3; const bf16* src = src0 + (size_t)row * pitch + q * 16;
#pragma unroll
    for (int i = 0; i < 2; ++i) *(LAS u32x4*)(Ds + row * KSTR + q * 16 + 8 * i) = *(const u32x4*)(src + 8 * i);
}
__device__ __forceinline__ void ret_a_item(Frame& F, int item) {
    const bf16* proj = (const bf16*)(F.ws + WS_PROJ); float* kvt = (float*)(F.ws + WS_KVT) + (size_t)item * 8192;
    const int bh = item >> 6, n = item & 63, b = bh >> 2, h = bh & 3, tok0 = b * SEQ + n * 128;
    LAS bf16* Vs = (LAS bf16*)F.lds; LAS bf16* Ks = (LAS bf16*)(F.lds + 128 * VSTR * 2);
    const float lg = log2gamma(h);
    ret_stage_v(F, proj, tok0, h, Vs);
    { const int row = F.tid() >> 2, q = F.tid() & 3; const bf16* src = proj + (size_t)(tok0 + row) * PJ + C_RK + h * 64 + q * 16; const float dk = 0.125f * exp2f((float)(127 - row) * lg);
#pragma unroll
      for (int i = 0; i < 2; ++i) { const u32x4 w = *(const u32x4*)(src + 8 * i); u32x4 o;
          o.x = cvtpk(bflo(w.x) * dk, bfhi(w.x) * dk); o.y = cvtpk(bflo(w.y) * dk, bfhi(w.y) * dk); o.z = cvtpk(bflo(w.z) * dk, bfhi(w.z) * dk); o.w = cvtpk(bflo(w.w) * dk, bfhi(w.w) * dk);
          *(LAS u32x4*)(Ks + row * KSTR + q * 16 + 8 * i) = o; } }
    __syncthreads();
    const int lane = F.lane(), n16 = lane & 15, c = lane >> 4, q4 = n16 >> 2, p4 = lane & 3, e0 = 16 * F.wave;
    f32x4 acc[4];
#pragma unroll
    for (int dt = 0; dt < 4; ++dt) acc[dt] = (f32x4){0.f, 0.f, 0.f, 0.f};
#pragma unroll
    for (int s = 0; s < 4; ++s) {
        const LAS bf16* ap = Vs + (32 * s + 4 * c + q4) * VSTR + e0 + 4 * p4;
        const bf16x8 A = cat8(trread(ap), trread(ap + 16 * VSTR));
#pragma unroll
        for (int dt = 0; dt < 4; ++dt) { const LAS bf16* bp = Ks + (32 * s + 4 * c + q4) * KSTR + 16 * dt + 4 * p4;
            const bf16x8 B = cat8(trread(bp), trread(bp + 16 * KSTR)); acc[dt] = MFMA16(A, B, acc[dt]); }
    }
#pragma unroll
    for (int dt = 0; dt < 4; ++dt)
#pragma unroll
        for (int r = 0; r < 4; ++r) kvt[(e0 + 4 * c + r) * 64 + 16 * dt + n16] = acc[dt][r];
    __syncthreads();
}
__device__ __forceinline__ void ret_scan(Frame& F) {
    const float* kvt = (const float*)(F.ws + WS_KVT); bf16* rpt = (bf16*)(F.ws + WS_RPT);
    for (int g = F.bid * NTHR + F.tid(); g < 16 * 8192; g += F.G * NTHR) {
        const int bh = g >> 13, ed = g & 8191, h = bh & 3; const float gC = exp2f(128.0f * log2gamma(h));
        float R = 0.f; const size_t base = (size_t)bh * 64 * 8192 + ed;
#pragma unroll 8
        for (int n = 0; n < 64; ++n) { const float kv = kvt[base + (size_t)n * 8192]; rpt[base + (size_t)n * 8192] = f2bf(R); R = R * gC + kv; }
    }
}
__device__ __forceinline__ void ret_c_item(Frame& F, int item) {
    const bf16* proj = (const bf16*)(F.ws + WS_PROJ); const bf16* rpt = (const bf16*)(F.ws + WS_RPT) + (size_t)item * 8192; bf16* mix = (bf16*)(F.ws + WS_MIX);
    const int bh = item >> 6, n = item & 63, b = bh >> 2, h = bh & 3, tok0 = b * SEQ + n * 128;
    LAS bf16* Qs = (LAS bf16*)F.lds; LAS bf16* Ks = Qs + 128 * KSTR; LAS bf16* Vs = Ks + 128 * KSTR; LAS bf16* Rs = Vs + 128 * VSTR;
    const float lg = log2gamma(h);
    ret_stage64(F, proj + (size_t)tok0 * PJ + C_RQ + h * 64, PJ, Qs);
    ret_stage64(F, proj + (size_t)tok0 * PJ + C_RK + h * 64, PJ, Ks);
    ret_stage_v(F, proj, tok0, h, Vs);
    ret_stage64(F, rpt, 64, Rs);
    __syncthreads();
    const int lane = F.lane(), n16 = lane & 15, c = lane >> 4, q4 = n16 >> 2, p4 = lane & 3, w = F.wave, i0 = 16 * w, il = i0 + n16;
    bf16x8 qf[2];
#pragma unroll
    for (int s = 0; s < 2; ++s) qf[s] = *(const LAS bf16x8*)(Qs + il * KSTR + 32 * s + 8 * c);
    f32x4 oin[8], ocr[8];
#pragma unroll
    for (int et = 0; et < 8; ++et) { oin[et] = (f32x4){0.f, 0.f, 0.f, 0.f}; ocr[et] = (f32x4){0.f, 0.f, 0.f, 0.f}; }
    const int nsp = (w >> 1) + 1;
    for (int sp = 0; sp < nsp; ++sp) {
        unsigned pw[4];
#pragma unroll
        for (int t2 = 0; t2 < 2; ++t2) { const int jt = 2 * sp + t2;
            const bf16x8 k0 = *(const LAS bf16x8*)(Ks + (16 * jt + n16) * KSTR + 8 * c), k1 = *(const LAS bf16x8*)(Ks + (16 * jt + n16) * KSTR + 32 + 8 * c);
            f32x4 st = MFMA16(k0, qf[0], ((f32x4){0.f, 0.f, 0.f, 0.f})); st = MFMA16(k1, qf[1], st);
            float pv[4];
#pragma unroll
            for (int r = 0; r < 4; ++r) { const int j = 16 * jt + 4 * c + r; const float f = (il >= j) ? 0.125f * exp2f((float)(il - j) * lg) : 0.f; pv[r] = st[r] * f; }
            pw[2 * t2] = cvtpk(pv[0], pv[1]); pw[2 * t2 + 1] = cvtpk(pv[2], pv[3]); }
        const bf16x8 P = __builtin_bit_cast(bf16x8, ((u32x4){pw[0], pw[1], pw[2], pw[3]}));
#pragma unroll
        for (int et = 0; et < 8; ++et) { const LAS bf16* ap = Vs + (32 * sp + 4 * c + q4) * VSTR + 16 * et + 4 * p4;
            const bf16x8 A = cat8(trread(ap), trread(ap + 16 * VSTR)); oin[et] = MFMA16(A, P, oin[et]); }
    }
#pragma unroll
    for (int et = 0; et < 8; ++et)
#pragma unroll
        for (int s = 0; s < 2; ++s) { const bf16x8 rf = *(const LAS bf16x8*)(Rs + (16 * et + n16) * KSTR + 32 * s + 8 * c); ocr[et] = MFMA16(rf, qf[s], ocr[et]); }
    const float qd = exp2f((float)(il + 1) * lg);
    float ss = 0.f;
#pragma unroll
    for (int et = 0; et < 8; ++et) { oin[et] = oin[et] + ocr[et] * qd; ss += (oin[et][0] * oin[et][0] + oin[et][1] * oin[et][1]) + (oin[et][2] * oin[et][2] + oin[et][3] * oin[et][3]); }
    ss += __shfl_xor(ss, 16); ss += __shfl_xor(ss, 32);
    const float rstd = rsqrtf(ss * (1.f / 128.f) + EPS);
    const bf16* gp = proj + (size_t)(tok0 + il) * PJ + C_RG + h * 128 + 4 * c; unsigned char* op = (unsigned char*)mix + (size_t)(tok0 + il) * DM + h * 128 + 4 * c;
#pragma unroll
    for (int et = 0; et < 8; ++et) { const u32x2 gw = *(const u32x2*)(gp + 16 * et);
        const float g0 = bflo(gw.x), g1 = bfhi(gw.x), g2 = bflo(gw.y), g3 = bfhi(gw.y);
        const float y0 = g0 / (1.f + __expf(-g0)) * (oin[et][0] * rstd), y1 = g1 / (1.f + __expf(-g1)) * (oin[et][1] * rstd), y2 = g2 / (1.f + __expf(-g2)) * (oin[et][2] * rstd), y3 = g3 / (1.f + __expf(-g3)) * (oin[et][3] * rstd);
        *(unsigned*)(op + 16 * et) = pk4_fp8(y0, y1, y2, y3); }
    __syncthreads();
}

constexpr int MTW = 2;
constexpr int RPW = 4 * MTW, QT = 8 * RPW, KT = 64, CAP = 131072 / (QT * 4), CAP_TRIG = CAP - KT, NSEL = 256, NREG = CAP / 64;
constexpr int KTS = 72;
constexpr int CAND_BYTES = QT * CAP * 4, KTILE_BYTES = KT * KTS * 2;
constexpr float WSCALE = 0.125f * 0.35355339059327373f;
__device__ __forceinline__ unsigned fmap(float s) { const unsigned u = __builtin_bit_cast(unsigned, s); return (u & 0x80000000u) ? ~u : (u | 0x80000000u); }
__device__ __forceinline__ float funmap(unsigned m) { const unsigned u = (m & 0x80000000u) ? (m ^ 0x80000000u) : ~m; return __builtin_bit_cast(float, u); }
#define DPP_ROR(v, n) ((unsigned)__builtin_amdgcn_update_dpp(0, (int)(v), 0x120 + (n), 0xf, 0xf, false))
#define DPP_SHR0(v, n) ((unsigned)__builtin_amdgcn_update_dpp(0, (int)(v), 0x110 + (n), 0xf, 0xf, true))
__device__ __forceinline__ unsigned wave_umin(unsigned v) {
    v = min(v, DPP_ROR(v, 1)); v = min(v, DPP_ROR(v, 2)); v = min(v, DPP_ROR(v, 4)); v = min(v, DPP_ROR(v, 8));
    const unsigned a = __builtin_amdgcn_readlane(v, 0), b = __builtin_amdgcn_readlane(v, 16), c = __builtin_amdgcn_readlane(v, 32), d = __builtin_amdgcn_readlane(v, 48);
    return min(min(a, b), min(c, d));
}
__device__ __forceinline__ unsigned wave_umax(unsigned v) {
    v = max(v, DPP_ROR(v, 1)); v = max(v, DPP_ROR(v, 2)); v = max(v, DPP_ROR(v, 4)); v = max(v, DPP_ROR(v, 8));
    const unsigned a = __builtin_amdgcn_readlane(v, 0), b = __builtin_amdgcn_readlane(v, 16), c = __builtin_amdgcn_readlane(v, 32), d = __builtin_amdgcn_readlane(v, 48);
    return max(max(a, b), max(c, d));
}
__device__ __forceinline__ unsigned wave_scan_incl(unsigned v, int lane) {
    v += DPP_SHR0(v, 1); v += DPP_SHR0(v, 2); v += DPP_SHR0(v, 4); v += DPP_SHR0(v, 8);
    const unsigned t0 = __builtin_amdgcn_readlane(v, 15), t1 = __builtin_amdgcn_readlane(v, 31), t2 = __builtin_amdgcn_readlane(v, 47);
    const int rw = lane >> 4;
    return v + (rw == 1 ? t0 : rw == 2 ? t0 + t1 : rw == 3 ? t0 + t1 + t2 : 0u);
}
__device__ __forceinline__ unsigned lt01(int a, int b) { unsigned r; asm("v_sub_u32 %0, %1, %2\n\tv_lshrrev_b32 %0, 31, %0" : "=&v"(r) : "v"(a), "v"(b)); return r; }
#define BIT01(m, j) ({ unsigned _r; asm("v_bfe_u32 %0, %1, %2, 1" : "=v"(_r) : "v"(m), "n"(j)); _r; })
#define LT01(a, b) lt01((int)(a), (int)(b))
__device__ __forceinline__ int select_row(LAS unsigned* row, int cnt, int limit, LAS unsigned* hist, LAS unsigned* trashp, int lane, unsigned& minkey, int need0 = NSEL) {
    unsigned e[NREG]; unsigned act = 0u, keep = 0u;
#pragma unroll
    for (int j = 0; j < NREG; ++j) { const unsigned v = LT01(64 * j + lane, cnt); e[j] = row[64 * j + lane] & (0u - v); act |= v << j; }
    int need = need0; bool first = true;
    for (;;) {
        unsigned lo = 0xFFFFFFFFu, hi = 0u;
#pragma unroll
        for (int j = 0; j < NREG; ++j) { const unsigned a = BIT01(act, j); lo = min(lo, e[j] | (a - 1u)); hi = max(hi, e[j] & (0u - a)); }
        lo = wave_umin(lo); hi = wave_umax(hi);
        if (hi == lo) break;
        hist[lane] = 0u;
        int rb[NREG];
        if (first) {
            const float slo = funmap(lo & 0xFFFFE000u), shi = funmap(hi & 0xFFFFE000u);
            const float scale = (shi > slo) ? 63.999f / (shi - slo) : 0.f;
#pragma unroll
            for (int j = 0; j < NREG; ++j) { const int bn = (int)((funmap(e[j] & 0xFFFFE000u) - slo) * scale); rb[j] = 63 - min(max(bn, 0), 63); }
        } else {
            const float scale = 63.999f / (float)(hi - lo);
#pragma unroll
            for (int j = 0; j < NREG; ++j) { const int bn = (int)((float)(e[j] - lo) * scale); rb[j] = 63 - min(max(bn, 0), 63); }
        }
        first = false;
#pragma unroll
        for (int j = 0; j < NREG; ++j) __hip_atomic_fetch_add(hist + rb[j], BIT01(act, j), __ATOMIC_RELAXED, __HIP_MEMORY_SCOPE_WAVEFRONT);
        const unsigned h = hist[lane];
        const unsigned ps = wave_scan_incl(h, lane);
        const unsigned long long m = __ballot(ps >= (unsigned)need);
        const int ls = (int)__builtin_ctzll(m);
        const int cge = (int)__builtin_amdgcn_readlane(ps, ls), nb = (int)__builtin_amdgcn_readlane(h, ls);
#pragma unroll
        for (int j = 0; j < NREG; ++j) { const unsigned a = BIT01(act, j), kp = a & LT01(rb[j], ls), dr = a & LT01(ls, rb[j]); keep |= kp << j; act &= ~((kp | dr) << j); }
        need -= cge - nb;
        if ((need0 - need) + nb <= limit) break;
    }
    keep |= act;
    const unsigned kcnt = (unsigned)__builtin_popcount(keep); const unsigned incl = wave_scan_incl(kcnt, lane);
    int pos = (int)(incl - kcnt); const int run = (int)__builtin_amdgcn_readlane(incl, 63); unsigned mk = 0xFFFFFFFFu;
#pragma unroll
    for (int j = 0; j < NREG; ++j) { const unsigned k = BIT01(keep, j);
        *(trashp + ((int)((row + pos) - trashp) & -(int)k)) = e[j];
        mk = min(mk, e[j] | (k - 1u)); pos += (int)k; }
    minkey = wave_umin(mk);
    return run;
}
__device__ __forceinline__ int compact_stream(LAS unsigned* row, int cnt, LAS unsigned* hist, LAS unsigned* trashp, int lane, float& thrf) {
    unsigned e[NREG];
#pragma unroll
    for (int j = 0; j < NREG; ++j) e[j] = row[64 * j + lane];
    const unsigned lo = wave_umin(min(e[0], e[1])), hi = wave_umax(max(e[0], e[1]));
    const float slo = funmap(lo & 0xFFFFE000u), shi = funmap(hi & 0xFFFFE000u);
    bool ok = shi > slo; int newcnt = 0, bstar = 0; int bn[NREG]; float scale = 0.f;
    if (ok) {
        scale = 63.999f / (shi - slo);
        hist[lane] = 0u;
#pragma unroll
        for (int j = 0; j < NREG; ++j) { const int b = (int)((funmap(e[j] & 0xFFFFE000u) - slo) * scale); bn[j] = min(max(b, 0), 63);
            __hip_atomic_fetch_add(hist + (63 - bn[j]), LT01(64 * j + lane, cnt), __ATOMIC_RELAXED, __HIP_MEMORY_SCOPE_WAVEFRONT); }
        const unsigned h = hist[lane];
        const unsigned ps = wave_scan_incl(h, lane);
        const unsigned long long m = __ballot(ps >= (unsigned)NSEL);
        const int ls = (int)__builtin_ctzll(m);
        newcnt = (int)__builtin_amdgcn_readlane(ps, ls); bstar = 63 - ls;
        ok = newcnt <= NSEL + 96;
    }
    if (!ok) { unsigned P; const int nc = select_row(row, cnt, NSEL + 64, hist, trashp, lane, P); thrf = funmap(P & 0xFFFFE000u); return nc; }
    unsigned keep = 0u;
#pragma unroll
    for (int j = 0; j < NREG; ++j) keep |= (LT01(64 * j + lane, cnt) & LT01(bstar - 1, bn[j])) << j;
    const unsigned kcnt = (unsigned)__builtin_popcount(keep); const unsigned incl = wave_scan_incl(kcnt, lane);
    int pos = (int)(incl - kcnt); const int run = (int)__builtin_amdgcn_readlane(incl, 63);
#pragma unroll
    for (int j = 0; j < NREG; ++j) { const unsigned k = BIT01(keep, j);
        *(trashp + ((int)((row + pos) - trashp) & -(int)k)) = e[j];
        pos += (int)k; }
    if (bstar > 0) thrf = slo + ((float)bstar - 0.01f) / scale;
    return run;
}
__device__ __forceinline__ int select_final(LAS unsigned* row, int cnt, LAS unsigned* hist, LAS unsigned* trashp, int lane) {
    unsigned e[NREG];
#pragma unroll
    for (int j = 0; j < NREG; ++j) e[j] = row[64 * j + lane] & (0u - LT01(64 * j + lane, cnt));
    const unsigned lo = wave_umin(min(e[0], e[1])), hi = wave_umax(max(e[0], e[1]));
    const float slo = funmap(lo & 0xFFFFE000u), shi = funmap(hi & 0xFFFFE000u);
    bool ok = shi > slo; int nb = 0, bstar = 0, cgt = 0; int bn[NREG];
    if (ok) {
        const float scale = 63.999f / (shi - slo);
        hist[lane] = 0u;
#pragma unroll
        for (int j = 0; j < NREG; ++j) { const int b = (int)((funmap(e[j] & 0xFFFFE000u) - slo) * scale); bn[j] = min(max(b, 0), 63);
            __hip_atomic_fetch_add(hist + (63 - bn[j]), LT01(64 * j + lane, cnt), __ATOMIC_RELAXED, __HIP_MEMORY_SCOPE_WAVEFRONT); }
        const unsigned h = hist[lane];
        const unsigned ps = wave_scan_incl(h, lane);
        const unsigned long long m = __ballot(ps >= (unsigned)NSEL);
        const int ls = (int)__builtin_ctzll(m);
        nb = (int)__builtin_amdgcn_readlane(h, ls); cgt = (int)__builtin_amdgcn_readlane(ps, ls) - nb; bstar = 63 - ls;
        ok = nb <= 64;
    }
    if (!ok) { unsigned P; return select_row(row, cnt, NSEL, hist, trashp, lane, P); }
    unsigned keepm = 0u, bndm = 0u;
#pragma unroll
    for (int j = 0; j < NREG; ++j) { const unsigned v = LT01(64 * j + lane, cnt); keepm |= (v & LT01(bstar, bn[j])) << j; bndm |= (v & (1u - LT01(bstar, bn[j])) & (1u - LT01(bn[j], bstar))) << j; }
    { const unsigned bc = (unsigned)__builtin_popcount(bndm); int bp = (int)(wave_scan_incl(bc, lane) - bc);
#pragma unroll
      for (int j = 0; j < NREG; ++j) { const unsigned k = BIT01(bndm, j); *(trashp + ((int)((hist + bp) - trashp) & -(int)k)) = e[j]; bp += (int)k; } }
    const unsigned x = hist[lane] & (0u - LT01(lane, nb));
    int rank = 0;
    for (int i = 0; i < nb; ++i) rank += (int)(hist[i] > x);
    const int needb = NSEL - cgt;
    { const unsigned kc = (unsigned)__builtin_popcount(keepm); int pos = (int)(wave_scan_incl(kc, lane) - kc);
#pragma unroll
      for (int j = 0; j < NREG; ++j) { const unsigned k = BIT01(keepm, j); *(trashp + ((int)((row + pos) - trashp) & -(int)k)) = e[j]; pos += (int)k; } }
    { const unsigned k = LT01(lane, nb) & LT01(rank, needb); *(trashp + ((int)((row + cgt + rank) - trashp) & -(int)k)) = x; }
    return NSEL;
}
__device__ __forceinline__ float sample_threshold(const LAS unsigned* row, int cnt, int rank, LAS unsigned* hist, int lane) {
    unsigned e[NREG];
#pragma unroll
    for (int j = 0; j < NREG; ++j) e[j] = row[64 * j + lane];
    unsigned lo = 0xFFFFFFFFu, hi = 0u;
#pragma unroll
    for (int j = 0; j < NREG; ++j) { const unsigned v = LT01(64 * j + lane, cnt); lo = min(lo, e[j] | (v - 1u)); hi = max(hi, e[j] & (0u - v)); }
    lo = wave_umin(lo); hi = wave_umax(hi);
    const float slo = funmap(lo & 0xFFFFE000u), shi = funmap(hi & 0xFFFFE000u);
    if (!(shi > slo)) return -INFINITY;
    const float scale = 63.999f / (shi - slo);
    hist[lane] = 0u;
#pragma unroll
    for (int j = 0; j < NREG; ++j) { const int b = (int)((funmap(e[j] & 0xFFFFE000u) - slo) * scale);
        __hip_atomic_fetch_add(hist + (63 - min(max(b, 0), 63)), LT01(64 * j + lane, cnt), __ATOMIC_RELAXED, __HIP_MEMORY_SCOPE_WAVEFRONT); }
    const unsigned ps = wave_scan_incl(hist[lane], lane);
    const int bstar = 63 - (int)__builtin_ctzll(__ballot(ps >= (unsigned)rank));
    return bstar > 0 ? slo + ((float)bstar - 0.01f) / scale : -INFINITY;
}
#if defined(PROBE_SUB)
#define PSUB_T(i) do { const unsigned long long _t = __builtin_amdgcn_s_memrealtime(); if ((i) == PROBE_SUB) F.tacc += _t - psub_last; psub_last = _t; } while (0)
#else
#define PSUB_T(i) do { } while (0)
#endif
#ifndef DSA_EXP
#define DSA_EXP 0
#endif
#define DSA_X(bit) (F.xpass != 0 && (DSA_EXP & (bit)))
__device__ __forceinline__ void dsa_a_wave(Frame& F, int b, int qt, int ws) {
#if defined(PROBE_SUB)
    unsigned long long psub_last = 0ull;
#endif
    const bf16* proj = (const bf16*)(F.ws + WS_PROJ); bf16* sel = (bf16*)(F.ws + WS_SEL);
    LAS unsigned* cand = (LAS unsigned*)F.lds;
    LAS unsigned* hist = (LAS unsigned*)(F.lds + CAND_BYTES) + 64 * F.wave;
    LAS int* rowcnt = (LAS int*)(F.lds + CAND_BYTES + 2048); LAS float* rowthr = (LAS float*)(F.lds + CAND_BYTES + 2048 + 256);
    const int lane = F.lane(), w = F.wave, r32 = lane & 31, hi = lane >> 5;
    const int trash = (CAND_BYTES + 2048 + 512) / 4 + 64 * w + lane;
    const int tokb = b * SEQ, q0 = qt * QT + RPW * ws;
    bf16x8 af[MTW][4]; float wv[MTW][16];
    { const int qq = 2 * ((r32 >> 2) & 1) + (r32 >> 4), hd = ((r32 >> 3) & 1) * 4 + (r32 & 3);
#pragma unroll
      for (int mt = 0; mt < MTW; ++mt) { const bf16* qp = proj + (size_t)(tokb + q0 + 4 * mt + qq) * PJ + C_IQ + hd * 64 + 32 * hi;
#pragma unroll
          for (int s = 0; s < 4; ++s) af[mt][s] = *(const bf16x8*)(qp + 8 * s);
#pragma unroll
          for (int u = 0; u < 2; ++u) { const u32x4 ww = *(const u32x4*)(proj + (size_t)(tokb + q0 + 4 * mt + 2 * hi + u) * PJ + C_IW);
              wv[mt][8 * u + 0] = bflo(ww.x) * WSCALE; wv[mt][8 * u + 1] = bfhi(ww.x) * WSCALE; wv[mt][8 * u + 2] = bflo(ww.y) * WSCALE; wv[mt][8 * u + 3] = bfhi(ww.y) * WSCALE;
              wv[mt][8 * u + 4] = bflo(ww.z) * WSCALE; wv[mt][8 * u + 5] = bfhi(ww.z) * WSCALE; wv[mt][8 * u + 6] = bflo(ww.w) * WSCALE; wv[mt][8 * u + 7] = bfhi(ww.w) * WSCALE; } } }
    float thrf[MTW][2]; int cntv[MTW][2];
    if (lane < RPW) { rowcnt[RPW * w + lane] = 0; rowthr[RPW * w + lane] = -INFINITY; }
    const int NT = (q0 + RPW + KT - 1) / KT;
    const char* kbase = (const char*)(proj + (size_t)tokb * PJ + C_IK + 32 * hi);
    const unsigned koff = (unsigned)r32 * (unsigned)(PJ * 2);
    constexpr int SSTR = 16, SOFF = 7, SRANK = 40;
    for (int pass = (NT >= 2 * SSTR ? 0 : 1); pass < 3; ++pass) {
        const int stride = pass == 0 ? SSTR : 1, kt0 = pass == 0 ? SOFF : 0;
#pragma unroll
        for (int mt = 0; mt < MTW; ++mt)
#pragma unroll
            for (int u = 0; u < 2; ++u) { cntv[mt][u] = 0; thrf[mt][u] = pass == 1 ? rowthr[RPW * w + 4 * mt + 2 * hi + u] : -INFINITY; }
        bf16x8 kc[2][4], kn[2][4];
        { const char* kb0 = kbase + (size_t)kt0 * KT * (PJ * 2);
#pragma unroll
          for (int sub = 0; sub < 2; ++sub)
#pragma unroll
              for (int s = 0; s < 4; ++s) kc[sub][s] = *(const bf16x8*)(kb0 + koff + (unsigned)(sub * 32) * (unsigned)(PJ * 2) + 16 * s); }
        auto tile_step = [&](int kt, bf16x8 (&kc)[2][4], bf16x8 (&kn)[2][4]) {
            PSUB_T(0);
            const char* kb1 = kbase + (size_t)(kt + stride) * KT * (PJ * 2);
#pragma unroll
            for (int sub = 0; sub < 2; ++sub) {
                if (kt + stride < NT) {
#pragma unroll
                    for (int s = 0; s < 4; ++s) kn[sub][s] = *(const bf16x8*)(kb1 + koff + (unsigned)(sub * 32) * (unsigned)(PJ * 2) + 16 * s); }
                const int key = kt * KT + sub * 32 + r32;
                f32x16 accs[MTW];
#pragma unroll
                for (int mt = 0; mt < MTW; ++mt) {
                    accs[mt] = MFMA32(af[mt][0], kc[sub][0], ((f32x16){0.f, 0.f, 0.f, 0.f, 0.f, 0.f, 0.f, 0.f, 0.f, 0.f, 0.f, 0.f, 0.f, 0.f, 0.f, 0.f}));
#pragma unroll
                    for (int s = 1; s < 4; ++s) accs[mt] = MFMA32(af[mt][s], kc[sub][s], accs[mt]);
                }
#pragma unroll
                for (int mt = 0; mt < MTW; ++mt) {
                    float sc[2] = {0.f, 0.f};
#pragma unroll
                    for (int r = 0; r < 16; ++r) sc[r >> 3] += wv[mt][r] * fmaxf(accs[mt][r], 0.f);
#pragma unroll
                    for (int u = 0; u < 2; ++u) {
                        const int ql = RPW * w + 4 * mt + 2 * hi + u;
                        const bool valid = (sc[u] >= thrf[mt][u]) && (key <= q0 + 4 * mt + 2 * hi + u);
                        const unsigned long long m = __ballot(valid);
                        const int nlo = __builtin_popcount((unsigned)m), nhi = __builtin_popcount((unsigned)(m >> 32));
                        const int off = mbcnt64(m) - (hi ? nlo : 0);
                        cand[valid ? ql * CAP + cntv[mt][u] + off : trash] = (fmap(sc[u]) & 0xFFFFE000u) | (unsigned)(8191 - key);
                        cntv[mt][u] += hi ? nhi : nlo;
                    }
                }
            }
            PSUB_T(1);
            bool anyc = false;
#pragma unroll
            for (int mt = 0; mt < MTW; ++mt)
#pragma unroll
                for (int u = 0; u < 2; ++u) anyc = anyc || (cntv[mt][u] > CAP_TRIG);
            if (__any(anyc)) {
                if ((lane & 31) == 0) {
#pragma unroll
                    for (int mt = 0; mt < MTW; ++mt)
#pragma unroll
                        for (int u = 0; u < 2; ++u) { rowcnt[RPW * w + 4 * mt + 2 * hi + u] = cntv[mt][u]; rowthr[RPW * w + 4 * mt + 2 * hi + u] = thrf[mt][u]; }
                }
#pragma unroll 1
                for (int rr = 0; rr < RPW; ++rr) { const int rowi = RPW * w + rr; const int cq = __builtin_amdgcn_readfirstlane(rowcnt[rowi]);
                    if (cq > NSEL + 64) { float tf = rowthr[rowi]; const int nc = compact_stream(cand + rowi * CAP, cq, hist, cand + trash, lane, tf);
                        if (lane == 0) { rowcnt[rowi] = nc; rowthr[rowi] = tf; } } }
#pragma unroll
                for (int mt = 0; mt < MTW; ++mt)
#pragma unroll
                    for (int u = 0; u < 2; ++u) { cntv[mt][u] = rowcnt[RPW * w + 4 * mt + 2 * hi + u]; thrf[mt][u] = rowthr[RPW * w + 4 * mt + 2 * hi + u]; }
            }
            PSUB_T(7);
        };
        for (int kt = kt0; kt < NT; kt += 2 * stride) { tile_step(kt, kc, kn); if (kt + stride < NT) tile_step(kt + stride, kn, kc); }
        if ((lane & 31) == 0) {
#pragma unroll
            for (int mt = 0; mt < MTW; ++mt)
#pragma unroll
                for (int u = 0; u < 2; ++u) rowcnt[RPW * w + 4 * mt + 2 * hi + u] = cntv[mt][u];
        }
        if (pass == 0) {
#pragma unroll 1
            for (int rr = 0; rr < RPW; ++rr) { const int rowi = RPW * w + rr; const int cq = __builtin_amdgcn_readfirstlane(rowcnt[rowi]); float tf = -INFINITY;
                if (cq > SRANK + 8) tf = sample_threshold(cand + rowi * CAP, cq, SRANK, hist, lane);
                if (lane == 0) rowthr[rowi] = tf; }
        } else {
            bool okall = true;
#pragma unroll 1
            for (int rr = 0; rr < RPW; ++rr) { const int cq = __builtin_amdgcn_readfirstlane(rowcnt[RPW * w + rr]); const int nrow = q0 + rr + 1; okall = okall && (cq >= (nrow < NSEL ? nrow : NSEL)); }
            if (okall) break;
        }
    }
    PSUB_T(5);
#pragma unroll 1
    for (int rr = 0; rr < RPW; ++rr) { const int ql = RPW * w + rr; LAS unsigned* row = cand + ql * CAP; int cq = __builtin_amdgcn_readfirstlane(rowcnt[ql]);
        if (cq > NSEL) cq = select_final(row, cq, hist, cand + trash, lane);
        bf16* so = sel + (size_t)(tokb + q0 + rr) * NSEL;
#pragma unroll
        for (int j = 0; j < 4; ++j) { const int p = 64 * j + lane; const unsigned v = row[p]; so[p] = (p < cq) ? (bf16)(8191u - (v & 0x1FFFu)) : (bf16)0; } }
    PSUB_T(6);
}

constexpr int VROW = 144;
constexpr int DSB_WAVE = 32 * VROW * 2 + 2 * 2048;
static_assert(8 * DSB_WAVE <= MISC_OFF, "DSA-B LDS map");
__device__ __forceinline__ void dsb_gather(const char* kvbase, const LAS unsigned* sl, int chunk, int colbyte, int c, int n16, u32x4 (&r)[8]) {
#pragma unroll
    for (int i = 0; i < 8; ++i) { const unsigned o = sl[32 * chunk + 4 * i + c] + (unsigned)(colbyte + n16 * 16); r[i] = *(const u32x4*)(kvbase + o); }
}
__device__ __forceinline__ void dsb_put_list(LAS unsigned* sl, u32x2 kk, int t, int lane) {
    const unsigned k0 = kk.x & 0xffffu, k1 = kk.x >> 16, k2 = kk.y & 0xffffu, k3 = kk.y >> 16;
    *(LAS u32x4*)(sl + 4 * lane) = (u32x4){k0 * (unsigned)(PJ * 2), k1 * (unsigned)(PJ * 2), k2 * (unsigned)(PJ * 2), k3 * (unsigned)(PJ * 2)};
    *(LAS f32x4*)((LAS float*)(sl + 256) + 4 * lane) = (f32x4){(float)(t - (int)k0), (float)(t - (int)k1), (float)(t - (int)k2), (float)(t - (int)k3)};
}
__device__ __forceinline__ void phase_dsa_b(Frame& F) {
    const bf16* proj = (const bf16*)(F.ws + WS_PROJ); const bf16* sel = (const bf16*)(F.ws + WS_SEL); bf16* mix = (bf16*)(F.ws + WS_MIX);
    const int lane = F.lane(), n16 = lane & 15, c = lane >> 4, q4 = n16 >> 2, p4 = lane & 3, w = F.wave;
    LAS unsigned char* wl = F.lds + w * DSB_WAVE;
    LAS bf16* buf = (LAS bf16*)wl; LAS unsigned* slb = (LAS unsigned*)(wl + 32 * VROW * 2);
    const float nslope[2] = {-exp2f(-(float)((n16 & 3) + 1)), -exp2f(-(float)((n16 & 3) + 5))};
    constexpr float L2E = 1.4426950408889634f;
    for (int blk = F.bid; blk < NTOK / 128; blk += F.G) {
        int T0 = blk * 128;
        if (F.G == 256) { const int x = F.bid & 7, jj = F.bid >> 3; T0 = (x & 3) * SEQ + (jj * 2 + (x >> 2)) * 128; }
        const char* kvbase = (const char*)(proj + (size_t)(T0 / SEQ) * SEQ * PJ);
        int tok = T0 + w;
        u32x4 kr[8], vr[8]; bf16x8 qf[2][2]; u32x2 selnext;
        dsb_put_list(slb, *(const u32x2*)(sel + (size_t)tok * NSEL + 4 * lane), tok % SEQ, lane);
        dsb_gather(kvbase, slb, 0, C_AK * 2, c, n16, kr); dsb_gather(kvbase, slb, 0, C_AV * 2, c, n16, vr);
#pragma unroll
        for (int g = 0; g < 2; ++g)
#pragma unroll
            for (int s = 0; s < 2; ++s) { bf16x8 v = (bf16x8){0, 0, 0, 0, 0, 0, 0, 0};
                if (n16 < 4) v = *(const bf16x8*)(proj + (size_t)tok * PJ + C_AQ + (g * 4 + n16) * 64 + 32 * s + 8 * c);
                qf[g][s] = v; }
        for (int qi = 0; qi < 16; ++qi) {
            const int t = tok % SEQ, nsel = (t + 1 < NSEL) ? t + 1 : NSEL; const int par = qi & 1;
            const LAS unsigned* sl = slb + par * 512; LAS unsigned* sln = slb + (par ^ 1) * 512;
            const bool more = qi + 1 < 16; const int tokn = tok + 8;
            if (more) selnext = *(const u32x2*)(sel + (size_t)tokn * NSEL + 4 * lane);
            float mrun[2] = {-INFINITY, -INFINITY}, lrun[2] = {0.f, 0.f};
            f32x4 O[2][4];
#pragma unroll
            for (int g = 0; g < 2; ++g)
#pragma unroll
                for (int dt = 0; dt < 4; ++dt) O[g][dt] = (f32x4){0.f, 0.f, 0.f, 0.f};
            bf16x8 qn[2][2];
#pragma unroll 4
            for (int ch = 0; ch < 8; ++ch) {
#pragma unroll
                for (int i = 0; i < 8; ++i) *(LAS u32x4*)(buf + (4 * i + c) * VROW + n16 * 8) = kr[i];
                if (ch == 3 && more) dsb_put_list(sln, selnext, tokn % SEQ, lane);
                asm volatile("" ::: "memory");
                if (ch < 7) dsb_gather(kvbase, sl, ch + 1, C_AK * 2, c, n16, kr);
                else if (more) dsb_gather(kvbase, sln, 0, C_AK * 2, c, n16, kr);
                if (ch == 6 && more) {
#pragma unroll
                    for (int g = 0; g < 2; ++g)
#pragma unroll
                        for (int s = 0; s < 2; ++s) { bf16x8 v = (bf16x8){0, 0, 0, 0, 0, 0, 0, 0};
                            if (n16 < 4) v = *(const bf16x8*)(proj + (size_t)tokn * PJ + C_AQ + (g * 4 + n16) * 64 + 32 * s + 8 * c);
                            qn[g][s] = v; } }
                f32x4 acc[2][2];
#pragma unroll
                for (int kt = 0; kt < 2; ++kt)
#pragma unroll
                    for (int g = 0; g < 2; ++g) { const LAS bf16* ap = buf + (16 * kt + n16) * VROW + g * 64 + 8 * c;
                        acc[kt][g] = MFMA16(*(const LAS bf16x8*)ap, qf[g][0], ((f32x4){0.f, 0.f, 0.f, 0.f})); acc[kt][g] = MFMA16(*(const LAS bf16x8*)(ap + 32), qf[g][1], acc[kt][g]); }
#pragma unroll
                for (int kt = 0; kt < 2; ++kt) { const f32x4 d4 = *(const LAS f32x4*)((const LAS float*)(sl + 256) + 32 * ch + 16 * kt + 4 * c);
#pragma unroll
                    for (int r = 0; r < 4; ++r)
#pragma unroll
                        for (int g = 0; g < 2; ++g) acc[kt][g][r] = fmaf(nslope[g], d4[r], acc[kt][g][r]); }
                if (nsel < NSEL) {
#pragma unroll
                    for (int kt = 0; kt < 2; ++kt)
#pragma unroll
                        for (int r = 0; r < 4; ++r) { const bool dead = 32 * ch + 16 * kt + 4 * c + r >= nsel;
#pragma unroll
                            for (int g = 0; g < 2; ++g) acc[kt][g][r] = dead ? -INFINITY : acc[kt][g][r]; }
                }
                bf16x8 pf[2]; float alpha[2]; bool grow = false;
#pragma unroll
                for (int g = 0; g < 2; ++g) {
                    float mx = fmaxf(fmaxf(fmaxf(acc[0][g][0], acc[0][g][1]), fmaxf(acc[0][g][2], acc[0][g][3])), fmaxf(fmaxf(acc[1][g][0], acc[1][g][1]), fmaxf(acc[1][g][2], acc[1][g][3])));
                    mx = fmaxf(mx, __shfl_xor(mx, 16)); mx = fmaxf(mx, __shfl_xor(mx, 32));
                    const float mnew = fmaxf(mrun[g], mx);
                    alpha[g] = (mnew == -INFINITY) ? 1.f : __builtin_amdgcn_exp2f((mrun[g] - mnew) * L2E);
                    grow = grow || (mnew > mrun[g]);
                    mrun[g] = mnew;
                    const float mm2 = (mnew == -INFINITY) ? 0.f : -mnew * L2E; float s = 0.f;
#pragma unroll
                    for (int kt = 0; kt < 2; ++kt)
#pragma unroll
                        for (int r = 0; r < 4; ++r) { const float e = __builtin_amdgcn_exp2f(fmaf(acc[kt][g][r], L2E, mm2)); acc[kt][g][r] = e; s += e; }
                    s += __shfl_xor(s, 16); s += __shfl_xor(s, 32);
                    lrun[g] = lrun[g] * alpha[g] + s;
                    u32x4 pw; pw.x = cvtpk(acc[0][g][0], acc[0][g][1]); pw.y = cvtpk(acc[0][g][2], acc[0][g][3]); pw.z = cvtpk(acc[1][g][0], acc[1][g][1]); pw.w = cvtpk(acc[1][g][2], acc[1][g][3]);
                    pf[g] = __builtin_bit_cast(bf16x8, pw); }
#pragma unroll
                for (int i = 0; i < 8; ++i) *(LAS u32x4*)(buf + (4 * i + c) * VROW + n16 * 8) = vr[i];
                asm volatile("" ::: "memory");
                if (ch < 7) dsb_gather(kvbase, sl, ch + 1, C_AV * 2, c, n16, vr);
                else if (more) dsb_gather(kvbase, sln, 0, C_AV * 2, c, n16, vr);
                if (__any(grow)) {
#pragma unroll
                    for (int g = 0; g < 2; ++g)
#pragma unroll
                        for (int r = 0; r < 4; ++r) { const float a = __builtin_bit_cast(float, __builtin_amdgcn_readlane(__builtin_bit_cast(int, alpha[g]), r));
#pragma unroll
                            for (int dt = 0; dt < 4; ++dt) O[g][dt][r] *= a; }
                }
#pragma unroll
                for (int dt = 0; dt < 4; ++dt) { const LAS bf16* vp = buf + (4 * c + q4) * VROW + dt * 16 + 4 * p4;
                    O[0][dt] = MFMA16(pf[0], cat8(trread(vp), trread(vp + 16 * VROW)), O[0][dt]);
                    O[1][dt] = MFMA16(pf[1], cat8(trread(vp + 64), trread(vp + 64 + 16 * VROW)), O[1][dt]); }
            }
            {
#pragma unroll
                for (int g = 0; g < 2; ++g)
#pragma unroll
                    for (int r = 0; r < 4; ++r) { const float li = __builtin_amdgcn_rcpf(__builtin_bit_cast(float, __builtin_amdgcn_readlane(__builtin_bit_cast(int, lrun[g]), r)));
                        if (lane < 16) {
#pragma unroll
                            for (int dt = 0; dt < 4; dt += 2) { const int w2 = __builtin_amdgcn_cvt_pk_fp8_f32(O[g][dt][r] * li, O[g][dt + 1][r] * li, 0, false);
                                ((LAS unsigned char*)buf)[(g * 4 + r) * 64 + 16 * dt + lane] = (unsigned char)(w2 & 0xff); ((LAS unsigned char*)buf)[(g * 4 + r) * 64 + 16 * (dt + 1) + lane] = (unsigned char)((w2 >> 8) & 0xff); } } }
                const u32x2 ov = *(const LAS u32x2*)((LAS unsigned char*)buf + 8 * lane);
                *(u32x2*)((unsigned char*)mix + (size_t)tok * DM + 512 + 8 * lane) = ov;
            }
            if (more) {
#pragma unroll
                for (int g = 0; g < 2; ++g)
#pragma unroll
                    for (int s = 0; s < 2; ++s) qf[g][s] = qn[g][s];
            }
            tok = tokn;
        }
    }
}

constexpr int HSTR = 1028;
__device__ __forceinline__ void phase_router(Frame& F) {
    const float* const norm2_g = F.in(8); const float* const router_w = F.in(9); const float* const router_b = F.in(10);
    const float* x1 = F.out; const float* mod = (const float*)(F.ws + WS_MOD); unsigned char* h2 = (unsigned char*)(F.ws + WS_H2);
    int* topi = (int*)(F.ws + WS_TOPI); float* topg = (float*)(F.ws + WS_TOPG); int* bbase = (int*)(F.ws + WS_BBASE);
    LAS float* hs = (LAS float*)F.lds; LAS float* part = (LAS float*)(F.lds + 16 * HSTR * 4); LAS int* hist = (LAS int*)(F.lds + 16 * HSTR * 4 + 8 * 16 * 32 * 4);
    const int lane = F.lane(), w = F.wave;
    for (int blk = F.bid; blk < NTOK / 128; blk += F.G) {
        const int T0 = blk * 128, b = T0 / SEQ;
        if (F.tid() < 32) hist[F.tid()] = 0;
        f32x4 ca[4], cb[4];
#pragma unroll
        for (int j = 0; j < 4; ++j) { const int col = 4 * lane + 256 * j;
            ca[j] = *(const f32x4*)(norm2_g + col) * (*(const f32x4*)(mod + b * 6144 + 4 * 1024 + col) + 1.0f); cb[j] = *(const f32x4*)(mod + b * 6144 + 3 * 1024 + col); }
        __syncthreads();
        for (int pass = 0; pass < 8; ++pass) {
#pragma unroll
            for (int tt = 0; tt < 2; ++tt) { const int tl = 2 * w + tt, tok = T0 + pass * 16 + tl;
                const f32x4* xr = (const f32x4*)(x1 + (size_t)tok * DM) + lane; f32x4 v[4]; float s = 0.f;
#pragma unroll
                for (int j = 0; j < 4; ++j) { v[j] = xr[64 * j]; s += (v[j][0] * v[j][0] + v[j][1] * v[j][1]) + (v[j][2] * v[j][2] + v[j][3] * v[j][3]); }
                const float rstd = rsqrtf(wave_sum(s) * (1.f / DM) + EPS);
                unsigned* o4 = (unsigned*)(h2 + (size_t)tok * DM) + lane;
#pragma unroll
                for (int j = 0; j < 4; ++j) { const f32x4 y = (v[j] * rstd) * ca[j] + cb[j];
                    o4[64 * j] = pk4_fp8(y[0], y[1], y[2], y[3]);
                    *(LAS f32x4*)(hs + tl * HSTR + 4 * lane + 256 * j) = y; } }
            __syncthreads();
            { const int ti = lane & 15, kk = lane >> 5, e = lane & 31; f32x16 acc;
#pragma unroll
              for (int r = 0; r < 16; ++r) acc[r] = 0.f;
              const LAS float* hp = hs + ti * HSTR + 128 * w + 64 * kk; const float* rwp = router_w + (size_t)(128 * w + 64 * kk) * NE + e;
#pragma unroll 4
              for (int s4 = 0; s4 < 16; ++s4) { const f32x4 a4 = *(const LAS f32x4*)(hp + 4 * s4);
#pragma unroll
                  for (int q = 0; q < 4; ++q) acc = __builtin_amdgcn_mfma_f32_32x32x2f32(a4[q], rwp[(4 * s4 + q) * NE], acc, 0, 0, 0); }
#pragma unroll
              for (int r = 0; r < 8; ++r) part[(w * 16 + (r & 3) + 8 * (r >> 2) + 4 * kk) * 32 + e] = acc[r]; }
            __syncthreads();
            { const int tl = F.tid() >> 5, e = F.tid() & 31, tok = T0 + pass * 16 + tl; float lg = router_b[e];
#pragma unroll
              for (int ww = 0; ww < 8; ++ww) lg += part[(ww * 16 + tl) * 32 + e];
              float myv = lg; float tv[4]; int ti4[4]; bool mine = false;
#pragma unroll
              for (int k = 0; k < 4; ++k) { float bv = myv; int bi = e;
#pragma unroll
                  for (int o = 16; o >= 1; o >>= 1) { const float ov = __shfl_xor(bv, o); const int oi = __shfl_xor(bi, o); if (ov > bv || (ov == bv && oi < bi)) { bv = ov; bi = oi; } }
                  tv[k] = bv; ti4[k] = bi; if (bi == e) { myv = -INFINITY; mine = true; } }
              if (mine) atomicAdd((int*)hist + e, 1);
              if (e == 0) { const float e0 = 1.0f, e1 = __expf(tv[1] - tv[0]), e2 = __expf(tv[2] - tv[0]), e3 = __expf(tv[3] - tv[0]); const float inv = 1.0f / (e0 + e1 + e2 + e3);
                  *(int4*)(topi + (size_t)tok * 4) = make_int4(ti4[0], ti4[1], ti4[2], ti4[3]); *(f32x4*)(topg + (size_t)tok * 4) = (f32x4){e0 * inv, e1 * inv, e2 * inv, e3 * inv}; } }
            __syncthreads();
        }
        if (F.tid() < 32) { const int base = atomicAdd((int*)(F.ctl + CW_GCNT) + F.tid(), hist[F.tid()]); bbase[blk * 32 + F.tid()] = base; }
        __syncthreads();
    }
}
__device__ __forceinline__ int moe_layout(Frame& F, LAS int* offs, LAS int* tile_e) {
    if (F.tid() == 0) { int o = 0;
        for (int e = 0; e < NE; ++e) { const int cnt = (int)__hip_atomic_load(F.ctl + CW_GCNT + e, __ATOMIC_RELAXED, __HIP_MEMORY_SCOPE_AGENT); const int nt = (cnt + 255) >> 8;
            offs[e] = o; if (tile_e) for (int t = 0; t < nt; ++t) tile_e[(o >> 8) + t] = e; o += nt << 8; }
        offs[NE] = o >> 8; }
    __syncthreads();
    return offs[NE];
}
__device__ __forceinline__ void phase_place(Frame& F) {
    const unsigned char* h2 = (const unsigned char*)(F.ws + WS_H2); unsigned char* xs = (unsigned char*)(F.ws + WS_XS);
    const int* topi = (const int*)(F.ws + WS_TOPI); const float* topg = (const float*)(F.ws + WS_TOPG); const int* bbase = (const int*)(F.ws + WS_BBASE);
    int* rowinfo = (int*)(F.ws + WS_ROWINFO); float* rowgate = (float*)(F.ws + WS_ROWGATE);
    LAS int* offs = (LAS int*)F.lds; LAS int* lcur = offs + 64; LAS int* posl = offs + 128;
    (void)moe_layout(F, offs, nullptr);
    for (int blk = F.bid; blk < NTOK / 128; blk += F.G) {
        const int T0 = blk * 128;
        if (F.tid() < 32) lcur[F.tid()] = 0;
        __syncthreads();
        { const int i = F.tid(), tok = T0 + (i >> 2); const int e = topi[(size_t)tok * 4 + (i & 3)];
          const int rank = atomicAdd((int*)lcur + e, 1); const int pos = offs[e] + bbase[blk * 32 + e] + rank;
          rowinfo[pos] = tok * 4 + (i & 3); rowgate[pos] = topg[(size_t)tok * 4 + (i & 3)]; posl[i] = pos; }
        __syncthreads();
        for (int jj = 0; jj < 64; ++jj) { const int i = F.wave * 64 + jj; const int pos = posl[i]; const int tok = T0 + (i >> 2);
            const u32x4* src = (const u32x4*)(h2 + (size_t)tok * DM) + F.lane(); u32x4* dst = (u32x4*)(xs + (size_t)pos * DM) + F.lane();
            dst[0] = src[0]; }
        __syncthreads();
    }
}
__device__ __forceinline__ void phase_final(Frame& F) {
    const float* const final_g = F.in(15);
    const float* mod = (const float*)(F.ws + WS_MOD); const bf16* Y = (const bf16*)(F.ws + WS_Y);
    const int gw = F.bid * NWAVES + F.wave, NGW = F.G * NWAVES;
    for (int m = gw; m < NTOK; m += NGW) {
        const int b = m / SEQ; f32x4* xr = (f32x4*)(F.out + (size_t)m * DM) + F.lane(); f32x4 v[4]; float s = 0.f;
#pragma unroll
        for (int j = 0; j < 4; ++j) { const int col = 4 * F.lane() + 256 * j; f32x4 y = (f32x4){0.f, 0.f, 0.f, 0.f};
#pragma unroll
            for (int k = 0; k < 4; ++k) { const unsigned w = *((const unsigned*)((const unsigned char*)Y + ((size_t)m * 4 + k) * DM) + F.lane() + 64 * j);
                const f32x2_t lo = __builtin_amdgcn_cvt_pk_f32_fp8(w, false), hi2 = __builtin_amdgcn_cvt_pk_f32_fp8(w, true); y[0] += lo[0]; y[1] += lo[1]; y[2] += hi2[0]; y[3] += hi2[1]; }
            v[j] = xr[64 * j] + *(const f32x4*)(mod + b * 6144 + 5 * 1024 + col) * y;
            s += (v[j][0] * v[j][0] + v[j][1] * v[j][1]) + (v[j][2] * v[j][2] + v[j][3] * v[j][3]); }
        const float rstd = rsqrtf(wave_sum(s) * (1.f / DM) + EPS);
#pragma unroll
        for (int j = 0; j < 4; ++j) xr[64 * j] = (v[j] * rstd) * *(const f32x4*)(final_g + 4 * F.lane() + 256 * j);
    }
}

#ifndef MK_N_LAUNCHES
#define MK_N_LAUNCHES 1
#endif
constexpr int N_PHASES = 12;
struct Args { const float* in[16]; float* out; unsigned char* ws; int ph_lo, ph_hi; };
static_assert(sizeof(Args) == 16 * 8 + 8 + 8 + 8, "Args has no padding");

__global__ void __launch_bounds__(NTHR, 2) mk_fwd(Args args) {
    extern __shared__ __attribute__((aligned(16))) unsigned char lds_raw[];
    Frame F;
    F.lds = (LAS unsigned char*)lds_raw;
    F.MISC = (volatile LAS unsigned*)(F.lds + MISC_OFF);
    F.wave = __builtin_amdgcn_readfirstlane((int)threadIdx.x >> 6);
    F.G = gridDim.x; F.bid = blockIdx.x; F.tacc = 0ull; F.xpass = 0;
    F.ws = args.ws; F.ctl = (unsigned*)(args.ws + WS_CTL); F.out = args.out;
    for (int u = F.tid(); u < (LDS_BYTES - MISC_OFF) / 4; u += NTHR) ((LAS unsigned*)(F.lds + MISC_OFF))[u] = 0u;
    __syncthreads();
    if (F.tid() < 16) *(LAS unsigned long long*)(F.lds + PTR_OFF + 8 * F.tid()) = (unsigned long long)args.in[F.tid()];
    __syncthreads();
    const int lo = args.ph_lo, hi = args.ph_hi;
    XcdBarrier bar; bar.bar = (unsigned*)(F.ctl + CW_BAR); bar.x = 0; bar.st = nullptr; bar.w0 = (F.wave == 0);
    if (hi - lo > 1) bar = xcd_barrier_post((unsigned*)(F.ctl + CW_BAR), F.MISC + 8, F.wave == 0);
#define IN(k) (lo <= (k) && (k) < hi)
#if defined(PROBE_PHASE)
    unsigned long long tp0 = 0ull, tp1 = 0ull;
#define STAMP(k) do { if ((k) == PROBE_PHASE) tp0 = __builtin_amdgcn_s_memrealtime(); if ((k) == PROBE_PHASE + 1) tp1 = __builtin_amdgcn_s_memrealtime(); } while (0)
#else
#define STAMP(k) do { } while (0)
#endif
#define SEAM(k) do { if (IN(k) && IN((k) + 1)) xcd_barrier(bar); } while (0)

    STAMP(0); if (IN(0)) { phase_p0a(F); } SEAM(0);
    STAMP(1); if (IN(1)) { phase_p0b(F); } SEAM(1);
    STAMP(2); if (IN(2)) {
        pg8::Gemm g{(const bf16*)(F.ws + WS_H0), (const bf16*)(F.ws + WS_WIN), NTOK, 3072, DM}; pg8::StaticOrder S; S.init(NTOK, 3072, F.G, F.bid);
        EpiProj E{(bf16*)(F.ws + WS_PROJ), PJ};
        pg8::gemm_phase<EpiProj, pg8::StaticOrder, true, true>(F.lds, g, S, E, F.wave);
    } SEAM(2);
    STAMP(3); if (IN(3)) {
#if defined(PROBE_SUB)
        const unsigned long long tra0 = __builtin_amdgcn_s_memrealtime();
#endif
        for (int it = F.bid; it < 1024; it += F.G) ret_a_item(F, it);
#if defined(PROBE_SUB)
        if (PROBE_SUB == 4) F.tacc += __builtin_amdgcn_s_memrealtime() - tra0;
#endif
        { constexpr int NQT = SEQ / QT, NITEM = NBATCH * NQT * 8;
          int cit = F.bid * NWAVES + F.wave;
          LAS float* scr = (LAS float*)(F.lds + F.wave * (RPW * CAP * 4));
          for (;;) { int t = 0; if (F.lane() == 0) t = (int)__hip_atomic_fetch_add(F.ctl + CW_Q3, 1u, __ATOMIC_RELAXED, __HIP_MEMORY_SCOPE_AGENT);
              t = __builtin_amdgcn_readfirstlane(t); const bool have = t < NITEM;
              if (have) dsa_a_wave(F, (t >> 3) & 3, NQT - 1 - (t >> 5), t & 7);
              cit = f8_burst(F, scr, cit, have ? 6 : (1 << 20));
              if (!have) break; } }
    } SEAM(3);
    STAMP(4); if (IN(4)) {
#if defined(PROBE_SUB)
        const unsigned long long tsc0 = __builtin_amdgcn_s_memrealtime();
#endif
        ret_scan(F);
#if defined(PROBE_SUB)
        if (PROBE_SUB == 5) F.tacc += __builtin_amdgcn_s_memrealtime() - tsc0;
#endif
        __syncthreads();
        phase_dsa_b(F);
    } SEAM(4);
    STAMP(5); if (IN(5)) { for (int it = F.bid; it < 1024; it += F.G) ret_c_item(F, it); } SEAM(5);
    STAMP(6); if (IN(6)) {
        pg8::Gemm g{(const bf16*)(F.ws + WS_MIX), (const bf16*)(F.ws + WS_WO), NTOK, DM, DM}; pg8::StaticOrder S; S.init(NTOK, DM, F.G, F.bid);
        EpiX1T<true> E{F.in(0), (const float*)(F.ws + WS_MOD), F.out};
        pg8::gemm_phase<EpiX1T<true>, pg8::StaticOrder, true, true, true>(F.lds, g, S, E, F.wave);
    } SEAM(6);
    STAMP(7); if (IN(7)) { phase_router(F); } SEAM(7);
    STAMP(8); if (IN(8)) { phase_place(F); } SEAM(8);
    STAMP(9); if (IN(9)) {
        LAS int* tile_e = (LAS int*)(F.lds + TILEE_OFF); const int nt = moe_layout(F, (LAS int*)(F.lds + TILEE_OFF + 4096), tile_e);
        pg8::Gemm g{(const bf16*)(F.ws + WS_XS), (const bf16*)(F.ws + WS_WGU), MOE_ROWS, 2048, DM};
        GroupedOrder S{tile_e, nt, 8, F.G, F.bid, (size_t)2048 * 1024};
        EpiGlu8 E{(unsigned char*)(F.ws + WS_HB), F.in(12)};
        pg8::gemm_phase<EpiGlu8, GroupedOrder, true, true, true>(F.lds, g, S, E, F.wave);
    } SEAM(9);
    STAMP(10); if (IN(10)) {
        LAS int* tile_e = (LAS int*)(F.lds + TILEE_OFF); const int nt = moe_layout(F, (LAS int*)(F.lds + TILEE_OFF + 4096), tile_e);
        pg8::Gemm g{(const bf16*)(F.ws + WS_HB), (const bf16*)(F.ws + WS_WDN), MOE_ROWS, DM, DM};
        GroupedOrder S{tile_e, nt, 4, F.G, F.bid, (size_t)1024 * 1024};
        EpiDownT<true> E{(bf16*)(F.ws + WS_Y), F.in(14), (const int*)(F.ws + WS_ROWINFO), (const float*)(F.ws + WS_ROWGATE)};
        pg8::gemm_phase<EpiDownT<true>, GroupedOrder, true, true, true>(F.lds, g, S, E, F.wave);
    } SEAM(10);
    STAMP(11); if (IN(11)) { phase_final(F); }
    STAMP(12);
#if defined(PROBE_SUB)
    if (F.bid == 0 && F.tid() == 0) { const unsigned long long te = __builtin_amdgcn_s_memrealtime(); while (__builtin_amdgcn_s_memrealtime() - te < F.tacc) __builtin_amdgcn_s_sleep(8); }
#elif defined(PROBE_PHASE)
    if (F.bid == 0 && F.tid() == 0) { const unsigned long long te = __builtin_amdgcn_s_memrealtime(), dur = tp1 - tp0; while (__builtin_amdgcn_s_memrealtime() - te < dur) __builtin_amdgcn_s_sleep(8); }
#endif
#undef IN
#undef SEAM
}

extern "C" void kernel_launch(void* const* d_in, const int* in_sizes, int n_in, void* d_out, int out_size, void* d_ws, size_t ws_size, hipStream_t stream) {
    static int grid = 0;
    if (grid == 0) {
        if (n_in != 16 || out_size != NTOK * DM || ws_size < WS_END) { fprintf(stderr, "kernel_launch: unexpected problem (n_in %d out %d ws %zu); nothing launched\n", n_in, out_size, ws_size); grid = -1; return; }
        int dev = 0, cus = 0;
        if (hipGetDevice(&dev) != hipSuccess || hipDeviceGetAttribute(&cus, hipDeviceAttributeMultiprocessorCount, dev) != hipSuccess) { grid = -1; return; }
        if (hipFuncSetAttribute((const void*)mk_fwd, hipFuncAttributeMaxDynamicSharedMemorySize, LDS_BYTES) != hipSuccess) { fprintf(stderr, "kernel_launch: hipFuncSetAttribute failed\n"); grid = -1; return; }
        int per_cu = 0;
        if (hipOccupancyMaxActiveBlocksPerMultiprocessor(&per_cu, (const void*)mk_fwd, NTHR, LDS_BYTES) != hipSuccess || per_cu < 1) fprintf(stderr, "kernel_launch: occupancy query reports %d workgroups per CU\n", per_cu);
        (void)hipGetLastError();
        grid = cus;
    }
    if (grid < 0) return;
    (void)hipMemsetAsync((char*)d_ws + WS_CTL, 0, CTL_ZERO_BYTES, stream);
    Args a{};
    for (int i = 0; i < 16; ++i) a.in[i] = (const float*)d_in[i];
    a.out = (float*)d_out; a.ws = (unsigned char*)d_ws;
#if MK_N_LAUNCHES == 1
    a.ph_lo = 0; a.ph_hi = N_PHASES;
    hipLaunchKernelGGL(mk_fwd, dim3(grid), dim3(NTHR), LDS_BYTES, stream, a);
#else
    for (int p = 0; p < N_PHASES; ++p) { a.ph_lo = p; a.ph_hi = p + 1; hipLaunchKernelGGL(mk_fwd, dim3(grid), dim3(NTHR), LDS_BYTES, stream, a); }
#endif
}
```

```cpp
#include <hip/hip_runtime.h>
#include <cstdio>
#include <cstdint>

#define LAS __attribute__((address_space(3)))
#define GAS __attribute__((address_space(1)))
typedef unsigned short bf16;
typedef short bf16x8 __attribute__((ext_vector_type(8)));
typedef short s16x4 __attribute__((ext_vector_type(4)));
typedef float f32x4 __attribute__((ext_vector_type(4)));
typedef float f32x16 __attribute__((ext_vector_type(16)));
typedef unsigned u32x4 __attribute__((ext_vector_type(4)));
typedef unsigned u32x2 __attribute__((ext_vector_type(2)));
typedef float f32x2_t __attribute__((ext_vector_type(2)));
typedef __bf16 bf16x2_t __attribute__((ext_vector_type(2)));

constexpr int DM = 1024, NBATCH = 4, SEQ = 8192, NTOK = NBATCH * SEQ;
constexpr int PJ = 3072;
constexpr int IN_COLS = 2888;
constexpr int C_RQ = 0, C_RK = 256, C_RV = 512, C_RG = 1024, C_AQ = 1536, C_AK = 2048, C_AV = 2176, C_IQ = 2304, C_IK = 2816, C_IW = 2880;
constexpr int NE = 32, TOPK = 4, MOE_ROWS = NTOK * TOPK + NE * 256;
constexpr int MOE_TILES = MOE_ROWS / 256;
constexpr float EPS = 1e-6f;
constexpr int NWAVES = 8, NTHR = 512;

constexpr size_t MiB = 1u << 20;
constexpr size_t WS_CTL = 0, CTL_ZERO_BYTES = 1 * MiB;
constexpr size_t WS_MOD = 1 * MiB;
constexpr size_t WS_TOPI = 2 * MiB;
constexpr size_t WS_TOPG = 2 * MiB + 512 * 1024;
constexpr size_t WS_BBASE = 3 * MiB;
constexpr size_t WS_ROWINFO = 4 * MiB;
constexpr size_t WS_ROWGATE = 5 * MiB;
constexpr size_t WS_WIN = 8 * MiB;
constexpr size_t WS_WO = 14 * MiB;
constexpr size_t WS_WGU = 16 * MiB;
constexpr size_t WS_WDN = 144 * MiB;
constexpr size_t WS_H0 = 208 * MiB;
constexpr size_t WS_PROJ = 272 * MiB;
constexpr size_t WS_XS = 208 * MiB;
constexpr size_t WS_Y = 208 * MiB;
constexpr size_t WS_KVT = 480 * MiB;
constexpr size_t WS_RPT = 512 * MiB;
constexpr size_t WS_SEL = 528 * MiB;
constexpr size_t WS_MIX = 544 * MiB;
constexpr size_t WS_H2 = 608 * MiB;
constexpr size_t WS_HB = 480 * MiB;
constexpr size_t WS_END = 752 * MiB;
constexpr int CW_GCNT = 1024;
constexpr int CW_Q1 = 2048;
constexpr int CW_Q3 = 2112;
constexpr int CW_SCAN = 2176;
constexpr int CW_BAR = 4096;

constexpr int LDS_BYTES = 153600;
constexpr int RING_BYTES = 131072;
constexpr int TILEE_OFF = 131072;
constexpr int MISC_OFF = 152576;
constexpr int PTR_OFF = MISC_OFF + 512;

__device__ __forceinline__ int hw_lane() { int l; asm volatile("v_mbcnt_lo_u32_b32 %0, -1, 0\n\tv_mbcnt_hi_u32_b32 %0, -1, %0" : "=v"(l)); return l; }
__device__ __forceinline__ unsigned cvtpk(float lo, float hi) { f32x2_t v = {lo, hi}; bf16x2_t b = __builtin_convertvector(v, bf16x2_t); return __builtin_bit_cast(unsigned, b); }
__device__ __forceinline__ float bflo(unsigned w) { return __builtin_bit_cast(float, w << 16); }
__device__ __forceinline__ float bfhi(unsigned w) { return __builtin_bit_cast(float, w & 0xffff0000u); }
__device__ __forceinline__ float bf2f(bf16 h) { return __builtin_bit_cast(float, (unsigned)h << 16); }
__device__ __forceinline__ bf16 f2bf(float f) { return (bf16)(cvtpk(f, 0.f) & 0xffffu); }
__device__ __forceinline__ float wave_sum(float v) {
#pragma unroll
    for (int o = 1; o < 64; o <<= 1) v += __shfl_xor(v, o);
    return v;
}
__device__ __forceinline__ int mbcnt64(unsigned long long m) { return (int)__builtin_amdgcn_mbcnt_hi((unsigned)(m >> 32), __builtin_amdgcn_mbcnt_lo((unsigned)m, 0u)); }
__device__ __forceinline__ s16x4 trread(const LAS void* p) { typedef short v4i16_t __attribute__((ext_vector_type(4))); return __builtin_bit_cast(s16x4, __builtin_amdgcn_ds_read_tr16_b64_v4i16((LAS v4i16_t*)p)); }
__device__ __forceinline__ bf16x8 cat8(s16x4 lo, s16x4 hi) { return (bf16x8){lo[0], lo[1], lo[2], lo[3], hi[0], hi[1], hi[2], hi[3]}; }
#define MFMA16(a, b, c) __builtin_amdgcn_mfma_f32_16x16x32_bf16((a), (b), (c), 0, 0, 0)
#define MFMA32(a, b, c) __builtin_amdgcn_mfma_f32_32x32x16_bf16((a), (b), (c), 0, 0, 0)

namespace pg8 {
#define PG8_LAS __attribute__((address_space(3)))
typedef unsigned short bf16_t;
typedef short bf16x8 __attribute__((ext_vector_type(8)));
typedef float f32x4 __attribute__((ext_vector_type(4)));
typedef unsigned u32x4 __attribute__((ext_vector_type(4)));
constexpr int BM = 256, BK = 64, HALF = 128, HTB = HALF * BK * 2  , STAGE_BYTES = 8 * HTB, NXCD = 8, WGM = 8;

__host__ __device__ __forceinline__ int lds_byte(int r, int c) { const int st = (r >> 4) * 2 + (c >> 5), rr = r & 15, cc = c & 31, ob = rr * 64 + cc * 2; return st * 1024 + (ob ^ (((ob >> 9) & 1) << 5)); }
__host__ __device__ __forceinline__ void stage_rc(int b, int& R, int& C) { const int st = b / 1024, sb = b % 1024, swz = sb ^ (((sb >> 9) & 1) << 5); R = (st >> 1) * 16 + swz / 64; C = (st & 1) * 32 + (swz % 64) / 2; }
__host__ __device__ __forceinline__ int perm32(int rho) { const int n = rho >> 4, i = rho & 15; return 8 * (i >> 2) + 4 * n + (i & 3); }

typedef int v8i32 __attribute__((ext_vector_type(8))); typedef int v4i32 __attribute__((ext_vector_type(4)));
__device__ __forceinline__ v8i32 pg8_cat(bf16x8 a, bf16x8 b) { return __builtin_shufflevector(__builtin_bit_cast(v4i32, a), __builtin_bit_cast(v4i32, b), 0, 1, 2, 3, 4, 5, 6, 7); }
struct Unit { int pm, pn, e; size_t bo; };
struct Gemm { const bf16_t* A; const bf16_t* Bt; int M, N, K; };

struct StaticOrder {
    int nM, nN, nwg, G, c;
    __host__ __device__ void init(int M, int N, int G_, int c_) { nM = M / BM; nN = N / BM; nwg = nM * nN; G = G_; c = c_; }
    __host__ __device__ bool next(int i, Unit& u) const {
        const long L = (long)i * G + c; if (L >= nwg) return false;
        int wgid = (int)L; { const int q = nwg / NXCD, r = nwg % NXCD, xcd = wgid % NXCD, off = wgid / NXCD; wgid = (xcd < r ? xcd * (q + 1) : r * (q + 1) + (xcd - r) * q) + off; }
        const int nig = WGM * nN, gid = wgid / nig, fm = gid * WGM, gsz = (nM - fm) < WGM ? (nM - fm) : WGM;
        u.pm = fm + ((wgid % nig) % gsz); u.pn = (wgid % nig) / gsz; u.e = 0; u.bo = 0; return true;
    }
    __device__ __forceinline__ void a_ready(const Unit&) const {}
    __device__ __forceinline__ void done(const Unit&) const {}
};

template <class Epi, class Sched, bool ALIGN_EPI = false, bool SP2 = false, bool F8 = false>
__device__ __forceinline__ void gemm_phase(PG8_LAS unsigned char* lds, const Gemm g, const Sched& S, const Epi& E, const int wid) {
    const int lane = hw_lane(), tid = wid * 64 + lane, wr = wid >> 2, wc = wid & 3, fr = lane & 15, fq = lane >> 4;
    constexpr int ESZ = F8 ? 1 : 2;
    const int K = g.K, nt = K * ESZ / (BK * 2);
    unsigned voffA[2], voffB[2];
#pragma unroll
    for (int i = 0; i < 2; ++i) { int R, C; stage_rc(tid * 16 + i * 8192, R, C); const int Rb = Epi::PERM ? ((R & ~31) + perm32(R & 31)) : R;
        voffA[i] = (unsigned)(R * K * ESZ + C * 2); voffB[i] = (unsigned)(Rb * K * ESZ + C * 2); }
    const size_t kstep = (size_t)(BK * 2);
    const size_t hstep = (size_t)HALF * K * ESZ;
    const size_t tstep = 2 * hstep;
    const unsigned ldsw = (unsigned)wid * 1024u;
    const int aoff = lds_byte(wr * 64 + fr, fq * 8), boff = lds_byte(wc * 32 + fr, fq * 8);
#define PG8_SA(b, h) (((b) * 2 + (h)) * HTB)
#define PG8_SB(b, h) ((4 + (b) * 2 + (h)) * HTB)
#define PG8_STAGE(bufoff, gbase, voff) do { _Pragma("unroll") for (int _i = 0; _i < 2; ++_i) { \
        if constexpr (F8) { unsigned _keep; const unsigned _l = (unsigned)(__UINTPTR_TYPE__)(lds + (bufoff) + ldsw + _i * 8192);   \
            asm volatile("s_mov_b32 %0, m0\n\ts_mov_b32 m0, %3\n\ts_nop 0\n\tglobal_load_lds_dwordx4 %1, %2\n\ts_mov_b32 m0, %0" : "=&s"(_keep) : "v"((voff)[_i]), "s"((const char*)(gbase)), "s"(_l) : "memory"); } \
        else __builtin_amdgcn_global_load_lds((const unsigned*)((const char*)(gbase) + (voff)[_i]), (PG8_LAS unsigned*)(lds + (bufoff) + ldsw + _i * 8192), 16, 0, 0); } } while (0)
#define PG8_LDA(dst, b, h) do { _Pragma("unroll") for (int m = 0; m < 4; ++m) _Pragma("unroll") for (int k = 0; k < 2; ++k) dst[m][k] = *(const PG8_LAS bf16x8*)(lds + PG8_SA(b, h) + aoff + m * 2048 + k * 1024); } while (0)
#define PG8_LDB(dst, b, h) do { _Pragma("unroll") for (int n = 0; n < 2; ++n) _Pragma("unroll") for (int k = 0; k < 2; ++k) dst[n][k] = *(const PG8_LAS bf16x8*)(lds + PG8_SB(b, h) + boff + n * 2048 + k * 1024); } while (0)
#define PG8_MMA(ai, bj, At, Bt) do { __builtin_amdgcn_s_setprio(1); _Pragma("unroll") for (int m = 0; m < 4; ++m) _Pragma("unroll") for (int n = 0; n < 2; ++n) { \
        if constexpr (F8) { acc[ai][bj][m][n] = __builtin_amdgcn_mfma_scale_f32_16x16x128_f8f6f4(pg8_cat(Bt[n][0], Bt[n][1]), pg8_cat(At[m][0], At[m][1]), acc[ai][bj][m][n], 0, 0, 0, 0, 0, 0); } \
        else { _Pragma("unroll") for (int k = 0; k < 2; ++k) acc[ai][bj][m][n] = __builtin_amdgcn_mfma_f32_16x16x32_bf16(Bt[n][k], At[m][k], acc[ai][bj][m][n], 0, 0, 0); } } __builtin_amdgcn_s_setprio(0); } while (0)
#define PG8_WAIT_V(n) asm volatile("s_waitcnt vmcnt(" #n ")" ::: "memory")
#define PG8_WAIT_L(n) asm volatile("s_waitcnt lgkmcnt(" #n ")" ::: "memory")
#define PG8_BAR __builtin_amdgcn_s_barrier()
#define PG8_SCHED __builtin_amdgcn_sched_barrier(0)
    Unit cur, nxt; int ui = 0;
    if (!S.next(0, cur)) return;
    f32x4 acc[2][2][4][2];
#pragma unroll
    for (int a = 0; a < 2; ++a)
#pragma unroll
        for (int b = 0; b < 2; ++b)
#pragma unroll
            for (int m = 0; m < 4; ++m)
#pragma unroll
                for (int n = 0; n < 2; ++n) acc[a][b][m][n] = (f32x4){0.f, 0.f, 0.f, 0.f};
    bf16x8 At[4][2], B0[2][2], B1[2][2];
    const char* cA = (const char*)g.A + (size_t)cur.pm * tstep; const char* cB = (const char*)g.Bt + (size_t)cur.pn * tstep + cur.bo;
    S.a_ready(cur);
    if constexpr (SP2) {
        PG8_STAGE(PG8_SB(0, 0), cB, voffB); PG8_STAGE(PG8_SB(0, 1), cB + hstep, voffB); PG8_STAGE(PG8_SA(0, 0), cA, voffA); PG8_STAGE(PG8_SA(0, 1), cA + hstep, voffA);
        if (wr == 1) PG8_BAR;
        PG8_WAIT_V(2); PG8_BAR;
        PG8_STAGE(PG8_SB(1, 0), cB + kstep, voffB); PG8_STAGE(PG8_SA(1, 0), cA + kstep, voffA); PG8_STAGE(PG8_SB(1, 1), cB + hstep + kstep, voffB);
        PG8_WAIT_V(6); PG8_BAR;
    } else {
        PG8_STAGE(PG8_SB(0, 0), cB, voffB); PG8_STAGE(PG8_SA(0, 0), cA, voffA); PG8_STAGE(PG8_SB(0, 1), cB + hstep, voffB); PG8_STAGE(PG8_SA(0, 1), cA + hstep, voffA);
        if (wr == 1) PG8_BAR;
        PG8_WAIT_V(4); PG8_BAR;
        PG8_STAGE(PG8_SB(1, 0), cB + kstep, voffB); PG8_STAGE(PG8_SA(1, 0), cA + kstep, voffA); PG8_STAGE(PG8_SB(1, 1), cB + hstep + kstep, voffB);
        PG8_WAIT_V(6); PG8_BAR;
    }
    for (;;) {
        const bool has_next = S.next(ui + 1, nxt);
        const char* nA = has_next ? (const char*)g.A + (size_t)nxt.pm * tstep : cA; const char* nB = has_next ? (const char*)g.Bt + (size_t)nxt.pn * tstep + nxt.bo : cB;
        for (int t = 0; t < nt; t += 2) {
            const bool last = (t == nt - 2);
            const char* a1 = cA + (size_t)(t + 1) * kstep;
            const char* a2 = last ? nA : cA + (size_t)(t + 2) * kstep; const char* b2 = last ? nB : cB + (size_t)(t + 2) * kstep;
            const char* a3 = a2 + kstep; const char* b3 = b2 + kstep;
            if (last && has_next) S.a_ready(nxt);
            if constexpr (SP2) {
            PG8_LDB(B0, 0, 0); PG8_LDB(B1, 0, 1); PG8_SCHED; PG8_LDA(At, 0, 0); PG8_STAGE(PG8_SA(1, 1), a1 + hstep, voffA);
            PG8_WAIT_V(8); PG8_WAIT_L(0); PG8_BAR; PG8_MMA(0, 0, At, B0); PG8_MMA(0, 1, At, B1); PG8_BAR; PG8_SCHED;
            PG8_LDA(At, 0, 1); PG8_STAGE(PG8_SB(0, 0), b2, voffB); PG8_STAGE(PG8_SB(0, 1), b2 + hstep, voffB); PG8_STAGE(PG8_SA(0, 0), a2, voffA);
            PG8_WAIT_V(8); PG8_WAIT_L(0); PG8_BAR; PG8_MMA(1, 0, At, B0); PG8_MMA(1, 1, At, B1); PG8_BAR; PG8_SCHED;
            PG8_LDB(B0, 1, 0); PG8_LDB(B1, 1, 1); PG8_SCHED; PG8_LDA(At, 1, 0); PG8_STAGE(PG8_SA(0, 1), a2 + hstep, voffA);
            PG8_WAIT_V(8); PG8_WAIT_L(0); PG8_BAR; PG8_MMA(0, 0, At, B0); PG8_MMA(0, 1, At, B1); PG8_BAR; PG8_SCHED;
            PG8_LDA(At, 1, 1); PG8_STAGE(PG8_SB(1, 0), b3, voffB); PG8_STAGE(PG8_SB(1, 1), b3 + hstep, voffB); PG8_STAGE(PG8_SA(1, 0), a3, voffA);
            PG8_WAIT_V(8); PG8_WAIT_L(0); PG8_BAR; PG8_MMA(1, 0, At, B0); PG8_MMA(1, 1, At, B1); PG8_BAR; PG8_SCHED;
            } else {
            PG8_LDB(B0, 0, 0); PG8_SCHED; PG8_LDA(At, 0, 0); PG8_STAGE(PG8_SA(1, 1), a1 + hstep, voffA);
            PG8_WAIT_L(8); PG8_BAR; PG8_WAIT_L(0); PG8_MMA(0, 0, At, B0); PG8_BAR; PG8_SCHED;
            PG8_LDB(B1, 0, 1); PG8_STAGE(PG8_SB(0, 0), b2, voffB);
            PG8_BAR; PG8_WAIT_L(0); PG8_MMA(0, 1, At, B1); PG8_BAR;
            PG8_LDA(At, 0, 1); PG8_STAGE(PG8_SA(0, 0), a2, voffA);
            PG8_BAR; PG8_WAIT_L(0); PG8_MMA(1, 0, At, B0); PG8_BAR; PG8_SCHED;
            PG8_STAGE(PG8_SB(0, 1), b2 + hstep, voffB);
            PG8_WAIT_V(6); PG8_BAR; PG8_MMA(1, 1, At, B1); PG8_BAR;
            PG8_LDB(B0, 1, 0); PG8_SCHED; PG8_LDA(At, 1, 0); PG8_STAGE(PG8_SA(0, 1), a2 + hstep, voffA);
            PG8_WAIT_L(8); PG8_BAR; PG8_WAIT_L(0); PG8_MMA(0, 0, At, B0); PG8_BAR; PG8_SCHED;
            PG8_LDB(B1, 1, 1); PG8_STAGE(PG8_SB(1, 0), b3, voffB);
            PG8_BAR; PG8_WAIT_L(0); PG8_MMA(0, 1, At, B1); PG8_BAR;
            PG8_LDA(At, 1, 1); PG8_STAGE(PG8_SA(1, 0), a3, voffA);
            PG8_BAR; PG8_WAIT_L(0); PG8_MMA(1, 0, At, B0); PG8_BAR; PG8_SCHED;
            PG8_STAGE(PG8_SB(1, 1), b3 + hstep, voffB);
            PG8_WAIT_V(6); PG8_BAR; PG8_MMA(1, 1, At, B1); PG8_BAR;
            }
        }
        if constexpr (ALIGN_EPI) { if (wr == 0) PG8_BAR; }
        if constexpr (!Epi::AFTER_DRAIN) { E(acc, cur, wr, wc, fr, fq); S.done(cur); }
        if (!has_next) break;
#pragma unroll
        for (int a = 0; a < 2; ++a)
#pragma unroll
            for (int b = 0; b < 2; ++b)
#pragma unroll
                for (int m = 0; m < 4; ++m)
#pragma unroll
                    for (int n = 0; n < 2; ++n) acc[a][b][m][n] = (f32x4){0.f, 0.f, 0.f, 0.f};
        cur = nxt; cA = nA; cB = nB; ++ui;
        if constexpr (ALIGN_EPI) { if (wr == 1) PG8_BAR; }
    }
    PG8_WAIT_V(0);
    if constexpr (!ALIGN_EPI) { if (wr == 0) PG8_BAR; }
    PG8_BAR;
    if constexpr (Epi::AFTER_DRAIN) { E.fused(acc, cur, wr, wc, fr, fq, lds, wid, lane); S.done(cur); }
#undef PG8_SA
#undef PG8_SB
#undef PG8_STAGE
#undef PG8_LDA
#undef PG8_LDB
#undef PG8_MMA
#undef PG8_WAIT_V
#undef PG8_WAIT_L
#undef PG8_BAR
#undef PG8_SCHED
}
}

struct EpiProj {
    static constexpr bool PERM = true, AFTER_DRAIN = false;
    bf16* O; int ldc;
    __device__ __forceinline__ void operator()(const f32x4 (&acc)[2][2][4][2], const pg8::Unit& u, int wr, int wc, int fr, int fq) const {
        const int row0 = u.pm * 256 + wr * 64 + fr; const int col0 = u.pn * 256 + wc * 32 + 8 * fq;
#pragma unroll
        for (int ai = 0; ai < 2; ++ai)
#pragma unroll
            for (int m = 0; m < 4; ++m) { bf16* rowp = O + (size_t)(row0 + ai * 128 + m * 16) * ldc + col0;
#pragma unroll
                for (int bj = 0; bj < 2; ++bj) { const f32x4 v0 = acc[ai][bj][m][0], v1 = acc[ai][bj][m][1];
                    u32x4 w; w.x = cvtpk(v0[0], v0[1]); w.y = cvtpk(v0[2], v0[3]); w.z = cvtpk(v1[0], v1[1]); w.w = cvtpk(v1[2], v1[3]);
                    *(u32x4*)(rowp + bj * 128) = w; } }
    }
};
constexpr float W8_SCALE = 64.0f, W8_INV = 1.0f / 64.0f;
template <bool F8> struct EpiX1T {
    static constexpr bool PERM = false, AFTER_DRAIN = false;
    const float* x; const float* mod; float* out;
    __device__ __forceinline__ void operator()(const f32x4 (&acc)[2][2][4][2], const pg8::Unit& u, int wr, int wc, int fr, int fq) const {
        const int col0 = u.pn * 256 + wc * 32 + 4 * fq; const int b = (u.pm * 256) / SEQ;
        f32x4 g[2][2];
#pragma unroll
        for (int bj = 0; bj < 2; ++bj)
#pragma unroll
            for (int n = 0; n < 2; ++n) g[bj][n] = *(const f32x4*)(mod + (size_t)b * 6144 + 2 * 1024 + col0 + bj * 128 + n * 16);
#pragma unroll
        for (int ai = 0; ai < 2; ++ai)
#pragma unroll
            for (int m = 0; m < 4; ++m) { const size_t off = (size_t)(u.pm * 256 + ai * 128 + wr * 64 + m * 16 + fr) * DM + col0;
#pragma unroll
                for (int bj = 0; bj < 2; ++bj)
#pragma unroll
                    for (int n = 0; n < 2; ++n) { const f32x4 xv = *(const f32x4*)(x + off + bj * 128 + n * 16); *(f32x4*)(out + off + bj * 128 + n * 16) = xv + g[bj][n] * (acc[ai][bj][m][n] * (F8 ? W8_INV : 1.0f)); }
                if (m & 1) asm volatile("" ::: "memory"); }
    }
};
__device__ __forceinline__ float glu_f(float gate, float up) {
    gate = fminf(gate, 7.0f); up = fminf(fmaxf(up, -7.0f), 7.0f);
    const float sg = __builtin_amdgcn_rcpf(1.0f + __expf(-1.702f * gate));
    return (up + 1.0f) * (gate * sg);
}
__device__ __forceinline__ unsigned pk4_fp8(float a, float b, float c, float d) { int w = __builtin_amdgcn_cvt_pk_fp8_f32(a, b, 0, false); w = __builtin_amdgcn_cvt_pk_fp8_f32(c, d, w, true); return (unsigned)w; }
struct EpiGlu8 {
    static constexpr bool PERM = true, AFTER_DRAIN = false;
    unsigned char* H; const float* b_gu;
    __device__ __forceinline__ void operator()(const f32x4 (&acc)[2][2][4][2], const pg8::Unit& u, int wr, int wc, int fr, int fq) const {
        const int row0 = u.pm * 256 + wr * 64 + fr; const int c0 = u.pn * 128 + wc * 32 + 8 * fq;
        const float* bg = b_gu + (size_t)u.e * 2048 + c0; const float* bu = bg + 1024;
        const f32x4 bg0 = *(const f32x4*)bg, bg1 = *(const f32x4*)(bg + 4), bu0 = *(const f32x4*)bu, bu1 = *(const f32x4*)(bu + 4);
#pragma unroll
        for (int ai = 0; ai < 2; ++ai)
#pragma unroll
            for (int m = 0; m < 4; ++m) {
                const f32x4 g0 = acc[ai][0][m][0] * W8_INV + bg0, g1 = acc[ai][0][m][1] * W8_INV + bg1, u0 = acc[ai][1][m][0] * W8_INV + bu0, u1 = acc[ai][1][m][1] * W8_INV + bu1;
                u32x2 w; w.x = pk4_fp8(glu_f(g0[0], u0[0]), glu_f(g0[1], u0[1]), glu_f(g0[2], u0[2]), glu_f(g0[3], u0[3]));
                w.y = pk4_fp8(glu_f(g1[0], u1[0]), glu_f(g1[1], u1[1]), glu_f(g1[2], u1[2]), glu_f(g1[3], u1[3]));
                *(u32x2*)(H + (size_t)(row0 + ai * 128 + m * 16) * DM + c0) = w; }
    }
};
struct EpiGlu {
    static constexpr bool PERM = true, AFTER_DRAIN = false;
    bf16* H; const float* b_gu;
    __device__ __forceinline__ void operator()(const f32x4 (&acc)[2][2][4][2], const pg8::Unit& u, int wr, int wc, int fr, int fq) const {
        const int row0 = u.pm * 256 + wr * 64 + fr; const int c0 = u.pn * 128 + wc * 32 + 8 * fq;
        const float* bg = b_gu + (size_t)u.e * 2048 + c0; const float* bu = bg + 1024;
        const f32x4 bg0 = *(const f32x4*)bg, bg1 = *(const f32x4*)(bg + 4), bu0 = *(const f32x4*)bu, bu1 = *(const f32x4*)(bu + 4);
#pragma unroll
        for (int ai = 0; ai < 2; ++ai)
#pragma unroll
            for (int m = 0; m < 4; ++m) {
                const f32x4 g0 = acc[ai][0][m][0] + bg0, g1 = acc[ai][0][m][1] + bg1, u0 = acc[ai][1][m][0] + bu0, u1 = acc[ai][1][m][1] + bu1;
                u32x4 w; w.x = cvtpk(glu_f(g0[0], u0[0]), glu_f(g0[1], u0[1])); w.y = cvtpk(glu_f(g0[2], u0[2]), glu_f(g0[3], u0[3]));
                w.z = cvtpk(glu_f(g1[0], u1[0]), glu_f(g1[1], u1[1])); w.w = cvtpk(glu_f(g1[2], u1[2]), glu_f(g1[3], u1[3]));
                *(u32x4*)(H + (size_t)(row0 + ai * 128 + m * 16) * DM + c0) = w; }
    }
};
template <bool F8> struct EpiDownT {
    static constexpr bool PERM = true, AFTER_DRAIN = false;
    bf16* Y; const float* b_down; const int* rowinfo; const float* rowgate;
    __device__ __forceinline__ void operator()(const f32x4 (&acc)[2][2][4][2], const pg8::Unit& u, int wr, int wc, int fr, int fq) const {
        const int row0 = u.pm * 256 + wr * 64 + fr; const int col0 = u.pn * 256 + wc * 32 + 8 * fq;
        const float* bd = b_down + (size_t)u.e * 1024 + col0;
        f32x4 bv[2][2];
#pragma unroll
        for (int bj = 0; bj < 2; ++bj)
#pragma unroll
            for (int n = 0; n < 2; ++n) bv[bj][n] = *(const f32x4*)(bd + bj * 128 + 4 * n);
#pragma unroll
        for (int ai = 0; ai < 2; ++ai) {
            int dsts[4]; float gts[4];
#pragma unroll
            for (int m = 0; m < 4; ++m) { dsts[m] = rowinfo[row0 + ai * 128 + m * 16]; gts[m] = rowgate[row0 + ai * 128 + m * 16]; }
#pragma unroll
            for (int m = 0; m < 4; ++m) { const int dst = dsts[m]; const float gt = gts[m];
                if (dst >= 0) {
#pragma unroll
                    for (int bj = 0; bj < 2; ++bj) { const float sa = F8 ? W8_INV : 1.0f; const f32x4 v0 = (acc[ai][bj][m][0] * sa + bv[bj][0]) * gt, v1 = (acc[ai][bj][m][1] * sa + bv[bj][1]) * gt;
                        if constexpr (F8) {
                            u32x2 w; w.x = pk4_fp8(v0[0], v0[1], v0[2], v0[3]); w.y = pk4_fp8(v1[0], v1[1], v1[2], v1[3]);
                            *(u32x2*)((unsigned char*)Y + (size_t)dst * DM + col0 + bj * 128) = w;
                        } else {
                            u32x4 w; w.x = cvtpk(v0[0], v0[1]); w.y = cvtpk(v0[2], v0[3]); w.z = cvtpk(v1[0], v1[1]); w.w = cvtpk(v1[2], v1[3]);
                            *(u32x4*)(Y + (size_t)dst * DM + col0 + bj * 128) = w; } } } } }
    }
};
struct GroupedOrder {
    const LAS int* tile_e; int ntiles, nN, G, c; size_t estride;
    __device__ __forceinline__ bool next(int i, pg8::Unit& u) const {
        int pm, pn;
        if (G == 256) { const int x = c & 7, j = c >> 3, rpx = 32 / nN; pn = j % nN; pm = i * (8 * rpx) + x * rpx + j / nN; }
        else { const long L = (long)i * G + c; pm = (int)(L / nN); pn = (int)(L % nN); }
        if (pm >= ntiles) return false;
        u.pm = pm; u.pn = pn; u.e = __builtin_amdgcn_readfirstlane(tile_e[pm]); u.bo = (size_t)u.e * estride; return true;
    }
    __device__ __forceinline__ void a_ready(const pg8::Unit&) const {}
    __device__ __forceinline__ void done(const pg8::Unit&) const {}
};

#define XB_TMO      128
#define XB_XCNT(j)  (256  + 64 * (j))
#define XB_XSUB(j)  (1280 + 64 * (j))
#define XB_XGEN(j)  (2304 + 64 * (j))
#define XB_TOP      3328
#define XB_TOPGEN   3392
#define XCD_BAR_WORDS 3456
#define XB_SPIN_CAP (1u << 18)

__device__ __forceinline__ unsigned xb_ld(unsigned* p)              { return __hip_atomic_load(p, __ATOMIC_RELAXED, __HIP_MEMORY_SCOPE_AGENT); }
__device__ __forceinline__ unsigned xb_add(unsigned* p, unsigned v) { return __hip_atomic_fetch_add(p, v, __ATOMIC_RELAXED, __HIP_MEMORY_SCOPE_AGENT); }
__device__ __forceinline__ unsigned xb_xcc_id() { return (unsigned)__builtin_amdgcn_s_getreg((3 << 11) | 20) & 0xFu; }
#define XB_SPIN(cond, bar) do { unsigned _sp = 0; while (cond) { __builtin_amdgcn_s_sleep(1); \
    if ((++_sp & 255u) == 0u) { if (xb_ld(&(bar)[XB_TMO])) break; if (_sp > XB_SPIN_CAP) { atomicAdd(&(bar)[XB_TMO], 1u); break; } } } } while (0)

struct XcdBarrier {
    unsigned* bar; unsigned x; bool w0;
    volatile LAS unsigned* st;
};

__device__ __forceinline__ XcdBarrier xcd_barrier_post(unsigned* bar, volatile LAS unsigned* st, bool w0) {
    XcdBarrier b; b.bar = bar; b.x = xb_xcc_id(); b.st = st; b.w0 = w0;
    if (w0 && hw_lane() == 0) (void)xb_add(&bar[XB_XCNT(b.x)], 1u);
    return b;
}
__device__ __forceinline__ void xcd_barrier_complete(unsigned* bar, unsigned x, unsigned& nloc, unsigned& nx) {
    const unsigned G = gridDim.x * gridDim.y * gridDim.z;
    unsigned sum, cnt, mine, sp = 0u;
    for (;;) {
        sum = 0u; cnt = 0u; mine = 0u;
#pragma unroll
        for (unsigned j = 0; j < 16; ++j) { const unsigned c = xb_ld(&bar[XB_XCNT(j)]); sum += c; cnt += (c > 0u) ? 1u : 0u; mine = (j == x) ? c : mine; }
        if (sum == G) break;
        __builtin_amdgcn_s_sleep(1);
        if ((++sp & 255u) == 0u) { if (xb_ld(&bar[XB_TMO])) break; if (sp > XB_SPIN_CAP) { atomicAdd(&bar[XB_TMO], 1u); break; } }
    }
    nloc = mine > 0u ? mine : 1u; nx = cnt > 0u ? cnt : 1u;
}

__device__ __forceinline__ void xcd_barrier(const XcdBarrier& b) {
    asm volatile("s_waitcnt vmcnt(0)" ::: "memory");
    __syncthreads();
    if (b.w0 && hw_lane() == 0) {
        unsigned* bar = b.bar;
        __builtin_amdgcn_s_waitcnt(0);
        unsigned nloc = b.st[0], nx = b.st[1];
        if (nloc == 0u) { xcd_barrier_complete(bar, b.x, nloc, nx); b.st[0] = nloc; b.st[1] = nx; }
        const unsigned old = xb_add(&bar[XB_XSUB(b.x)], 1u);
        const unsigned gen = old / nloc;
        if (old + 1u == (gen + 1u) * nloc) {
            __builtin_amdgcn_fence(__ATOMIC_RELEASE, "agent");
            asm volatile("s_waitcnt vmcnt(0)" ::: "memory");
            const unsigned og = xb_add(&bar[XB_TOP], 1u);
            const unsigned tg = og / nx;
            if (og + 1u == (tg + 1u) * nx) xb_add(&bar[XB_TOPGEN], 1u);
            else XB_SPIN(xb_ld(&bar[XB_TOPGEN]) == tg, bar);
            __builtin_amdgcn_fence(__ATOMIC_ACQUIRE, "agent");
            xb_add(&bar[XB_XGEN(b.x)], 1u);
            asm volatile("s_waitcnt vmcnt(0)" ::: "memory");
        } else {
            XB_SPIN(xb_ld(&bar[XB_XGEN(b.x)]) == gen, bar);
            __builtin_amdgcn_fence(__ATOMIC_ACQUIRE, "agent");
            asm volatile("s_waitcnt vmcnt(0)" ::: "memory");
        }
    }
    __syncthreads();
}

struct Frame {
    LAS unsigned char* lds;
    volatile LAS unsigned* MISC;
    unsigned* ctl;
    int wave, G, bid;
    __device__ __forceinline__ int lane() const { return hw_lane(); }
    __device__ __forceinline__ int tid() const { return wave * 64 + hw_lane(); }
    __device__ __forceinline__ const float* in(int i) const { const LAS unsigned* p = (const LAS unsigned*)(lds + PTR_OFF) + 2 * i;
        const unsigned lo = __builtin_amdgcn_readfirstlane(p[0]), hi = __builtin_amdgcn_readfirstlane(p[1]); return (const float*)(((unsigned long long)hi << 32) | lo); }
    float* out; unsigned char* ws;
    unsigned long long tacc; int xpass;
};
__device__ __forceinline__ float log2gamma(int h) { return log2f(1.0f - exp2f(-5.0f - (float)h)); }

template <bool F8, class RowMap>
__device__ __forceinline__ void transpose_item(const float* W, int N, bf16* WT, int K, const float* kscale, LAS float* scr, int kb, int nb, int lane, RowMap rm) {
    const int k0 = 64 * kb, n0 = 64 * nb;
#pragma unroll 4
    for (int i = 0; i < 16; ++i) {
        const int kk = 4 * i + (lane >> 4), nn = 4 * (lane & 15);
        f32x4 v = (f32x4){0.f, 0.f, 0.f, 0.f};
        if (n0 + nn < N) v = *(const f32x4*)(W + (size_t)(k0 + kk) * N + n0 + nn);
        if (kscale) v = v * kscale[k0 + kk];
        LAS float* s = scr + kk * 65 + nn; s[0] = v[0]; s[1] = v[1]; s[2] = v[2]; s[3] = v[3];
    }
    asm volatile("s_waitcnt lgkmcnt(0)" ::: "memory");
    const int cch = lane & 7;
#pragma unroll
    for (int j = 0; j < 8; ++j) {
        const int n = 8 * j + (lane >> 3); const LAS float* s = scr + (8 * cch) * 65 + n;
        if constexpr (F8) {
            u32x2 o; o.x = pk4_fp8(s[0 * 65] * W8_SCALE, s[1 * 65] * W8_SCALE, s[2 * 65] * W8_SCALE, s[3 * 65] * W8_SCALE); o.y = pk4_fp8(s[4 * 65] * W8_SCALE, s[5 * 65] * W8_SCALE, s[6 * 65] * W8_SCALE, s[7 * 65] * W8_SCALE);
            if (n0 + n < N) *(u32x2*)((unsigned char*)WT + (size_t)rm(n0 + n) * K + k0 + 8 * cch) = o;
        } else {
        const float cs = (N == IN_COLS && n0 + n >= C_AQ && n0 + n < C_AK) ? 0.125f : 1.0f;
        u32x4 o; o.x = cvtpk(s[0 * 65] * cs, s[1 * 65] * cs); o.y = cvtpk(s[2 * 65] * cs, s[3 * 65] * cs); o.z = cvtpk(s[4 * 65] * cs, s[5 * 65] * cs); o.w = cvtpk(s[6 * 65] * cs, s[7 * 65] * cs);
        if (n0 + n < N) *(u32x4*)(WT + (size_t)rm(n0 + n) * K + k0 + 8 * cch) = o; }
    }
    asm volatile("s_waitcnt lgkmcnt(0)" ::: "memory");
}
__device__ __forceinline__ void f8_item_load(const float* W, int N, int kb, int nb, int lane, f32x4 (&v)[16]) {
    const int k0 = 128 * kb, n0 = 32 * nb;
#pragma unroll
    for (int i = 0; i < 16; ++i) v[i] = *(const f32x4*)(W + (size_t)(k0 + 8 * i + (lane >> 3)) * N + n0 + 4 * (lane & 7));
}
template <class RowMap>
__device__ __forceinline__ void f8_item_store(const f32x4 (&v)[16], unsigned char* WT, int K, LAS float* scr, int kb, int nb, int lane, RowMap rm) {
    const int k0 = 128 * kb, n0 = 32 * nb;
#pragma unroll
    for (int i = 0; i < 16; ++i) { const int kk = 8 * i + (lane >> 3), nn = 4 * (lane & 7); LAS float* s = scr + kk * 32;
        s[(nn + 0) ^ (kk & 31)] = v[i][0]; s[(nn + 1) ^ (kk & 31)] = v[i][1]; s[(nn + 2) ^ (kk & 31)] = v[i][2]; s[(nn + 3) ^ (kk & 31)] = v[i][3]; }
    asm volatile("s_waitcnt lgkmcnt(0)" ::: "memory");
    const int cch = lane & 7;
#pragma unroll
    for (int j = 0; j < 4; ++j) {
        const int n = 8 * j + (lane >> 3); float t[16];
#pragma unroll
        for (int i = 0; i < 16; ++i) { const int kk = 16 * cch + i; t[i] = scr[kk * 32 + (n ^ (kk & 31))] * W8_SCALE; }
        u32x4 o; o.x = pk4_fp8(t[0], t[1], t[2], t[3]); o.y = pk4_fp8(t[4], t[5], t[6], t[7]); o.z = pk4_fp8(t[8], t[9], t[10], t[11]); o.w = pk4_fp8(t[12], t[13], t[14], t[15]);
        *(u32x4*)(WT + (size_t)rm(n0 + n) * K + k0 + 16 * cch) = o;
    }
    asm volatile("s_waitcnt lgkmcnt(0)" ::: "memory");
}
struct RmId { __device__ __forceinline__ int operator()(int n) const { return n; } };
struct RmGu { __device__ __forceinline__ int operator()(int n) const { const int j = n & 1023; return (j >> 7) * 256 + (n >> 10) * 128 + (j & 127); } };

template <class RowMap>
__device__ __forceinline__ void f8_item_lowreg(const float* W, int N, unsigned char* WT, int K, LAS float* scr, int kb, int nb, int lane, RowMap rm, const float* kscale = nullptr) {
    const int k0 = 128 * kb, n0 = 32 * nb;
#pragma unroll 1
    for (int h = 0; h < 2; ++h) {
        f32x4 v[8];
#pragma unroll
        for (int i = 0; i < 8; ++i) { v[i] = *(const f32x4*)(W + (size_t)(k0 + 64 * h + 8 * i + (lane >> 3)) * N + n0 + 4 * (lane & 7)); if (kscale) v[i] = v[i] * kscale[k0 + 64 * h + 8 * i + (lane >> 3)]; }
#pragma unroll
        for (int i = 0; i < 8; ++i) { const int kk = 64 * h + 8 * i + (lane >> 3), nn = 4 * (lane & 7); LAS float* s = scr + kk * 32;
            s[(nn + 0) ^ (kk & 31)] = v[i][0]; s[(nn + 1) ^ (kk & 31)] = v[i][1]; s[(nn + 2) ^ (kk & 31)] = v[i][2]; s[(nn + 3) ^ (kk & 31)] = v[i][3]; }
    }
    asm volatile("s_waitcnt lgkmcnt(0)" ::: "memory");
    const int cch = lane & 7;
#pragma unroll 1
    for (int j = 0; j < 4; ++j) {
        const int n = 8 * j + (lane >> 3); float t[16];
#pragma unroll
        for (int i = 0; i < 16; ++i) { const int kk = 16 * cch + i; t[i] = scr[kk * 32 + (n ^ (kk & 31))] * W8_SCALE; }
        u32x4 o; o.x = pk4_fp8(t[0], t[1], t[2], t[3]); o.y = pk4_fp8(t[4], t[5], t[6], t[7]); o.z = pk4_fp8(t[8], t[9], t[10], t[11]); o.w = pk4_fp8(t[12], t[13], t[14], t[15]);
        *(u32x4*)(WT + (size_t)rm(n0 + n) * K + k0 + 16 * cch) = o;
    }
    asm volatile("s_waitcnt lgkmcnt(0)" ::: "memory");
}
__device__ __forceinline__ void phase_p0a(Frame& F) {
    const float* const c_in = F.in(1); const float* const ada_w = F.in(2); const float* const ada_b = F.in(3); const float* const w_in = F.in(5); const float* const mix_scale = F.in(6);
    const float* const w_o = F.in(7); const float* const w_gu = F.in(11); const float* const w_down = F.in(13);
    if (F.bid < 96) {
        LAS float* sc = (LAS float*)F.lds;
        LAS float* part = (LAS float*)(F.lds + 16384);
        for (int i = F.tid(); i < 1024; i += NTHR) {
#pragma unroll
            for (int b = 0; b < 4; ++b) { const float cv = c_in[b * 1024 + i]; sc[i * 4 + b] = cv / (1.0f + __expf(-cv)); }
        }
        __syncthreads();
        const int j0 = F.bid * 64;
        float a0 = 0.f, a1 = 0.f, a2 = 0.f, a3 = 0.f;
#pragma unroll 8
        for (int ii = 0; ii < 128; ++ii) {
            const int i = F.wave * 128 + ii; const float w = ada_w[(size_t)i * 6144 + j0 + F.lane()];
            const f32x4 s4 = *(const LAS f32x4*)(sc + i * 4);
            a0 += s4[0] * w; a1 += s4[1] * w; a2 += s4[2] * w; a3 += s4[3] * w;
        }
        part[(F.wave * 4 + 0) * 64 + F.lane()] = a0; part[(F.wave * 4 + 1) * 64 + F.lane()] = a1; part[(F.wave * 4 + 2) * 64 + F.lane()] = a2; part[(F.wave * 4 + 3) * 64 + F.lane()] = a3;
        __syncthreads();
        if (F.tid() < 256) { const int b = F.tid() >> 6, l = F.tid() & 63; float s = ada_b[j0 + l];
#pragma unroll
            for (int w = 0; w < 8; ++w) s += part[(w * 4 + b) * 64 + l];
            ((float*)(F.ws + WS_MOD))[b * 6144 + j0 + l] = s; }
        __syncthreads();
    }
    { int* ri = (int*)(F.ws + WS_ROWINFO); for (int i = F.bid * NTHR + F.tid(); i < MOE_ROWS; i += F.G * NTHR) ri[i] = -1; }
    LAS float* scr = (LAS float*)(F.lds + F.wave * 16896);
    const int gw = F.bid * NWAVES + F.wave, NGW = F.G * NWAVES;
    constexpr int I_IN = 16 * 46, I_O = 16 * 16, I_GU = 32 * 16 * 32, I_DN = 32 * 16 * 16, NITEMS = I_IN + I_O + I_GU + I_DN;
    for (int it = (F.G >= 224 ? gw - 96 * NWAVES : gw); it >= 0 && it < I_IN + I_O; it += NGW) {
        int r = it;
        if (r < I_IN) { transpose_item<false>(w_in, IN_COLS, (bf16*)(F.ws + WS_WIN), 1024, nullptr, scr, r / 46, r % 46, F.lane(), RmId()); continue; } r -= I_IN;
        f8_item_lowreg(w_o, 1024, F.ws + WS_WO, 1024, scr, r / 32, r % 32, F.lane(), RmId(), mix_scale);
    }
}

constexpr int F8_I_GU = 32 * 8 * 64, F8_I_DN = 32 * 8 * 32, F8_ITEMS = F8_I_GU + F8_I_DN;
__device__ __forceinline__ int f8_burst(Frame& F, LAS float* scr, int it, int count) {
    const float* const w_gu = F.in(11); const float* const w_down = F.in(13);
    const int NGW = F.G * NWAVES, lane = F.lane();
    auto item_src = [&](int r, const float*& W, int& N, int& kb, int& nb) { if (r < F8_I_GU) { const int e = r / 512, q = r % 512; W = w_gu + (size_t)e * 1024 * 2048; N = 2048; kb = q / 64; nb = q % 64; }
                                                                             else { r -= F8_I_GU; const int e = r / 256, q = r % 256; W = w_down + (size_t)e * 1024 * 1024; N = 1024; kb = q / 32; nb = q % 32; } };
    asm volatile("" ::: "memory");
    for (int c = 0; c < count && it < F8_ITEMS; ++c) {
        const float* W; int N, kb, nb;
        item_src(it, W, N, kb, nb);
        if (it < F8_I_GU) f8_item_lowreg(W, N, F.ws + WS_WGU + (size_t)(it / 512) * 2048 * 1024, 1024, scr, kb, nb, lane, RmGu());
        else f8_item_lowreg(W, N, F.ws + WS_WDN + (size_t)((it - F8_I_GU) / 256) * 1024 * 1024, 1024, scr, kb, nb, lane, RmId());
        it += NGW;
        asm volatile("" ::: "memory");
    }
    asm volatile("" ::: "memory");
    return it;
}

__device__ __forceinline__ void phase_p0b(Frame& F) {
    const float* const x_in = F.in(0); const float* const norm1_g = F.in(4);
    const int gw = F.bid * NWAVES + F.wave, NGW = F.G * NWAVES, lane = F.lane();
    const float* mod = (const float*)(F.ws + WS_MOD); bf16* h0 = (bf16*)(F.ws + WS_H0);
    for (int m = gw; m < NTOK / 2; m += NGW) {
        f32x4 v[2][4]; float s[2] = {0.f, 0.f};
#pragma unroll
        for (int u = 0; u < 2; ++u) { const f32x4* xr = (const f32x4*)(x_in + (size_t)(m + u * (NTOK / 2)) * DM) + lane;
#pragma unroll
            for (int j = 0; j < 4; ++j) v[u][j] = xr[64 * j]; }
#pragma unroll
        for (int u = 0; u < 2; ++u)
#pragma unroll
            for (int j = 0; j < 4; ++j) s[u] += (v[u][j][0] * v[u][j][0] + v[u][j][1] * v[u][j][1]) + (v[u][j][2] * v[u][j][2] + v[u][j][3] * v[u][j][3]);
#pragma unroll
        for (int o = 1; o < 64; o <<= 1) { s[0] += __shfl_xor(s[0], o); s[1] += __shfl_xor(s[1], o); }
#pragma unroll
        for (int u = 0; u < 2; ++u) { const int mm = m + u * (NTOK / 2), b = mm / SEQ; const float rstd = rsqrtf(s[u] * (1.f / DM) + EPS);
            u32x2* o8 = (u32x2*)(h0 + (size_t)mm * DM) + lane;
#pragma unroll
            for (int j = 0; j < 4; ++j) { const int col = 4 * lane + 256 * j;
                const f32x4 g = *(const f32x4*)(norm1_g + col), sh = *(const f32x4*)(mod + b * 6144 + col), sc = *(const f32x4*)(mod + b * 6144 + 1024 + col);
                const f32x4 y = (v[u][j] * rstd) * g * (sc + 1.0f) + sh;
                u32x2 w; w.x = cvtpk(y[0], y[1]); w.y = cvtpk(y[2], y[3]); o8[64 * j] = w; } }
    }
}

constexpr int VSTR = 144, KSTR = 80;
__device__ __forceinline__ void ret_stage_v(Frame& F, const bf16* proj, int tok0, int h, LAS bf16* Vs) {
    const int row = F.tid() >> 2, q = F.tid() & 3; const bf16* src = proj + (size_t)(tok0 + row) * PJ + C_RV + h * 128 + q * 32;
#pragma unroll
    for (int i = 0; i < 4; ++i) *(LAS u32x4*)(Vs + row * VSTR + q * 32 + 8 * i) = *(const u32x4*)(src + 8 * i);
}
__device__ __forceinline__ void ret_stage64(Frame& F, const bf16* src0, size_t pitch, LAS bf16* Ds) {
    const int row = F.tid() >> 2, q = F.tid() & 3; const bf16* src = src0 + (size_t)row * pitch + q * 16;
#pragma unroll
    for (int i = 0; i < 2; ++i) *(LAS u32x4*)(Ds + row * KSTR + q * 16 + 8 * i) = *(const u32x4*)(src + 8 * i);
}
__device__ __forceinline__ void ret_a_item(Frame& F, int item) {
    const bf16* proj = (const bf16*)(F.ws + WS_PROJ); float* kvt = (float*)(F.ws + WS_KVT) + (size_t)item * 8192;
    const int bh = item >> 6, n = item & 63, b = bh >> 2, h = bh & 3, tok0 = b * SEQ + n * 128;
    LAS bf16* Vs = (LAS bf16*)F.lds; LAS bf16* Ks = (LAS bf16*)(F.lds + 128 * VSTR * 2);
    const float lg = log2gamma(h);
    ret_stage_v(F, proj, tok0, h, Vs);
    { const int row = F.tid() >> 2, q = F.tid() & 3; const bf16* src = proj + (size_t)(tok0 + row) * PJ + C_RK + h * 64 + q * 16; const float dk = 0.125f * exp2f((float)(127 - row) * lg);
#pragma unroll
      for (int i = 0; i < 2; ++i) { const u32x4 w = *(const u32x4*)(src + 8 * i); u32x4 o;
          o.x = cvtpk(bflo(w.x) * dk, bfhi(w.x) * dk); o.y = cvtpk(bflo(w.y) * dk, bfhi(w.y) * dk); o.z = cvtpk(bflo(w.z) * dk, bfhi(w.z) * dk); o.w = cvtpk(bflo(w.w) * dk, bfhi(w.w) * dk);
          *(LAS u32x4*)(Ks + row * KSTR + q * 16 + 8 * i) = o; } }
    __syncthreads();
    const int lane = F.lane(), n16 = lane & 15, c = lane >> 4, q4 = n16 >> 2, p4 = lane & 3, e0 = 16 * F.wave;
    f32x4 acc[4];
#pragma unroll
    for (int dt = 0; dt < 4; ++dt) acc[dt] = (f32x4){0.f, 0.f, 0.f, 0.f};
#pragma unroll
    for (int s = 0; s < 4; ++s) {
        const LAS bf16* ap = Vs + (32 * s + 4 * c + q4) * VSTR + e0 + 4 * p4;
        const bf16x8 A = cat8(trread(ap), trread(ap + 16 * VSTR));
#pragma unroll
        for (int dt = 0; dt < 4; ++dt) { const LAS bf16* bp = Ks + (32 * s + 4 * c + q4) * KSTR + 16 * dt + 4 * p4;
            const bf16x8 B = cat8(trread(bp), trread(bp + 16 * KSTR)); acc[dt] = MFMA16(A, B, acc[dt]); }
    }
#pragma unroll
    for (int dt = 0; dt < 4; ++dt)
#pragma unroll
        for (int r = 0; r < 4; ++r) kvt[(e0 + 4 * c + r) * 64 + 16 * dt + n16] = acc[dt][r];
    __syncthreads();
}
__device__ __forceinline__ void ret_scan(Frame& F) {
    const float* kvt = (const float*)(F.ws + WS_KVT); bf16* rpt = (bf16*)(F.ws + WS_RPT);
    for (int g = F.bid * NTHR + F.tid(); g < 16 * 8192; g += F.G * NTHR) {
        const int bh = g >> 13, ed = g & 8191, h = bh & 3; const float gC = exp2f(128.0f * log2gamma(h));
        float R = 0.f; const size_t base = (size_t)bh * 64 * 8192 + ed;
#pragma unroll 8
        for (int n = 0; n < 64; ++n) { const float kv = kvt[base + (size_t)n * 8192]; rpt[base + (size_t)n * 8192] = f2bf(R); R = R * gC + kv; }
    }
}
__device__ __forceinline__ void ret_c_item(Frame& F, int item) {
    const bf16* proj = (const bf16*)(F.ws + WS_PROJ); const bf16* rpt = (const bf16*)(F.ws + WS_RPT) + (size_t)item * 8192; bf16* mix = (bf16*)(F.ws + WS_MIX);
    const int bh = item >> 6, n = item & 63, b = bh >> 2, h = bh & 3, tok0 = b * SEQ + n * 128;
    LAS bf16* Qs = (LAS bf16*)F.lds; LAS bf16* Ks = Qs + 128 * KSTR; LAS bf16* Vs = Ks + 128 * KSTR; LAS bf16* Rs = Vs + 128 * VSTR;
    const float lg = log2gamma(h);
    ret_stage64(F, proj + (size_t)tok0 * PJ + C_RQ + h * 64, PJ, Qs);
    ret_stage64(F, proj + (size_t)tok0 * PJ + C_RK + h * 64, PJ, Ks);
    ret_stage_v(F, proj, tok0, h, Vs);
    ret_stage64(F, rpt, 64, Rs);
    __syncthreads();
    const int lane = F.lane(), n16 = lane & 15, c = lane >> 4, q4 = n16 >> 2, p4 = lane & 3, w = F.wave, i0 = 16 * w, il = i0 + n16;
    bf16x8 qf[2];
#pragma unroll
    for (int s = 0; s < 2; ++s) qf[s] = *(const LAS bf16x8*)(Qs + il * KSTR + 32 * s + 8 * c);
    f32x4 oin[8], ocr[8];
#pragma unroll
    for (int et = 0; et < 8; ++et) { oin[et] = (f32x4){0.f, 0.f, 0.f, 0.f}; ocr[et] = (f32x4){0.f, 0.f, 0.f, 0.f}; }
    const int nsp = (w >> 1) + 1;
    for (int sp = 0; sp < nsp; ++sp) {
        unsigned pw[4];
#pragma unroll
        for (int t2 = 0; t2 < 2; ++t2) { const int jt = 2 * sp + t2;
            const bf16x8 k0 = *(const LAS bf16x8*)(Ks + (16 * jt + n16) * KSTR + 8 * c), k1 = *(const LAS bf16x8*)(Ks + (16 * jt + n16) * KSTR + 32 + 8 * c);
            f32x4 st = MFMA16(k0, qf[0], ((f32x4){0.f, 0.f, 0.f, 0.f})); st = MFMA16(k1, qf[1], st);
            float pv[4];
#pragma unroll
            for (int r = 0; r < 4; ++r) { const int j = 16 * jt + 4 * c + r; const float f = (il >= j) ? 0.125f * exp2f((float)(il - j) * lg) : 0.f; pv[r] = st[r] * f; }
            pw[2 * t2] = cvtpk(pv[0], pv[1]); pw[2 * t2 + 1] = cvtpk(pv[2], pv[3]); }
        const bf16x8 P = __builtin_bit_cast(bf16x8, ((u32x4){pw[0], pw[1], pw[2], pw[3]}));
#pragma unroll
        for (int et = 0; et < 8; ++et) { const LAS bf16* ap = Vs + (32 * sp + 4 * c + q4) * VSTR + 16 * et + 4 * p4;
            const bf16x8 A = cat8(trread(ap), trread(ap + 16 * VSTR)); oin[et] = MFMA16(A, P, oin[et]); }
    }
#pragma unroll
    for (int et = 0; et < 8; ++et)
#pragma unroll
        for (int s = 0; s < 2; ++s) { const bf16x8 rf = *(const LAS bf16x8*)(Rs + (16 * et + n16) * KSTR + 32 * s + 8 * c); ocr[et] = MFMA16(rf, qf[s], ocr[et]); }
    const float qd = exp2f((float)(il + 1) * lg);
    float ss = 0.f;
#pragma unroll
    for (int et = 0; et < 8; ++et) { oin[et] = oin[et] + ocr[et] * qd; ss += (oin[et][0] * oin[et][0] + oin[et][1] * oin[et][1]) + (oin[et][2] * oin[et][2] + oin[et][3] * oin[et][3]); }
    ss += __shfl_xor(ss, 16); ss += __shfl_xor(ss, 32);
    const float rstd = rsqrtf(ss * (1.f / 128.f) + EPS);
    const bf16* gp = proj + (size_t)(tok0 + il) * PJ + C_RG + h * 128 + 4 * c; unsigned char* op = (unsigned char*)mix + (size_t)(tok0 + il) * DM + h * 128 + 4 * c;
#pragma unroll
    for (int et = 0; et < 8; ++et) { const u32x2 gw = *(const u32x2*)(gp + 16 * et);
        const float g0 = bflo(gw.x), g1 = bfhi(gw.x), g2 = bflo(gw.y), g3 = bfhi(gw.y);
        const float y0 = g0 / (1.f + __expf(-g0)) * (oin[et][0] * rstd), y1 = g1 / (1.f + __expf(-g1)) * (oin[et][1] * rstd), y2 = g2 / (1.f + __expf(-g2)) * (oin[et][2] * rstd), y3 = g3 / (1.f + __expf(-g3)) * (oin[et][3] * rstd);
        *(unsigned*)(op + 16 * et) = pk4_fp8(y0, y1, y2, y3); }
    __syncthreads();
}

constexpr int MTW = 2;
constexpr int RPW = 4 * MTW, QT = 8 * RPW, KT = 64, CAP = 131072 / (QT * 4), CAP_TRIG = CAP - KT, NSEL = 256, NREG = CAP / 64;
constexpr int KTS = 72;
constexpr int CAND_BYTES = QT * CAP * 4, KTILE_BYTES = KT * KTS * 2;
constexpr float WSCALE = 0.125f * 0.35355339059327373f;
__device__ __forceinline__ unsigned fmap(float s) { const unsigned u = __builtin_bit_cast(unsigned, s); return (u & 0x80000000u) ? ~u : (u | 0x80000000u); }
__device__ __forceinline__ float funmap(unsigned m) { const unsigned u = (m & 0x80000000u) ? (m ^ 0x80000000u) : ~m; return __builtin_bit_cast(float, u); }
#define DPP_ROR(v, n) ((unsigned)__builtin_amdgcn_update_dpp(0, (int)(v), 0x120 + (n), 0xf, 0xf, false))
#define DPP_SHR0(v, n) ((unsigned)__builtin_amdgcn_update_dpp(0, (int)(v), 0x110 + (n), 0xf, 0xf, true))
__device__ __forceinline__ unsigned wave_umin(unsigned v) {
    v = min(v, DPP_ROR(v, 1)); v = min(v, DPP_ROR(v, 2)); v = min(v, DPP_ROR(v, 4)); v = min(v, DPP_ROR(v, 8));
    const unsigned a = __builtin_amdgcn_readlane(v, 0), b = __builtin_amdgcn_readlane(v, 16), c = __builtin_amdgcn_readlane(v, 32), d = __builtin_amdgcn_readlane(v, 48);
    return min(min(a, b), min(c, d));
}
__device__ __forceinline__ unsigned wave_umax(unsigned v) {
    v = max(v, DPP_ROR(v, 1)); v = max(v, DPP_ROR(v, 2)); v = max(v, DPP_ROR(v, 4)); v = max(v, DPP_ROR(v, 8));
    const unsigned a = __builtin_amdgcn_readlane(v, 0), b = __builtin_amdgcn_readlane(v, 16), c = __builtin_amdgcn_readlane(v, 32), d = __builtin_amdgcn_readlane(v, 48);
    return max(max(a, b), max(c, d));
}
__device__ __forceinline__ unsigned wave_scan_incl(unsigned v, int lane) {
    v += DPP_SHR0(v, 1); v += DPP_SHR0(v, 2); v += DPP_SHR0(v, 4); v += DPP_SHR0(v, 8);
    const unsigned t0 = __builtin_amdgcn_readlane(v, 15), t1 = __builtin_amdgcn_readlane(v, 31), t2 = __builtin_amdgcn_readlane(v, 47);
    const int rw = lane >> 4;
    return v + (rw == 1 ? t0 : rw == 2 ? t0 + t1 : rw == 3 ? t0 + t1 + t2 : 0u);
}
__device__ __forceinline__ unsigned lt01(int a, int b) { unsigned r; asm("v_sub_u32 %0, %1, %2\n\tv_lshrrev_b32 %0, 31, %0" : "=&v"(r) : "v"(a), "v"(b)); return r; }
#define BIT01(m, j) ({ unsigned _r; asm("v_bfe_u32 %0, %1, %2, 1" : "=v"(_r) : "v"(m), "n"(j)); _r; })
#define LT01(a, b) lt01((int)(a), (int)(b))
__device__ __forceinline__ int select_row(LAS unsigned* row, int cnt, int limit, LAS unsigned* hist, LAS unsigned* trashp, int lane, unsigned& minkey, int need0 = NSEL) {
    unsigned e[NREG]; unsigned act = 0u, keep = 0u;
#pragma unroll
    for (int j = 0; j < NREG; ++j) { const unsigned v = LT01(64 * j + lane, cnt); e[j] = row[64 * j + lane] & (0u - v); act |= v << j; }
    int need = need0; bool first = true;
    for (;;) {
        unsigned lo = 0xFFFFFFFFu, hi = 0u;
#pragma unroll
        for (int j = 0; j < NREG; ++j) { const unsigned a = BIT01(act, j); lo = min(lo, e[j] | (a - 1u)); hi = max(hi, e[j] & (0u - a)); }
        lo = wave_umin(lo); hi = wave_umax(hi);
        if (hi == lo) break;
        hist[lane] = 0u;
        int rb[NREG];
        if (first) {
            const float slo = funmap(lo & 0xFFFFE000u), shi = funmap(hi & 0xFFFFE000u);
            const float scale = (shi > slo) ? 63.999f / (shi - slo) : 0.f;
#pragma unroll
            for (int j = 0; j < NREG; ++j) { const int bn = (int)((funmap(e[j] & 0xFFFFE000u) - slo) * scale); rb[j] = 63 - min(max(bn, 0), 63); }
        } else {
            const float scale = 63.999f / (float)(hi - lo);
#pragma unroll
            for (int j = 0; j < NREG; ++j) { const int bn = (int)((float)(e[j] - lo) * scale); rb[j] = 63 - min(max(bn, 0), 63); }
        }
        first = false;
#pragma unroll
        for (int j = 0; j < NREG; ++j) __hip_atomic_fetch_add(hist + rb[j], BIT01(act, j), __ATOMIC_RELAXED, __HIP_MEMORY_SCOPE_WAVEFRONT);
        const unsigned h = hist[lane];
        const unsigned ps = wave_scan_incl(h, lane);
        const unsigned long long m = __ballot(ps >= (unsigned)need);
        const int ls = (int)__builtin_ctzll(m);
        const int cge = (int)__builtin_amdgcn_readlane(ps, ls), nb = (int)__builtin_amdgcn_readlane(h, ls);
#pragma unroll
        for (int j = 0; j < NREG; ++j) { const unsigned a = BIT01(act, j), kp = a & LT01(rb[j], ls), dr = a & LT01(ls, rb[j]); keep |= kp << j; act &= ~((kp | dr) << j); }
        need -= cge - nb;
        if ((need0 - need) + nb <= limit) break;
    }
    keep |= act;
    const unsigned kcnt = (unsigned)__builtin_popcount(keep); const unsigned incl = wave_scan_incl(kcnt, lane);
    int pos = (int)(incl - kcnt); const int run = (int)__builtin_amdgcn_readlane(incl, 63); unsigned mk = 0xFFFFFFFFu;
#pragma unroll
    for (int j = 0; j < NREG; ++j) { const unsigned k = BIT01(keep, j);
        *(trashp + ((int)((row + pos) - trashp) & -(int)k)) = e[j];
        mk = min(mk, e[j] | (k - 1u)); pos += (int)k; }
    minkey = wave_umin(mk);
    return run;
}
__device__ __forceinline__ int compact_stream(LAS unsigned* row, int cnt, LAS unsigned* hist, LAS unsigned* trashp, int lane, float& thrf) {
    unsigned e[NREG];
#pragma unroll
    for (int j = 0; j < NREG; ++j) e[j] = row[64 * j + lane];
    const unsigned lo = wave_umin(min(e[0], e[1])), hi = wave_umax(max(e[0], e[1]));
    const float slo = funmap(lo & 0xFFFFE000u), shi = funmap(hi & 0xFFFFE000u);
    bool ok = shi > slo; int newcnt = 0, bstar = 0; int bn[NREG]; float scale = 0.f;
    if (ok) {
        scale = 63.999f / (shi - slo);
        hist[lane] = 0u;
#pragma unroll
        for (int j = 0; j < NREG; ++j) { const int b = (int)((funmap(e[j] & 0xFFFFE000u) - slo) * scale); bn[j] = min(max(b, 0), 63);
            __hip_atomic_fetch_add(hist + (63 - bn[j]), LT01(64 * j + lane, cnt), __ATOMIC_RELAXED, __HIP_MEMORY_SCOPE_WAVEFRONT); }
        const unsigned h = hist[lane];
        const unsigned ps = wave_scan_incl(h, lane);
        const unsigned long long m = __ballot(ps >= (unsigned)NSEL);
        const int ls = (int)__builtin_ctzll(m);
        newcnt = (int)__builtin_amdgcn_readlane(ps, ls); bstar = 63 - ls;
        ok = newcnt <= NSEL + 96;
    }
    if (!ok) { unsigned P; const int nc = select_row(row, cnt, NSEL + 64, hist, trashp, lane, P); thrf = funmap(P & 0xFFFFE000u); return nc; }
    unsigned keep = 0u;
#pragma unroll
    for (int j = 0; j < NREG; ++j) keep |= (LT01(64 * j + lane, cnt) & LT01(bstar - 1, bn[j])) << j;
    const unsigned kcnt = (unsigned)__builtin_popcount(keep); const unsigned incl = wave_scan_incl(kcnt, lane);
    int pos = (int)(incl - kcnt); const int run = (int)__builtin_amdgcn_readlane(incl, 63);
#pragma unroll
    for (int j = 0; j < NREG; ++j) { const unsigned k = BIT01(keep, j);
        *(trashp + ((int)((row + pos) - trashp) & -(int)k)) = e[j];
        pos += (int)k; }
    if (bstar > 0) thrf = slo + ((float)bstar - 0.01f) / scale;
    return run;
}
__device__ __forceinline__ int select_final(LAS unsigned* row, int cnt, LAS unsigned* hist, LAS unsigned* trashp, int lane) {
    unsigned e[NREG];
#pragma unroll
    for (int j = 0; j < NREG; ++j) e[j] = row[64 * j + lane] & (0u - LT01(64 * j + lane, cnt));
    const unsigned lo = wave_umin(min(e[0], e[1])), hi = wave_umax(max(e[0], e[1]));
    const float slo = funmap(lo & 0xFFFFE000u), shi = funmap(hi & 0xFFFFE000u);
    bool ok = shi > slo; int nb = 0, bstar = 0, cgt = 0; int bn[NREG];
    if (ok) {
        const float scale = 63.999f / (shi - slo);
        hist[lane] = 0u;
#pragma unroll
        for (int j = 0; j < NREG; ++j) { const int b = (int)((funmap(e[j] & 0xFFFFE000u) - slo) * scale); bn[j] = min(max(b, 0), 63);
            __hip_atomic_fetch_add(hist + (63 - bn[j]), LT01(64 * j + lane, cnt), __ATOMIC_RELAXED, __HIP_MEMORY_SCOPE_WAVEFRONT); }
        const unsigned h = hist[lane];
        const unsigned ps = wave_scan_incl(h, lane);
        const unsigned long long m = __ballot(ps >= (unsigned)NSEL);
        const int ls = (int)__builtin_ctzll(m);
        nb = (int)__builtin_amdgcn_readlane(h, ls); cgt = (int)__builtin_amdgcn_readlane(ps, ls) - nb; bstar = 63 - ls;
        ok = nb <= 64;
    }
    if (!ok) { unsigned P; return select_row(row, cnt, NSEL, hist, trashp, lane, P); }
    unsigned keepm = 0u, bndm = 0u;
#pragma unroll
    for (int j = 0; j < NREG; ++j) { const unsigned v = LT01(64 * j + lane, cnt); keepm |= (v & LT01(bstar, bn[j])) << j; bndm |= (v & (1u - LT01(bstar, bn[j])) & (1u - LT01(bn[j], bstar))) << j; }
    { const unsigned bc = (unsigned)__builtin_popcount(bndm); int bp = (int)(wave_scan_incl(bc, lane) - bc);
#pragma unroll
      for (int j = 0; j < NREG; ++j) { const unsigned k = BIT01(bndm, j); *(trashp + ((int)((hist + bp) - trashp) & -(int)k)) = e[j]; bp += (int)k; } }
    const unsigned x = hist[lane] & (0u - LT01(lane, nb));
    int rank = 0;
    for (int i = 0; i < nb; ++i) rank += (int)(hist[i] > x);
    const int needb = NSEL - cgt;
    { const unsigned kc = (unsigned)__builtin_popcount(keepm); int pos = (int)(wave_scan_incl(kc, lane) - kc);
#pragma unroll
      for (int j = 0; j < NREG; ++j) { const unsigned k = BIT01(keepm, j); *(trashp + ((int)((row + pos) - trashp) & -(int)k)) = e[j]; pos += (int)k; } }
    { const unsigned k = LT01(lane, nb) & LT01(rank, needb); *(trashp + ((int)((row + cgt + rank) - trashp) & -(int)k)) = x; }
    return NSEL;
}
__device__ __forceinline__ float sample_threshold(const LAS unsigned* row, int cnt, int rank, LAS unsigned* hist, int lane) {
    unsigned e[NREG];
#pragma unroll
    for (int j = 0; j < NREG; ++j) e[j] = row[64 * j + lane];
    unsigned lo = 0xFFFFFFFFu, hi = 0u;
#pragma unroll
    for (int j = 0; j < NREG; ++j) { const unsigned v = LT01(64 * j + lane, cnt); lo = min(lo, e[j] | (v - 1u)); hi = max(hi, e[j] & (0u - v)); }
    lo = wave_umin(lo); hi = wave_umax(hi);
    const float slo = funmap(lo & 0xFFFFE000u), shi = funmap(hi & 0xFFFFE000u);
    if (!(shi > slo)) return -INFINITY;
    const float scale = 63.999f / (shi - slo);
    hist[lane] = 0u;
#pragma unroll
    for (int j = 0; j < NREG; ++j) { const int b = (int)((funmap(e[j] & 0xFFFFE000u) - slo) * scale);
        __hip_atomic_fetch_add(hist + (63 - min(max(b, 0), 63)), LT01(64 * j + lane, cnt), __ATOMIC_RELAXED, __HIP_MEMORY_SCOPE_WAVEFRONT); }
    const unsigned ps = wave_scan_incl(hist[lane], lane);
    const int bstar = 63 - (int)__builtin_ctzll(__ballot(ps >= (unsigned)rank));
    return bstar > 0 ? slo + ((float)bstar - 0.01f) / scale : -INFINITY;
}
#if defined(PROBE_SUB)
#define PSUB_T(i) do { const unsigned long long _t = __builtin_amdgcn_s_memrealtime(); if ((i) == PROBE_SUB) F.tacc += _t - psub_last; psub_last = _t; } while (0)
#else
#define PSUB_T(i) do { } while (0)
#endif
#ifndef DSA_EXP
#define DSA_EXP 0
#endif
#define DSA_X(bit) (F.xpass != 0 && (DSA_EXP & (bit)))
__device__ __forceinline__ void dsa_a_wave(Frame& F, int b, int qt, int ws) {
#if defined(PROBE_SUB)
    unsigned long long psub_last = 0ull;
#endif
    const bf16* proj = (const bf16*)(F.ws + WS_PROJ); bf16* sel = (bf16*)(F.ws + WS_SEL);
    LAS unsigned* cand = (LAS unsigned*)F.lds;
    LAS unsigned* hist = (LAS unsigned*)(F.lds + CAND_BYTES) + 64 * F.wave;
    LAS int* rowcnt = (LAS int*)(F.lds + CAND_BYTES + 2048); LAS float* rowthr = (LAS float*)(F.lds + CAND_BYTES + 2048 + 256);
    const int lane = F.lane(), w = F.wave, r32 = lane & 31, hi = lane >> 5;
    const int trash = (CAND_BYTES + 2048 + 512) / 4 + 64 * w + lane;
    const int tokb = b * SEQ, q0 = qt * QT + RPW * ws;
    bf16x8 af[MTW][4]; float wv[MTW][16];
    { const int qq = 2 * ((r32 >> 2) & 1) + (r32 >> 4), hd = ((r32 >> 3) & 1) * 4 + (r32 & 3);
#pragma unroll
      for (int mt = 0; mt < MTW; ++mt) { const bf16* qp = proj + (size_t)(tokb + q0 + 4 * mt + qq) * PJ + C_IQ + hd * 64 + 32 * hi;
#pragma unroll
          for (int s = 0; s < 4; ++s) af[mt][s] = *(const bf16x8*)(qp + 8 * s);
#pragma unroll
          for (int u = 0; u < 2; ++u) { const u32x4 ww = *(const u32x4*)(proj + (size_t)(tokb + q0 + 4 * mt + 2 * hi + u) * PJ + C_IW);
              wv[mt][8 * u + 0] = bflo(ww.x) * WSCALE; wv[mt][8 * u + 1] = bfhi(ww.x) * WSCALE; wv[mt][8 * u + 2] = bflo(ww.y) * WSCALE; wv[mt][8 * u + 3] = bfhi(ww.y) * WSCALE;
              wv[mt][8 * u + 4] = bflo(ww.z) * WSCALE; wv[mt][8 * u + 5] = bfhi(ww.z) * WSCALE; wv[mt][8 * u + 6] = bflo(ww.w) * WSCALE; wv[mt][8 * u + 7] = bfhi(ww.w) * WSCALE; } } }
    float thrf[MTW][2]; int cntv[MTW][2];
    if (lane < RPW) { rowcnt[RPW * w + lane] = 0; rowthr[RPW * w + lane] = -INFINITY; }
    const int NT = (q0 + RPW + KT - 1) / KT;
    const char* kbase = (const char*)(proj + (size_t)tokb * PJ + C_IK + 32 * hi);
    const unsigned koff = (unsigned)r32 * (unsigned)(PJ * 2);
    constexpr int SSTR = 16, SOFF = 7, SRANK = 40;
    for (int pass = (NT >= 2 * SSTR ? 0 : 1); pass < 3; ++pass) {
        const int stride = pass == 0 ? SSTR : 1, kt0 = pass == 0 ? SOFF : 0;
#pragma unroll
        for (int mt = 0; mt < MTW; ++mt)
#pragma unroll
            for (int u = 0; u < 2; ++u) { cntv[mt][u] = 0; thrf[mt][u] = pass == 1 ? rowthr[RPW * w + 4 * mt + 2 * hi + u] : -INFINITY; }
        bf16x8 kc[2][4], kn[2][4];
        { const char* kb0 = kbase + (size_t)kt0 * KT * (PJ * 2);
#pragma unroll
          for (int sub = 0; sub < 2; ++sub)
#pragma unroll
              for (int s = 0; s < 4; ++s) kc[sub][s] = *(const bf16x8*)(kb0 + koff + (unsigned)(sub * 32) * (unsigned)(PJ * 2) + 16 * s); }
        auto tile_step = [&](int kt, bf16x8 (&kc)[2][4], bf16x8 (&kn)[2][4]) {
            PSUB_T(0);
            const char* kb1 = kbase + (size_t)(kt + stride) * KT * (PJ * 2);
#pragma unroll
            for (int sub = 0; sub < 2; ++sub) {
                if (kt + stride < NT) {
#pragma unroll
                    for (int s = 0; s < 4; ++s) kn[sub][s] = *(const bf16x8*)(kb1 + koff + (unsigned)(sub * 32) * (unsigned)(PJ * 2) + 16 * s); }
                const int key = kt * KT + sub * 32 + r32;
                f32x16 accs[MTW];
#pragma unroll
                for (int mt = 0; mt < MTW; ++mt) {
                    accs[mt] = MFMA32(af[mt][0], kc[sub][0], ((f32x16){0.f, 0.f, 0.f, 0.f, 0.f, 0.f, 0.f, 0.f, 0.f, 0.f, 0.f, 0.f, 0.f, 0.f, 0.f, 0.f}));
#pragma unroll
                    for (int s = 1; s < 4; ++s) accs[mt] = MFMA32(af[mt][s], kc[sub][s], accs[mt]);
                }
#pragma unroll
                for (int mt = 0; mt < MTW; ++mt) {
                    float sc[2] = {0.f, 0.f};
#pragma unroll
                    for (int r = 0; r < 16; ++r) sc[r >> 3] += wv[mt][r] * fmaxf(accs[mt][r], 0.f);
#pragma unroll
                    for (int u = 0; u < 2; ++u) {
                        const int ql = RPW * w + 4 * mt + 2 * hi + u;
                        const bool valid = (sc[u] >= thrf[mt][u]) && (key <= q0 + 4 * mt + 2 * hi + u);
                        const unsigned long long m = __ballot(valid);
                        const int nlo = __builtin_popcount((unsigned)m), nhi = __builtin_popcount((unsigned)(m >> 32));
                        const int off = mbcnt64(m) - (hi ? nlo : 0);
                        cand[valid ? ql * CAP + cntv[mt][u] + off : trash] = (fmap(sc[u]) & 0xFFFFE000u) | (unsigned)(8191 - key);
                        cntv[mt][u] += hi ? nhi : nlo;
                    }
                }
            }
            PSUB_T(1);
            bool anyc = false;
#pragma unroll
            for (int mt = 0; mt < MTW; ++mt)
#pragma unroll
                for (int u = 0; u < 2; ++u) anyc = anyc || (cntv[mt][u] > CAP_TRIG);
            if (__any(anyc)) {
                if ((lane & 31) == 0) {
#pragma unroll
                    for (int mt = 0; mt < MTW; ++mt)
#pragma unroll
                        for (int u = 0; u < 2; ++u) { rowcnt[RPW * w + 4 * mt + 2 * hi + u] = cntv[mt][u]; rowthr[RPW * w + 4 * mt + 2 * hi + u] = thrf[mt][u]; }
                }
#pragma unroll 1
                for (int rr = 0; rr < RPW; ++rr) { const int rowi = RPW * w + rr; const int cq = __builtin_amdgcn_readfirstlane(rowcnt[rowi]);
                    if (cq > NSEL + 64) { float tf = rowthr[rowi]; const int nc = compact_stream(cand + rowi * CAP, cq, hist, cand + trash, lane, tf);
                        if (lane == 0) { rowcnt[rowi] = nc; rowthr[rowi] = tf; } } }
#pragma unroll
                for (int mt = 0; mt < MTW; ++mt)
#pragma unroll
                    for (int u = 0; u < 2; ++u) { cntv[mt][u] = rowcnt[RPW * w + 4 * mt + 2 * hi + u]; thrf[mt][u] = rowthr[RPW * w + 4 * mt + 2 * hi + u]; }
            }
            PSUB_T(7);
        };
        for (int kt = kt0; kt < NT; kt += 2 * stride) { tile_step(kt, kc, kn); if (kt + stride < NT) tile_step(kt + stride, kn, kc); }
        if ((lane & 31) == 0) {
#pragma unroll
            for (int mt = 0; mt < MTW; ++mt)
#pragma unroll
                for (int u = 0; u < 2; ++u) rowcnt[RPW * w + 4 * mt + 2 * hi + u] = cntv[mt][u];
        }
        if (pass == 0) {
#pragma unroll 1
            for (int rr = 0; rr < RPW; ++rr) { const int rowi = RPW * w + rr; const int cq = __builtin_amdgcn_readfirstlane(rowcnt[rowi]); float tf = -INFINITY;
                if (cq > SRANK + 8) tf = sample_threshold(cand + rowi * CAP, cq, SRANK, hist, lane);
                if (lane == 0) rowthr[rowi] = tf; }
        } else {
            bool okall = true;
#pragma unroll 1
            for (int rr = 0; rr < RPW; ++rr) { const int cq = __builtin_amdgcn_readfirstlane(rowcnt[RPW * w + rr]); const int nrow = q0 + rr + 1; okall = okall && (cq >= (nrow < NSEL ? nrow : NSEL)); }
            if (okall) break;
        }
    }
    PSUB_T(5);
#pragma unroll 1
    for (int rr = 0; rr < RPW; ++rr) { const int ql = RPW * w + rr; LAS unsigned* row = cand + ql * CAP; int cq = __builtin_amdgcn_readfirstlane(rowcnt[ql]);
        if (cq > NSEL) cq = select_final(row, cq, hist, cand + trash, lane);
        bf16* so = sel + (size_t)(tokb + q0 + rr) * NSEL;
#pragma unroll
        for (int j = 0; j < 4; ++j) { const int p = 64 * j + lane; const unsigned v = row[p]; so[p] = (p < cq) ? (bf16)(8191u - (v & 0x1FFFu)) : (bf16)0; } }
    PSUB_T(6);
}

constexpr int VROW = 144;
constexpr int DSB_WAVE = 32 * VROW * 2 + 2 * 2048;
static_assert(8 * DSB_WAVE <= MISC_OFF, "DSA-B LDS map");
__device__ __forceinline__ void dsb_gather(const char* kvbase, const LAS unsigned* sl, int chunk, int colbyte, int c, int n16, u32x4 (&r)[8]) {
#pragma unroll
    for (int i = 0; i < 8; ++i) { const unsigned o = sl[32 * chunk + 4 * i + c] + (unsigned)(colbyte + n16 * 16); r[i] = *(const u32x4*)(kvbase + o); }
}
__device__ __forceinline__ void dsb_put_list(LAS unsigned* sl, u32x2 kk, int t, int lane) {
    const unsigned k0 = kk.x & 0xffffu, k1 = kk.x >> 16, k2 = kk.y & 0xffffu, k3 = kk.y >> 16;
    *(LAS u32x4*)(sl + 4 * lane) = (u32x4){k0 * (unsigned)(PJ * 2), k1 * (unsigned)(PJ * 2), k2 * (unsigned)(PJ * 2), k3 * (unsigned)(PJ * 2)};
    *(LAS f32x4*)((LAS float*)(sl + 256) + 4 * lane) = (f32x4){(float)(t - (int)k0), (float)(t - (int)k1), (float)(t - (int)k2), (float)(t - (int)k3)};
}
__device__ __forceinline__ void phase_dsa_b(Frame& F) {
    const bf16* proj = (const bf16*)(F.ws + WS_PROJ); const bf16* sel = (const bf16*)(F.ws + WS_SEL); bf16* mix = (bf16*)(F.ws + WS_MIX);
    const int lane = F.lane(), n16 = lane & 15, c = lane >> 4, q4 = n16 >> 2, p4 = lane & 3, w = F.wave;
    LAS unsigned char* wl = F.lds + w * DSB_WAVE;
    LAS bf16* buf = (LAS bf16*)wl; LAS unsigned* slb = (LAS unsigned*)(wl + 32 * VROW * 2);
    const float nslope[2] = {-exp2f(-(float)((n16 & 3) + 1)), -exp2f(-(float)((n16 & 3) + 5))};
    constexpr float L2E = 1.4426950408889634f;
    for (int blk = F.bid; blk < NTOK / 128; blk += F.G) {
        int T0 = blk * 128;
        if (F.G == 256) { const int x = F.bid & 7, jj = F.bid >> 3; T0 = (x & 3) * SEQ + (jj * 2 + (x >> 2)) * 128; }
        const char* kvbase = (const char*)(proj + (size_t)(T0 / SEQ) * SEQ * PJ);
        int tok = T0 + w;
        u32x4 kr[8], vr[8]; bf16x8 qf[2][2]; u32x2 selnext;
        dsb_put_list(slb, *(const u32x2*)(sel + (size_t)tok * NSEL + 4 * lane), tok % SEQ, lane);
        dsb_gather(kvbase, slb, 0, C_AK * 2, c, n16, kr); dsb_gather(kvbase, slb, 0, C_AV * 2, c, n16, vr);
#pragma unroll
        for (int g = 0; g < 2; ++g)
#pragma unroll
            for (int s = 0; s < 2; ++s) { bf16x8 v = (bf16x8){0, 0, 0, 0, 0, 0, 0, 0};
                if (n16 < 4) v = *(const bf16x8*)(proj + (size_t)tok * PJ + C_AQ + (g * 4 + n16) * 64 + 32 * s + 8 * c);
                qf[g][s] = v; }
        for (int qi = 0; qi < 16; ++qi) {
            const int t = tok % SEQ, nsel = (t + 1 < NSEL) ? t + 1 : NSEL; const int par = qi & 1;
            const LAS unsigned* sl = slb + par * 512; LAS unsigned* sln = slb + (par ^ 1) * 512;
            const bool more = qi + 1 < 16; const int tokn = tok + 8;
            if (more) selnext = *(const u32x2*)(sel + (size_t)tokn * NSEL + 4 * lane);
            float mrun[2] = {-INFINITY, -INFINITY}, lrun[2] = {0.f, 0.f};
            f32x4 O[2][4];
#pragma unroll
            for (int g = 0; g < 2; ++g)
#pragma unroll
                for (int dt = 0; dt < 4; ++dt) O[g][dt] = (f32x4){0.f, 0.f, 0.f, 0.f};
            bf16x8 qn[2][2];
#pragma unroll 4
            for (int ch = 0; ch < 8; ++ch) {
#pragma unroll
                for (int i = 0; i < 8; ++i) *(LAS u32x4*)(buf + (4 * i + c) * VROW + n16 * 8) = kr[i];
                if (ch == 3 && more) dsb_put_list(sln, selnext, tokn % SEQ, lane);
                asm volatile("" ::: "memory");
                if (ch < 7) dsb_gather(kvbase, sl, ch + 1, C_AK * 2, c, n16, kr);
                else if (more) dsb_gather(kvbase, sln, 0, C_AK * 2, c, n16, kr);
                if (ch == 6 && more) {
#pragma unroll
                    for (int g = 0; g < 2; ++g)
#pragma unroll
                        for (int s = 0; s < 2; ++s) { bf16x8 v = (bf16x8){0, 0, 0, 0, 0, 0, 0, 0};
                            if (n16 < 4) v = *(const bf16x8*)(proj + (size_t)tokn * PJ + C_AQ + (g * 4 + n16) * 64 + 32 * s + 8 * c);
                            qn[g][s] = v; } }
                f32x4 acc[2][2];
#pragma unroll
                for (int kt = 0; kt < 2; ++kt)
#pragma unroll
                    for (int g = 0; g < 2; ++g) { const LAS bf16* ap = buf + (16 * kt + n16) * VROW + g * 64 + 8 * c;
                        acc[kt][g] = MFMA16(*(const LAS bf16x8*)ap, qf[g][0], ((f32x4){0.f, 0.f, 0.f, 0.f})); acc[kt][g] = MFMA16(*(const LAS bf16x8*)(ap + 32), qf[g][1], acc[kt][g]); }
#pragma unroll
                for (int kt = 0; kt < 2; ++kt) { const f32x4 d4 = *(const LAS f32x4*)((const LAS float*)(sl + 256) + 32 * ch + 16 * kt + 4 * c);
#pragma unroll
                    for (int r = 0; r < 4; ++r)
#pragma unroll
                        for (int g = 0; g < 2; ++g) acc[kt][g][r] = fmaf(nslope[g], d4[r], acc[kt][g][r]); }
                if (nsel < NSEL) {
#pragma unroll
                    for (int kt = 0; kt < 2; ++kt)
#pragma unroll
                        for (int r = 0; r < 4; ++r) { const bool dead = 32 * ch + 16 * kt + 4 * c + r >= nsel;
#pragma unroll
                            for (int g = 0; g < 2; ++g) acc[kt][g][r] = dead ? -INFINITY : acc[kt][g][r]; }
                }
                bf16x8 pf[2]; float alpha[2]; bool grow = false;
#pragma unroll
                for (int g = 0; g < 2; ++g) {
                    float mx = fmaxf(fmaxf(fmaxf(acc[0][g][0], acc[0][g][1]), fmaxf(acc[0][g][2], acc[0][g][3])), fmaxf(fmaxf(acc[1][g][0], acc[1][g][1]), fmaxf(acc[1][g][2], acc[1][g][3])));
                    mx = fmaxf(mx, __shfl_xor(mx, 16)); mx = fmaxf(mx, __shfl_xor(mx, 32));
                    const float mnew = fmaxf(mrun[g], mx);
                    alpha[g] = (mnew == -INFINITY) ? 1.f : __builtin_amdgcn_exp2f((mrun[g] - mnew) * L2E);
                    grow = grow || (mnew > mrun[g]);
                    mrun[g] = mnew;
                    const float mm2 = (mnew == -INFINITY) ? 0.f : -mnew * L2E; float s = 0.f;
#pragma unroll
                    for (int kt = 0; kt < 2; ++kt)
#pragma unroll
                        for (int r = 0; r < 4; ++r) { const float e = __builtin_amdgcn_exp2f(fmaf(acc[kt][g][r], L2E, mm2)); acc[kt][g][r] = e; s += e; }
                    s += __shfl_xor(s, 16); s += __shfl_xor(s, 32);
                    lrun[g] = lrun[g] * alpha[g] + s;
                    u32x4 pw; pw.x = cvtpk(acc[0][g][0], acc[0][g][1]); pw.y = cvtpk(acc[0][g][2], acc[0][g][3]); pw.z = cvtpk(acc[1][g][0], acc[1][g][1]); pw.w = cvtpk(acc[1][g][2], acc[1][g][3]);
                    pf[g] = __builtin_bit_cast(bf16x8, pw); }
#pragma unroll
                for (int i = 0; i < 8; ++i) *(LAS u32x4*)(buf + (4 * i + c) * VROW + n16 * 8) = vr[i];
                asm volatile("" ::: "memory");
                if (ch < 7) dsb_gather(kvbase, sl, ch + 1, C_AV * 2, c, n16, vr);
                else if (more) dsb_gather(kvbase, sln, 0, C_AV * 2, c, n16, vr);
                if (__any(grow)) {
#pragma unroll
                    for (int g = 0; g < 2; ++g)
#pragma unroll
                        for (int r = 0; r < 4; ++r) { const float a = __builtin_bit_cast(float, __builtin_amdgcn_readlane(__builtin_bit_cast(int, alpha[g]), r));
#pragma unroll
                            for (int dt = 0; dt < 4; ++dt) O[g][dt][r] *= a; }
                }
#pragma unroll
                for (int dt = 0; dt < 4; ++dt) { const LAS bf16* vp = buf + (4 * c + q4) * VROW + dt * 16 + 4 * p4;
                    O[0][dt] = MFMA16(pf[0], cat8(trread(vp), trread(vp + 16 * VROW)), O[0][dt]);
                    O[1][dt] = MFMA16(pf[1], cat8(trread(vp + 64), trread(vp + 64 + 16 * VROW)), O[1][dt]); }
            }
            {
#pragma unroll
                for (int g = 0; g < 2; ++g)
#pragma unroll
                    for (int r = 0; r < 4; ++r) { const float li = __builtin_amdgcn_rcpf(__builtin_bit_cast(float, __builtin_amdgcn_readlane(__builtin_bit_cast(int, lrun[g]), r)));
                        if (lane < 16) {
#pragma unroll
                            for (int dt = 0; dt < 4; dt += 2) { const int w2 = __builtin_amdgcn_cvt_pk_fp8_f32(O[g][dt][r] * li, O[g][dt + 1][r] * li, 0, false);
                                ((LAS unsigned char*)buf)[(g * 4 + r) * 64 + 16 * dt + lane] = (unsigned char)(w2 & 0xff); ((LAS unsigned char*)buf)[(g * 4 + r) * 64 + 16 * (dt + 1) + lane] = (unsigned char)((w2 >> 8) & 0xff); } } }
                const u32x2 ov = *(const LAS u32x2*)((LAS unsigned char*)buf + 8 * lane);
                *(u32x2*)((unsigned char*)mix + (size_t)tok * DM + 512 + 8 * lane) = ov;
            }
            if (more) {
#pragma unroll
                for (int g = 0; g < 2; ++g)
#pragma unroll
                    for (int s = 0; s < 2; ++s) qf[g][s] = qn[g][s];
            }
            tok = tokn;
        }
    }
}

constexpr int HSTR = 1028;
__device__ __forceinline__ void phase_router(Frame& F) {
    const float* const norm2_g = F.in(8); const float* const router_w = F.in(9); const float* const router_b = F.in(10);
    const float* x1 = F.out; const float* mod = (const float*)(F.ws + WS_MOD); unsigned char* h2 = (unsigned char*)(F.ws + WS_H2);
    int* topi = (int*)(F.ws + WS_TOPI); float* topg = (float*)(F.ws + WS_TOPG); int* bbase = (int*)(F.ws + WS_BBASE);
    LAS float* hs = (LAS float*)F.lds; LAS float* part = (LAS float*)(F.lds + 16 * HSTR * 4); LAS int* hist = (LAS int*)(F.lds + 16 * HSTR * 4 + 8 * 16 * 32 * 4);
    const int lane = F.lane(), w = F.wave;
    for (int blk = F.bid; blk < NTOK / 128; blk += F.G) {
        const int T0 = blk * 128, b = T0 / SEQ;
        if (F.tid() < 32) hist[F.tid()] = 0;
        f32x4 ca[4], cb[4];
#pragma unroll
        for (int j = 0; j < 4; ++j) { const int col = 4 * lane + 256 * j;
            ca[j] = *(const f32x4*)(norm2_g + col) * (*(const f32x4*)(mod + b * 6144 + 4 * 1024 + col) + 1.0f); cb[j] = *(const f32x4*)(mod + b * 6144 + 3 * 1024 + col); }
        __syncthreads();
        for (int pass = 0; pass < 8; ++pass) {
#pragma unroll
            for (int tt = 0; tt < 2; ++tt) { const int tl = 2 * w + tt, tok = T0 + pass * 16 + tl;
                const f32x4* xr = (const f32x4*)(x1 + (size_t)tok * DM) + lane; f32x4 v[4]; float s = 0.f;
#pragma unroll
                for (int j = 0; j < 4; ++j) { v[j] = xr[64 * j]; s += (v[j][0] * v[j][0] + v[j][1] * v[j][1]) + (v[j][2] * v[j][2] + v[j][3] * v[j][3]); }
                const float rstd = rsqrtf(wave_sum(s) * (1.f / DM) + EPS);
                unsigned* o4 = (unsigned*)(h2 + (size_t)tok * DM) + lane;
#pragma unroll
                for (int j = 0; j < 4; ++j) { const f32x4 y = (v[j] * rstd) * ca[j] + cb[j];
                    o4[64 * j] = pk4_fp8(y[0], y[1], y[2], y[3]);
                    *(LAS f32x4*)(hs + tl * HSTR + 4 * lane + 256 * j) = y; } }
            __syncthreads();
            { const int ti = lane & 15, kk = lane >> 5, e = lane & 31; f32x16 acc;
#pragma unroll
              for (int r = 0; r < 16; ++r) acc[r] = 0.f;
              const LAS float* hp = hs + ti * HSTR + 128 * w + 64 * kk; const float* rwp = router_w + (size_t)(128 * w + 64 * kk) * NE + e;
#pragma unroll 4
              for (int s4 = 0; s4 < 16; ++s4) { const f32x4 a4 = *(const LAS f32x4*)(hp + 4 * s4);
#pragma unroll
                  for (int q = 0; q < 4; ++q) acc = __builtin_amdgcn_mfma_f32_32x32x2f32(a4[q], rwp[(4 * s4 + q) * NE], acc, 0, 0, 0); }
#pragma unroll
              for (int r = 0; r < 8; ++r) part[(w * 16 + (r & 3) + 8 * (r >> 2) + 4 * kk) * 32 + e] = acc[r]; }
            __syncthreads();
            { const int tl = F.tid() >> 5, e = F.tid() & 31, tok = T0 + pass * 16 + tl; float lg = router_b[e];
#pragma unroll
              for (int ww = 0; ww < 8; ++ww) lg += part[(ww * 16 + tl) * 32 + e];
              float myv = lg; float tv[4]; int ti4[4]; bool mine = false;
#pragma unroll
              for (int k = 0; k < 4; ++k) { float bv = myv; int bi = e;
#pragma unroll
                  for (int o = 16; o >= 1; o >>= 1) { const float ov = __shfl_xor(bv, o); const int oi = __shfl_xor(bi, o); if (ov > bv || (ov == bv && oi < bi)) { bv = ov; bi = oi; } }
                  tv[k] = bv; ti4[k] = bi; if (bi == e) { myv = -INFINITY; mine = true; } }
              if (mine) atomicAdd((int*)hist + e, 1);
              if (e == 0) { const float e0 = 1.0f, e1 = __expf(tv[1] - tv[0]), e2 = __expf(tv[2] - tv[0]), e3 = __expf(tv[3] - tv[0]); const float inv = 1.0f / (e0 + e1 + e2 + e3);
                  *(int4*)(topi + (size_t)tok * 4) = make_int4(ti4[0], ti4[1], ti4[2], ti4[3]); *(f32x4*)(topg + (size_t)tok * 4) = (f32x4){e0 * inv, e1 * inv, e2 * inv, e3 * inv}; } }
            __syncthreads();
        }
        if (F.tid() < 32) { const int base = atomicAdd((int*)(F.ctl + CW_GCNT) + F.tid(), hist[F.tid()]); bbase[blk * 32 + F.tid()] = base; }
        __syncthreads();
    }
}
__device__ __forceinline__ int moe_layout(Frame& F, LAS int* offs, LAS int* tile_e) {
    if (F.tid() == 0) { int o = 0;
        for (int e = 0; e < NE; ++e) { const int cnt = (int)__hip_atomic_load(F.ctl + CW_GCNT + e, __ATOMIC_RELAXED, __HIP_MEMORY_SCOPE_AGENT); const int nt = (cnt + 255) >> 8;
            offs[e] = o; if (tile_e) for (int t = 0; t < nt; ++t) tile_e[(o >> 8) + t] = e; o += nt << 8; }
        offs[NE] = o >> 8; }
    __syncthreads();
    return offs[NE];
}
__device__ __forceinline__ void phase_place(Frame& F) {
    const unsigned char* h2 = (const unsigned char*)(F.ws + WS_H2); unsigned char* xs = (unsigned char*)(F.ws + WS_XS);
    const int* topi = (const int*)(F.ws + WS_TOPI); const float* topg = (const float*)(F.ws + WS_TOPG); const int* bbase = (const int*)(F.ws + WS_BBASE);
    int* rowinfo = (int*)(F.ws + WS_ROWINFO); float* rowgate = (float*)(F.ws + WS_ROWGATE);
    LAS int* offs = (LAS int*)F.lds; LAS int* lcur = offs + 64; LAS int* posl = offs + 128;
    (void)moe_layout(F, offs, nullptr);
    for (int blk = F.bid; blk < NTOK / 128; blk += F.G) {
        const int T0 = blk * 128;
        if (F.tid() < 32) lcur[F.tid()] = 0;
        __syncthreads();
        { const int i = F.tid(), tok = T0 + (i >> 2); const int e = topi[(size_t)tok * 4 + (i & 3)];
          const int rank = atomicAdd((int*)lcur + e, 1); const int pos = offs[e] + bbase[blk * 32 + e] + rank;
          rowinfo[pos] = tok * 4 + (i & 3); rowgate[pos] = topg[(size_t)tok * 4 + (i & 3)]; posl[i] = pos; }
        __syncthreads();
        for (int j8 = 0; j8 < 64; j8 += 8) {
            u32x4 v[8]; int pp[8];
#pragma unroll
            for (int u = 0; u < 8; ++u) { const int i = F.wave * 64 + j8 + u; pp[u] = posl[i]; v[u] = *((const u32x4*)(h2 + (size_t)(T0 + (i >> 2)) * DM) + F.lane()); }
#pragma unroll
            for (int u = 0; u < 8; ++u) *((u32x4*)(xs + (size_t)pp[u] * DM) + F.lane()) = v[u];
        }
        __syncthreads();
    }
}
__device__ __forceinline__ void phase_final(Frame& F) {
    const float* const final_g = F.in(15);
    const float* mod = (const float*)(F.ws + WS_MOD); const unsigned char* Y = (const unsigned char*)(F.ws + WS_Y);
    const int gw = F.bid * NWAVES + F.wave, NGW = F.G * NWAVES, lane = F.lane();
    for (int m = gw; m < NTOK; m += NGW) {
        const int b = m / SEQ; f32x4* xr = (f32x4*)(F.out + (size_t)m * DM) + lane; f32x4 v[4]; unsigned yw[4][4]; float s = 0.f;
#pragma unroll
        for (int j = 0; j < 4; ++j) { v[j] = xr[64 * j];
#pragma unroll
            for (int k = 0; k < 4; ++k) yw[j][k] = *((const unsigned*)(Y + ((size_t)m * 4 + k) * DM) + lane + 64 * j); }
#pragma unroll
        for (int j = 0; j < 4; ++j) { const int col = 4 * lane + 256 * j; f32x4 y = (f32x4){0.f, 0.f, 0.f, 0.f};
#pragma unroll
            for (int k = 0; k < 4; ++k) { const f32x2_t lo = __builtin_amdgcn_cvt_pk_f32_fp8(yw[j][k], false), hi2 = __builtin_amdgcn_cvt_pk_f32_fp8(yw[j][k], true); y[0] += lo[0]; y[1] += lo[1]; y[2] += hi2[0]; y[3] += hi2[1]; }
            v[j] = v[j] + *(const f32x4*)(mod + b * 6144 + 5 * 1024 + col) * y;
            s += (v[j][0] * v[j][0] + v[j][1] * v[j][1]) + (v[j][2] * v[j][2] + v[j][3] * v[j][3]); }
        const float rstd = rsqrtf(wave_sum(s) * (1.f / DM) + EPS);
#pragma unroll
        for (int j = 0; j < 4; ++j) xr[64 * j] = (v[j] * rstd) * *(const f32x4*)(final_g + 4 * lane + 256 * j);
    }
}

#ifndef MK_N_LAUNCHES
#define MK_N_LAUNCHES 1
#endif
constexpr int N_PHASES = 12;
struct Args { const float* in[16]; float* out; unsigned char* ws; int ph_lo, ph_hi; };
static_assert(sizeof(Args) == 16 * 8 + 8 + 8 + 8, "Args has no padding");

__global__ void __launch_bounds__(NTHR, 2) mk_fwd(Args args) {
    extern __shared__ __attribute__((aligned(16))) unsigned char lds_raw[];
    Frame F;
    F.lds = (LAS unsigned char*)lds_raw;
    F.MISC = (volatile LAS unsigned*)(F.lds + MISC_OFF);
    F.wave = __builtin_amdgcn_readfirstlane((int)threadIdx.x >> 6);
    F.G = gridDim.x; F.bid = blockIdx.x; F.tacc = 0ull; F.xpass = 0;
    F.ws = args.ws; F.ctl = (unsigned*)(args.ws + WS_CTL); F.out = args.out;
    for (int u = F.tid(); u < (LDS_BYTES - MISC_OFF) / 4; u += NTHR) ((LAS unsigned*)(F.lds + MISC_OFF))[u] = 0u;
    __syncthreads();
    if (F.tid() < 16) *(LAS unsigned long long*)(F.lds + PTR_OFF + 8 * F.tid()) = (unsigned long long)args.in[F.tid()];
    __syncthreads();
    const int lo = args.ph_lo, hi = args.ph_hi;
    XcdBarrier bar; bar.bar = (unsigned*)(F.ctl + CW_BAR); bar.x = 0; bar.st = nullptr; bar.w0 = (F.wave == 0);
    if (hi - lo > 1) bar = xcd_barrier_post((unsigned*)(F.ctl + CW_BAR), F.MISC + 8, F.wave == 0);
#define IN(k) (lo <= (k) && (k) < hi)
#if defined(PROBE_PHASE)
    unsigned long long tp0 = 0ull, tp1 = 0ull;
#define STAMP(k) do { if ((k) == PROBE_PHASE) tp0 = __builtin_amdgcn_s_memrealtime(); if ((k) == PROBE_PHASE + 1) tp1 = __builtin_amdgcn_s_memrealtime(); } while (0)
#else
#define STAMP(k) do { } while (0)
#endif
#define SEAM(k) do { if (IN(k) && IN((k) + 1)) xcd_barrier(bar); } while (0)

    STAMP(0); if (IN(0)) { phase_p0a(F); } SEAM(0);
    STAMP(1); if (IN(1)) { phase_p0b(F); } SEAM(1);
    STAMP(2); if (IN(2)) {
        pg8::Gemm g{(const bf16*)(F.ws + WS_H0), (const bf16*)(F.ws + WS_WIN), NTOK, 3072, DM}; pg8::StaticOrder S; S.init(NTOK, 3072, F.G, F.bid);
        EpiProj E{(bf16*)(F.ws + WS_PROJ), PJ};
        pg8::gemm_phase<EpiProj, pg8::StaticOrder, true, true>(F.lds, g, S, E, F.wave);
    } SEAM(2);
    STAMP(3); if (IN(3)) {
#if defined(PROBE_SUB)
        const unsigned long long tra0 = __builtin_amdgcn_s_memrealtime();
#endif
        for (int it = F.bid; it < 1024; it += F.G) ret_a_item(F, it);
#if defined(PROBE_SUB)
        if (PROBE_SUB == 4) F.tacc += __builtin_amdgcn_s_memrealtime() - tra0;
#endif
        { constexpr int NQT = SEQ / QT, NITEM = NBATCH * NQT * 8;
          int cit = F.bid * NWAVES + F.wave;
          LAS float* scr = (LAS float*)(F.lds + F.wave * (RPW * CAP * 4));
          for (;;) { int t = 0; if (F.lane() == 0) t = (int)__hip_atomic_fetch_add(F.ctl + CW_Q3, 1u, __ATOMIC_RELAXED, __HIP_MEMORY_SCOPE_AGENT);
              t = __builtin_amdgcn_readfirstlane(t); const bool have = t < NITEM;
              if (have) dsa_a_wave(F, (t >> 3) & 3, NQT - 1 - (t >> 5), t & 7);
              cit = f8_burst(F, scr, cit, have ? 6 : (1 << 20));
              if (!have) break; } }
    } SEAM(3);
    STAMP(4); if (IN(4)) {
#if defined(PROBE_SUB)
        const unsigned long long tsc0 = __builtin_amdgcn_s_memrealtime();
#endif
        ret_scan(F);
#if defined(PROBE_SUB)
        if (PROBE_SUB == 5) F.tacc += __builtin_amdgcn_s_memrealtime() - tsc0;
#endif
        __syncthreads();
        phase_dsa_b(F);
    } SEAM(4);
    STAMP(5); if (IN(5)) { for (int it = F.bid; it < 1024; it += F.G) ret_c_item(F, it); } SEAM(5);
    STAMP(6); if (IN(6)) {
        pg8::Gemm g{(const bf16*)(F.ws + WS_MIX), (const bf16*)(F.ws + WS_WO), NTOK, DM, DM}; pg8::StaticOrder S; S.init(NTOK, DM, F.G, F.bid);
        EpiX1T<true> E{F.in(0), (const float*)(F.ws + WS_MOD), F.out};
        pg8::gemm_phase<EpiX1T<true>, pg8::StaticOrder, true, true, true>(F.lds, g, S, E, F.wave);
    } SEAM(6);
    STAMP(7); if (IN(7)) { phase_router(F); } SEAM(7);
    STAMP(8); if (IN(8)) { phase_place(F); } SEAM(8);
    STAMP(9); if (IN(9)) {
        LAS int* tile_e = (LAS int*)(F.lds + TILEE_OFF); const int nt = moe_layout(F, (LAS int*)(F.lds + TILEE_OFF + 4096), tile_e);
        pg8::Gemm g{(const bf16*)(F.ws + WS_XS), (const bf16*)(F.ws + WS_WGU), MOE_ROWS, 2048, DM};
        GroupedOrder S{tile_e, nt, 8, F.G, F.bid, (size_t)2048 * 1024};
        EpiGlu8 E{(unsigned char*)(F.ws + WS_HB), F.in(12)};
        pg8::gemm_phase<EpiGlu8, GroupedOrder, true, true, true>(F.lds, g, S, E, F.wave);
    } SEAM(9);
    STAMP(10); if (IN(10)) {
        LAS int* tile_e = (LAS int*)(F.lds + TILEE_OFF); const int nt = moe_layout(F, (LAS int*)(F.lds + TILEE_OFF + 4096), tile_e);
        pg8::Gemm g{(const bf16*)(F.ws + WS_HB), (const bf16*)(F.ws + WS_WDN), MOE_ROWS, DM, DM};
        GroupedOrder S{tile_e, nt, 4, F.G, F.bid, (size_t)1024 * 1024};
        EpiDownT<true> E{(bf16*)(F.ws + WS_Y), F.in(14), (const int*)(F.ws + WS_ROWINFO), (const float*)(F.ws + WS_ROWGATE)};
        pg8::gemm_phase<EpiDownT<true>, GroupedOrder, true, true, true>(F.lds, g, S, E, F.wave);
    } SEAM(10);
    STAMP(11); if (IN(11)) { phase_final(F); }
    STAMP(12);
#if defined(PROBE_SUB)
    if (F.bid == 0 && F.tid() == 0) { const unsigned long long te = __builtin_amdgcn_s_memrealtime(); while (__builtin_amdgcn_s_memrealtime() - te < F.tacc) __builtin_amdgcn_s_sleep(8); }
#elif defined(PROBE_PHASE)
    if (F.bid == 0 && F.tid() == 0) { const unsigned long long te = __builtin_amdgcn_s_memrealtime(), dur = tp1 - tp0; while (__builtin_amdgcn_s_memrealtime() - te < dur) __builtin_amdgcn_s_sleep(8); }
#endif
#undef IN
#undef SEAM
}

extern "C" void kernel_launch(void* const* d_in, const int* in_sizes, int n_in, void* d_out, int out_size, void* d_ws, size_t ws_size, hipStream_t stream) {
    static int grid = 0;
    if (grid == 0) {
        if (n_in != 16 || out_size != NTOK * DM || ws_size < WS_END) { fprintf(stderr, "kernel_launch: unexpected problem (n_in %d out %d ws %zu); nothing launched\n", n_in, out_size, ws_size); grid = -1; return; }
        int dev = 0, cus = 0;
        if (hipGetDevice(&dev) != hipSuccess || hipDeviceGetAttribute(&cus, hipDeviceAttributeMultiprocessorCount, dev) != hipSuccess) { grid = -1; return; }
        if (hipFuncSetAttribute((const void*)mk_fwd, hipFuncAttributeMaxDynamicSharedMemorySize, LDS_BYTES) != hipSuccess) { fprintf(stderr, "kernel_launch: hipFuncSetAttribute failed\n"); grid = -1; return; }
        int per_cu = 0;
        if (hipOccupancyMaxActiveBlocksPerMultiprocessor(&per_cu, (const void*)mk_fwd, NTHR, LDS_BYTES) != hipSuccess || per_cu < 1) fprintf(stderr, "kernel_launch: occupancy query reports %d workgroups per CU\n", per_cu);
        (void)hipGetLastError();
        grid = cus;
    }
    if (grid < 0) return;
    (void)hipMemsetAsync((char*)d_ws + WS_CTL, 0, CTL_ZERO_BYTES, stream);
    Args a{};
    for (int i = 0; i < 16; ++i) a.in[i] = (const float*)d_in[i];
    a.out = (float*)d_out; a.ws = (unsigned char*)d_ws;
#if MK_N_LAUNCHES == 1
    a.ph_lo = 0; a.ph_hi = N_PHASES;
    hipLaunchKernelGGL(mk_fwd, dim3(grid), dim3(NTHR), LDS_BYTES, stream, a);
#else
    for (int p = 0; p < N_PHASES; ++p) { a.ph_lo = p; a.ph_hi = p + 1; hipLaunchKernelGGL(mk_fwd, dim3(grid), dim3(NTHR), LDS_BYTES, stream, a); }
#endif
}
```

```cpp
#include <hip/hip_runtime.h>
#include <cstdio>
#include <cstdint>

#define LAS __attribute__((address_space(3)))
#define GAS __attribute__((address_space(1)))
typedef unsigned short bf16;
typedef short bf16x8 __attribute__((ext_vector_type(8)));
typedef short s16x4 __attribute__((ext_vector_type(4)));
typedef float f32x4 __attribute__((ext_vector_type(4)));
typedef float f32x16 __attribute__((ext_vector_type(16)));
typedef unsigned u32x4 __attribute__((ext_vector_type(4)));
typedef unsigned u32x2 __attribute__((ext_vector_type(2)));
typedef float f32x2_t __attribute__((ext_vector_type(2)));
typedef __bf16 bf16x2_t __attribute__((ext_vector_type(2)));

constexpr int DM = 1024, NBATCH = 4, SEQ = 8192, NTOK = NBATCH * SEQ;
constexpr int PJ = 3072;
constexpr int IN_COLS = 2888;
constexpr int C_RQ = 0, C_RK = 256, C_RV = 512, C_RG = 1024, C_AQ = 1536, C_AK = 2048, C_AV = 2176, C_IQ = 2304, C_IK = 2816, C_IW = 2880;
constexpr int NE = 32, TOPK = 4, MOE_ROWS = NTOK * TOPK + NE * 256;
constexpr int MOE_TILES = MOE_ROWS / 256;
constexpr float EPS = 1e-6f;
constexpr int NWAVES = 8, NTHR = 512;

constexpr size_t MiB = 1u << 20;
constexpr size_t WS_CTL = 0, CTL_ZERO_BYTES = 1 * MiB;
constexpr size_t WS_MOD = 1 * MiB;
constexpr size_t WS_TOPI = 2 * MiB;
constexpr size_t WS_TOPG = 2 * MiB + 512 * 1024;
constexpr size_t WS_BBASE = 3 * MiB;
constexpr size_t WS_ROWINFO = 4 * MiB;
constexpr size_t WS_ROWGATE = 5 * MiB;
constexpr size_t WS_WIN = 8 * MiB;
constexpr size_t WS_WO = 14 * MiB;
constexpr size_t WS_WGU = 16 * MiB;
constexpr size_t WS_WDN = 144 * MiB;
constexpr size_t WS_H0 = 208 * MiB;
constexpr size_t WS_PROJ = 272 * MiB;
constexpr size_t WS_XS = 208 * MiB;
constexpr size_t WS_Y = 208 * MiB;
constexpr size_t WS_KVT = 480 * MiB;
constexpr size_t WS_RPT = 512 * MiB;
constexpr size_t WS_SEL = 528 * MiB;
constexpr size_t WS_MIX = 544 * MiB;
constexpr size_t WS_H2 = 608 * MiB;
constexpr size_t WS_HB = 480 * MiB;
constexpr size_t WS_END = 752 * MiB;
constexpr int CW_GCNT = 1024;
constexpr int CW_Q1 = 2048;
constexpr int CW_Q3 = 2112;
constexpr int CW_SCAN = 2176;
constexpr int CW_BAR = 4096;

constexpr int LDS_BYTES = 153600;
constexpr int RING_BYTES = 131072;
constexpr int TILEE_OFF = 131072;
constexpr int MISC_OFF = 152576;
constexpr int PTR_OFF = MISC_OFF + 512;

__device__ __forceinline__ int hw_lane() { int l; asm volatile("v_mbcnt_lo_u32_b32 %0, -1, 0\n\tv_mbcnt_hi_u32_b32 %0, -1, %0" : "=v"(l)); return l; }
__device__ __forceinline__ unsigned cvtpk(float lo, float hi) { f32x2_t v = {lo, hi}; bf16x2_t b = __builtin_convertvector(v, bf16x2_t); return __builtin_bit_cast(unsigned, b); }
__device__ __forceinline__ float bflo(unsigned w) { return __builtin_bit_cast(float, w << 16); }
__device__ __forceinline__ float bfhi(unsigned w) { return __builtin_bit_cast(float, w & 0xffff0000u); }
__device__ __forceinline__ float bf2f(bf16 h) { return __builtin_bit_cast(float, (unsigned)h << 16); }
__device__ __forceinline__ bf16 f2bf(float f) { return (bf16)(cvtpk(f, 0.f) & 0xffffu); }
__device__ __forceinline__ float wave_sum(float v) {
#pragma unroll
    for (int o = 1; o < 64; o <<= 1) v += __shfl_xor(v, o);
    return v;
}
__device__ __forceinline__ int mbcnt64(unsigned long long m) { return (int)__builtin_amdgcn_mbcnt_hi((unsigned)(m >> 32), __builtin_amdgcn_mbcnt_lo((unsigned)m, 0u)); }
__device__ __forceinline__ s16x4 trread(const LAS void* p) { typedef short v4i16_t __attribute__((ext_vector_type(4))); return __builtin_bit_cast(s16x4, __builtin_amdgcn_ds_read_tr16_b64_v4i16((LAS v4i16_t*)p)); }
__device__ __forceinline__ bf16x8 cat8(s16x4 lo, s16x4 hi) { return (bf16x8){lo[0], lo[1], lo[2], lo[3], hi[0], hi[1], hi[2], hi[3]}; }
#define MFMA16(a, b, c) __builtin_amdgcn_mfma_f32_16x16x32_bf16((a), (b), (c), 0, 0, 0)
#define MFMA32(a, b, c) __builtin_amdgcn_mfma_f32_32x32x16_bf16((a), (b), (c), 0, 0, 0)

namespace pg8 {
#define PG8_LAS __attribute__((address_space(3)))
typedef unsigned short bf16_t;
typedef short bf16x8 __attribute__((ext_vector_type(8)));
typedef float f32x4 __attribute__((ext_vector_type(4)));
typedef unsigned u32x4 __attribute__((ext_vector_type(4)));
constexpr int BM = 256, BK = 64, HALF = 128, HTB = HALF * BK * 2  , STAGE_BYTES = 8 * HTB, NXCD = 8, WGM = 8;

__host__ __device__ __forceinline__ int lds_byte(int r, int c) { const int st = (r >> 4) * 2 + (c >> 5), rr = r & 15, cc = c & 31, ob = rr * 64 + cc * 2; return st * 1024 + (ob ^ (((ob >> 9) & 1) << 5)); }
__host__ __device__ __forceinline__ void stage_rc(int b, int& R, int& C) { const int st = b / 1024, sb = b % 1024, swz = sb ^ (((sb >> 9) & 1) << 5); R = (st >> 1) * 16 + swz / 64; C = (st & 1) * 32 + (swz % 64) / 2; }
__host__ __device__ __forceinline__ int perm32(int rho) { const int n = rho >> 4, i = rho & 15; return 8 * (i >> 2) + 4 * n + (i & 3); }

typedef int v8i32 __attribute__((ext_vector_type(8))); typedef int v4i32 __attribute__((ext_vector_type(4)));
__device__ __forceinline__ v8i32 pg8_cat(bf16x8 a, bf16x8 b) { return __builtin_shufflevector(__builtin_bit_cast(v4i32, a), __builtin_bit_cast(v4i32, b), 0, 1, 2, 3, 4, 5, 6, 7); }
struct Unit { int pm, pn, e; size_t bo; };
struct Gemm { const bf16_t* A; const bf16_t* Bt; int M, N, K; };

struct StaticOrder {
    int nM, nN, nwg, G, c;
    __host__ __device__ void init(int M, int N, int G_, int c_) { nM = M / BM; nN = N / BM; nwg = nM * nN; G = G_; c = c_; }
    __host__ __device__ bool next(int i, Unit& u) const {
        const long L = (long)i * G + c; if (L >= nwg) return false;
        int wgid = (int)L; { const int q = nwg / NXCD, r = nwg % NXCD, xcd = wgid % NXCD, off = wgid / NXCD; wgid = (xcd < r ? xcd * (q + 1) : r * (q + 1) + (xcd - r) * q) + off; }
        const int nig = WGM * nN, gid = wgid / nig, fm = gid * WGM, gsz = (nM - fm) < WGM ? (nM - fm) : WGM;
        u.pm = fm + ((wgid % nig) % gsz); u.pn = (wgid % nig) / gsz; u.e = 0; u.bo = 0; return true;
    }
    __device__ __forceinline__ void a_ready(const Unit&) const {}
    __device__ __forceinline__ void done(const Unit&) const {}
};

template <class Epi, class Sched, bool ALIGN_EPI = false, bool SP2 = false, bool F8 = false>
__device__ __forceinline__ void gemm_phase(PG8_LAS unsigned char* lds, const Gemm g, const Sched& S, const Epi& E, const int wid) {
    const int lane = hw_lane(), tid = wid * 64 + lane, wr = wid >> 2, wc = wid & 3, fr = lane & 15, fq = lane >> 4;
    constexpr int ESZ = F8 ? 1 : 2;
    const int K = g.K, nt = K * ESZ / (BK * 2);
    unsigned voffA[2], voffB[2];
#pragma unroll
    for (int i = 0; i < 2; ++i) { int R, C; stage_rc(tid * 16 + i * 8192, R, C); const int Rb = Epi::PERM ? ((R & ~31) + perm32(R & 31)) : R;
        voffA[i] = (unsigned)(R * K * ESZ + C * 2); voffB[i] = (unsigned)(Rb * K * ESZ + C * 2); }
    const size_t kstep = (size_t)(BK * 2);
    const size_t hstep = (size_t)HALF * K * ESZ;
    const size_t tstep = 2 * hstep;
    const unsigned ldsw = (unsigned)wid * 1024u;
    const int aoff = lds_byte(wr * 64 + fr, fq * 8), boff = lds_byte(wc * 32 + fr, fq * 8);
#define PG8_SA(b, h) (((b) * 2 + (h)) * HTB)
#define PG8_SB(b, h) ((4 + (b) * 2 + (h)) * HTB)
#define PG8_STAGE(bufoff, gbase, voff) do { _Pragma("unroll") for (int _i = 0; _i < 2; ++_i) { \
        if constexpr (F8) { unsigned _keep; const unsigned _l = (unsigned)(__UINTPTR_TYPE__)(lds + (bufoff) + ldsw + _i * 8192);   \
            asm volatile("s_mov_b32 %0, m0\n\ts_mov_b32 m0, %3\n\ts_nop 0\n\tglobal_load_lds_dwordx4 %1, %2\n\ts_mov_b32 m0, %0" : "=&s"(_keep) : "v"((voff)[_i]), "s"((const char*)(gbase)), "s"(_l) : "memory"); } \
        else __builtin_amdgcn_global_load_lds((const unsigned*)((const char*)(gbase) + (voff)[_i]), (PG8_LAS unsigned*)(lds + (bufoff) + ldsw + _i * 8192), 16, 0, 0); } } while (0)
#define PG8_LDA(dst, b, h) do { _Pragma("unroll") for (int m = 0; m < 4; ++m) _Pragma("unroll") for (int k = 0; k < 2; ++k) dst[m][k] = *(const PG8_LAS bf16x8*)(lds + PG8_SA(b, h) + aoff + m * 2048 + k * 1024); } while (0)
#define PG8_LDB(dst, b, h) do { _Pragma("unroll") for (int n = 0; n < 2; ++n) _Pragma("unroll") for (int k = 0; k < 2; ++k) dst[n][k] = *(const PG8_LAS bf16x8*)(lds + PG8_SB(b, h) + boff + n * 2048 + k * 1024); } while (0)
#define PG8_MMA(ai, bj, At, Bt) do { __builtin_amdgcn_s_setprio(1); _Pragma("unroll") for (int m = 0; m < 4; ++m) _Pragma("unroll") for (int n = 0; n < 2; ++n) { \
        if constexpr (F8) { acc[ai][bj][m][n] = __builtin_amdgcn_mfma_scale_f32_16x16x128_f8f6f4(pg8_cat(Bt[n][0], Bt[n][1]), pg8_cat(At[m][0], At[m][1]), acc[ai][bj][m][n], 0, 0, 0, 0, 0, 0); } \
        else { _Pragma("unroll") for (int k = 0; k < 2; ++k) acc[ai][bj][m][n] = __builtin_amdgcn_mfma_f32_16x16x32_bf16(Bt[n][k], At[m][k], acc[ai][bj][m][n], 0, 0, 0); } } __builtin_amdgcn_s_setprio(0); } while (0)
#define PG8_WAIT_V(n) asm volatile("s_waitcnt vmcnt(" #n ")" ::: "memory")
#define PG8_WAIT_L(n) asm volatile("s_waitcnt lgkmcnt(" #n ")" ::: "memory")
#define PG8_BAR __builtin_amdgcn_s_barrier()
#define PG8_SCHED __builtin_amdgcn_sched_barrier(0)
    Unit cur, nxt; int ui = 0;
    if (!S.next(0, cur)) return;
    f32x4 acc[2][2][4][2];
#pragma unroll
    for (int a = 0; a < 2; ++a)
#pragma unroll
        for (int b = 0; b < 2; ++b)
#pragma unroll
            for (int m = 0; m < 4; ++m)
#pragma unroll
                for (int n = 0; n < 2; ++n) acc[a][b][m][n] = (f32x4){0.f, 0.f, 0.f, 0.f};
    bf16x8 At[4][2], B0[2][2], B1[2][2];
    const char* cA = (const char*)g.A + (size_t)cur.pm * tstep; const char* cB = (const char*)g.Bt + (size_t)cur.pn * tstep + cur.bo;
    S.a_ready(cur);
    if constexpr (SP2) {
        PG8_STAGE(PG8_SB(0, 0), cB, voffB); PG8_STAGE(PG8_SB(0, 1), cB + hstep, voffB); PG8_STAGE(PG8_SA(0, 0), cA, voffA); PG8_STAGE(PG8_SA(0, 1), cA + hstep, voffA);
        if (wr == 1) PG8_BAR;
        PG8_WAIT_V(2); PG8_BAR;
        PG8_STAGE(PG8_SB(1, 0), cB + kstep, voffB); PG8_STAGE(PG8_SA(1, 0), cA + kstep, voffA); PG8_STAGE(PG8_SB(1, 1), cB + hstep + kstep, voffB);
        PG8_WAIT_V(6); PG8_BAR;
    } else {
        PG8_STAGE(PG8_SB(0, 0), cB, voffB); PG8_STAGE(PG8_SA(0, 0), cA, voffA); PG8_STAGE(PG8_SB(0, 1), cB + hstep, voffB); PG8_STAGE(PG8_SA(0, 1), cA + hstep, voffA);
        if (wr == 1) PG8_BAR;
        PG8_WAIT_V(4); PG8_BAR;
        PG8_STAGE(PG8_SB(1, 0), cB + kstep, voffB); PG8_STAGE(PG8_SA(1, 0), cA + kstep, voffA); PG8_STAGE(PG8_SB(1, 1), cB + hstep + kstep, voffB);
        PG8_WAIT_V(6); PG8_BAR;
    }
    for (;;) {
        const bool has_next = S.next(ui + 1, nxt);
        const char* nA = has_next ? (const char*)g.A + (size_t)nxt.pm * tstep : cA; const char* nB = has_next ? (const char*)g.Bt + (size_t)nxt.pn * tstep + nxt.bo : cB;
        for (int t = 0; t < nt; t += 2) {
            const bool last = (t == nt - 2);
            const char* a1 = cA + (size_t)(t + 1) * kstep;
            const char* a2 = last ? nA : cA + (size_t)(t + 2) * kstep; const char* b2 = last ? nB : cB + (size_t)(t + 2) * kstep;
            const char* a3 = a2 + kstep; const char* b3 = b2 + kstep;
            if (last && has_next) S.a_ready(nxt);
            if constexpr (SP2) {
            PG8_LDB(B0, 0, 0); PG8_LDB(B1, 0, 1); PG8_SCHED; PG8_LDA(At, 0, 0); PG8_STAGE(PG8_SA(1, 1), a1 + hstep, voffA);
            PG8_WAIT_V(8); PG8_WAIT_L(0); PG8_BAR; PG8_MMA(0, 0, At, B0); PG8_MMA(0, 1, At, B1); PG8_BAR; PG8_SCHED;
            PG8_LDA(At, 0, 1); PG8_STAGE(PG8_SB(0, 0), b2, voffB); PG8_STAGE(PG8_SB(0, 1), b2 + hstep, voffB); PG8_STAGE(PG8_SA(0, 0), a2, voffA);
            PG8_WAIT_V(8); PG8_WAIT_L(0); PG8_BAR; PG8_MMA(1, 0, At, B0); PG8_MMA(1, 1, At, B1); PG8_BAR; PG8_SCHED;
            PG8_LDB(B0, 1, 0); PG8_LDB(B1, 1, 1); PG8_SCHED; PG8_LDA(At, 1, 0); PG8_STAGE(PG8_SA(0, 1), a2 + hstep, voffA);
            PG8_WAIT_V(8); PG8_WAIT_L(0); PG8_BAR; PG8_MMA(0, 0, At, B0); PG8_MMA(0, 1, At, B1); PG8_BAR; PG8_SCHED;
            PG8_LDA(At, 1, 1); PG8_STAGE(PG8_SB(1, 0), b3, voffB); PG8_STAGE(PG8_SB(1, 1), b3 + hstep, voffB); PG8_STAGE(PG8_SA(1, 0), a3, voffA);
            PG8_WAIT_V(8); PG8_WAIT_L(0); PG8_BAR; PG8_MMA(1, 0, At, B0); PG8_MMA(1, 1, At, B1); PG8_BAR; PG8_SCHED;
            } else {
            PG8_LDB(B0, 0, 0); PG8_SCHED; PG8_LDA(At, 0, 0); PG8_STAGE(PG8_SA(1, 1), a1 + hstep, voffA);
            PG8_WAIT_L(8); PG8_BAR; PG8_WAIT_L(0); PG8_MMA(0, 0, At, B0); PG8_BAR; PG8_SCHED;
            PG8_LDB(B1, 0, 1); PG8_STAGE(PG8_SB(0, 0), b2, voffB);
            PG8_BAR; PG8_WAIT_L(0); PG8_MMA(0, 1, At, B1); PG8_BAR;
            PG8_LDA(At, 0, 1); PG8_STAGE(PG8_SA(0, 0), a2, voffA);
            PG8_BAR; PG8_WAIT_L(0); PG8_MMA(1, 0, At, B0); PG8_BAR; PG8_SCHED;
            PG8_STAGE(PG8_SB(0, 1), b2 + hstep, voffB);
            PG8_WAIT_V(6); PG8_BAR; PG8_MMA(1, 1, At, B1); PG8_BAR;
            PG8_LDB(B0, 1, 0); PG8_SCHED; PG8_LDA(At, 1, 0); PG8_STAGE(PG8_SA(0, 1), a2 + hstep, voffA);
            PG8_WAIT_L(8); PG8_BAR; PG8_WAIT_L(0); PG8_MMA(0, 0, At, B0); PG8_BAR; PG8_SCHED;
            PG8_LDB(B1, 1, 1); PG8_STAGE(PG8_SB(1, 0), b3, voffB);
            PG8_BAR; PG8_WAIT_L(0); PG8_MMA(0, 1, At, B1); PG8_BAR;
            PG8_LDA(At, 1, 1); PG8_STAGE(PG8_SA(1, 0), a3, voffA);
            PG8_BAR; PG8_WAIT_L(0); PG8_MMA(1, 0, At, B0); PG8_BAR; PG8_SCHED;
            PG8_STAGE(PG8_SB(1, 1), b3 + hstep, voffB);
            PG8_WAIT_V(6); PG8_BAR; PG8_MMA(1, 1, At, B1); PG8_BAR;
            }
        }
        if constexpr (ALIGN_EPI) { if (wr == 0) PG8_BAR; }
        if constexpr (!Epi::AFTER_DRAIN) { E(acc, cur, wr, wc, fr, fq); S.done(cur); }
        if (!has_next) break;
#pragma unroll
        for (int a = 0; a < 2; ++a)
#pragma unroll
            for (int b = 0; b < 2; ++b)
#pragma unroll
                for (int m = 0; m < 4; ++m)
#pragma unroll
                    for (int n = 0; n < 2; ++n) acc[a][b][m][n] = (f32x4){0.f, 0.f, 0.f, 0.f};
        cur = nxt; cA = nA; cB = nB; ++ui;
        if constexpr (ALIGN_EPI) { if (wr == 1) PG8_BAR; }
    }
    PG8_WAIT_V(0);
    if constexpr (!ALIGN_EPI) { if (wr == 0) PG8_BAR; }
    PG8_BAR;
    if constexpr (Epi::AFTER_DRAIN) { E.fused(acc, cur, wr, wc, fr, fq, lds, wid, lane); S.done(cur); }
#undef PG8_SA
#undef PG8_SB
#undef PG8_STAGE
#undef PG8_LDA
#undef PG8_LDB
#undef PG8_MMA
#undef PG8_WAIT_V
#undef PG8_WAIT_L
#undef PG8_BAR
#undef PG8_SCHED
}
}

struct EpiProj {
    static constexpr bool PERM = true, AFTER_DRAIN = false;
    bf16* O; int ldc;
    __device__ __forceinline__ void operator()(const f32x4 (&acc)[2][2][4][2], const pg8::Unit& u, int wr, int wc, int fr, int fq) const {
        const int row0 = u.pm * 256 + wr * 64 + fr; const int col0 = u.pn * 256 + wc * 32 + 8 * fq;
#pragma unroll
        for (int ai = 0; ai < 2; ++ai)
#pragma unroll
            for (int m = 0; m < 4; ++m) { bf16* rowp = O + (size_t)(row0 + ai * 128 + m * 16) * ldc + col0;
#pragma unroll
                for (int bj = 0; bj < 2; ++bj) { const f32x4 v0 = acc[ai][bj][m][0], v1 = acc[ai][bj][m][1];
                    u32x4 w; w.x = cvtpk(v0[0], v0[1]); w.y = cvtpk(v0[2], v0[3]); w.z = cvtpk(v1[0], v1[1]); w.w = cvtpk(v1[2], v1[3]);
                    *(u32x4*)(rowp + bj * 128) = w; } }
    }
};
constexpr float W8_SCALE = 64.0f, W8_INV = 1.0f / 64.0f;
template <bool F8> struct EpiX1T {
    static constexpr bool PERM = false, AFTER_DRAIN = false;
    const float* x; const float* mod; float* out;
    __device__ __forceinline__ void operator()(const f32x4 (&acc)[2][2][4][2], const pg8::Unit& u, int wr, int wc, int fr, int fq) const {
        const int col0 = u.pn * 256 + wc * 32 + 4 * fq; const int b = (u.pm * 256) / SEQ;
        f32x4 g[2][2];
#pragma unroll
        for (int bj = 0; bj < 2; ++bj)
#pragma unroll
            for (int n = 0; n < 2; ++n) g[bj][n] = *(const f32x4*)(mod + (size_t)b * 6144 + 2 * 1024 + col0 + bj * 128 + n * 16);
#pragma unroll
        for (int ai = 0; ai < 2; ++ai)
#pragma unroll
            for (int m = 0; m < 4; ++m) { const size_t off = (size_t)(u.pm * 256 + ai * 128 + wr * 64 + m * 16 + fr) * DM + col0;
#pragma unroll
                for (int bj = 0; bj < 2; ++bj)
#pragma unroll
                    for (int n = 0; n < 2; ++n) { const f32x4 xv = __builtin_nontemporal_load((const f32x4*)(x + off + bj * 128 + n * 16)); *(f32x4*)(out + off + bj * 128 + n * 16) = xv + g[bj][n] * (acc[ai][bj][m][n] * (F8 ? W8_INV : 1.0f)); }
                if (m & 1) asm volatile("" ::: "memory"); }
    }
};
__device__ __forceinline__ float glu_f(float gate, float up) {
    gate = fminf(gate, 7.0f); up = fminf(fmaxf(up, -7.0f), 7.0f);
    const float sg = __builtin_amdgcn_rcpf(1.0f + __expf(-1.702f * gate));
    return (up + 1.0f) * (gate * sg);
}
__device__ __forceinline__ unsigned pk4_fp8(float a, float b, float c, float d) { int w = __builtin_amdgcn_cvt_pk_fp8_f32(a, b, 0, false); w = __builtin_amdgcn_cvt_pk_fp8_f32(c, d, w, true); return (unsigned)w; }
struct EpiGlu8 {
    static constexpr bool PERM = true, AFTER_DRAIN = false;
    unsigned char* H; const float* b_gu;
    __device__ __forceinline__ void operator()(const f32x4 (&acc)[2][2][4][2], const pg8::Unit& u, int wr, int wc, int fr, int fq) const {
        const int row0 = u.pm * 256 + wr * 64 + fr; const int c0 = u.pn * 128 + wc * 32 + 8 * fq;
        const float* bg = b_gu + (size_t)u.e * 2048 + c0; const float* bu = bg + 1024;
        const f32x4 bg0 = *(const f32x4*)bg, bg1 = *(const f32x4*)(bg + 4), bu0 = *(const f32x4*)bu, bu1 = *(const f32x4*)(bu + 4);
#pragma unroll
        for (int ai = 0; ai < 2; ++ai)
#pragma unroll
            for (int m = 0; m < 4; ++m) {
                const f32x4 g0 = acc[ai][0][m][0] * W8_INV + bg0, g1 = acc[ai][0][m][1] * W8_INV + bg1, u0 = acc[ai][1][m][0] * W8_INV + bu0, u1 = acc[ai][1][m][1] * W8_INV + bu1;
                u32x2 w; w.x = pk4_fp8(glu_f(g0[0], u0[0]), glu_f(g0[1], u0[1]), glu_f(g0[2], u0[2]), glu_f(g0[3], u0[3]));
                w.y = pk4_fp8(glu_f(g1[0], u1[0]), glu_f(g1[1], u1[1]), glu_f(g1[2], u1[2]), glu_f(g1[3], u1[3]));
                *(u32x2*)(H + (size_t)(row0 + ai * 128 + m * 16) * DM + c0) = w; }
    }
};
struct EpiGlu {
    static constexpr bool PERM = true, AFTER_DRAIN = false;
    bf16* H; const float* b_gu;
    __device__ __forceinline__ void operator()(const f32x4 (&acc)[2][2][4][2], const pg8::Unit& u, int wr, int wc, int fr, int fq) const {
        const int row0 = u.pm * 256 + wr * 64 + fr; const int c0 = u.pn * 128 + wc * 32 + 8 * fq;
        const float* bg = b_gu + (size_t)u.e * 2048 + c0; const float* bu = bg + 1024;
        const f32x4 bg0 = *(const f32x4*)bg, bg1 = *(const f32x4*)(bg + 4), bu0 = *(const f32x4*)bu, bu1 = *(const f32x4*)(bu + 4);
#pragma unroll
        for (int ai = 0; ai < 2; ++ai)
#pragma unroll
            for (int m = 0; m < 4; ++m) {
                const f32x4 g0 = acc[ai][0][m][0] + bg0, g1 = acc[ai][0][m][1] + bg1, u0 = acc[ai][1][m][0] + bu0, u1 = acc[ai][1][m][1] + bu1;
                u32x4 w; w.x = cvtpk(glu_f(g0[0], u0[0]), glu_f(g0[1], u0[1])); w.y = cvtpk(glu_f(g0[2], u0[2]), glu_f(g0[3], u0[3]));
                w.z = cvtpk(glu_f(g1[0], u1[0]), glu_f(g1[1], u1[1])); w.w = cvtpk(glu_f(g1[2], u1[2]), glu_f(g1[3], u1[3]));
                *(u32x4*)(H + (size_t)(row0 + ai * 128 + m * 16) * DM + c0) = w; }
    }
};
template <bool F8> struct EpiDownT {
    static constexpr bool PERM = true, AFTER_DRAIN = false;
    bf16* Y; const float* b_down; const int* rowinfo; const float* rowgate;
    __device__ __forceinline__ void operator()(const f32x4 (&acc)[2][2][4][2], const pg8::Unit& u, int wr, int wc, int fr, int fq) const {
        const int row0 = u.pm * 256 + wr * 64 + fr; const int col0 = u.pn * 256 + wc * 32 + 8 * fq;
        const float* bd = b_down + (size_t)u.e * 1024 + col0;
        f32x4 bv[2][2];
#pragma unroll
        for (int bj = 0; bj < 2; ++bj)
#pragma unroll
            for (int n = 0; n < 2; ++n) bv[bj][n] = *(const f32x4*)(bd + bj * 128 + 4 * n);
#pragma unroll
        for (int ai = 0; ai < 2; ++ai) {
            int dsts[4]; float gts[4];
#pragma unroll
            for (int m = 0; m < 4; ++m) { dsts[m] = rowinfo[row0 + ai * 128 + m * 16]; gts[m] = rowgate[row0 + ai * 128 + m * 16]; }
#pragma unroll
            for (int m = 0; m < 4; ++m) { const int dst = dsts[m]; const float gt = gts[m];
                if (dst >= 0) {
#pragma unroll
                    for (int bj = 0; bj < 2; ++bj) { const float sa = F8 ? W8_INV : 1.0f; const f32x4 v0 = (acc[ai][bj][m][0] * sa + bv[bj][0]) * gt, v1 = (acc[ai][bj][m][1] * sa + bv[bj][1]) * gt;
                        if constexpr (F8) {
                            u32x2 w; w.x = pk4_fp8(v0[0], v0[1], v0[2], v0[3]); w.y = pk4_fp8(v1[0], v1[1], v1[2], v1[3]);
                            *(u32x2*)((unsigned char*)Y + (size_t)dst * DM + col0 + bj * 128) = w;
                        } else {
                            u32x4 w; w.x = cvtpk(v0[0], v0[1]); w.y = cvtpk(v0[2], v0[3]); w.z = cvtpk(v1[0], v1[1]); w.w = cvtpk(v1[2], v1[3]);
                            *(u32x4*)(Y + (size_t)dst * DM + col0 + bj * 128) = w; } } } } }
    }
};
struct GroupedOrder {
    const LAS int* tile_e; int ntiles, nN, G, c; size_t estride;
    __device__ __forceinline__ bool next(int i, pg8::Unit& u) const {
        int pm, pn;
        if (G == 256) { const int x = c & 7, j = c >> 3, rpx = 32 / nN; pn = j % nN; pm = i * (8 * rpx) + x * rpx + j / nN; }
        else { const long L = (long)i * G + c; pm = (int)(L / nN); pn = (int)(L % nN); }
        if (pm >= ntiles) return false;
        u.pm = pm; u.pn = pn; u.e = __builtin_amdgcn_readfirstlane(tile_e[pm]); u.bo = (size_t)u.e * estride; return true;
    }
    __device__ __forceinline__ void a_ready(const pg8::Unit&) const {}
    __device__ __forceinline__ void done(const pg8::Unit&) const {}
};

#define XB_TMO      128
#define XB_XCNT(j)  (256  + 64 * (j))
#define XB_XSUB(j)  (1280 + 64 * (j))
#define XB_XGEN(j)  (2304 + 64 * (j))
#define XB_TOP      3328
#define XB_TOPGEN   3392
#define XCD_BAR_WORDS 3456
#define XB_SPIN_CAP (1u << 18)

__device__ __forceinline__ unsigned xb_ld(unsigned* p)              { return __hip_atomic_load(p, __ATOMIC_RELAXED, __HIP_MEMORY_SCOPE_AGENT); }
__device__ __forceinline__ unsigned xb_add(unsigned* p, unsigned v) { return __hip_atomic_fetch_add(p, v, __ATOMIC_RELAXED, __HIP_MEMORY_SCOPE_AGENT); }
__device__ __forceinline__ unsigned xb_xcc_id() { return (unsigned)__builtin_amdgcn_s_getreg((3 << 11) | 20) & 0xFu; }
#define XB_SPIN(cond, bar) do { unsigned _sp = 0; while (cond) { __builtin_amdgcn_s_sleep(1); \
    if ((++_sp & 255u) == 0u) { if (xb_ld(&(bar)[XB_TMO])) break; if (_sp > XB_SPIN_CAP) { atomicAdd(&(bar)[XB_TMO], 1u); break; } } } } while (0)

struct XcdBarrier {
    unsigned* bar; unsigned x; bool w0;
    volatile LAS unsigned* st;
};

__device__ __forceinline__ XcdBarrier xcd_barrier_post(unsigned* bar, volatile LAS unsigned* st, bool w0) {
    XcdBarrier b; b.bar = bar; b.x = xb_xcc_id(); b.st = st; b.w0 = w0;
    if (w0 && hw_lane() == 0) (void)xb_add(&bar[XB_XCNT(b.x)], 1u);
    return b;
}
__device__ __forceinline__ void xcd_barrier_complete(unsigned* bar, unsigned x, unsigned& nloc, unsigned& nx) {
    const unsigned G = gridDim.x * gridDim.y * gridDim.z;
    unsigned sum, cnt, mine, sp = 0u;
    for (;;) {
        sum = 0u; cnt = 0u; mine = 0u;
#pragma unroll
        for (unsigned j = 0; j < 16; ++j) { const unsigned c = xb_ld(&bar[XB_XCNT(j)]); sum += c; cnt += (c > 0u) ? 1u : 0u; mine = (j == x) ? c : mine; }
        if (sum == G) break;
        __builtin_amdgcn_s_sleep(1);
        if ((++sp & 255u) == 0u) { if (xb_ld(&bar[XB_TMO])) break; if (sp > XB_SPIN_CAP) { atomicAdd(&bar[XB_TMO], 1u); break; } }
    }
    nloc = mine > 0u ? mine : 1u; nx = cnt > 0u ? cnt : 1u;
}

__device__ __forceinline__ void xcd_barrier(const XcdBarrier& b) {
    asm volatile("s_waitcnt vmcnt(0)" ::: "memory");
    __syncthreads();
    if (b.w0 && hw_lane() == 0) {
        unsigned* bar = b.bar;
        __builtin_amdgcn_s_waitcnt(0);
        unsigned nloc = b.st[0], nx = b.st[1];
        if (nloc == 0u) { xcd_barrier_complete(bar, b.x, nloc, nx); b.st[0] = nloc; b.st[1] = nx; }
        const unsigned old = xb_add(&bar[XB_XSUB(b.x)], 1u);
        const unsigned gen = old / nloc;
        if (old + 1u == (gen + 1u) * nloc) {
            __builtin_amdgcn_fence(__ATOMIC_RELEASE, "agent");
            asm volatile("s_waitcnt vmcnt(0)" ::: "memory");
            const unsigned og = xb_add(&bar[XB_TOP], 1u);
            const unsigned tg = og / nx;
            if (og + 1u == (tg + 1u) * nx) xb_add(&bar[XB_TOPGEN], 1u);
            else XB_SPIN(xb_ld(&bar[XB_TOPGEN]) == tg, bar);
            __builtin_amdgcn_fence(__ATOMIC_ACQUIRE, "agent");
            xb_add(&bar[XB_XGEN(b.x)], 1u);
            asm volatile("s_waitcnt vmcnt(0)" ::: "memory");
        } else {
            XB_SPIN(xb_ld(&bar[XB_XGEN(b.x)]) == gen, bar);
            __builtin_amdgcn_fence(__ATOMIC_ACQUIRE, "agent");
            asm volatile("s_waitcnt vmcnt(0)" ::: "memory");
        }
    }
    __syncthreads();
}

struct Frame {
    LAS unsigned char* lds;
    volatile LAS unsigned* MISC;
    unsigned* ctl;
    int wave, G, bid;
    __device__ __forceinline__ int lane() const { return hw_lane(); }
    __device__ __forceinline__ int tid() const { return wave * 64 + hw_lane(); }
    __device__ __forceinline__ const float* in(int i) const { const LAS unsigned* p = (const LAS unsigned*)(lds + PTR_OFF) + 2 * i;
        const unsigned lo = __builtin_amdgcn_readfirstlane(p[0]), hi = __builtin_amdgcn_readfirstlane(p[1]); return (const float*)(((unsigned long long)hi << 32) | lo); }
    float* out; unsigned char* ws;
    unsigned long long tacc; int xpass;
};
__device__ __forceinline__ float log2gamma(int h) { return log2f(1.0f - exp2f(-5.0f - (float)h)); }

template <bool F8, class RowMap>
__device__ __forceinline__ void transpose_item(const float* W, int N, bf16* WT, int K, const float* kscale, LAS float* scr, int kb, int nb, int lane, RowMap rm) {
    const int k0 = 64 * kb, n0 = 64 * nb;
#pragma unroll 4
    for (int i = 0; i < 16; ++i) {
        const int kk = 4 * i + (lane >> 4), nn = 4 * (lane & 15);
        f32x4 v = (f32x4){0.f, 0.f, 0.f, 0.f};
        if (n0 + nn < N) v = __builtin_nontemporal_load((const f32x4*)(W + (size_t)(k0 + kk) * N + n0 + nn));
        if (kscale) v = v * kscale[k0 + kk];
        LAS float* s = scr + kk * 65 + nn; s[0] = v[0]; s[1] = v[1]; s[2] = v[2]; s[3] = v[3];
    }
    asm volatile("s_waitcnt lgkmcnt(0)" ::: "memory");
    const int cch = lane & 7;
#pragma unroll
    for (int j = 0; j < 8; ++j) {
        const int n = 8 * j + (lane >> 3); const LAS float* s = scr + (8 * cch) * 65 + n;
        if constexpr (F8) {
            u32x2 o; o.x = pk4_fp8(s[0 * 65] * W8_SCALE, s[1 * 65] * W8_SCALE, s[2 * 65] * W8_SCALE, s[3 * 65] * W8_SCALE); o.y = pk4_fp8(s[4 * 65] * W8_SCALE, s[5 * 65] * W8_SCALE, s[6 * 65] * W8_SCALE, s[7 * 65] * W8_SCALE);
            if (n0 + n < N) *(u32x2*)((unsigned char*)WT + (size_t)rm(n0 + n) * K + k0 + 8 * cch) = o;
        } else {
        const float cs = (N == IN_COLS && n0 + n >= C_AQ && n0 + n < C_AK) ? 0.125f : 1.0f;
        u32x4 o; o.x = cvtpk(s[0 * 65] * cs, s[1 * 65] * cs); o.y = cvtpk(s[2 * 65] * cs, s[3 * 65] * cs); o.z = cvtpk(s[4 * 65] * cs, s[5 * 65] * cs); o.w = cvtpk(s[6 * 65] * cs, s[7 * 65] * cs);
        if (n0 + n < N) *(u32x4*)(WT + (size_t)rm(n0 + n) * K + k0 + 8 * cch) = o; }
    }
    asm volatile("s_waitcnt lgkmcnt(0)" ::: "memory");
}
__device__ __forceinline__ void f8_item_load(const float* W, int N, int kb, int nb, int lane, f32x4 (&v)[16]) {
    const int k0 = 128 * kb, n0 = 32 * nb;
#pragma unroll
    for (int i = 0; i < 16; ++i) v[i] = *(const f32x4*)(W + (size_t)(k0 + 8 * i + (lane >> 3)) * N + n0 + 4 * (lane & 7));
}
template <class RowMap>
__device__ __forceinline__ void f8_item_store(const f32x4 (&v)[16], unsigned char* WT, int K, LAS float* scr, int kb, int nb, int lane, RowMap rm) {
    const int k0 = 128 * kb, n0 = 32 * nb;
#pragma unroll
    for (int i = 0; i < 16; ++i) { const int kk = 8 * i + (lane >> 3), nn = 4 * (lane & 7); LAS float* s = scr + kk * 32;
        s[(nn + 0) ^ (kk & 31)] = v[i][0]; s[(nn + 1) ^ (kk & 31)] = v[i][1]; s[(nn + 2) ^ (kk & 31)] = v[i][2]; s[(nn + 3) ^ (kk & 31)] = v[i][3]; }
    asm volatile("s_waitcnt lgkmcnt(0)" ::: "memory");
    const int cch = lane & 7;
#pragma unroll
    for (int j = 0; j < 4; ++j) {
        const int n = 8 * j + (lane >> 3); float t[16];
#pragma unroll
        for (int i = 0; i < 16; ++i) { const int kk = 16 * cch + i; t[i] = scr[kk * 32 + (n ^ (kk & 31))] * W8_SCALE; }
        u32x4 o; o.x = pk4_fp8(t[0], t[1], t[2], t[3]); o.y = pk4_fp8(t[4], t[5], t[6], t[7]); o.z = pk4_fp8(t[8], t[9], t[10], t[11]); o.w = pk4_fp8(t[12], t[13], t[14], t[15]);
        *(u32x4*)(WT + (size_t)rm(n0 + n) * K + k0 + 16 * cch) = o;
    }
    asm volatile("s_waitcnt lgkmcnt(0)" ::: "memory");
}
struct RmId { __device__ __forceinline__ int operator()(int n) const { return n; } };
struct RmGu { __device__ __forceinline__ int operator()(int n) const { const int j = n & 1023; return (j >> 7) * 256 + (n >> 10) * 128 + (j & 127); } };

template <class RowMap>
__device__ __forceinline__ void f8_item_lowreg(const float* W, int N, unsigned char* WT, int K, LAS float* scr, int kb, int nb, int lane, RowMap rm, const float* kscale = nullptr) {
    const int k0 = 128 * kb, n0 = 32 * nb;
#pragma unroll 1
    for (int h = 0; h < 2; ++h) {
        f32x4 v[8];
#pragma unroll
        for (int i = 0; i < 8; ++i) { v[i] = __builtin_nontemporal_load((const f32x4*)(W + (size_t)(k0 + 64 * h + 8 * i + (lane >> 3)) * N + n0 + 4 * (lane & 7))); if (kscale) v[i] = v[i] * kscale[k0 + 64 * h + 8 * i + (lane >> 3)]; }
#pragma unroll
        for (int i = 0; i < 8; ++i) { const int kk = 64 * h + 8 * i + (lane >> 3), nn = 4 * (lane & 7); LAS float* s = scr + kk * 32;
            s[(nn + 0) ^ (kk & 31)] = v[i][0]; s[(nn + 1) ^ (kk & 31)] = v[i][1]; s[(nn + 2) ^ (kk & 31)] = v[i][2]; s[(nn + 3) ^ (kk & 31)] = v[i][3]; }
    }
    asm volatile("s_waitcnt lgkmcnt(0)" ::: "memory");
    const int cch = lane & 7;
#pragma unroll 1
    for (int j = 0; j < 4; ++j) {
        const int n = 8 * j + (lane >> 3); float t[16];
#pragma unroll
        for (int i = 0; i < 16; ++i) { const int kk = 16 * cch + i; t[i] = scr[kk * 32 + (n ^ (kk & 31))] * W8_SCALE; }
        u32x4 o; o.x = pk4_fp8(t[0], t[1], t[2], t[3]); o.y = pk4_fp8(t[4], t[5], t[6], t[7]); o.z = pk4_fp8(t[8], t[9], t[10], t[11]); o.w = pk4_fp8(t[12], t[13], t[14], t[15]);
        *(u32x4*)(WT + (size_t)rm(n0 + n) * K + k0 + 16 * cch) = o;
    }
    asm volatile("s_waitcnt lgkmcnt(0)" ::: "memory");
}
__device__ __forceinline__ void phase_p0a(Frame& F) {
    const float* const c_in = F.in(1); const float* const ada_w = F.in(2); const float* const ada_b = F.in(3); const float* const w_in = F.in(5); const float* const mix_scale = F.in(6);
    const float* const w_o = F.in(7); const float* const w_gu = F.in(11); const float* const w_down = F.in(13);
    if (F.bid < 96) {
        LAS float* sc = (LAS float*)F.lds;
        LAS float* part = (LAS float*)(F.lds + 16384);
        for (int i = F.tid(); i < 1024; i += NTHR) {
#pragma unroll
            for (int b = 0; b < 4; ++b) { const float cv = c_in[b * 1024 + i]; sc[i * 4 + b] = cv / (1.0f + __expf(-cv)); }
        }
        __syncthreads();
        const int j0 = F.bid * 64;
        { const int lane = F.lane(), kq = lane >> 4, cq = lane & 15; f32x4 acc4[4];
#pragma unroll
          for (int bb = 0; bb < 4; ++bb) acc4[bb] = (f32x4){0.f, 0.f, 0.f, 0.f};
#pragma unroll 8
          for (int ii = 0; ii < 32; ++ii) { const int i = F.wave * 128 + 4 * ii + kq;
              const f32x4 wv4 = __builtin_nontemporal_load((const f32x4*)(ada_w + (size_t)i * 6144 + j0 + 4 * cq)); const f32x4 s4 = *(const LAS f32x4*)(sc + i * 4);
#pragma unroll
              for (int bb = 0; bb < 4; ++bb) acc4[bb] = acc4[bb] + wv4 * s4[bb]; }
#pragma unroll
          for (int bb = 0; bb < 4; ++bb)
#pragma unroll
              for (int q = 0; q < 4; ++q) { float t = acc4[bb][q]; t += __shfl_xor(t, 16); t += __shfl_xor(t, 32); if (kq == 0) part[(F.wave * 4 + bb) * 64 + 4 * cq + q] = t; } }
        __syncthreads();
        if (F.tid() < 256) { const int b = F.tid() >> 6, l = F.tid() & 63; float s = ada_b[j0 + l];
#pragma unroll
            for (int w = 0; w < 8; ++w) s += part[(w * 4 + b) * 64 + l];
            ((float*)(F.ws + WS_MOD))[b * 6144 + j0 + l] = s; }
        __syncthreads();
    }
    { int* ri = (int*)(F.ws + WS_ROWINFO); for (int i = F.bid * NTHR + F.tid(); i < MOE_ROWS; i += F.G * NTHR) ri[i] = -1; }
    LAS float* scr = (LAS float*)(F.lds + F.wave * 16896);
    const int gw = F.bid * NWAVES + F.wave, NGW = F.G * NWAVES;
    constexpr int I_IN = 16 * 46, I_O = 16 * 16, I_GU = 32 * 16 * 32, I_DN = 32 * 16 * 16, NITEMS = I_IN + I_O + I_GU + I_DN;
    for (int it = (F.G >= 224 ? gw - 96 * NWAVES : gw); it >= 0 && it < I_IN + I_O; it += NGW) {
        int r = it;
        if (r < I_IN) { transpose_item<false>(w_in, IN_COLS, (bf16*)(F.ws + WS_WIN), 1024, nullptr, scr, r / 46, r % 46, F.lane(), RmId()); continue; } r -= I_IN;
        f8_item_lowreg(w_o, 1024, F.ws + WS_WO, 1024, scr, r / 32, r % 32, F.lane(), RmId(), mix_scale);
    }
}

constexpr int F8_I_GU = 32 * 8 * 64, F8_I_DN = 32 * 8 * 32, F8_ITEMS = F8_I_GU + F8_I_DN;
__device__ __forceinline__ int f8_burst(Frame& F, LAS float* scr, int it, int count) {
    const float* const w_gu = F.in(11); const float* const w_down = F.in(13);
    const int NGW = F.G * NWAVES, lane = F.lane();
    auto item_src = [&](int r, const float*& W, int& N, int& kb, int& nb) { if (r < F8_I_GU) { const int e = r / 512, q = r % 512; W = w_gu + (size_t)e * 1024 * 2048; N = 2048; kb = q / 64; nb = q % 64; }
                                                                             else { r -= F8_I_GU; const int e = r / 256, q = r % 256; W = w_down + (size_t)e * 1024 * 1024; N = 1024; kb = q / 32; nb = q % 32; } };
    asm volatile("" ::: "memory");
    for (int c = 0; c < count && it < F8_ITEMS; ++c) {
        const float* W; int N, kb, nb;
        item_src(it, W, N, kb, nb);
        if (it < F8_I_GU) f8_item_lowreg(W, N, F.ws + WS_WGU + (size_t)(it / 512) * 2048 * 1024, 1024, scr, kb, nb, lane, RmGu());
        else f8_item_lowreg(W, N, F.ws + WS_WDN + (size_t)((it - F8_I_GU) / 256) * 1024 * 1024, 1024, scr, kb, nb, lane, RmId());
        it += NGW;
        asm volatile("" ::: "memory");
    }
    asm volatile("" ::: "memory");
    return it;
}

__device__ __forceinline__ void phase_p0b(Frame& F) {
    const float* const x_in = F.in(0); const float* const norm1_g = F.in(4);
    const int gw = F.bid * NWAVES + F.wave, NGW = F.G * NWAVES, lane = F.lane();
    const float* mod = (const float*)(F.ws + WS_MOD); bf16* h0 = (bf16*)(F.ws + WS_H0);
    constexpr int RU = 4;
    for (int m = gw; m < NTOK / RU; m += NGW) {
        f32x4 v[RU][4]; float s[RU] = {0.f, 0.f, 0.f, 0.f};
#pragma unroll
        for (int u = 0; u < RU; ++u) { const f32x4* xr = (const f32x4*)(x_in + (size_t)(m + u * (NTOK / RU)) * DM) + lane;
#pragma unroll
            for (int j = 0; j < 4; ++j) v[u][j] = __builtin_nontemporal_load(xr + 64 * j); }
#pragma unroll
        for (int u = 0; u < RU; ++u)
#pragma unroll
            for (int j = 0; j < 4; ++j) s[u] += (v[u][j][0] * v[u][j][0] + v[u][j][1] * v[u][j][1]) + (v[u][j][2] * v[u][j][2] + v[u][j][3] * v[u][j][3]);
#pragma unroll
        for (int o = 1; o < 64; o <<= 1) {
#pragma unroll
            for (int u = 0; u < RU; ++u) s[u] += __shfl_xor(s[u], o); }
#pragma unroll
        for (int u = 0; u < RU; ++u) { const int mm = m + u * (NTOK / RU), b = mm / SEQ; const float rstd = rsqrtf(s[u] * (1.f / DM) + EPS);
            u32x2* o8 = (u32x2*)(h0 + (size_t)mm * DM) + lane;
#pragma unroll
            for (int j = 0; j < 4; ++j) { const int col = 4 * lane + 256 * j;
                const f32x4 g = *(const f32x4*)(norm1_g + col), sh = *(const f32x4*)(mod + b * 6144 + col), sc = *(const f32x4*)(mod + b * 6144 + 1024 + col);
                const f32x4 y = (v[u][j] * rstd) * g * (sc + 1.0f) + sh;
                u32x2 w; w.x = cvtpk(y[0], y[1]); w.y = cvtpk(y[2], y[3]); o8[64 * j] = w; } }
    }
}

constexpr int VSTR = 144, KSTR = 80;
__device__ __forceinline__ void ret_stage_v(Frame& F, const bf16* proj, int tok0, int h, LAS bf16* Vs) {
    const int row = F.tid() >> 2, q = F.tid() & 3; const bf16* src = proj + (size_t)(tok0 + row) * PJ + C_RV + h * 128 + q * 32;
#pragma unroll
    for (int i = 0; i < 4; ++i) *(LAS u32x4*)(Vs + row * VSTR + q * 32 + 8 * i) = *(const u32x4*)(src + 8 * i);
}
__device__ __forceinline__ void ret_stage64(Frame& F, const bf16* src0, size_t pitch, LAS bf16* Ds) {
    const int row = F.tid() >> 2, q = F.tid() & 3; const bf16* src = src0 + (size_t)row * pitch + q * 16;
#pragma unroll
    for (int i = 0; i < 2; ++i) *(LAS u32x4*)(Ds + row * KSTR + q * 16 + 8 * i) = *(const u32x4*)(src + 8 * i);
}
__device__ __forceinline__ void ret_a_item(Frame& F, int item) {
    const bf16* proj = (const bf16*)(F.ws + WS_PROJ); float* kvt = (float*)(F.ws + WS_KVT) + (size_t)item * 8192;
    const int bh = item >> 6, n = item & 63, b = bh >> 2, h = bh & 3, tok0 = b * SEQ + n * 128;
    LAS bf16* Vs = (LAS bf16*)F.lds; LAS bf16* Ks = (LAS bf16*)(F.lds + 128 * VSTR * 2);
    const float lg = log2gamma(h);
    ret_stage_v(F, proj, tok0, h, Vs);
    { const int row = F.tid() >> 2, q = F.tid() & 3; const bf16* src = proj + (size_t)(tok0 + row) * PJ + C_RK + h * 64 + q * 16; const float dk = 0.125f * exp2f((float)(127 - row) * lg);
#pragma unroll
      for (int i = 0; i < 2; ++i) { const u32x4 w = *(const u32x4*)(src + 8 * i); u32x4 o;
          o.x = cvtpk(bflo(w.x) * dk, bfhi(w.x) * dk); o.y = cvtpk(bflo(w.y) * dk, bfhi(w.y) * dk); o.z = cvtpk(bflo(w.z) * dk, bfhi(w.z) * dk); o.w = cvtpk(bflo(w.w) * dk, bfhi(w.w) * dk);
          *(LAS u32x4*)(Ks + row * KSTR + q * 16 + 8 * i) = o; } }
    __syncthreads();
    const int lane = F.lane(), n16 = lane & 15, c = lane >> 4, q4 = n16 >> 2, p4 = lane & 3, e0 = 16 * F.wave;
    f32x4 acc[4];
#pragma unroll
    for (int dt = 0; dt < 4; ++dt) acc[dt] = (f32x4){0.f, 0.f, 0.f, 0.f};
#pragma unroll
    for (int s = 0; s < 4; ++s) {
        const LAS bf16* ap = Vs + (32 * s + 4 * c + q4) * VSTR + e0 + 4 * p4;
        const bf16x8 A = cat8(trread(ap), trread(ap + 16 * VSTR));
#pragma unroll
        for (int dt = 0; dt < 4; ++dt) { const LAS bf16* bp = Ks + (32 * s + 4 * c + q4) * KSTR + 16 * dt + 4 * p4;
            const bf16x8 B = cat8(trread(bp), trread(bp + 16 * KSTR)); acc[dt] = MFMA16(A, B, acc[dt]); }
    }
#pragma unroll
    for (int dt = 0; dt < 4; ++dt)
#pragma unroll
        for (int r = 0; r < 4; ++r) kvt[(e0 + 4 * c + r) * 64 + 16 * dt + n16] = acc[dt][r];
    __syncthreads();
}
__device__ __forceinline__ void ret_scan(Frame& F) {
    const float* kvt = (const float*)(F.ws + WS_KVT); bf16* rpt = (bf16*)(F.ws + WS_RPT);
    for (int g = F.bid * NTHR + F.tid(); g < 16 * 8192; g += F.G * NTHR) {
        const int bh = g >> 13, ed = g & 8191, h = bh & 3; const float gC = exp2f(128.0f * log2gamma(h));
        float R = 0.f; const size_t base = (size_t)bh * 64 * 8192 + ed;
#pragma unroll 8
        for (int n = 0; n < 64; ++n) { const float kv = kvt[base + (size_t)n * 8192]; rpt[base + (size_t)n * 8192] = f2bf(R); R = R * gC + kv; }
    }
}
__device__ __forceinline__ void ret_c_item(Frame& F, int item) {
    const bf16* proj = (const bf16*)(F.ws + WS_PROJ); const bf16* rpt = (const bf16*)(F.ws + WS_RPT) + (size_t)item * 8192; bf16* mix = (bf16*)(F.ws + WS_MIX);
    const int bh = item >> 6, n = item & 63, b = bh >> 2, h = bh & 3, tok0 = b * SEQ + n * 128;
    LAS bf16* Qs = (LAS bf16*)F.lds; LAS bf16* Ks = Qs + 128 * KSTR; LAS bf16* Vs = Ks + 128 * KSTR; LAS bf16* Rs = Vs + 128 * VSTR;
    const float lg = log2gamma(h);
    ret_stage64(F, proj + (size_t)tok0 * PJ + C_RQ + h * 64, PJ, Qs);
    ret_stage64(F, proj + (size_t)tok0 * PJ + C_RK + h * 64, PJ, Ks);
    ret_stage_v(F, proj, tok0, h, Vs);
    ret_stage64(F, rpt, 64, Rs);
    __syncthreads();
    const int lane = F.lane(), n16 = lane & 15, c = lane >> 4, q4 = n16 >> 2, p4 = lane & 3, w = F.wave, i0 = 16 * w, il = i0 + n16;
    bf16x8 qf[2];
#pragma unroll
    for (int s = 0; s < 2; ++s) qf[s] = *(const LAS bf16x8*)(Qs + il * KSTR + 32 * s + 8 * c);
    f32x4 oin[8], ocr[8];
#pragma unroll
    for (int et = 0; et < 8; ++et) { oin[et] = (f32x4){0.f, 0.f, 0.f, 0.f}; ocr[et] = (f32x4){0.f, 0.f, 0.f, 0.f}; }
    const int nsp = (w >> 1) + 1;
    for (int sp = 0; sp < nsp; ++sp) {
        unsigned pw[4];
#pragma unroll
        for (int t2 = 0; t2 < 2; ++t2) { const int jt = 2 * sp + t2;
            const bf16x8 k0 = *(const LAS bf16x8*)(Ks + (16 * jt + n16) * KSTR + 8 * c), k1 = *(const LAS bf16x8*)(Ks + (16 * jt + n16) * KSTR + 32 + 8 * c);
            f32x4 st = MFMA16(k0, qf[0], ((f32x4){0.f, 0.f, 0.f, 0.f})); st = MFMA16(k1, qf[1], st);
            float pv[4];
#pragma unroll
            for (int r = 0; r < 4; ++r) { const int j = 16 * jt + 4 * c + r; const float f = (il >= j) ? 0.125f * exp2f((float)(il - j) * lg) : 0.f; pv[r] = st[r] * f; }
            pw[2 * t2] = cvtpk(pv[0], pv[1]); pw[2 * t2 + 1] = cvtpk(pv[2], pv[3]); }
        const bf16x8 P = __builtin_bit_cast(bf16x8, ((u32x4){pw[0], pw[1], pw[2], pw[3]}));
#pragma unroll
        for (int et = 0; et < 8; ++et) { const LAS bf16* ap = Vs + (32 * sp + 4 * c + q4) * VSTR + 16 * et + 4 * p4;
            const bf16x8 A = cat8(trread(ap), trread(ap + 16 * VSTR)); oin[et] = MFMA16(A, P, oin[et]); }
    }
#pragma unroll
    for (int et = 0; et < 8; ++et)
#pragma unroll
        for (int s = 0; s < 2; ++s) { const bf16x8 rf = *(const LAS bf16x8*)(Rs + (16 * et + n16) * KSTR + 32 * s + 8 * c); ocr[et] = MFMA16(rf, qf[s], ocr[et]); }
    const float qd = exp2f((float)(il + 1) * lg);
    float ss = 0.f;
#pragma unroll
    for (int et = 0; et < 8; ++et) { oin[et] = oin[et] + ocr[et] * qd; ss += (oin[et][0] * oin[et][0] + oin[et][1] * oin[et][1]) + (oin[et][2] * oin[et][2] + oin[et][3] * oin[et][3]); }
    ss += __shfl_xor(ss, 16); ss += __shfl_xor(ss, 32);
    const float rstd = rsqrtf(ss * (1.f / 128.f) + EPS);
    const bf16* gp = proj + (size_t)(tok0 + il) * PJ + C_RG + h * 128 + 4 * c; unsigned char* op = (unsigned char*)mix + (size_t)(tok0 + il) * DM + h * 128 + 4 * c;
#pragma unroll
    for (int et = 0; et < 8; ++et) { const u32x2 gw = *(const u32x2*)(gp + 16 * et);
        const float g0 = bflo(gw.x), g1 = bfhi(gw.x), g2 = bflo(gw.y), g3 = bfhi(gw.y);
        const float y0 = g0 / (1.f + __expf(-g0)) * (oin[et][0] * rstd), y1 = g1 / (1.f + __expf(-g1)) * (oin[et][1] * rstd), y2 = g2 / (1.f + __expf(-g2)) * (oin[et][2] * rstd), y3 = g3 / (1.f + __expf(-g3)) * (oin[et][3] * rstd);
        *(unsigned*)(op + 16 * et) = pk4_fp8(y0, y1, y2, y3); }
    __syncthreads();
}

constexpr int MTW = 2;
constexpr int RPW = 4 * MTW, QT = 8 * RPW, KT = 64, CAP = 131072 / (QT * 4), CAP_TRIG = CAP - KT, NSEL = 256, NREG = CAP / 64;
constexpr int KTS = 72;
constexpr int CAND_BYTES = QT * CAP * 4, KTILE_BYTES = KT * KTS * 2;
constexpr float WSCALE = 0.125f * 0.35355339059327373f;
__device__ __forceinline__ unsigned fmap(float s) { const unsigned u = __builtin_bit_cast(unsigned, s); return (u & 0x80000000u) ? ~u : (u | 0x80000000u); }
__device__ __forceinline__ float funmap(unsigned m) { const unsigned u = (m & 0x80000000u) ? (m ^ 0x80000000u) : ~m; return __builtin_bit_cast(float, u); }
#define DPP_ROR(v, n) ((unsigned)__builtin_amdgcn_update_dpp(0, (int)(v), 0x120 + (n), 0xf, 0xf, false))
#define DPP_SHR0(v, n) ((unsigned)__builtin_amdgcn_update_dpp(0, (int)(v), 0x110 + (n), 0xf, 0xf, true))
__device__ __forceinline__ unsigned wave_umin(unsigned v) {
    v = min(v, DPP_ROR(v, 1)); v = min(v, DPP_ROR(v, 2)); v = min(v, DPP_ROR(v, 4)); v = min(v, DPP_ROR(v, 8));
    const unsigned a = __builtin_amdgcn_readlane(v, 0), b = __builtin_amdgcn_readlane(v, 16), c = __builtin_amdgcn_readlane(v, 32), d = __builtin_amdgcn_readlane(v, 48);
    return min(min(a, b), min(c, d));
}
__device__ __forceinline__ unsigned wave_umax(unsigned v) {
    v = max(v, DPP_ROR(v, 1)); v = max(v, DPP_ROR(v, 2)); v = max(v, DPP_ROR(v, 4)); v = max(v, DPP_ROR(v, 8));
    const unsigned a = __builtin_amdgcn_readlane(v, 0), b = __builtin_amdgcn_readlane(v, 16), c = __builtin_amdgcn_readlane(v, 32), d = __builtin_amdgcn_readlane(v, 48);
    return max(max(a, b), max(c, d));
}
__device__ __forceinline__ unsigned wave_scan_incl(unsigned v, int lane) {
    v += DPP_SHR0(v, 1); v += DPP_SHR0(v, 2); v += DPP_SHR0(v, 4); v += DPP_SHR0(v, 8);
    const unsigned t0 = __builtin_amdgcn_readlane(v, 15), t1 = __builtin_amdgcn_readlane(v, 31), t2 = __builtin_amdgcn_readlane(v, 47);
    const int rw = lane >> 4;
    return v + (rw == 1 ? t0 : rw == 2 ? t0 + t1 : rw == 3 ? t0 + t1 + t2 : 0u);
}
__device__ __forceinline__ unsigned lt01(int a, int b) { unsigned r; asm("v_sub_u32 %0, %1, %2\n\tv_lshrrev_b32 %0, 31, %0" : "=&v"(r) : "v"(a), "v"(b)); return r; }
#define BIT01(m, j) ({ unsigned _r; asm("v_bfe_u32 %0, %1, %2, 1" : "=v"(_r) : "v"(m), "n"(j)); _r; })
#define LT01(a, b) lt01((int)(a), (int)(b))
__device__ __forceinline__ int select_row(LAS unsigned* row, int cnt, int limit, LAS unsigned* hist, LAS unsigned* trashp, int lane, unsigned& minkey, int need0 = NSEL) {
    unsigned e[NREG]; unsigned act = 0u, keep = 0u;
#pragma unroll
    for (int j = 0; j < NREG; ++j) { const unsigned v = LT01(64 * j + lane, cnt); e[j] = row[64 * j + lane] & (0u - v); act |= v << j; }
    int need = need0; bool first = true;
    for (;;) {
        unsigned lo = 0xFFFFFFFFu, hi = 0u;
#pragma unroll
        for (int j = 0; j < NREG; ++j) { const unsigned a = BIT01(act, j); lo = min(lo, e[j] | (a - 1u)); hi = max(hi, e[j] & (0u - a)); }
        lo = wave_umin(lo); hi = wave_umax(hi);
        if (hi == lo) break;
        hist[lane] = 0u;
        int rb[NREG];
        if (first) {
            const float slo = funmap(lo & 0xFFFFE000u), shi = funmap(hi & 0xFFFFE000u);
            const float scale = (shi > slo) ? 63.999f / (shi - slo) : 0.f;
#pragma unroll
            for (int j = 0; j < NREG; ++j) { const int bn = (int)((funmap(e[j] & 0xFFFFE000u) - slo) * scale); rb[j] = 63 - min(max(bn, 0), 63); }
        } else {
            const float scale = 63.999f / (float)(hi - lo);
#pragma unroll
            for (int j = 0; j < NREG; ++j) { const int bn = (int)((float)(e[j] - lo) * scale); rb[j] = 63 - min(max(bn, 0), 63); }
        }
        first = false;
#pragma unroll
        for (int j = 0; j < NREG; ++j) __hip_atomic_fetch_add(hist + rb[j], BIT01(act, j), __ATOMIC_RELAXED, __HIP_MEMORY_SCOPE_WAVEFRONT);
        const unsigned h = hist[lane];
        const unsigned ps = wave_scan_incl(h, lane);
        const unsigned long long m = __ballot(ps >= (unsigned)need);
        const int ls = (int)__builtin_ctzll(m);
        const int cge = (int)__builtin_amdgcn_readlane(ps, ls), nb = (int)__builtin_amdgcn_readlane(h, ls);
#pragma unroll
        for (int j = 0; j < NREG; ++j) { const unsigned a = BIT01(act, j), kp = a & LT01(rb[j], ls), dr = a & LT01(ls, rb[j]); keep |= kp << j; act &= ~((kp | dr) << j); }
        need -= cge - nb;
        if ((need0 - need) + nb <= limit) break;
    }
    keep |= act;
    const unsigned kcnt = (unsigned)__builtin_popcount(keep); const unsigned incl = wave_scan_incl(kcnt, lane);
    int pos = (int)(incl - kcnt); const int run = (int)__builtin_amdgcn_readlane(incl, 63); unsigned mk = 0xFFFFFFFFu;
#pragma unroll
    for (int j = 0; j < NREG; ++j) { const unsigned k = BIT01(keep, j);
        *(trashp + ((int)((row + pos) - trashp) & -(int)k)) = e[j];
        mk = min(mk, e[j] | (k - 1u)); pos += (int)k; }
    minkey = wave_umin(mk);
    return run;
}
__device__ __forceinline__ int compact_stream(LAS unsigned* row, int cnt, LAS unsigned* hist, LAS unsigned* trashp, int lane, float& thrf) {
    unsigned e[NREG];
#pragma unroll
    for (int j = 0; j < NREG; ++j) e[j] = row[64 * j + lane];
    const unsigned lo = wave_umin(min(e[0], e[1])), hi = wave_umax(max(e[0], e[1]));
    const float slo = funmap(lo & 0xFFFFE000u), shi = funmap(hi & 0xFFFFE000u);
    bool ok = shi > slo; int newcnt = 0, bstar = 0; int bn[NREG]; float scale = 0.f;
    if (ok) {
        scale = 63.999f / (shi - slo);
        hist[lane] = 0u;
#pragma unroll
        for (int j = 0; j < NREG; ++j) { const int b = (int)((funmap(e[j] & 0xFFFFE000u) - slo) * scale); bn[j] = min(max(b, 0), 63);
            __hip_atomic_fetch_add(hist + (63 - bn[j]), LT01(64 * j + lane, cnt), __ATOMIC_RELAXED, __HIP_MEMORY_SCOPE_WAVEFRONT); }
        const unsigned h = hist[lane];
        const unsigned ps = wave_scan_incl(h, lane);
        const unsigned long long m = __ballot(ps >= (unsigned)NSEL);
        const int ls = (int)__builtin_ctzll(m);
        newcnt = (int)__builtin_amdgcn_readlane(ps, ls); bstar = 63 - ls;
        ok = newcnt <= NSEL + 96;
    }
    if (!ok) { unsigned P; const int nc = select_row(row, cnt, NSEL + 64, hist, trashp, lane, P); thrf = funmap(P & 0xFFFFE000u); return nc; }
    unsigned keep = 0u;
#pragma unroll
    for (int j = 0; j < NREG; ++j) keep |= (LT01(64 * j + lane, cnt) & LT01(bstar - 1, bn[j])) << j;
    const unsigned kcnt = (unsigned)__builtin_popcount(keep); const unsigned incl = wave_scan_incl(kcnt, lane);
    int pos = (int)(incl - kcnt); const int run = (int)__builtin_amdgcn_readlane(incl, 63);
#pragma unroll
    for (int j = 0; j < NREG; ++j) { const unsigned k = BIT01(keep, j);
        *(trashp + ((int)((row + pos) - trashp) & -(int)k)) = e[j];
        pos += (int)k; }
    if (bstar > 0) thrf = slo + ((float)bstar - 0.01f) / scale;
    return run;
}
__device__ __forceinline__ int select_final(LAS unsigned* row, int cnt, LAS unsigned* hist, LAS unsigned* trashp, int lane) {
    unsigned e[NREG];
#pragma unroll
    for (int j = 0; j < NREG; ++j) e[j] = row[64 * j + lane] & (0u - LT01(64 * j + lane, cnt));
    const unsigned lo = wave_umin(min(e[0], e[1])), hi = wave_umax(max(e[0], e[1]));
    const float slo = funmap(lo & 0xFFFFE000u), shi = funmap(hi & 0xFFFFE000u);
    bool ok = shi > slo; int nb = 0, bstar = 0, cgt = 0; int bn[NREG];
    if (ok) {
        const float scale = 63.999f / (shi - slo);
        hist[lane] = 0u;
#pragma unroll
        for (int j = 0; j < NREG; ++j) { const int b = (int)((funmap(e[j] & 0xFFFFE000u) - slo) * scale); bn[j] = min(max(b, 0), 63);
            __hip_atomic_fetch_add(hist + (63 - bn[j]), LT01(64 * j + lane, cnt), __ATOMIC_RELAXED, __HIP_MEMORY_SCOPE_WAVEFRONT); }
        const unsigned h = hist[lane];
        const unsigned ps = wave_scan_incl(h, lane);
        const unsigned long long m = __ballot(ps >= (unsigned)NSEL);
        const int ls = (int)__builtin_ctzll(m);
        nb = (int)__builtin_amdgcn_readlane(h, ls); cgt = (int)__builtin_amdgcn_readlane(ps, ls) - nb; bstar = 63 - ls;
        ok = nb <= 64;
    }
    if (!ok) { unsigned P; return select_row(row, cnt, NSEL, hist, trashp, lane, P); }
    unsigned keepm = 0u, bndm = 0u;
#pragma unroll
    for (int j = 0; j < NREG; ++j) { const unsigned v = LT01(64 * j + lane, cnt); keepm |= (v & LT01(bstar, bn[j])) << j; bndm |= (v & (1u - LT01(bstar, bn[j])) & (1u - LT01(bn[j], bstar))) << j; }
    { const unsigned bc = (unsigned)__builtin_popcount(bndm); int bp = (int)(wave_scan_incl(bc, lane) - bc);
#pragma unroll
      for (int j = 0; j < NREG; ++j) { const unsigned k = BIT01(bndm, j); *(trashp + ((int)((hist + bp) - trashp) & -(int)k)) = e[j]; bp += (int)k; } }
    const unsigned x = hist[lane] & (0u - LT01(lane, nb));
    int rank = 0;
    for (int i = 0; i < nb; ++i) rank += (int)(hist[i] > x);
    const int needb = NSEL - cgt;
    { const unsigned kc = (unsigned)__builtin_popcount(keepm); int pos = (int)(wave_scan_incl(kc, lane) - kc);
#pragma unroll
      for (int j = 0; j < NREG; ++j) { const unsigned k = BIT01(keepm, j); *(trashp + ((int)((row + pos) - trashp) & -(int)k)) = e[j]; pos += (int)k; } }
    { const unsigned k = LT01(lane, nb) & LT01(rank, needb); *(trashp + ((int)((row + cgt + rank) - trashp) & -(int)k)) = x; }
    return NSEL;
}
__device__ __forceinline__ float sample_threshold(const LAS unsigned* row, int cnt, int rank, LAS unsigned* hist, int lane) {
    unsigned e[NREG];
#pragma unroll
    for (int j = 0; j < NREG; ++j) e[j] = row[64 * j + lane];
    unsigned lo = 0xFFFFFFFFu, hi = 0u;
#pragma unroll
    for (int j = 0; j < NREG; ++j) { const unsigned v = LT01(64 * j + lane, cnt); lo = min(lo, e[j] | (v - 1u)); hi = max(hi, e[j] & (0u - v)); }
    lo = wave_umin(lo); hi = wave_umax(hi);
    const float slo = funmap(lo & 0xFFFFE000u), shi = funmap(hi & 0xFFFFE000u);
    if (!(shi > slo)) return -INFINITY;
    const float scale = 63.999f / (shi - slo);
    hist[lane] = 0u;
#pragma unroll
    for (int j = 0; j < NREG; ++j) { const int b = (int)((funmap(e[j] & 0xFFFFE000u) - slo) * scale);
        __hip_atomic_fetch_add(hist + (63 - min(max(b, 0), 63)), LT01(64 * j + lane, cnt), __ATOMIC_RELAXED, __HIP_MEMORY_SCOPE_WAVEFRONT); }
    const unsigned ps = wave_scan_incl(hist[lane], lane);
    const int bstar = 63 - (int)__builtin_ctzll(__ballot(ps >= (unsigned)rank));
    return bstar > 0 ? slo + ((float)bstar - 0.01f) / scale : -INFINITY;
}
#if defined(PROBE_SUB)
#define PSUB_T(i) do { const unsigned long long _t = __builtin_amdgcn_s_memrealtime(); if ((i) == PROBE_SUB) F.tacc += _t - psub_last; psub_last = _t; } while (0)
#else
#define PSUB_T(i) do { } while (0)
#endif
#ifndef DSA_EXP
#define DSA_EXP 0
#endif
#define DSA_X(bit) (F.xpass != 0 && (DSA_EXP & (bit)))
__device__ __forceinline__ void dsa_a_wave(Frame& F, int b, int qt, int ws) {
#if defined(PROBE_SUB)
    unsigned long long psub_last = 0ull;
#endif
    const bf16* proj = (const bf16*)(F.ws + WS_PROJ); bf16* sel = (bf16*)(F.ws + WS_SEL);
    LAS unsigned* cand = (LAS unsigned*)F.lds;
    LAS unsigned* hist = (LAS unsigned*)(F.lds + CAND_BYTES) + 64 * F.wave;
    LAS int* rowcnt = (LAS int*)(F.lds + CAND_BYTES + 2048); LAS float* rowthr = (LAS float*)(F.lds + CAND_BYTES + 2048 + 256);
    const int lane = F.lane(), w = F.wave, r32 = lane & 31, hi = lane >> 5;
    const int trash = (CAND_BYTES + 2048 + 512) / 4 + 64 * w + lane;
    const int tokb = b * SEQ, q0 = qt * QT + RPW * ws;
    bf16x8 af[MTW][4]; float wv[MTW][16];
    { const int qq = 2 * ((r32 >> 2) & 1) + (r32 >> 4), hd = ((r32 >> 3) & 1) * 4 + (r32 & 3);
#pragma unroll
      for (int mt = 0; mt < MTW; ++mt) { const bf16* qp = proj + (size_t)(tokb + q0 + 4 * mt + qq) * PJ + C_IQ + hd * 64 + 32 * hi;
#pragma unroll
          for (int s = 0; s < 4; ++s) af[mt][s] = *(const bf16x8*)(qp + 8 * s);
#pragma unroll
          for (int u = 0; u < 2; ++u) { const u32x4 ww = *(const u32x4*)(proj + (size_t)(tokb + q0 + 4 * mt + 2 * hi + u) * PJ + C_IW);
              wv[mt][8 * u + 0] = bflo(ww.x) * WSCALE; wv[mt][8 * u + 1] = bfhi(ww.x) * WSCALE; wv[mt][8 * u + 2] = bflo(ww.y) * WSCALE; wv[mt][8 * u + 3] = bfhi(ww.y) * WSCALE;
              wv[mt][8 * u + 4] = bflo(ww.z) * WSCALE; wv[mt][8 * u + 5] = bfhi(ww.z) * WSCALE; wv[mt][8 * u + 6] = bflo(ww.w) * WSCALE; wv[mt][8 * u + 7] = bfhi(ww.w) * WSCALE; } } }
    float thrf[MTW][2]; int cntv[MTW][2];
    if (lane < RPW) { rowcnt[RPW * w + lane] = 0; rowthr[RPW * w + lane] = -INFINITY; }
    const int NT = (q0 + RPW + KT - 1) / KT;
    const char* kbase = (const char*)(proj + (size_t)tokb * PJ + C_IK + 32 * hi);
    const unsigned koff = (unsigned)r32 * (unsigned)(PJ * 2);
    constexpr int SSTR = 16, SOFF = 7, SRANK = 40;
    for (int pass = (NT >= 2 * SSTR ? 0 : 1); pass < 3; ++pass) {
        const int stride = pass == 0 ? SSTR : 1, kt0 = pass == 0 ? SOFF : 0;
#pragma unroll
        for (int mt = 0; mt < MTW; ++mt)
#pragma unroll
            for (int u = 0; u < 2; ++u) { cntv[mt][u] = 0; thrf[mt][u] = pass == 1 ? rowthr[RPW * w + 4 * mt + 2 * hi + u] : -INFINITY; }
        bf16x8 kc[2][4], kn[2][4];
        { const char* kb0 = kbase + (size_t)kt0 * KT * (PJ * 2);
#pragma unroll
          for (int sub = 0; sub < 2; ++sub)
#pragma unroll
              for (int s = 0; s < 4; ++s) kc[sub][s] = *(const bf16x8*)(kb0 + koff + (unsigned)(sub * 32) * (unsigned)(PJ * 2) + 16 * s); }
        auto tile_step = [&](int kt, bf16x8 (&kc)[2][4], bf16x8 (&kn)[2][4]) {
            PSUB_T(0);
            const char* kb1 = kbase + (size_t)(kt + stride) * KT * (PJ * 2);
#pragma unroll
            for (int sub = 0; sub < 2; ++sub) {
                if (kt + stride < NT) {
#pragma unroll
                    for (int s = 0; s < 4; ++s) kn[sub][s] = *(const bf16x8*)(kb1 + koff + (unsigned)(sub * 32) * (unsigned)(PJ * 2) + 16 * s); }
                const int key = kt * KT + sub * 32 + r32;
                f32x16 accs[MTW];
#pragma unroll
                for (int mt = 0; mt < MTW; ++mt) {
                    accs[mt] = MFMA32(af[mt][0], kc[sub][0], ((f32x16){0.f, 0.f, 0.f, 0.f, 0.f, 0.f, 0.f, 0.f, 0.f, 0.f, 0.f, 0.f, 0.f, 0.f, 0.f, 0.f}));
#pragma unroll
                    for (int s = 1; s < 4; ++s) accs[mt] = MFMA32(af[mt][s], kc[sub][s], accs[mt]);
                }
#pragma unroll
                for (int mt = 0; mt < MTW; ++mt) {
                    float sc[2] = {0.f, 0.f};
#pragma unroll
                    for (int r = 0; r < 16; ++r) sc[r >> 3] += wv[mt][r] * fmaxf(accs[mt][r], 0.f);
#pragma unroll
                    for (int u = 0; u < 2; ++u) {
                        const int ql = RPW * w + 4 * mt + 2 * hi + u;
                        const bool valid = (sc[u] >= thrf[mt][u]) && (key <= q0 + 4 * mt + 2 * hi + u);
                        const unsigned long long m = __ballot(valid);
                        const int nlo = __builtin_popcount((unsigned)m), nhi = __builtin_popcount((unsigned)(m >> 32));
                        const int off = mbcnt64(m) - (hi ? nlo : 0);
                        cand[valid ? ql * CAP + cntv[mt][u] + off : trash] = (fmap(sc[u]) & 0xFFFFE000u) | (unsigned)(8191 - key);
                        cntv[mt][u] += hi ? nhi : nlo;
                    }
                }
            }
            PSUB_T(1);
            bool anyc = false;
#pragma unroll
            for (int mt = 0; mt < MTW; ++mt)
#pragma unroll
                for (int u = 0; u < 2; ++u) anyc = anyc || (cntv[mt][u] > CAP_TRIG);
            if (__any(anyc)) {
                if ((lane & 31) == 0) {
#pragma unroll
                    for (int mt = 0; mt < MTW; ++mt)
#pragma unroll
                        for (int u = 0; u < 2; ++u) { rowcnt[RPW * w + 4 * mt + 2 * hi + u] = cntv[mt][u]; rowthr[RPW * w + 4 * mt + 2 * hi + u] = thrf[mt][u]; }
                }
#pragma unroll 1
                for (int rr = 0; rr < RPW; ++rr) { const int rowi = RPW * w + rr; const int cq = __builtin_amdgcn_readfirstlane(rowcnt[rowi]);
                    if (cq > NSEL + 64) { float tf = rowthr[rowi]; const int nc = compact_stream(cand + rowi * CAP, cq, hist, cand + trash, lane, tf);
                        if (lane == 0) { rowcnt[rowi] = nc; rowthr[rowi] = tf; } } }
#pragma unroll
                for (int mt = 0; mt < MTW; ++mt)
#pragma unroll
                    for (int u = 0; u < 2; ++u) { cntv[mt][u] = rowcnt[RPW * w + 4 * mt + 2 * hi + u]; thrf[mt][u] = rowthr[RPW * w + 4 * mt + 2 * hi + u]; }
            }
            PSUB_T(7);
        };
        for (int kt = kt0; kt < NT; kt += 2 * stride) { tile_step(kt, kc, kn); if (kt + stride < NT) tile_step(kt + stride, kn, kc); }
        if ((lane & 31) == 0) {
#pragma unroll
            for (int mt = 0; mt < MTW; ++mt)
#pragma unroll
                for (int u = 0; u < 2; ++u) rowcnt[RPW * w + 4 * mt + 2 * hi + u] = cntv[mt][u];
        }
        if (pass == 0) {
#pragma unroll 1
            for (int rr = 0; rr < RPW; ++rr) { const int rowi = RPW * w + rr; const int cq = __builtin_amdgcn_readfirstlane(rowcnt[rowi]); float tf = -INFINITY;
                if (cq > SRANK + 8) tf = sample_threshold(cand + rowi * CAP, cq, SRANK, hist, lane);
                if (lane == 0) rowthr[rowi] = tf; }
        } else {
            bool okall = true;
#pragma unroll 1
            for (int rr = 0; rr < RPW; ++rr) { const int cq = __builtin_amdgcn_readfirstlane(rowcnt[RPW * w + rr]); const int nrow = q0 + rr + 1; okall = okall && (cq >= (nrow < NSEL ? nrow : NSEL)); }
            if (okall) break;
        }
    }
    PSUB_T(5);
#pragma unroll 1
    for (int rr = 0; rr < RPW; ++rr) { const int ql = RPW * w + rr; LAS unsigned* row = cand + ql * CAP; int cq = __builtin_amdgcn_readfirstlane(rowcnt[ql]);
        if (cq > NSEL) cq = select_final(row, cq, hist, cand + trash, lane);
        bf16* so = sel + (size_t)(tokb + q0 + rr) * NSEL;
#pragma unroll
        for (int j = 0; j < 4; ++j) { const int p = 64 * j + lane; const unsigned v = row[p]; so[p] = (p < cq) ? (bf16)(8191u - (v & 0x1FFFu)) : (bf16)0; } }
    PSUB_T(6);
}

constexpr int VROW = 144;
constexpr int DSB_WAVE = 32 * VROW * 2 + 2 * 2048;
static_assert(8 * DSB_WAVE <= MISC_OFF, "DSA-B LDS map");
__device__ __forceinline__ void dsb_gather(const char* kvbase, const LAS unsigned* sl, int chunk, int colbyte, int c, int n16, u32x4 (&r)[8]) {
#pragma unroll
    for (int i = 0; i < 8; ++i) { const unsigned o = sl[32 * chunk + 4 * i + c] + (unsigned)(colbyte + n16 * 16); r[i] = *(const u32x4*)(kvbase + o); }
}
__device__ __forceinline__ void dsb_put_list(LAS unsigned* sl, u32x2 kk, int t, int lane) {
    const unsigned k0 = kk.x & 0xffffu, k1 = kk.x >> 16, k2 = kk.y & 0xffffu, k3 = kk.y >> 16;
    *(LAS u32x4*)(sl + 4 * lane) = (u32x4){k0 * (unsigned)(PJ * 2), k1 * (unsigned)(PJ * 2), k2 * (unsigned)(PJ * 2), k3 * (unsigned)(PJ * 2)};
    *(LAS f32x4*)((LAS float*)(sl + 256) + 4 * lane) = (f32x4){(float)(t - (int)k0), (float)(t - (int)k1), (float)(t - (int)k2), (float)(t - (int)k3)};
}
__device__ __forceinline__ void phase_dsa_b(Frame& F) {
    const bf16* proj = (const bf16*)(F.ws + WS_PROJ); const bf16* sel = (const bf16*)(F.ws + WS_SEL); bf16* mix = (bf16*)(F.ws + WS_MIX);
    const int lane = F.lane(), n16 = lane & 15, c = lane >> 4, q4 = n16 >> 2, p4 = lane & 3, w = F.wave;
    LAS unsigned char* wl = F.lds + w * DSB_WAVE;
    LAS bf16* buf = (LAS bf16*)wl; LAS unsigned* slb = (LAS unsigned*)(wl + 32 * VROW * 2);
    const float nslope[2] = {-exp2f(-(float)((n16 & 3) + 1)), -exp2f(-(float)((n16 & 3) + 5))};
    constexpr float L2E = 1.4426950408889634f;
    for (int blk = F.bid; blk < NTOK / 128; blk += F.G) {
        int T0 = blk * 128;
        if (F.G == 256) { const int x = F.bid & 7, jj = F.bid >> 3; T0 = (x & 3) * SEQ + (jj * 2 + (x >> 2)) * 128; }
        const char* kvbase = (const char*)(proj + (size_t)(T0 / SEQ) * SEQ * PJ);
        int tok = T0 + w;
        u32x4 kr[8], vr[8]; bf16x8 qf[2][2]; u32x2 selnext;
        dsb_put_list(slb, *(const u32x2*)(sel + (size_t)tok * NSEL + 4 * lane), tok % SEQ, lane);
        dsb_gather(kvbase, slb, 0, C_AK * 2, c, n16, kr); dsb_gather(kvbase, slb, 0, C_AV * 2, c, n16, vr);
#pragma unroll
        for (int g = 0; g < 2; ++g)
#pragma unroll
            for (int s = 0; s < 2; ++s) { bf16x8 v = (bf16x8){0, 0, 0, 0, 0, 0, 0, 0};
                if (n16 < 4) v = *(const bf16x8*)(proj + (size_t)tok * PJ + C_AQ + (g * 4 + n16) * 64 + 32 * s + 8 * c);
                qf[g][s] = v; }
        for (int qi = 0; qi < 16; ++qi) {
            const int t = tok % SEQ, nsel = (t + 1 < NSEL) ? t + 1 : NSEL; const int par = qi & 1;
            const LAS unsigned* sl = slb + par * 512; LAS unsigned* sln = slb + (par ^ 1) * 512;
            const bool more = qi + 1 < 16; const int tokn = tok + 8;
            if (more) selnext = *(const u32x2*)(sel + (size_t)tokn * NSEL + 4 * lane);
            float mrun[2] = {-INFINITY, -INFINITY}, lrun[2] = {0.f, 0.f};
            f32x4 O[2][4];
#pragma unroll
            for (int g = 0; g < 2; ++g)
#pragma unroll
                for (int dt = 0; dt < 4; ++dt) O[g][dt] = (f32x4){0.f, 0.f, 0.f, 0.f};
            bf16x8 qn[2][2];
#pragma unroll 4
            for (int ch = 0; ch < 8; ++ch) {
#pragma unroll
                for (int i = 0; i < 8; ++i) *(LAS u32x4*)(buf + (4 * i + c) * VROW + n16 * 8) = kr[i];
                if (ch == 3 && more) dsb_put_list(sln, selnext, tokn % SEQ, lane);
                asm volatile("" ::: "memory");
                if (ch < 7) dsb_gather(kvbase, sl, ch + 1, C_AK * 2, c, n16, kr);
                else if (more) dsb_gather(kvbase, sln, 0, C_AK * 2, c, n16, kr);
                if (ch == 6 && more) {
#pragma unroll
                    for (int g = 0; g < 2; ++g)
#pragma unroll
                        for (int s = 0; s < 2; ++s) { bf16x8 v = (bf16x8){0, 0, 0, 0, 0, 0, 0, 0};
                            if (n16 < 4) v = *(const bf16x8*)(proj + (size_t)tokn * PJ + C_AQ + (g * 4 + n16) * 64 + 32 * s + 8 * c);
                            qn[g][s] = v; } }
                f32x4 acc[2][2];
#pragma unroll
                for (int kt = 0; kt < 2; ++kt)
#pragma unroll
                    for (int g = 0; g < 2; ++g) { const LAS bf16* ap = buf + (16 * kt + n16) * VROW + g * 64 + 8 * c;
                        acc[kt][g] = MFMA16(*(const LAS bf16x8*)ap, qf[g][0], ((f32x4){0.f, 0.f, 0.f, 0.f})); acc[kt][g] = MFMA16(*(const LAS bf16x8*)(ap + 32), qf[g][1], acc[kt][g]); }
#pragma unroll
                for (int kt = 0; kt < 2; ++kt) { const f32x4 d4 = *(const LAS f32x4*)((const LAS float*)(sl + 256) + 32 * ch + 16 * kt + 4 * c);
#pragma unroll
                    for (int r = 0; r < 4; ++r)
#pragma unroll
                        for (int g = 0; g < 2; ++g) acc[kt][g][r] = fmaf(nslope[g], d4[r], acc[kt][g][r]); }
                if (nsel < NSEL) {
#pragma unroll
                    for (int kt = 0; kt < 2; ++kt)
#pragma unroll
                        for (int r = 0; r < 4; ++r) { const bool dead = 32 * ch + 16 * kt + 4 * c + r >= nsel;
#pragma unroll
                            for (int g = 0; g < 2; ++g) acc[kt][g][r] = dead ? -INFINITY : acc[kt][g][r]; }
                }
                bf16x8 pf[2]; float alpha[2]; bool grow = false;
#pragma unroll
                for (int g = 0; g < 2; ++g) {
                    float mx = fmaxf(fmaxf(fmaxf(acc[0][g][0], acc[0][g][1]), fmaxf(acc[0][g][2], acc[0][g][3])), fmaxf(fmaxf(acc[1][g][0], acc[1][g][1]), fmaxf(acc[1][g][2], acc[1][g][3])));
                    mx = fmaxf(mx, __shfl_xor(mx, 16)); mx = fmaxf(mx, __shfl_xor(mx, 32));
                    const float mnew = fmaxf(mrun[g], mx);
                    alpha[g] = (mnew == -INFINITY) ? 1.f : __builtin_amdgcn_exp2f((mrun[g] - mnew) * L2E);
                    grow = grow || (mnew > mrun[g]);
                    mrun[g] = mnew;
                    const float mm2 = (mnew == -INFINITY) ? 0.f : -mnew * L2E; float s = 0.f;
#pragma unroll
                    for (int kt = 0; kt < 2; ++kt)
#pragma unroll
                        for (int r = 0; r < 4; ++r) { const float e = __builtin_amdgcn_exp2f(fmaf(acc[kt][g][r], L2E, mm2)); acc[kt][g][r] = e; s += e; }
                    s += __shfl_xor(s, 16); s += __shfl_xor(s, 32);
                    lrun[g] = lrun[g] * alpha[g] + s;
                    u32x4 pw; pw.x = cvtpk(acc[0][g][0], acc[0][g][1]); pw.y = cvtpk(acc[0][g][2], acc[0][g][3]); pw.z = cvtpk(acc[1][g][0], acc[1][g][1]); pw.w = cvtpk(acc[1][g][2], acc[1][g][3]);
                    pf[g] = __builtin_bit_cast(bf16x8, pw); }
#pragma unroll
                for (int i = 0; i < 8; ++i) *(LAS u32x4*)(buf + (4 * i + c) * VROW + n16 * 8) = vr[i];
                asm volatile("" ::: "memory");
                if (ch < 7) dsb_gather(kvbase, sl, ch + 1, C_AV * 2, c, n16, vr);
                else if (more) dsb_gather(kvbase, sln, 0, C_AV * 2, c, n16, vr);
                if (__any(grow)) {
#pragma unroll
                    for (int g = 0; g < 2; ++g)
#pragma unroll
                        for (int r = 0; r < 4; ++r) { const float a = __builtin_bit_cast(float, __builtin_amdgcn_readlane(__builtin_bit_cast(int, alpha[g]), r));
#pragma unroll
                            for (int dt = 0; dt < 4; ++dt) O[g][dt][r] *= a; }
                }
#pragma unroll
                for (int dt = 0; dt < 4; ++dt) { const LAS bf16* vp = buf + (4 * c + q4) * VROW + dt * 16 + 4 * p4;
                    O[0][dt] = MFMA16(pf[0], cat8(trread(vp), trread(vp + 16 * VROW)), O[0][dt]);
                    O[1][dt] = MFMA16(pf[1], cat8(trread(vp + 64), trread(vp + 64 + 16 * VROW)), O[1][dt]); }
            }
            {
#pragma unroll
                for (int g = 0; g < 2; ++g)
#pragma unroll
                    for (int r = 0; r < 4; ++r) { const float li = __builtin_amdgcn_rcpf(__builtin_bit_cast(float, __builtin_amdgcn_readlane(__builtin_bit_cast(int, lrun[g]), r)));
                        if (lane < 16) {
#pragma unroll
                            for (int dt = 0; dt < 4; dt += 2) { const int w2 = __builtin_amdgcn_cvt_pk_fp8_f32(O[g][dt][r] * li, O[g][dt + 1][r] * li, 0, false);
                                ((LAS unsigned char*)buf)[(g * 4 + r) * 64 + 16 * dt + lane] = (unsigned char)(w2 & 0xff); ((LAS unsigned char*)buf)[(g * 4 + r) * 64 + 16 * (dt + 1) + lane] = (unsigned char)((w2 >> 8) & 0xff); } } }
                const u32x2 ov = *(const LAS u32x2*)((LAS unsigned char*)buf + 8 * lane);
                *(u32x2*)((unsigned char*)mix + (size_t)tok * DM + 512 + 8 * lane) = ov;
            }
            if (more) {
#pragma unroll
                for (int g = 0; g < 2; ++g)
#pragma unroll
                    for (int s = 0; s < 2; ++s) qf[g][s] = qn[g][s];
            }
            tok = tokn;
        }
    }
}

constexpr int HSTR = 1028;
constexpr int RT = 32;
__device__ __forceinline__ void phase_router(Frame& F) {
    const float* const norm2_g = F.in(8); const float* const router_w = F.in(9); const float* const router_b = F.in(10);
    const float* x1 = F.out; const float* mod = (const float*)(F.ws + WS_MOD); unsigned char* h2 = (unsigned char*)(F.ws + WS_H2);
    int* topi = (int*)(F.ws + WS_TOPI); float* topg = (float*)(F.ws + WS_TOPG); int* bbase = (int*)(F.ws + WS_BBASE);
    LAS float* hs = (LAS float*)F.lds; LAS float* part = hs;
    LAS int* hist = (LAS int*)(F.lds + RT * HSTR * 4);
    const int lane = F.lane(), w = F.wave;
    for (int blk = F.bid; blk < NTOK / 128; blk += F.G) {
        const int T0 = blk * 128, b = T0 / SEQ;
        if (F.tid() < 32) hist[F.tid()] = 0;
        f32x4 ca[4], cb[4];
#pragma unroll
        for (int j = 0; j < 4; ++j) { const int col = 4 * lane + 256 * j;
            ca[j] = *(const f32x4*)(norm2_g + col) * (*(const f32x4*)(mod + b * 6144 + 4 * 1024 + col) + 1.0f); cb[j] = *(const f32x4*)(mod + b * 6144 + 3 * 1024 + col); }
        __syncthreads();
        for (int pass = 0; pass < 128 / RT; ++pass) {
            { f32x4 v[4][4]; float s[4] = {0.f, 0.f, 0.f, 0.f};
#pragma unroll
              for (int tt = 0; tt < 4; ++tt) { const f32x4* xr = (const f32x4*)(x1 + (size_t)(T0 + pass * RT + 4 * w + tt) * DM) + lane;
#pragma unroll
                  for (int j = 0; j < 4; ++j) { v[tt][j] = xr[64 * j]; s[tt] += (v[tt][j][0] * v[tt][j][0] + v[tt][j][1] * v[tt][j][1]) + (v[tt][j][2] * v[tt][j][2] + v[tt][j][3] * v[tt][j][3]); } }
#pragma unroll
              for (int o = 1; o < 64; o <<= 1) {
#pragma unroll
                  for (int tt = 0; tt < 4; ++tt) s[tt] += __shfl_xor(s[tt], o); }
#pragma unroll
              for (int tt = 0; tt < 4; ++tt) { const int tl = 4 * w + tt, tok = T0 + pass * RT + tl; const float rstd = rsqrtf(s[tt] * (1.f / DM) + EPS);
                  unsigned* o4 = (unsigned*)(h2 + (size_t)tok * DM) + lane;
#pragma unroll
                  for (int j = 0; j < 4; ++j) { const f32x4 y = (v[tt][j] * rstd) * ca[j] + cb[j];
                      o4[64 * j] = pk4_fp8(y[0], y[1], y[2], y[3]);
                      *(LAS f32x4*)(hs + tl * HSTR + 4 * lane + 256 * j) = y; } } }
            __syncthreads();
            f32x16 acc;
            { const int ti = lane & 31, kk = lane >> 5, e = lane & 31;
#pragma unroll
              for (int r = 0; r < 16; ++r) acc[r] = 0.f;
              const LAS float* hp = hs + ti * HSTR + 128 * w + 64 * kk; const float* rwp = router_w + (size_t)(128 * w + 64 * kk) * NE + e;
#pragma unroll 4
              for (int s4 = 0; s4 < 16; ++s4) { const f32x4 a4 = *(const LAS f32x4*)(hp + 4 * s4);
#pragma unroll
                  for (int q = 0; q < 4; ++q) acc = __builtin_amdgcn_mfma_f32_32x32x2f32(a4[q], rwp[(4 * s4 + q) * NE], acc, 0, 0, 0); } }
            __syncthreads();
            { const int kk = lane >> 5, e = lane & 31;
#pragma unroll
              for (int r = 0; r < 16; ++r) part[(w * 32 + (r & 3) + 8 * (r >> 2) + 4 * kk) * 32 + e] = acc[r]; }
            __syncthreads();
#pragma unroll
            for (int hh = 0; hh < 2; ++hh) { const int tl = hh * 16 + (F.tid() >> 5), e = F.tid() & 31, tok = T0 + pass * RT + tl; float lg = router_b[e];
#pragma unroll
              for (int ww = 0; ww < 8; ++ww) lg += part[(ww * 32 + tl) * 32 + e];
              float myv = lg; float tv[4]; int ti4[4]; bool mine = false;
#pragma unroll
              for (int k = 0; k < 4; ++k) { float bv = myv; int bi = e;
#pragma unroll
                  for (int o = 16; o >= 1; o >>= 1) { const float ov = __shfl_xor(bv, o); const int oi = __shfl_xor(bi, o); if (ov > bv || (ov == bv && oi < bi)) { bv = ov; bi = oi; } }
                  tv[k] = bv; ti4[k] = bi; if (bi == e) { myv = -INFINITY; mine = true; } }
              if (mine) atomicAdd((int*)hist + e, 1);
              if (e == 0) { const float e0 = 1.0f, e1 = __expf(tv[1] - tv[0]), e2 = __expf(tv[2] - tv[0]), e3 = __expf(tv[3] - tv[0]); const float inv = 1.0f / (e0 + e1 + e2 + e3);
                  *(int4*)(topi + (size_t)tok * 4) = make_int4(ti4[0], ti4[1], ti4[2], ti4[3]); *(f32x4*)(topg + (size_t)tok * 4) = (f32x4){e0 * inv, e1 * inv, e2 * inv, e3 * inv}; } }
            __syncthreads();
        }
        if (F.tid() < 32) { const int base = atomicAdd((int*)(F.ctl + CW_GCNT) + F.tid(), hist[F.tid()]); bbase[blk * 32 + F.tid()] = base; }
        __syncthreads();
    }
}
__device__ __forceinline__ int moe_layout(Frame& F, LAS int* offs, LAS int* tile_e) {
    if (F.tid() == 0) { int o = 0;
        for (int e = 0; e < NE; ++e) { const int cnt = (int)__hip_atomic_load(F.ctl + CW_GCNT + e, __ATOMIC_RELAXED, __HIP_MEMORY_SCOPE_AGENT); const int nt = (cnt + 255) >> 8;
            offs[e] = o; if (tile_e) for (int t = 0; t < nt; ++t) tile_e[(o >> 8) + t] = e; o += nt << 8; }
        offs[NE] = o >> 8; }
    __syncthreads();
    return offs[NE];
}
__device__ __forceinline__ void phase_place(Frame& F) {
    const unsigned char* h2 = (const unsigned char*)(F.ws + WS_H2); unsigned char* xs = (unsigned char*)(F.ws + WS_XS);
    const int* topi = (const int*)(F.ws + WS_TOPI); const float* topg = (const float*)(F.ws + WS_TOPG); const int* bbase = (const int*)(F.ws + WS_BBASE);
    int* rowinfo = (int*)(F.ws + WS_ROWINFO); float* rowgate = (float*)(F.ws + WS_ROWGATE);
    LAS int* offs = (LAS int*)F.lds; LAS int* lcur = offs + 64; LAS int* posl = offs + 128;
    (void)moe_layout(F, offs, nullptr);
    for (int blk = F.bid; blk < NTOK / 128; blk += F.G) {
        const int T0 = blk * 128;
        if (F.tid() < 32) lcur[F.tid()] = 0;
        __syncthreads();
        { const int i = F.tid(), tok = T0 + (i >> 2); const int e = topi[(size_t)tok * 4 + (i & 3)];
          const int rank = atomicAdd((int*)lcur + e, 1); const int pos = offs[e] + bbase[blk * 32 + e] + rank;
          rowinfo[pos] = tok * 4 + (i & 3); rowgate[pos] = topg[(size_t)tok * 4 + (i & 3)]; posl[i] = pos; }
        __syncthreads();
        for (int j8 = 0; j8 < 64; j8 += 8) {
            u32x4 v[8]; int pp[8];
#pragma unroll
            for (int u = 0; u < 8; ++u) { const int i = F.wave * 64 + j8 + u; pp[u] = posl[i]; v[u] = *((const u32x4*)(h2 + (size_t)(T0 + (i >> 2)) * DM) + F.lane()); }
#pragma unroll
            for (int u = 0; u < 8; ++u) *((u32x4*)(xs + (size_t)pp[u] * DM) + F.lane()) = v[u];
        }
        __syncthreads();
    }
}
__device__ __forceinline__ void phase_final(Frame& F) {
    const float* const final_g = F.in(15);
    const float* mod = (const float*)(F.ws + WS_MOD); const unsigned char* Y = (const unsigned char*)(F.ws + WS_Y);
    const int gw = F.bid * NWAVES + F.wave, NGW = F.G * NWAVES, lane = F.lane();
    for (int m = gw; m < NTOK; m += NGW) {
        const int b = m / SEQ; f32x4* xr = (f32x4*)(F.out + (size_t)m * DM) + lane; f32x4 v[4]; unsigned yw[4][4]; float s = 0.f;
#pragma unroll
        for (int j = 0; j < 4; ++j) { v[j] = xr[64 * j];
#pragma unroll
            for (int k = 0; k < 4; ++k) yw[j][k] = __builtin_nontemporal_load((const unsigned*)(Y + ((size_t)m * 4 + k) * DM) + lane + 64 * j); }
#pragma unroll
        for (int j = 0; j < 4; ++j) { const int col = 4 * lane + 256 * j; f32x4 y = (f32x4){0.f, 0.f, 0.f, 0.f};
#pragma unroll
            for (int k = 0; k < 4; ++k) { const f32x2_t lo = __builtin_amdgcn_cvt_pk_f32_fp8(yw[j][k], false), hi2 = __builtin_amdgcn_cvt_pk_f32_fp8(yw[j][k], true); y[0] += lo[0]; y[1] += lo[1]; y[2] += hi2[0]; y[3] += hi2[1]; }
            v[j] = v[j] + *(const f32x4*)(mod + b * 6144 + 5 * 1024 + col) * y;
            s += (v[j][0] * v[j][0] + v[j][1] * v[j][1]) + (v[j][2] * v[j][2] + v[j][3] * v[j][3]); }
        const float rstd = rsqrtf(wave_sum(s) * (1.f / DM) + EPS);
#pragma unroll
        for (int j = 0; j < 4; ++j) __builtin_nontemporal_store((v[j] * rstd) * *(const f32x4*)(final_g + 4 * lane + 256 * j), xr + 64 * j);
    }
}

#ifndef MK_N_LAUNCHES
#define MK_N_LAUNCHES 1
#endif
constexpr int N_PHASES = 12;
struct Args { const float* in[16]; float* out; unsigned char* ws; int ph_lo, ph_hi; };
static_assert(sizeof(Args) == 16 * 8 + 8 + 8 + 8, "Args has no padding");

__global__ void __launch_bounds__(NTHR, 2) mk_fwd(Args args) {
    extern __shared__ __attribute__((aligned(16))) unsigned char lds_raw[];
    Frame F;
    F.lds = (LAS unsigned char*)lds_raw;
    F.MISC = (volatile LAS unsigned*)(F.lds + MISC_OFF);
    F.wave = __builtin_amdgcn_readfirstlane((int)threadIdx.x >> 6);
    F.G = gridDim.x; F.bid = blockIdx.x; F.tacc = 0ull; F.xpass = 0;
    F.ws = args.ws; F.ctl = (unsigned*)(args.ws + WS_CTL); F.out = args.out;
    for (int u = F.tid(); u < (LDS_BYTES - MISC_OFF) / 4; u += NTHR) ((LAS unsigned*)(F.lds + MISC_OFF))[u] = 0u;
    __syncthreads();
    if (F.tid() < 16) *(LAS unsigned long long*)(F.lds + PTR_OFF + 8 * F.tid()) = (unsigned long long)args.in[F.tid()];
    __syncthreads();
    const int lo = args.ph_lo, hi = args.ph_hi;
    XcdBarrier bar; bar.bar = (unsigned*)(F.ctl + CW_BAR); bar.x = 0; bar.st = nullptr; bar.w0 = (F.wave == 0);
    if (hi - lo > 1) bar = xcd_barrier_post((unsigned*)(F.ctl + CW_BAR), F.MISC + 8, F.wave == 0);
#define IN(k) (lo <= (k) && (k) < hi)
#if defined(PROBE_PHASE)
    unsigned long long tp0 = 0ull, tp1 = 0ull;
#define STAMP(k) do { if ((k) == PROBE_PHASE) tp0 = __builtin_amdgcn_s_memrealtime(); if ((k) == PROBE_PHASE + 1) tp1 = __builtin_amdgcn_s_memrealtime(); } while (0)
#else
#define STAMP(k) do { } while (0)
#endif
#define SEAM(k) do { if (IN(k) && IN((k) + 1)) xcd_barrier(bar); } while (0)

    STAMP(0); if (IN(0)) { phase_p0a(F); } SEAM(0);
    STAMP(1); if (IN(1)) { phase_p0b(F); } SEAM(1);
    STAMP(2); if (IN(2)) {
        pg8::Gemm g{(const bf16*)(F.ws + WS_H0), (const bf16*)(F.ws + WS_WIN), NTOK, 3072, DM}; pg8::StaticOrder S; S.init(NTOK, 3072, F.G, F.bid);
        EpiProj E{(bf16*)(F.ws + WS_PROJ), PJ};
        pg8::gemm_phase<EpiProj, pg8::StaticOrder, true, true>(F.lds, g, S, E, F.wave);
    } SEAM(2);
    STAMP(3); if (IN(3)) {
#if defined(PROBE_SUB)
        const unsigned long long tra0 = __builtin_amdgcn_s_memrealtime();
#endif
        for (int it = F.bid; it < 1024; it += F.G) ret_a_item(F, it);
#if defined(PROBE_SUB)
        if (PROBE_SUB == 4) F.tacc += __builtin_amdgcn_s_memrealtime() - tra0;
#endif
        { constexpr int NQT = SEQ / QT, NITEM = NBATCH * NQT * 8;
          int cit = F.bid * NWAVES + F.wave;
          LAS float* scr = (LAS float*)(F.lds + F.wave * (RPW * CAP * 4));
          for (;;) { int t = 0; if (F.lane() == 0) t = (int)__hip_atomic_fetch_add(F.ctl + CW_Q3, 1u, __ATOMIC_RELAXED, __HIP_MEMORY_SCOPE_AGENT);
              t = __builtin_amdgcn_readfirstlane(t); const bool have = t < NITEM;
              if (have) dsa_a_wave(F, (t >> 3) & 3, NQT - 1 - (t >> 5), t & 7);
              cit = f8_burst(F, scr, cit, have ? 6 : (1 << 20));
              if (!have) break; } }
    } SEAM(3);
    STAMP(4); if (IN(4)) {
#if defined(PROBE_SUB)
        const unsigned long long tsc0 = __builtin_amdgcn_s_memrealtime();
#endif
        ret_scan(F);
#if defined(PROBE_SUB)
        if (PROBE_SUB == 5) F.tacc += __builtin_amdgcn_s_memrealtime() - tsc0;
#endif
        __syncthreads();
        phase_dsa_b(F);
    } SEAM(4);
    STAMP(5); if (IN(5)) { for (int it = F.bid; it < 1024; it += F.G) ret_c_item(F, it); } SEAM(5);
    STAMP(6); if (IN(6)) {
        pg8::Gemm g{(const bf16*)(F.ws + WS_MIX), (const bf16*)(F.ws + WS_WO), NTOK, DM, DM}; pg8::StaticOrder S; S.init(NTOK, DM, F.G, F.bid);
        EpiX1T<true> E{F.in(0), (const float*)(F.ws + WS_MOD), F.out};
        pg8::gemm_phase<EpiX1T<true>, pg8::StaticOrder, true, true, true>(F.lds, g, S, E, F.wave);
    } SEAM(6);
    STAMP(7); if (IN(7)) { phase_router(F); } SEAM(7);
    STAMP(8); if (IN(8)) { phase_place(F); } SEAM(8);
    STAMP(9); if (IN(9)) {
        LAS int* tile_e = (LAS int*)(F.lds + TILEE_OFF); const int nt = moe_layout(F, (LAS int*)(F.lds + TILEE_OFF + 4096), tile_e);
        pg8::Gemm g{(const bf16*)(F.ws + WS_XS), (const bf16*)(F.ws + WS_WGU), MOE_ROWS, 2048, DM};
        GroupedOrder S{tile_e, nt, 8, F.G, F.bid, (size_t)2048 * 1024};
        EpiGlu8 E{(unsigned char*)(F.ws + WS_HB), F.in(12)};
        pg8::gemm_phase<EpiGlu8, GroupedOrder, true, true, true>(F.lds, g, S, E, F.wave);
    } SEAM(9);
    STAMP(10); if (IN(10)) {
        LAS int* tile_e = (LAS int*)(F.lds + TILEE_OFF); const int nt = moe_layout(F, (LAS int*)(F.lds + TILEE_OFF + 4096), tile_e);
        pg8::Gemm g{(const bf16*)(F.ws + WS_HB), (const bf16*)(F.ws + WS_WDN), MOE_ROWS, DM, DM};
        GroupedOrder S{tile_e, nt, 4, F.G, F.bid, (size_t)1024 * 1024};
        EpiDownT<true> E{(bf16*)(F.ws + WS_Y), F.in(14), (const int*)(F.ws + WS_ROWINFO), (const float*)(F.ws + WS_ROWGATE)};
        pg8::gemm_phase<EpiDownT<true>, GroupedOrder, true, true, true>(F.lds, g, S, E, F.wave);
    } SEAM(10);
    STAMP(11); if (IN(11)) { phase_final(F); }
    STAMP(12);
#if defined(PROBE_SUB)
    if (F.bid == 0 && F.tid() == 0) { const unsigned long long te = __builtin_amdgcn_s_memrealtime(); while (__builtin_amdgcn_s_memrealtime() - te < F.tacc) __builtin_amdgcn_s_sleep(8); }
#elif defined(PROBE_PHASE)
    if (F.bid == 0 && F.tid() == 0) { const unsigned long long te = __builtin_amdgcn_s_memrealtime(), dur = tp1 - tp0; while (__builtin_amdgcn_s_memrealtime() - te < dur) __builtin_amdgcn_s_sleep(8); }
#endif
#undef IN
#undef SEAM
}

extern "C" void kernel_launch(void* const* d_in, const int* in_sizes, int n_in, void* d_out, int out_size, void* d_ws, size_t ws_size, hipStream_t stream) {
    static int grid = 0;
    if (grid == 0) {
        if (n_in != 16 || out_size != NTOK * DM || ws_size < WS_END) { fprintf(stderr, "kernel_launch: unexpected problem (n_in %d out %d ws %zu); nothing launched\n", n_in, out_size, ws_size); grid = -1; return; }
        int dev = 0, cus = 0;
        if (hipGetDevice(&dev) != hipSuccess || hipDeviceGetAttribute(&cus, hipDeviceAttributeMultiprocessorCount, dev) != hipSuccess) { grid = -1; return; }
        if (hipFuncSetAttribute((const void*)mk_fwd, hipFuncAttributeMaxDynamicSharedMemorySize, LDS_BYTES) != hipSuccess) { fprintf(stderr, "kernel_launch: hipFuncSetAttribute failed\n"); grid = -1; return; }
        int per_cu = 0;
        if (hipOccupancyMaxActiveBlocksPerMultiprocessor(&per_cu, (const void*)mk_fwd, NTHR, LDS_BYTES) != hipSuccess || per_cu < 1) fprintf(stderr, "kernel_launch: occupancy query reports %d workgroups per CU\n", per_cu);
        (void)hipGetLastError();
        grid = cus;
    }
    if (grid < 0) return;
    (void)hipMemsetAsync((char*)d_ws + WS_CTL, 0, CTL_ZERO_BYTES, stream);
    Args a{};
    for (int i = 0; i < 16; ++i) a.in[i] = (const float*)d_in[i];
    a.out = (float*)d_out; a.ws = (unsigned char*)d_ws;
#if MK_N_LAUNCHES == 1
    a.ph_lo = 0; a.ph_hi = N_PHASES;
    hipLaunchKernelGGL(mk_fwd, dim3(grid), dim3(NTHR), LDS_BYTES, stream, a);
#else
    for (int p = 0; p < N_PHASES; ++p) { a.ph_lo = p; a.ph_hi = p + 1; hipLaunchKernelGGL(mk_fwd, dim3(grid), dim3(NTHR), LDS_BYTES, stream, a); }
#endif
}
```
